# Optimizing an MI355X kernel written in HIP

```python
import math
import jax, jax.numpy as jnp
from jax import lax
import numpy as np

D_MODEL = 2048
BATCH = 1
SEQ = 16384
DEPTH = 1
DEC_BATCH = 16
DEC_SEQ = 16
PAST_LEN = 1024

CHUNK = 64
Q_BLOCK = 128
N_HEADS_A = 16
HEAD_DIM_A = 128
IDX_HEADS = 16
IDX_DIM = 64
TOPK_MAX = 256
REL_BUCKETS = 32
REL_MAX_DIST = 128
N_HEADS_B = 16
QK_NOPE_DIM = 128
ROPE_DIM = 64
V_DIM_B = 128
Q_LORA = 512
KV_LORA = 256
ROPE_THETA = 10000.0
MLA_SCALE = (QK_NOPE_DIM + ROPE_DIM) ** -0.5
A_SCALE = HEAD_DIM_A ** -0.5
D_FF = 4 * D_MODEL
EPS = 1e-6
NEG_INF = -1e30
COL_SIZES = (N_HEADS_A * HEAD_DIM_A, N_HEADS_A * HEAD_DIM_A, N_HEADS_A * HEAD_DIM_A,
             IDX_HEADS * IDX_DIM, IDX_DIM, IDX_HEADS,
             Q_LORA, KV_LORA, ROPE_DIM,
             D_MODEL, D_MODEL)
IN_COLS = sum(COL_SIZES)

kernel_name = "hybrid_dsa_mla_streaming_step"


def rmsnorm(x, g):
    xf = x.astype(jnp.float32)
    y = xf * lax.rsqrt(jnp.mean(xf * xf, axis=-1, keepdims=True) + EPS)
    return (y * g.astype(jnp.float32)).astype(x.dtype)


def split_cols(z):
    outs, off = [], 0
    for n in COL_SIZES:
        outs.append(z[..., off:off + n])
        off += n
    return outs


def rope(x, pos):
    half = ROPE_DIM // 2
    inv_freq = jnp.power(ROPE_THETA, -jnp.arange(half, dtype=jnp.float32) / half)
    ang = pos.astype(jnp.float32)[:, None] * inv_freq[None, :]
    shp = (ang.shape[0],) + (1,) * (x.ndim - 3) + (half,)
    cos = jnp.cos(ang).reshape(shp)
    sin = jnp.sin(ang).reshape(shp)
    x1 = x[..., :half].astype(jnp.float32)
    x2 = x[..., half:].astype(jnp.float32)
    return jnp.concatenate([x1 * cos - x2 * sin, x1 * sin + x2 * cos], axis=-1).astype(x.dtype)


def t5_bucket(rel):
    nb = REL_BUCKETS // 2
    ret = (rel > 0).astype(jnp.int32) * nb
    n = jnp.abs(rel)
    max_exact = nb // 2
    large = max_exact + (jnp.log(jnp.maximum(n, 1).astype(jnp.float32) / max_exact)
                         / math.log(REL_MAX_DIST / max_exact) * (nb - max_exact)).astype(jnp.int32)
    large = jnp.minimum(large, nb - 1)
    return ret + jnp.where(n < max_exact, n, large)


def dsa_attend(q, ix_q, ix_w, qpos, k_all, v_all, ixk_all, kpos, rel_table, topk):
    dots = jnp.einsum('bthd,bsd->bths', ix_q, ixk_all)
    score = jnp.einsum('bths,bth->bts', jax.nn.relu(dots), ix_w).astype(jnp.float32)
    admissible = (kpos[None, :] // CHUNK) <= (qpos[:, None] // CHUNK)
    score = jnp.where(admissible[None], score, NEG_INF)
    top_val, top_idx = lax.top_k(score, topk)
    valid = top_val > 0.5 * NEG_INF
    take = jax.vmap(lambda rows, idx: rows[idx])
    k_sel = take(k_all, top_idx)
    v_sel = take(v_all, top_idx)
    logits = jnp.einsum('bthd,btkhd->bhtk', q, k_sel).astype(jnp.float32) * A_SCALE
    rel = kpos[top_idx] - qpos[None, :, None]
    bias = jnp.moveaxis(rel_table[t5_bucket(rel)], -1, 1).astype(jnp.float32)
    logits = jnp.where(valid[:, None], logits + bias, NEG_INF)
    p = jax.nn.softmax(logits, axis=-1).astype(v_sel.dtype)
    out = jnp.einsum('bhtk,btkhd->bthd', p, v_sel)
    return out.reshape(out.shape[0], out.shape[1], -1)


def mla_attend(q_nope, q_rope, qpos, k_nope, k_rope, v, kpos):
    logits = (jnp.einsum('bthd,bshd->bhts', q_nope, k_nope)
              + jnp.einsum('bthr,bsr->bhts', q_rope, k_rope)).astype(jnp.float32) * MLA_SCALE
    visible = (kpos[None, :] // CHUNK) <= (qpos[:, None] // CHUNK)
    logits = jnp.where(visible[None, None], logits, NEG_INF)
    p = jax.nn.softmax(logits, axis=-1).astype(v.dtype)
    out = jnp.einsum('bhts,bshd->bthd', p, v)
    return out.reshape(out.shape[0], out.shape[1], -1)


def to_blocks(a):
    b, l = a.shape[0], a.shape[1]
    return a.reshape((b, l // Q_BLOCK, Q_BLOCK) + a.shape[2:]).swapaxes(0, 1)


def from_blocks(a):
    nb, b, q = a.shape[0], a.shape[1], a.shape[2]
    return a.swapaxes(0, 1).reshape((b, nb * q) + a.shape[3:])


def trunk_layer(x, past, rel_table, norm_mix_g, w_in, q_lora_g, w_uq, kv_lora_g, w_uk, w_uv,
                w_out, norm_ffn_g, w_ff_up, w_ff_down, topk, blocked):
    b, l, _ = x.shape
    p_len = 0 if past is None else past[0].shape[1]
    qpos = p_len + jnp.arange(l, dtype=jnp.int32)
    kpos = jnp.arange(p_len + l, dtype=jnp.int32)

    h = rmsnorm(x, norm_mix_g)
    z = h @ w_in
    a_q, a_k, a_v, ix_q, ix_k, ix_w, cq, ckv, kr, gate_a, gate_b = split_cols(z)
    a_q = a_q.reshape(b, l, N_HEADS_A, HEAD_DIM_A)
    a_k = a_k.reshape(b, l, N_HEADS_A, HEAD_DIM_A)
    a_v = a_v.reshape(b, l, N_HEADS_A, HEAD_DIM_A)
    ix_q = ix_q.reshape(b, l, IDX_HEADS, IDX_DIM)
    ix_w = ix_w * (IDX_HEADS ** -0.5)

    c_q = rmsnorm(cq, q_lora_g)
    qb = jnp.einsum('blc,chd->blhd', c_q, w_uq)
    qb_nope = qb[..., :QK_NOPE_DIM]
    qb_rope = rope(qb[..., QK_NOPE_DIM:], qpos)
    c_kv = rmsnorm(ckv, kv_lora_g)
    k_rope_new = rope(kr, qpos)

    new_state = (a_k, a_v, ix_k, c_kv, k_rope_new)
    if past is None:
        keys = new_state
    else:
        keys = tuple(jnp.concatenate([pr, nw.astype(pr.dtype)], axis=1) for pr, nw in zip(past, new_state))
    k_all, v_all, ixk_all, ckv_all, kr_all = keys
    kb_nope = jnp.einsum('bsc,chd->bshd', ckv_all, w_uk)
    vb = jnp.einsum('bsc,chd->bshd', ckv_all, w_uv)

    if blocked:
        def block_fn(args):
            aq, iq, iw, qp, bqn, bqr = args
            return (dsa_attend(aq, iq, iw, qp, k_all, v_all, ixk_all, kpos, rel_table, topk),
                    mla_attend(bqn, bqr, qp, kb_nope, kr_all, vb, kpos))
        xs = (to_blocks(a_q), to_blocks(ix_q), to_blocks(ix_w), qpos.reshape(-1, Q_BLOCK),
              to_blocks(qb_nope), to_blocks(qb_rope))
        oa_blk, ob_blk = lax.map(block_fn, xs)
        o_a = from_blocks(oa_blk)
        o_b = from_blocks(ob_blk)
    else:
        o_a = dsa_attend(a_q, ix_q, ix_w, qpos, k_all, v_all, ixk_all, kpos, rel_table, topk)
        o_b = mla_attend(qb_nope, qb_rope, qpos, kb_nope, kr_all, vb, kpos)

    mix = jax.nn.sigmoid(gate_a) * o_a + jax.nn.sigmoid(gate_b) * o_b
    x = x + mix @ w_out
    h2 = rmsnorm(x, norm_ffn_g)
    x = x + jnp.square(jax.nn.relu(h2 @ w_ff_up)) @ w_ff_down
    return x, new_state


def setup_inputs(seed: int = 0) -> dict:
    key = jax.random.key(seed)
    ks = jax.random.split(key, 24)
    f32 = jnp.float32
    nrm = lambda k, shp, s=1.0: jax.random.normal(k, shp, f32) * s
    return {
        "x_prompt": nrm(ks[0], (BATCH, SEQ, D_MODEL)),
        "x_sample": nrm(ks[1], (DEC_BATCH, DEC_SEQ, D_MODEL)),
        "cache_a_k": nrm(ks[2], (DEPTH, DEC_BATCH, PAST_LEN, N_HEADS_A, HEAD_DIM_A)),
        "cache_a_v": nrm(ks[3], (DEPTH, DEC_BATCH, PAST_LEN, N_HEADS_A, HEAD_DIM_A)),
        "cache_a_idx_k": nrm(ks[4], (DEPTH, DEC_BATCH, PAST_LEN, IDX_DIM)),
        "cache_b_ckv": nrm(ks[5], (DEPTH, DEC_BATCH, PAST_LEN, KV_LORA)),
        "cache_b_krope": nrm(ks[6], (DEPTH, DEC_BATCH, PAST_LEN, ROPE_DIM)),
        "rel_bias_table": nrm(ks[7], (REL_BUCKETS, N_HEADS_A), 0.5),
        "norm_mix_g": 1.0 + nrm(ks[8], (DEPTH, D_MODEL), 0.05),
        "w_in": nrm(ks[9], (DEPTH, D_MODEL, IN_COLS), D_MODEL ** -0.5),
        "q_lora_g": 1.0 + nrm(ks[10], (DEPTH, Q_LORA), 0.05),
        "w_uq": nrm(ks[11], (DEPTH, Q_LORA, N_HEADS_B, QK_NOPE_DIM + ROPE_DIM), Q_LORA ** -0.5),
        "kv_lora_g": 1.0 + nrm(ks[12], (DEPTH, KV_LORA), 0.05),
        "w_uk": nrm(ks[13], (DEPTH, KV_LORA, N_HEADS_B, QK_NOPE_DIM), KV_LORA ** -0.5),
        "w_uv": nrm(ks[14], (DEPTH, KV_LORA, N_HEADS_B, V_DIM_B), KV_LORA ** -0.5),
        "w_out": nrm(ks[15], (DEPTH, D_MODEL, D_MODEL), D_MODEL ** -0.5),
        "norm_ffn_g": 1.0 + nrm(ks[16], (DEPTH, D_MODEL), 0.05),
        "w_ff_up": nrm(ks[17], (DEPTH, D_MODEL, D_FF), D_MODEL ** -0.5),
        "w_ff_down": nrm(ks[18], (DEPTH, D_FF, D_MODEL), D_FF ** -0.5),
        "final_norm_g": 1.0 + nrm(ks[19], (D_MODEL,), 0.05),
    }


def reference(x_prompt, x_sample, cache_a_k, cache_a_v, cache_a_idx_k, cache_b_ckv, cache_b_krope,
              rel_bias_table, norm_mix_g, w_in, q_lora_g, w_uq, kv_lora_g, w_uk, w_uv, w_out,
              norm_ffn_g, w_ff_up, w_ff_down, final_norm_g):
    topk_p = min(TOPK_MAX, x_prompt.shape[1] // 4)
    topk_s = min(TOPK_MAX, (cache_a_k.shape[2] + x_sample.shape[1]) // 4)
    hp, hs = x_prompt, x_sample
    st_p, st_s = [], []
    for l in range(DEPTH):
        params = (norm_mix_g[l], w_in[l], q_lora_g[l], w_uq[l], kv_lora_g[l], w_uk[l], w_uv[l],
                  w_out[l], norm_ffn_g[l], w_ff_up[l], w_ff_down[l])
        hp, sp = trunk_layer(hp, None, rel_bias_table, *params, topk=topk_p, blocked=True)
        past = (cache_a_k[l], cache_a_v[l], cache_a_idx_k[l], cache_b_ckv[l], cache_b_krope[l])
        hs, ss = trunk_layer(hs, past, rel_bias_table, *params, topk=topk_s, blocked=False)
        st_p.append(sp)
        st_s.append(ss)
    y_prompt = rmsnorm(hp, final_norm_g)
    y_sample = rmsnorm(hs, final_norm_g)
    a_k_p = jnp.stack([s[0] for s in st_p])
    a_v_p = jnp.stack([s[1] for s in st_p])
    a_idx_p = jnp.stack([s[2] for s in st_p])
    b_ckv_p = jnp.stack([s[3] for s in st_p])
    b_kr_p = jnp.stack([s[4] for s in st_p])
    a_k_s = jnp.stack([s[0] for s in st_s])
    a_v_s = jnp.stack([s[1] for s in st_s])
    a_idx_s = jnp.stack([s[2] for s in st_s])
    b_ckv_s = jnp.stack([s[3] for s in st_s])
    b_kr_s = jnp.stack([s[4] for s in st_s])
    return (y_prompt, y_sample, a_k_p, a_v_p, a_idx_p, b_ckv_p, b_kr_p, a_k_s, a_v_s, a_idx_s, b_ckv_s, b_kr_s)
```

```cpp
#include <hip/hip_runtime.h>
#include <hip/hip_cooperative_groups.h>
#include <cstdio>
#include <cstdint>
namespace cg = cooperative_groups;

typedef unsigned short u16;
typedef __attribute__((ext_vector_type(8))) short bf16x8;
typedef __attribute__((ext_vector_type(4))) short bf16x4;
typedef __attribute__((ext_vector_type(4))) float f32x4;
typedef __attribute__((ext_vector_type(2))) float f32x2;
typedef __attribute__((ext_vector_type(2))) __bf16 bf16x2_t;
typedef __attribute__((ext_vector_type(4))) unsigned u32x4;
typedef __attribute__((ext_vector_type(2))) unsigned u32x2;

#define DI __device__ __forceinline__

constexpr int MP = 16384;
constexpr int MS = 256;
constexpr int MT = MP + MS;
constexpr int DM = 2048;
constexpr int INC = 12176;
constexpr int INP = 12288;
constexpr int SK = 1040;
constexpr int KROWS = MP + 16 * SK;
constexpr int VSS = 1088;
constexpr int DFF = 8192;
constexpr int ZRW = 832;
#ifndef PH
#define PH 0x7ff
#endif
constexpr int NTHREADS = 256;
constexpr int LDS_BYTES = 75776;

constexpr size_t O_Y = 0;
constexpr size_t O_AKP = 34078720;
constexpr size_t O_AVP = 67633152;
constexpr size_t O_IDXP = 101187584;
constexpr size_t O_CKVP = 102236160;
constexpr size_t O_KRP = 106430464;
constexpr size_t O_AKS = 107479040;
constexpr size_t O_AVS = 108003328;
constexpr size_t O_IDXS = 108527616;
constexpr size_t O_CKVS = 108544000;
constexpr size_t O_KRS = 108609536;

struct Params {
  const float *x_p, *x_s, *c_ak, *c_av, *c_idx, *c_ckv, *c_kr, *rel, *g_mix, *w_in, *g_q, *w_uq, *g_kv, *w_uk, *w_uv, *w_out, *g_ffn, *w_up, *w_down, *g_fin;
  float* out;
  u16 *WT_UQ, *WT_UK, *WT_UV, *WT_OUT, *WT_UP, *WT_DOWN, *CQ, *CKV, *KR, *GA, *GB;
  float *CS, *SN;
  u16 *WT_IN, *H, *AQ, *KA, *VA, *IXQ, *IXK, *TOPK;
  float* IXW;
  int* CNT;
  u16 *QB, *KB, *VBT_P, *VBT_S;
  u16 *H2, *U;
};

DI int otid() { int t = threadIdx.x; asm volatile("" : "+v"(t)); return t; }
DI unsigned cvtpk(float lo, float hi) {
  f32x2 v = {lo, hi};
  bf16x2_t b = __builtin_convertvector(v, bf16x2_t);
  return __builtin_bit_cast(unsigned, b);
}
DI u16 f2bf(float x) { return (u16)(cvtpk(x, 0.f) & 0xffffu); }
DI float bf2f(u16 b) { return __uint_as_float(((unsigned)b) << 16); }
DI float bflo(unsigned w) { return __uint_as_float(w << 16); }
DI float bfhi(unsigned w) { return __uint_as_float(w & 0xffff0000u); }
DI float dot2bf(unsigned a, unsigned b, float c) {
  return __builtin_amdgcn_fdot2_f32_bf16(__builtin_bit_cast(bf16x2_t, a), __builtin_bit_cast(bf16x2_t, b), c, false);
}
DI float wave_sum(float v) {
#pragma unroll
  for (int o = 32; o > 0; o >>= 1) v += __shfl_xor(v, o);
  return v;
}
DI int qpos_of(int t) { return t < MP ? t : 1024 + ((t - MP) & 15); }
DI int krow_of(int t) { return t < MP ? t : MP + ((t - MP) >> 4) * SK + 1024 + ((t - MP) & 15); }
DI float inv_freq(int i) { return exp2f(-(float)i * 0.41524101186092029f); }

DI void transpose_tile(const float* __restrict__ W, int K, int N, u16* __restrict__ Wt, int tile, float* s  ) {
  const int nkt = K >> 6;
  const int kt = tile % nkt, nt = tile / nkt;
  const int k0 = kt << 6, n0 = nt << 6;
  const int tid = otid();
  const int c = tid & 63, r0 = tid >> 6;
  __syncthreads();
#pragma unroll
  for (int i = 0; i < 16; ++i) {
    int r = i * 4 + r0;
    float v = (n0 + c < N) ? W[(size_t)(k0 + r) * N + n0 + c] : 0.f;
    s[r * 65 + c] = v;
  }
  __syncthreads();
  const int kp = (tid & 31) * 2, rr0 = tid >> 5;
#pragma unroll
  for (int i = 0; i < 8; ++i) {
    int rr = i * 8 + rr0;
    unsigned pk = cvtpk(s[kp * 65 + rr], s[(kp + 1) * 65 + rr]);
    *(unsigned*)(Wt + (size_t)(n0 + rr) * K + k0 + kp) = pk;
  }
}

DI void rms_row_2048(const float* __restrict__ x, const float* __restrict__ g, u16* __restrict__ out, int lane) {
  f32x4 v[8];
  float ss = 0.f;
#pragma unroll
  for (int i = 0; i < 8; ++i) {
    v[i] = *(const f32x4*)(x + i * 256 + lane * 4);
    ss += v[i][0] * v[i][0] + v[i][1] * v[i][1] + v[i][2] * v[i][2] + v[i][3] * v[i][3];
  }
  ss = wave_sum(ss);
  float r = rsqrtf(ss * (1.f / 2048.f) + 1e-6f);
#pragma unroll
  for (int i = 0; i < 8; ++i) {
    f32x4 gg = *(const f32x4*)(g + i * 256 + lane * 4);
    u32x2 o;
    o[0] = cvtpk(v[i][0] * r * gg[0], v[i][1] * r * gg[1]);
    o[1] = cvtpk(v[i][2] * r * gg[2], v[i][3] * r * gg[3]);
    *(u32x2*)(out + i * 256 + lane * 4) = o;
  }
}

enum { EPI_IN = 0, EPI_QB, EPI_BF16, EPI_VT, EPI_RES, EPI_RELU2, EPI_ACC };
constexpr int LSTR = 72;

template <int EPI>
DI void gemm_epilogue(const Params& p, f32x4 (&acc)[4][4], int m0, int n0, int wr, int wc, int fr, int fq, u16* Cb, int ldc) {
  const int cw = n0 + wc * 64;
#pragma unroll
  for (int m = 0; m < 4; ++m) {
    const int rb = m0 + wr * 64 + m * 16 + fq * 4;
    if (EPI == EPI_QB) {
      const int within = cw % 192;
      if (within == 128) {
#pragma unroll
        for (int n = 0; n < 2; ++n) {
          const int i = n * 16 + fr;
#pragma unroll
          for (int j = 0; j < 4; ++j) {
            const int row = rb + j;
            const float cs = p.CS[(size_t)row * 32 + i], sn = p.SN[(size_t)row * 32 + i];
            float x1 = acc[m][n][j], x2 = acc[m][n + 2][j];
            p.QB[(size_t)row * 3072 + cw + i] = f2bf(x1 * cs - x2 * sn);
            p.QB[(size_t)row * 3072 + cw + i + 32] = f2bf(x1 * sn + x2 * cs);
          }
        }
        continue;
      }
    }
#pragma unroll
    for (int n = 0; n < 4; ++n) {
      const int colt = cw + n * 16;
      const int col = colt + fr;
      if (EPI == EPI_VT) {
        u32x2 pk;
        pk[0] = cvtpk(acc[m][n][0], acc[m][n][1]);
        pk[1] = cvtpk(acc[m][n][2], acc[m][n][3]);
        u16* dst;
        if (rb < MP) dst = p.VBT_P + (size_t)col * MP + rb;
        else { int r2 = rb - MP; int b = r2 / SK; int s = r2 - b * SK; dst = p.VBT_S + ((size_t)b * 2048 + col) * VSS + s; }
        *(u32x2*)dst = pk;
        continue;
      }
#pragma unroll
      for (int j = 0; j < 4; ++j) {
        const int row = rb + j;
        const float v = acc[m][n][j];
        if (EPI == EPI_IN) {
          if (colt < 2048) p.AQ[(size_t)row * 2048 + col] = f2bf(v);
          else if (colt < 4096) {
            int c = col - 2048;
            if (row < MP) { p.out[O_AKP + (size_t)row * 2048 + c] = v; p.KA[(size_t)row * 2048 + c] = f2bf(v); }
            else p.out[O_AKS + (size_t)(row - MP) * 2048 + c] = v;
          } else if (colt < 6144) {
            int c = col - 4096;
            if (row < MP) { p.out[O_AVP + (size_t)row * 2048 + c] = v; p.VA[(size_t)row * 2048 + c] = f2bf(v); }
            else p.out[O_AVS + (size_t)(row - MP) * 2048 + c] = v;
          } else if (colt < 7168) p.IXQ[(size_t)row * 1024 + (col - 6144)] = f2bf(v);
          else if (colt < 7232) {
            int c = col - 7168;
            if (row < MP) p.out[O_IDXP + (size_t)row * 64 + c] = v; else p.out[O_IDXS + (size_t)(row - MP) * 64 + c] = v;
            p.IXK[(size_t)krow_of(row) * 64 + c] = f2bf(v);
          } else if (colt < 7248) p.IXW[(size_t)row * 16 + (col - 7232)] = v * 0.25f;
          else if (colt < 8080) p.out[O_Y + (size_t)row * ZRW + (col - 7248)] = v;
          else if (colt < 10128) p.GA[(size_t)row * 2048 + (col - 8080)] = f2bf(1.f / (1.f + __expf(-v)));
          else if (colt < INC) p.GB[(size_t)row * 2048 + (col - 10128)] = f2bf(1.f / (1.f + __expf(-v)));
        } else if (EPI == EPI_QB || EPI == EPI_BF16) {
          Cb[(size_t)row * ldc + col] = f2bf(v);
        } else if (EPI == EPI_RES) {
          float xv = row < MP ? p.x_p[(size_t)row * 2048 + col] : p.x_s[(size_t)(row - MP) * 2048 + col];
          p.out[O_Y + (size_t)row * 2048 + col] = xv + v;
        } else if (EPI == EPI_RELU2) {
          float r = fmaxf(v, 0.f);
          p.U[(size_t)row * DFF + col] = f2bf(r * r);
        } else if (EPI == EPI_ACC) {
          p.out[O_Y + (size_t)row * 2048 + col] += v;
        }
      }
    }
  }
}

template <int EPI>
DI void gemm_tile(const Params& p, const u16* __restrict__ A, int lda, const u16* __restrict__ Bt, int ldb, int K, int m0, int n0,
                  char* smem, u16* Cb, int ldc) {
  u16* sA = (u16*)smem;
  u16* sB = sA + 2 * 128 * LSTR;
  const int tid = otid(), lane = tid & 63, w = tid >> 6;
  const int wr = w >> 1, wc = w & 1, fr = lane & 15, fq = lane >> 4;
  f32x4 acc[4][4];
#pragma unroll
  for (int m = 0; m < 4; ++m)
#pragma unroll
    for (int n = 0; n < 4; ++n) acc[m][n] = (f32x4){0.f, 0.f, 0.f, 0.f};
  u32x4 ra[4], rb[4];
  const int lr = tid >> 3, lk = (tid & 7) * 8;
  const u16* Ag = A + (size_t)(m0 + lr) * lda + lk;
  const u16* Bg = Bt + (size_t)(n0 + lr) * ldb + lk;
  const int nk = K >> 6;
  __syncthreads();
#pragma unroll
  for (int i = 0; i < 4; ++i) {
    ra[i] = *(const u32x4*)(Ag + (size_t)(i * 32) * lda);
    rb[i] = *(const u32x4*)(Bg + (size_t)(i * 32) * ldb);
  }
#pragma unroll
  for (int i = 0; i < 4; ++i) {
    *(u32x4*)(sA + (lr + i * 32) * LSTR + lk) = ra[i];
    *(u32x4*)(sB + (lr + i * 32) * LSTR + lk) = rb[i];
  }
  __syncthreads();
  for (int kt = 0; kt < nk; ++kt) {
    const int buf = kt & 1;
    const bool more = kt + 1 < nk;
    if (more) {
      const int k0 = (kt + 1) << 6;
#pragma unroll
      for (int i = 0; i < 4; ++i) {
        ra[i] = *(const u32x4*)(Ag + (size_t)(i * 32) * lda + k0);
        rb[i] = *(const u32x4*)(Bg + (size_t)(i * 32) * ldb + k0);
      }
    }
    const u16* cA = sA + buf * 128 * LSTR + (wr * 64 + fr) * LSTR + fq * 8;
    const u16* cB = sB + buf * 128 * LSTR + (wc * 64 + fr) * LSTR + fq * 8;
#pragma unroll
    for (int ks = 0; ks < 2; ++ks) {
      bf16x8 af[4], bfr[4];
#pragma unroll
      for (int m = 0; m < 4; ++m) af[m] = *(const bf16x8*)(cA + m * 16 * LSTR + ks * 32);
#pragma unroll
      for (int n = 0; n < 4; ++n) bfr[n] = *(const bf16x8*)(cB + n * 16 * LSTR + ks * 32);
#pragma unroll
      for (int m = 0; m < 4; ++m)
#pragma unroll
        for (int n = 0; n < 4; ++n) acc[m][n] = __builtin_amdgcn_mfma_f32_16x16x32_bf16(af[m], bfr[n], acc[m][n], 0, 0, 0);
    }
    if (more) {
      u16* dA = sA + (buf ^ 1) * 128 * LSTR;
      u16* dB = sB + (buf ^ 1) * 128 * LSTR;
#pragma unroll
      for (int i = 0; i < 4; ++i) {
        *(u32x4*)(dA + (lr + i * 32) * LSTR + lk) = ra[i];
        *(u32x4*)(dB + (lr + i * 32) * LSTR + lk) = rb[i];
      }
    }
    __syncthreads();
  }
  gemm_epilogue<EPI>(p, acc, m0, n0, wr, wc, fr, fq, Cb, ldc);
}

template <int EPI>
DI void gemm_phase(const Params& p, const u16* A, int lda, const u16* Bt, int ldb, int K, int mtiles, int ntiles, char* smem, u16* Cb, int ldc,
                   int start, int stride) {
  const int total = mtiles * ntiles;
  const int GM = 8;
  for (int id = start; id < total; id += stride) {
    const int per = GM * ntiles;
    const int g = id / per, rem = id - g * per;
    const int fm = g * GM;
    const int gsz = min(GM, mtiles - fm);
    const int mt = fm + rem % gsz, nt = rem / gsz;
    gemm_tile<EPI>(p, A, lda, Bt, ldb, K, mt * 128, nt * 128, smem, Cb, ldc);
  }
}

DI void post_row(const Params& p, int t, int lane) {
  const float* zr = p.out + O_Y + (size_t)t * ZRW;
  {
    f32x4 a = *(const f32x4*)(zr + lane * 4), b = *(const f32x4*)(zr + 256 + lane * 4);
    float ss = a[0] * a[0] + a[1] * a[1] + a[2] * a[2] + a[3] * a[3] + b[0] * b[0] + b[1] * b[1] + b[2] * b[2] + b[3] * b[3];
    ss = wave_sum(ss);
    float r = rsqrtf(ss * (1.f / 512.f) + 1e-6f);
    f32x4 ga = *(const f32x4*)(p.g_q + lane * 4), gb = *(const f32x4*)(p.g_q + 256 + lane * 4);
    u32x2 o;
    o[0] = cvtpk(a[0] * r * ga[0], a[1] * r * ga[1]); o[1] = cvtpk(a[2] * r * ga[2], a[3] * r * ga[3]);
    *(u32x2*)(p.CQ + (size_t)t * 512 + lane * 4) = o;
    o[0] = cvtpk(b[0] * r * gb[0], b[1] * r * gb[1]); o[1] = cvtpk(b[2] * r * gb[2], b[3] * r * gb[3]);
    *(u32x2*)(p.CQ + (size_t)t * 512 + 256 + lane * 4) = o;
  }
  const int kr_row = krow_of(t);
  {
    f32x4 a = *(const f32x4*)(zr + 512 + lane * 4);
    float ss = a[0] * a[0] + a[1] * a[1] + a[2] * a[2] + a[3] * a[3];
    ss = wave_sum(ss);
    float r = rsqrtf(ss * (1.f / 256.f) + 1e-6f);
    f32x4 g = *(const f32x4*)(p.g_kv + lane * 4);
    f32x4 o = {a[0] * r * g[0], a[1] * r * g[1], a[2] * r * g[2], a[3] * r * g[3]};
    float* od = t < MP ? p.out + O_CKVP + (size_t)t * 256 : p.out + O_CKVS + (size_t)(t - MP) * 256;
    *(f32x4*)(od + lane * 4) = o;
    u32x2 ob; ob[0] = cvtpk(o[0], o[1]); ob[1] = cvtpk(o[2], o[3]);
    *(u32x2*)(p.CKV + (size_t)kr_row * 256 + lane * 4) = ob;
  }
  if (lane < 32) {
    float x1 = zr[768 + lane], x2 = zr[768 + 32 + lane];
    float ang = (float)qpos_of(t) * inv_freq(lane);
    float cs = cosf(ang), sn = sinf(ang);
    p.CS[(size_t)t * 32 + lane] = cs; p.SN[(size_t)t * 32 + lane] = sn;
    float o1 = x1 * cs - x2 * sn, o2 = x1 * sn + x2 * cs;
    float* od = t < MP ? p.out + O_KRP + (size_t)t * 64 : p.out + O_KRS + (size_t)(t - MP) * 64;
    od[lane] = o1; od[lane + 32] = o2;
    p.KR[(size_t)kr_row * 64 + lane] = f2bf(o1);
    p.KR[(size_t)kr_row * 64 + lane + 32] = f2bf(o2);
  }
}

DI unsigned fkey(float f) { unsigned u = __float_as_uint(f); return (u & 0x80000000u) ? ~u : (u | 0x80000000u); }

DI void topk_query(const Params& p, int t, char* smem) {
  unsigned* sc = (unsigned*)smem;
  int* hist = (int*)(smem + 65536);
  int* misc = hist + 2048;
  const int tid = otid(), lane = tid & 63, w = tid >> 6, fr = lane & 15, fq = lane >> 4;
  int n; const u16* ixk;
  if (t < MP) { n = 64 * ((t >> 6) + 1); ixk = p.IXK; }
  else { int b = (t - MP) >> 4; n = SK; ixk = p.IXK + (size_t)(MP + b * SK) * 64; }
  u16* outidx = p.TOPK + (size_t)t * 256;
  __syncthreads();
  if (n <= 256) {
    outidx[tid] = (u16)(tid < n ? tid : 0);
    if (tid == 0) p.CNT[t] = n;
    return;
  }
  {
    const u16* q = p.IXQ + (size_t)t * 1024 + fr * 64 + fq * 8;
    const bf16x8 a0 = *(const bf16x8*)q, a1 = *(const bf16x8*)(q + 32);
    const f32x4 wv = *(const f32x4*)(p.IXW + (size_t)t * 16 + fq * 4);
    const int ntile = n >> 4;
    for (int kt = w; kt < ntile; kt += 4) {
      const int key = kt * 16 + fr;
      const u16* kp = ixk + (size_t)key * 64 + fq * 8;
      bf16x8 b0 = *(const bf16x8*)kp, b1 = *(const bf16x8*)(kp + 32);
      f32x4 c = {0.f, 0.f, 0.f, 0.f};
      c = __builtin_amdgcn_mfma_f32_16x16x32_bf16(a0, b0, c, 0, 0, 0);
      c = __builtin_amdgcn_mfma_f32_16x16x32_bf16(a1, b1, c, 0, 0, 0);
      float s = fmaxf(c[0], 0.f) * wv[0] + fmaxf(c[1], 0.f) * wv[1] + fmaxf(c[2], 0.f) * wv[2] + fmaxf(c[3], 0.f) * wv[3];
      s += __shfl_xor(s, 16);
      s += __shfl_xor(s, 32);
      if (fq == 0) sc[key] = fkey(s);
    }
  }
  __syncthreads();
  unsigned prefix = 0;
  int remaining = 256;
#pragma unroll 1
  for (int pass = 0; pass < 3; ++pass) {
    const int shift = pass == 0 ? 21 : (pass == 1 ? 10 : 0);
    const int bits = pass == 2 ? 10 : 11;
    const unsigned bmask = (1u << bits) - 1u;
    for (int i = tid; i < 2048; i += NTHREADS) hist[i] = 0;
    __syncthreads();
    const int hs = shift + bits;
    for (int i = tid; i < n; i += NTHREADS) {
      unsigned u = sc[i];
      bool match = (pass == 0) || ((u >> hs) == (prefix >> hs));
      if (match) atomicAdd(&hist[(u >> shift) & bmask], 1);
    }
    __syncthreads();
    const int4 h0 = *(const int4*)&hist[tid * 8], h1 = *(const int4*)&hist[tid * 8 + 4];
    const int s8 = h0.x + h0.y + h0.z + h0.w + h1.x + h1.y + h1.z + h1.w;
    int suf = s8;
#pragma unroll
    for (int d = 1; d < 64; d <<= 1) { int v = __shfl_down(suf, d); if (lane + d < 64) suf += v; }
    if (lane == 0) misc[w] = suf;
    __syncthreads();
    int above = 0;
    for (int ww = w + 1; ww < 4; ++ww) above += misc[ww];
    const int excl = above + suf - s8;
    if (excl < remaining && remaining <= excl + s8) {
      int c = excl, bin = 0, nrem = 0;
#define TK_STEP(val, idx) if (c < remaining && remaining <= c + (val)) { bin = tid * 8 + (idx); nrem = remaining - c; } c += (val);
      TK_STEP(h1.w, 7) TK_STEP(h1.z, 6) TK_STEP(h1.y, 5) TK_STEP(h1.x, 4) TK_STEP(h0.w, 3) TK_STEP(h0.z, 2) TK_STEP(h0.y, 1) TK_STEP(h0.x, 0)
#undef TK_STEP
      misc[4] = bin; misc[5] = nrem;
    }
    __syncthreads();
    prefix |= ((unsigned)misc[4]) << shift;
    remaining = misc[5];
    __syncthreads();
  }
  const unsigned T = prefix;
  const int seg = ((n + 255) >> 8) << 6;
  const int beg = w * seg;
  int cgt = 0, ceq = 0;
  for (int i = beg + lane; i < beg + seg; i += 64) {
    bool in = i < n; unsigned u = in ? sc[i] : 0u;
    bool g = in && u > T, e = in && u == T;
    cgt += __popcll(__ballot(g)); ceq += __popcll(__ballot(e));
  }
  if (lane == 0) { misc[8 + w] = cgt; misc[12 + w] = ceq; }
  __syncthreads();
  int og = 0, oe = 0;
  for (int ww = 0; ww < w; ++ww) { og += misc[8 + ww]; oe += misc[12 + ww]; }
  const int G = 256 - remaining;
  const unsigned long long lt = (1ull << lane) - 1ull;
  for (int i = beg + lane; i < beg + seg; i += 64) {
    bool in = i < n; unsigned u = in ? sc[i] : 0u;
    bool g = in && u > T, e = in && u == T;
    unsigned long long bg = __ballot(g), be = __ballot(e);
    int pg = og + __popcll(bg & lt), pe = oe + __popcll(be & lt);
    if (g && pg < 256) outidx[pg] = (u16)i;
    if (e && pe < remaining) outidx[G + pe] = (u16)i;
    og += __popcll(bg); oe += __popcll(be);
  }
  if (tid == 0) p.CNT[t] = 256;
}

DI float dsa_bias(const float* sRel, const unsigned char* sBk, int rel, int h) {
  int r = min(max(rel, -128), 128) + 128;
  return sRel[(int)sBk[r] * 16 + h];
}

DI void dsa_query_prompt(const Params& p, int t, int lane, const float* sRel, const unsigned char* sBk) {
  const int h = lane >> 2;
  const int cnt = p.CNT[t];
  const u16* idx = p.TOPK + (size_t)t * 256;
  u32x4 q[4];
  {
    const u16* qp = p.AQ + (size_t)t * 2048 + lane * 32;
#pragma unroll
    for (int i = 0; i < 4; ++i) q[i] = *(const u32x4*)(qp + i * 8);
  }
  float acc[32];
#pragma unroll
  for (int i = 0; i < 32; ++i) acc[i] = 0.f;
  float m = -1e30f, l = 0.f;
  const float SC = 0.08838834764831845f * 1.4426950408889634f;
  for (int k0 = 0; k0 < cnt; k0 += 4) {
    int s[4];
    u32x4 kv[4][4], vv[4][4];
#pragma unroll
    for (int g = 0; g < 4; ++g) {
      s[g] = idx[k0 + g];
      const u16* kp = p.KA + (size_t)s[g] * 2048 + lane * 32;
      const u16* vp = p.VA + (size_t)s[g] * 2048 + lane * 32;
#pragma unroll
      for (int i = 0; i < 4; ++i) { kv[g][i] = *(const u32x4*)(kp + i * 8); vv[g][i] = *(const u32x4*)(vp + i * 8); }
    }
    float lg[4];
#pragma unroll
    for (int g = 0; g < 4; ++g) {
      float d0 = 0.f, d1 = 0.f;
#pragma unroll
      for (int i = 0; i < 4; ++i) {
        d0 = dot2bf(kv[g][i][0], q[i][0], d0); d1 = dot2bf(kv[g][i][1], q[i][1], d1);
        d0 = dot2bf(kv[g][i][2], q[i][2], d0); d1 = dot2bf(kv[g][i][3], q[i][3], d1);
      }
      float d = d0 + d1;
      d += __shfl_xor(d, 1);
      d += __shfl_xor(d, 2);
      lg[g] = (d * 0.08838834764831845f + dsa_bias(sRel, sBk, s[g] - t, h)) * 1.4426950408889634f;
    }
    float mx = fmaxf(fmaxf(lg[0], lg[1]), fmaxf(lg[2], lg[3]));
    float mn = fmaxf(m, mx);
    float alpha = exp2f(m - mn);
    m = mn;
    float pw[4];
#pragma unroll
    for (int g = 0; g < 4; ++g) pw[g] = exp2f(lg[g] - mn);
    l = l * alpha + (pw[0] + pw[1] + pw[2] + pw[3]);
#pragma unroll
    for (int i = 0; i < 32; ++i) acc[i] *= alpha;
#pragma unroll
    for (int g = 0; g < 4; ++g) {
#pragma unroll
      for (int i = 0; i < 4; ++i) {
#pragma unroll
        for (int e = 0; e < 4; ++e) {
          unsigned wv = vv[g][i][e];
          acc[i * 8 + e * 2] += pw[g] * bflo(wv);
          acc[i * 8 + e * 2 + 1] += pw[g] * bfhi(wv);
        }
      }
    }
  }
  (void)SC;
  const float inv = 1.f / l;
  u16* gp = p.GA + (size_t)t * 2048 + lane * 32;
#pragma unroll
  for (int i = 0; i < 4; ++i) {
    u32x4 gv = *(const u32x4*)(gp + i * 8);
    u32x4 o;
#pragma unroll
    for (int e = 0; e < 4; ++e)
      o[e] = cvtpk(bflo(gv[e]) * acc[i * 8 + e * 2] * inv, bfhi(gv[e]) * acc[i * 8 + e * 2 + 1] * inv);
    *(u32x4*)(gp + i * 8) = o;
  }
}

DI void dsa_query_sample(const Params& p, int t, int lane, const float* sRel, const unsigned char* sBk) {
  const int h = lane >> 2;
  const int ts = t - MP, b = ts >> 4;
  const int qp_ = 1024 + (ts & 15);
  const int cnt = p.CNT[t];
  const u16* idx = p.TOPK + (size_t)t * 256;
  float q[32];
  {
    const u16* qp = p.AQ + (size_t)t * 2048 + lane * 32;
#pragma unroll
    for (int i = 0; i < 4; ++i) {
      u32x4 v = *(const u32x4*)(qp + i * 8);
#pragma unroll
      for (int e = 0; e < 4; ++e) { q[i * 8 + e * 2] = bflo(v[e]); q[i * 8 + e * 2 + 1] = bfhi(v[e]); }
    }
  }
  float acc[32];
#pragma unroll
  for (int i = 0; i < 32; ++i) acc[i] = 0.f;
  float m = -1e30f, l = 0.f;
  for (int k0 = 0; k0 < cnt; k0 += 2) {
    int s[2];
    f32x4 kv[2][8], vv[2][8];
#pragma unroll
    for (int g = 0; g < 2; ++g) {
      s[g] = idx[k0 + g];
      const float *kp, *vp;
      if (s[g] < 1024) {
        size_t o = ((size_t)b * 1024 + s[g]) * 2048 + lane * 32;
        kp = p.c_ak + o; vp = p.c_av + o;
      } else {
        size_t o = ((size_t)b * 16 + (s[g] - 1024)) * 2048 + lane * 32;
        kp = p.out + O_AKS + o; vp = p.out + O_AVS + o;
      }
#pragma unroll
      for (int i = 0; i < 8; ++i) { kv[g][i] = *(const f32x4*)(kp + i * 4); vv[g][i] = *(const f32x4*)(vp + i * 4); }
    }
    float lg[2];
#pragma unroll
    for (int g = 0; g < 2; ++g) {
      float d0 = 0.f, d1 = 0.f;
#pragma unroll
      for (int i = 0; i < 8; ++i) {
        d0 += kv[g][i][0] * q[i * 4] + kv[g][i][2] * q[i * 4 + 2];
        d1 += kv[g][i][1] * q[i * 4 + 1] + kv[g][i][3] * q[i * 4 + 3];
      }
      float d = d0 + d1;
      d += __shfl_xor(d, 1);
      d += __shfl_xor(d, 2);
      lg[g] = (d * 0.08838834764831845f + dsa_bias(sRel, sBk, s[g] - qp_, h)) * 1.4426950408889634f;
    }
    float mn = fmaxf(m, fmaxf(lg[0], lg[1]));
    float alpha = exp2f(m - mn);
    m = mn;
    float p0 = exp2f(lg[0] - mn), p1 = exp2f(lg[1] - mn);
    l = l * alpha + p0 + p1;
#pragma unroll
    for (int i = 0; i < 8; ++i) {
#pragma unroll
      for (int e = 0; e < 4; ++e) acc[i * 4 + e] = acc[i * 4 + e] * alpha + p0 * vv[0][i][e] + p1 * vv[1][i][e];
    }
  }
  const float inv = 1.f / l;
  u16* gp = p.GA + (size_t)t * 2048 + lane * 32;
#pragma unroll
  for (int i = 0; i < 4; ++i) {
    u32x4 gv = *(const u32x4*)(gp + i * 8);
    u32x4 o;
#pragma unroll
    for (int e = 0; e < 4; ++e)
      o[e] = cvtpk(bflo(gv[e]) * acc[i * 8 + e * 2] * inv, bfhi(gv[e]) * acc[i * 8 + e * 2 + 1] * inv);
    *(u32x4*)(gp + i * 8) = o;
  }
}

constexpr int KSTR = 200;
constexpr int VSTR = 72;

DI void mla_item(const Params& p, int item, char* smem) {
  u16* sK = (u16*)smem;
  u16* sV = sK + 64 * KSTR;
  const int tid = otid(), lane = tid & 63, w = tid >> 6, fr = lane & 15, fq = lane >> 4;
  int h, q0, nq, krow0, nkeys, ntiles, myt;
  const u16* vt; size_t vstride;
  if (item < 2048) {
    const int i = 127 - (item >> 4);
    h = item & 15; q0 = i * 128; nq = 128; krow0 = 0; nkeys = q0 + 128; ntiles = 2 * i + 2;
    vt = p.VBT_P + (size_t)h * 128 * MP; vstride = MP;
    myt = (w < 2) ? ntiles - 1 : ntiles;
  } else {
    const int j = item - 2048, b = j >> 4;
    h = j & 15; q0 = MP + b * 16; nq = 16; krow0 = MP + b * SK; nkeys = SK; ntiles = 17;
    vt = p.VBT_S + ((size_t)b * 2048 + h * 128) * VSS; vstride = VSS;
    myt = ntiles;
  }
  const int wq0 = w * 32;
  const bool active = wq0 < nq;
  bf16x8 qf[2][6];
#pragma unroll
  for (int qt = 0; qt < 2; ++qt) {
    const int qr = min(wq0 + qt * 16 + fr, nq - 1);
    const u16* qp = p.QB + (size_t)(q0 + qr) * 3072 + h * 192 + fq * 8;
#pragma unroll
    for (int ks = 0; ks < 6; ++ks) qf[qt][ks] = *(const bf16x8*)(qp + ks * 32);
  }
  f32x4 o[2][8];
#pragma unroll
  for (int qt = 0; qt < 2; ++qt)
#pragma unroll
    for (int dt = 0; dt < 8; ++dt) o[qt][dt] = (f32x4){0.f, 0.f, 0.f, 0.f};
  float mrow[2] = {-1e30f, -1e30f}, lrow[2] = {0.f, 0.f};
  const float SC = 0.07216878364870322f * 1.4426950408889634f;

  for (int jt = 0; jt < ntiles; ++jt) {
    const int key0 = jt * 64;
    __syncthreads();
#pragma unroll
    for (int i = 0; i < 6; ++i) {
      const int c = tid + i * 256;
      const int key = c / 24, part = c - key * 24;
      const size_t kk = (size_t)(min(key0 + key, nkeys - 1) + krow0);
      u32x4 v;
      if (part < 16) v = *(const u32x4*)(p.KB + kk * 2048 + h * 128 + part * 8);
      else v = *(const u32x4*)(p.KR + kk * 64 + (part - 16) * 8);
      *(u32x4*)(sK + key * KSTR + part * 8) = v;
    }
    __builtin_amdgcn_sched_barrier(0);
#pragma unroll
    for (int i = 0; i < 4; ++i) {
      const int c = tid + i * 256;
      const int d = c >> 3, part = c & 7;
      u32x4 v = *(const u32x4*)(vt + (size_t)d * vstride + key0 + part * 8);
      *(u32x4*)(sV + d * VSTR + part * 8) = v;
    }
    __syncthreads();
    if (active && jt < myt) {
      f32x4 s[2][4];
#pragma unroll
      for (int qt = 0; qt < 2; ++qt)
#pragma unroll
        for (int kt = 0; kt < 4; ++kt) s[qt][kt] = (f32x4){0.f, 0.f, 0.f, 0.f};
#pragma unroll
      for (int kt = 0; kt < 4; ++kt) {
#pragma unroll
        for (int ks = 0; ks < 6; ++ks) {
          bf16x8 kf = *(const bf16x8*)(sK + (kt * 16 + fr) * KSTR + ks * 32 + fq * 8);
          s[0][kt] = __builtin_amdgcn_mfma_f32_16x16x32_bf16(kf, qf[0][ks], s[0][kt], 0, 0, 0);
          s[1][kt] = __builtin_amdgcn_mfma_f32_16x16x32_bf16(kf, qf[1][ks], s[1][kt], 0, 0, 0);
        }
      }
      if (key0 + 64 > nkeys) {
#pragma unroll
        for (int kt = 0; kt < 4; ++kt)
#pragma unroll
          for (int j = 0; j < 4; ++j)
            if (key0 + kt * 16 + fq * 4 + j >= nkeys) { s[0][kt][j] = -1e30f; s[1][kt][j] = -1e30f; }
      }
      bf16x8 pf[2][2];
#pragma unroll
      for (int qt = 0; qt < 2; ++qt) {
        float mx = -1e30f;
#pragma unroll
        for (int kt = 0; kt < 4; ++kt)
#pragma unroll
          for (int j = 0; j < 4; ++j) mx = fmaxf(mx, s[qt][kt][j]);
        mx = fmaxf(mx, __shfl_xor(mx, 16));
        mx = fmaxf(mx, __shfl_xor(mx, 32));
        const float mn = fmaxf(mrow[qt], mx * SC);
        const float alpha = exp2f(mrow[qt] - mn);
        mrow[qt] = mn;
        float rs = 0.f;
#pragma unroll
        for (int kt = 0; kt < 4; ++kt)
#pragma unroll
          for (int j = 0; j < 4; ++j) { float pv = exp2f(s[qt][kt][j] * SC - mn); s[qt][kt][j] = pv; rs += pv; }
        rs += __shfl_xor(rs, 16);
        rs += __shfl_xor(rs, 32);
        lrow[qt] = lrow[qt] * alpha + rs;
#pragma unroll
        for (int dt = 0; dt < 8; ++dt) o[qt][dt] *= alpha;
#pragma unroll
        for (int s2 = 0; s2 < 2; ++s2) {
          u32x4 pk;
          pk[0] = cvtpk(s[qt][2 * s2][0], s[qt][2 * s2][1]);
          pk[1] = cvtpk(s[qt][2 * s2][2], s[qt][2 * s2][3]);
          pk[2] = cvtpk(s[qt][2 * s2 + 1][0], s[qt][2 * s2 + 1][1]);
          pk[3] = cvtpk(s[qt][2 * s2 + 1][2], s[qt][2 * s2 + 1][3]);
          pf[qt][s2] = __builtin_bit_cast(bf16x8, pk);
        }
      }
#pragma unroll
      for (int dt = 0; dt < 8; ++dt) {
#pragma unroll
        for (int s2 = 0; s2 < 2; ++s2) {
          const u16* vp = sV + (dt * 16 + fr) * VSTR + fq * 4;
          u32x2 v0 = *(const u32x2*)(vp + (2 * s2) * 16);
          u32x2 v1 = *(const u32x2*)(vp + (2 * s2 + 1) * 16);
          u32x4 vv = {v0[0], v0[1], v1[0], v1[1]};
          bf16x8 vf = __builtin_bit_cast(bf16x8, vv);
          o[0][dt] = __builtin_amdgcn_mfma_f32_16x16x32_bf16(vf, pf[0][s2], o[0][dt], 0, 0, 0);
          o[1][dt] = __builtin_amdgcn_mfma_f32_16x16x32_bf16(vf, pf[1][s2], o[1][dt], 0, 0, 0);
        }
      }
    }
  }
  if (active) {
#pragma unroll
    for (int qt = 0; qt < 2; ++qt) {
      const int qr = wq0 + qt * 16 + fr;
      if (qr < nq) {
        const float inv = 1.f / lrow[qt];
        const size_t row = (size_t)(q0 + qr);
#pragma unroll
        for (int dt = 0; dt < 8; ++dt) {
          const size_t off = row * 2048 + h * 128 + dt * 16 + fq * 4;
          u32x2 ga = *(const u32x2*)(p.GA + off), gb = *(const u32x2*)(p.GB + off);
          u32x2 r;
          r[0] = cvtpk(bflo(gb[0]) * o[qt][dt][0] * inv + bflo(ga[0]), bfhi(gb[0]) * o[qt][dt][1] * inv + bfhi(ga[0]));
          r[1] = cvtpk(bflo(gb[1]) * o[qt][dt][2] * inv + bflo(ga[1]), bfhi(gb[1]) * o[qt][dt][3] * inv + bfhi(ga[1]));
          *(u32x2*)(p.GB + off) = r;
        }
      }
    }
  }
}

__global__ void __launch_bounds__(NTHREADS, 2) fwd_megakernel(Params p) {
  extern __shared__ __attribute__((aligned(16))) char smem[];
  cg::grid_group grid = cg::this_grid();
#define IDS const int tid = otid(); const int lane = tid & 63, w = tid >> 6; const int bid = blockIdx.x, nb = gridDim.x; \
  const int gw = bid * 4 + w, ngw = nb * 4; (void)tid; (void)lane; (void)gw; (void)ngw; (void)bid; (void)nb;

#if PH & (1 << 0)
  { IDS
  {
    float* st = (float*)smem;
    for (int t = bid; t < 32 * 192; t += nb) transpose_tile(p.w_in, 2048, INC, p.WT_IN, t, st);
    for (int t = bid; t < 8 * 48; t += nb) transpose_tile(p.w_uq, 512, 3072, p.WT_UQ, t, st);
    for (int t = bid; t < 4 * 32; t += nb) transpose_tile(p.w_uk, 256, 2048, p.WT_UK, t, st);
    for (int t = bid; t < 4 * 32; t += nb) transpose_tile(p.w_uv, 256, 2048, p.WT_UV, t, st);
    for (int t = bid; t < 32 * 32; t += nb) transpose_tile(p.w_out, 2048, 2048, p.WT_OUT, t, st);
    for (int t = bid; t < 32 * 128; t += nb) transpose_tile(p.w_up, 2048, 8192, p.WT_UP, t, st);
    for (int t = bid; t < 128 * 32; t += nb) transpose_tile(p.w_down, 8192, 2048, p.WT_DOWN, t, st);
    for (int r = gw; r < MT; r += ngw) {
      const float* x = r < MP ? p.x_p + (size_t)r * 2048 : p.x_s + (size_t)(r - MP) * 2048;
      rms_row_2048(x, p.g_mix, p.H + (size_t)r * 2048, lane);
    }
    const int gt = bid * NTHREADS + tid, ngt = nb * NTHREADS;
    for (int i = gt; i < 16 * 1024 * 64 / 4; i += ngt) {
      int e = i * 4; int b = e >> 16; int rem = e & 65535; int s = rem >> 6, c = rem & 63;
      size_t dst = (size_t)(MP + b * SK + s) * 64 + c;
      f32x4 a = *(const f32x4*)(p.c_idx + e), k = *(const f32x4*)(p.c_kr + e);
      u32x2 o; o[0] = cvtpk(a[0], a[1]); o[1] = cvtpk(a[2], a[3]);
      *(u32x2*)(p.IXK + dst) = o;
      o[0] = cvtpk(k[0], k[1]); o[1] = cvtpk(k[2], k[3]);
      *(u32x2*)(p.KR + dst) = o;
    }
    for (int i = gt; i < 16 * 1024 * 256 / 4; i += ngt) {
      int e = i * 4; int b = e >> 18; int rem = e & 262143; int s = rem >> 8, c = rem & 255;
      size_t dst = (size_t)(MP + b * SK + s) * 256 + c;
      f32x4 a = *(const f32x4*)(p.c_ckv + e);
      u32x2 o; o[0] = cvtpk(a[0], a[1]); o[1] = cvtpk(a[2], a[3]);
      *(u32x2*)(p.CKV + dst) = o;
    }
  }
  }
#endif
  grid.sync();
#if PH & (1 << 1)
  { IDS
  gemm_phase<EPI_IN>(p, p.H, 2048, p.WT_IN, 2048, 2048, MT / 128, INP / 128, smem, nullptr, 0, bid, nb);
  }
#endif
  grid.sync();
#if PH & (1 << 2)
  { IDS
  for (int t = gw; t < MT; t += ngw) post_row(p, t, lane);
  for (int t = bid; t < MT; t += nb) topk_query(p, t, smem);
  }
#endif
  grid.sync();
#if PH & (1 << 3)
  { IDS
  {
    float* sRel = (float*)smem;
    unsigned char* sBk = (unsigned char*)(smem + 2048);
    __syncthreads();
    for (int i = tid; i < 512; i += NTHREADS) sRel[i] = p.rel[i];
    for (int i = tid; i < 257; i += NTHREADS) {
      int rel = i - 128;
      int ret = rel > 0 ? 16 : 0;
      int n = rel < 0 ? -rel : rel;
      float lf = logf((float)max(n, 1) / 8.0f) / 2.772588722239781f * 8.0f;
      int large = min(8 + (int)lf, 15);
      sBk[i] = (unsigned char)(ret + (n < 8 ? n : large));
    }
    __syncthreads();
    for (int t = gw; t < MT; t += ngw) {
      int tu = __builtin_amdgcn_readfirstlane(t);
      if (tu < MP) dsa_query_prompt(p, tu, lane, sRel, sBk);
      else dsa_query_sample(p, tu, lane, sRel, sBk);
    }
  }
  }
#endif
  grid.sync();
#if PH & (1 << 4)
  { IDS
  {
    const int nqb = (MT / 128) * 24, nkb = (KROWS / 128) * 16;
    const int gt = bid * NTHREADS + tid, ngt = nb * NTHREADS;
    for (int i = gt; i < 16 * 2048 * 6; i += ngt) {
      int r = i / 6, c = i - r * 6;
      *(u32x4*)(p.VBT_S + (size_t)r * VSS + SK + c * 8) = (u32x4){0u, 0u, 0u, 0u};
    }
    const int total = nqb + 2 * nkb;
    for (int id = bid; id < total; id += nb) {
      if (id < nqb) gemm_phase<EPI_QB>(p, p.CQ, 512, p.WT_UQ, 512, 512, MT / 128, 24, smem, p.QB, 3072, id, 1 << 30);
      else if (id < nqb + nkb) gemm_phase<EPI_BF16>(p, p.CKV, 256, p.WT_UK, 256, 256, KROWS / 128, 16, smem, p.KB, 2048, id - nqb, 1 << 30);
      else gemm_phase<EPI_VT>(p, p.CKV, 256, p.WT_UV, 256, 256, KROWS / 128, 16, smem, nullptr, 0, id - nqb - nkb, 1 << 30);
    }
  }
  }
#endif
  grid.sync();
#if PH & (1 << 5)
  { IDS
  {
    const int total = 2048 + 256;
    for (int r = 0;; ++r) {
      int id = (r & 1) ? r * nb + (nb - 1 - bid) : r * nb + bid;
      if (r * nb >= total) break;
      if (id < total) mla_item(p, id, smem);
    }
  }
  }
#endif
  grid.sync();
#if PH & (1 << 6)
  { IDS
  gemm_phase<EPI_RES>(p, p.GB, 2048, p.WT_OUT, 2048, 2048, MT / 128, 16, smem, nullptr, 0, bid, nb);
  }
#endif
  grid.sync();
#if PH & (1 << 7)
  { IDS
  for (int r = gw; r < MT; r += ngw) rms_row_2048(p.out + O_Y + (size_t)r * 2048, p.g_ffn, p.H2 + (size_t)r * 2048, lane);
  }
#endif
  grid.sync();
#if PH & (1 << 8)
  { IDS
  gemm_phase<EPI_RELU2>(p, p.H2, 2048, p.WT_UP, 2048, 2048, MT / 128, 64, smem, nullptr, 0, bid, nb);
  }
#endif
  grid.sync();
#if PH & (1 << 9)
  { IDS
  gemm_phase<EPI_ACC>(p, p.U, DFF, p.WT_DOWN, DFF, DFF, MT / 128, 16, smem, nullptr, 0, bid, nb);
  }
#endif
  grid.sync();
#if PH & (1 << 10)
  { IDS
  for (int r = gw; r < MT; r += ngw) {
    float* x = p.out + O_Y + (size_t)r * 2048;
    f32x4 v[8];
    float ss = 0.f;
#pragma unroll
    for (int i = 0; i < 8; ++i) {
      v[i] = *(const f32x4*)(x + i * 256 + lane * 4);
      ss += v[i][0] * v[i][0] + v[i][1] * v[i][1] + v[i][2] * v[i][2] + v[i][3] * v[i][3];
    }
    ss = wave_sum(ss);
    float rr = rsqrtf(ss * (1.f / 2048.f) + 1e-6f);
#pragma unroll
    for (int i = 0; i < 8; ++i) {
      f32x4 gg = *(const f32x4*)(p.g_fin + i * 256 + lane * 4);
      f32x4 o = {v[i][0] * rr * gg[0], v[i][1] * rr * gg[1], v[i][2] * rr * gg[2], v[i][3] * rr * gg[3]};
      *(f32x4*)(x + i * 256 + lane * 4) = o;
    }
  }
  }
#endif
}

extern "C" void kernel_launch(void* const* d_in, const int* in_sizes, int n_in, void* d_out, int out_size, void* d_ws, size_t ws_size,
                              hipStream_t stream) {
  static int grid_blocks = 0;
  if (!grid_blocks) {
    int dev = 0, cus = 0, per_cu = 0;
    hipGetDevice(&dev);
    hipDeviceGetAttribute(&cus, hipDeviceAttributeMultiprocessorCount, dev);
    if (hipFuncSetAttribute((const void*)fwd_megakernel, hipFuncAttributeMaxDynamicSharedMemorySize, LDS_BYTES) != hipSuccess)
      fprintf(stderr, "kernel_launch: hipFuncSetAttribute failed\n");
    hipOccupancyMaxActiveBlocksPerMultiprocessor(&per_cu, (const void*)fwd_megakernel, NTHREADS, LDS_BYTES);
    if (per_cu < 1) per_cu = 1;
    if (per_cu > 2) per_cu = 2;
    grid_blocks = cus * per_cu;
  }
  Params p{};
  const float* const* in = (const float* const*)d_in;
  p.x_p = in[0]; p.x_s = in[1]; p.c_ak = in[2]; p.c_av = in[3]; p.c_idx = in[4]; p.c_ckv = in[5]; p.c_kr = in[6]; p.rel = in[7];
  p.g_mix = in[8]; p.w_in = in[9]; p.g_q = in[10]; p.w_uq = in[11]; p.g_kv = in[12]; p.w_uk = in[13]; p.w_uv = in[14]; p.w_out = in[15];
  p.g_ffn = in[16]; p.w_up = in[17]; p.w_down = in[18]; p.g_fin = in[19];
  p.out = (float*)d_out;
  char* ws = (char*)d_ws;
  size_t off = 0;
  auto alloc = [&](size_t bytes) { char* r = ws + off; off += (bytes + 255) & ~(size_t)255; return r; };
  p.WT_UQ = (u16*)alloc((size_t)3072 * 512 * 2);
  p.WT_UK = (u16*)alloc((size_t)2048 * 256 * 2);
  p.WT_UV = (u16*)alloc((size_t)2048 * 256 * 2);
  p.WT_OUT = (u16*)alloc((size_t)2048 * 2048 * 2);
  p.WT_UP = (u16*)alloc((size_t)8192 * 2048 * 2);
  p.WT_DOWN = (u16*)alloc((size_t)2048 * 8192 * 2);
  p.CQ = (u16*)alloc((size_t)MT * 512 * 2);
  p.CKV = (u16*)alloc((size_t)KROWS * 256 * 2);
  p.KR = (u16*)alloc((size_t)KROWS * 64 * 2);
  p.GA = (u16*)alloc((size_t)MT * 2048 * 2);
  p.GB = (u16*)alloc((size_t)MT * 2048 * 2);
  p.CS = (float*)alloc((size_t)MT * 32 * 4);
  p.SN = (float*)alloc((size_t)MT * 32 * 4);
  const size_t ubase = off;
  p.WT_IN = (u16*)alloc((size_t)INP * 2048 * 2);
  p.H = (u16*)alloc((size_t)MT * 2048 * 2);
  p.AQ = (u16*)alloc((size_t)MT * 2048 * 2);
  p.KA = (u16*)alloc((size_t)MP * 2048 * 2);
  p.VA = (u16*)alloc((size_t)MP * 2048 * 2);
  p.IXQ = (u16*)alloc((size_t)MT * 1024 * 2);
  p.IXK = (u16*)alloc((size_t)KROWS * 64 * 2);
  p.TOPK = (u16*)alloc((size_t)MT * 256 * 2);
  p.IXW = (float*)alloc((size_t)MT * 16 * 4);
  p.CNT = (int*)alloc((size_t)MT * 4);
  const size_t endA = off;
  off = ubase;
  p.QB = (u16*)alloc((size_t)MT * 3072 * 2);
  p.KB = (u16*)alloc((size_t)KROWS * 2048 * 2);
  p.VBT_P = (u16*)alloc((size_t)2048 * MP * 2);
  p.VBT_S = (u16*)alloc((size_t)16 * 2048 * VSS * 2);
  const size_t endB = off;
  off = ubase;
  p.H2 = (u16*)alloc((size_t)MT * 2048 * 2);
  p.U = (u16*)alloc((size_t)MT * DFF * 2);
  const size_t endC = off;
  size_t need = endA > endB ? endA : endB;
  if (endC > need) need = endC;
  if (need > ws_size) { fprintf(stderr, "kernel_launch: workspace too small: need %zu have %zu\n", need, ws_size); return; }
  void* args[] = {&p};
  hipError_t e = hipLaunchCooperativeKernel((const void*)fwd_megakernel, dim3(grid_blocks), dim3(NTHREADS), args, LDS_BYTES, stream);
  if (e != hipSuccess) fprintf(stderr, "cooperative launch failed: %s (grid %d)\n", hipGetErrorString(e), grid_blocks);
}
```

```cpp
#include <hip/hip_runtime.h>
#include <hip/hip_cooperative_groups.h>
#include <cstdio>
#include <cstdint>
namespace cg = cooperative_groups;

typedef unsigned short u16;
typedef __attribute__((ext_vector_type(8))) short bf16x8;
typedef __attribute__((ext_vector_type(4))) short bf16x4;
typedef __attribute__((ext_vector_type(4))) float f32x4;
typedef __attribute__((ext_vector_type(2))) float f32x2;
typedef __attribute__((ext_vector_type(2))) __bf16 bf16x2_t;
typedef __attribute__((ext_vector_type(4))) unsigned u32x4;
typedef __attribute__((ext_vector_type(2))) unsigned u32x2;

#define DI __device__ __forceinline__

constexpr int MP = 16384;
constexpr int MS = 256;
constexpr int MT = MP + MS;
constexpr int DM = 2048;
constexpr int INC = 12176;
constexpr int INP = 12288;
constexpr int SK = 1040;
constexpr int KROWS = MP + 16 * SK;
constexpr int VSS = 1088;
constexpr int DFF = 8192;
constexpr int ZRW = 832;
#ifndef PH
#define PH 0x7ff
#endif
#ifndef REP
#define REP 0
#endif
#define NREP(k) (((REP >> (k)) & 1) + 1)
constexpr int NTHREADS = 256;
constexpr int LDS_BYTES = 75776;

constexpr size_t O_Y = 0;
constexpr size_t O_AKP = 34078720;
constexpr size_t O_AVP = 67633152;
constexpr size_t O_IDXP = 101187584;
constexpr size_t O_CKVP = 102236160;
constexpr size_t O_KRP = 106430464;
constexpr size_t O_AKS = 107479040;
constexpr size_t O_AVS = 108003328;
constexpr size_t O_IDXS = 108527616;
constexpr size_t O_CKVS = 108544000;
constexpr size_t O_KRS = 108609536;

struct Params {
  const float *x_p, *x_s, *c_ak, *c_av, *c_idx, *c_ckv, *c_kr, *rel, *g_mix, *w_in, *g_q, *w_uq, *g_kv, *w_uk, *w_uv, *w_out, *g_ffn, *w_up, *w_down, *g_fin;
  float* out;
  u16 *WT_UQ, *WT_UK, *WT_UV, *WT_OUT, *WT_UP, *WT_DOWN, *CQ, *CKV, *KR, *GA, *GB;
  float *CS, *SN;
  u16 *WT_IN, *H, *AQ, *KA, *VAT, *IXQ, *IXK;
  float* IXW;
  unsigned long long* SEL;
  u16 *QB, *KB, *VBT_P, *VBT_S;
  u16 *H2, *U;
};

DI int otid() { int t = threadIdx.x; asm volatile("" : "+v"(t)); return t; }
DI unsigned cvtpk(float lo, float hi) {
  f32x2 v = {lo, hi};
  bf16x2_t b = __builtin_convertvector(v, bf16x2_t);
  return __builtin_bit_cast(unsigned, b);
}
DI u16 f2bf(float x) { return (u16)(cvtpk(x, 0.f) & 0xffffu); }
DI float bf2f(u16 b) { return __uint_as_float(((unsigned)b) << 16); }
DI float bflo(unsigned w) { return __uint_as_float(w << 16); }
DI float bfhi(unsigned w) { return __uint_as_float(w & 0xffff0000u); }
DI float dot2bf(unsigned a, unsigned b, float c) {
  return __builtin_amdgcn_fdot2_f32_bf16(__builtin_bit_cast(bf16x2_t, a), __builtin_bit_cast(bf16x2_t, b), c, false);
}
DI float wave_sum(float v) {
#pragma unroll
  for (int o = 32; o > 0; o >>= 1) v += __shfl_xor(v, o);
  return v;
}
DI int qpos_of(int t) { return t < MP ? t : 1024 + ((t - MP) & 15); }
DI int krow_of(int t) { return t < MP ? t : MP + ((t - MP) >> 4) * SK + 1024 + ((t - MP) & 15); }
DI float inv_freq(int i) { return exp2f(-(float)i * 0.41524101186092029f); }

DI void transpose_tile(const float* __restrict__ W, int K, int N, u16* __restrict__ Wt, int tile, float* s  ) {
  const int nkt = K >> 6;
  const int kt = tile % nkt, nt = tile / nkt;
  const int k0 = kt << 6, n0 = nt << 6;
  const int tid = otid();
  const int c = tid & 63, r0 = tid >> 6;
  __syncthreads();
#pragma unroll
  for (int i = 0; i < 16; ++i) {
    int r = i * 4 + r0;
    float v = (n0 + c < N) ? W[(size_t)(k0 + r) * N + n0 + c] : 0.f;
    s[r * 65 + c] = v;
  }
  __syncthreads();
  const int kp = (tid & 31) * 2, rr0 = tid >> 5;
#pragma unroll
  for (int i = 0; i < 8; ++i) {
    int rr = i * 8 + rr0;
    unsigned pk = cvtpk(s[kp * 65 + rr], s[(kp + 1) * 65 + rr]);
    *(unsigned*)(Wt + (size_t)(n0 + rr) * K + k0 + kp) = pk;
  }
}

DI void rms_row_2048(const float* __restrict__ x, const float* __restrict__ g, u16* __restrict__ out, int lane) {
  f32x4 v[8];
  float ss = 0.f;
#pragma unroll
  for (int i = 0; i < 8; ++i) {
    v[i] = *(const f32x4*)(x + i * 256 + lane * 4);
    ss += v[i][0] * v[i][0] + v[i][1] * v[i][1] + v[i][2] * v[i][2] + v[i][3] * v[i][3];
  }
  ss = wave_sum(ss);
  float r = rsqrtf(ss * (1.f / 2048.f) + 1e-6f);
#pragma unroll
  for (int i = 0; i < 8; ++i) {
    f32x4 gg = *(const f32x4*)(g + i * 256 + lane * 4);
    u32x2 o;
    o[0] = cvtpk(v[i][0] * r * gg[0], v[i][1] * r * gg[1]);
    o[1] = cvtpk(v[i][2] * r * gg[2], v[i][3] * r * gg[3]);
    *(u32x2*)(out + i * 256 + lane * 4) = o;
  }
}

enum { EPI_IN = 0, EPI_QB, EPI_BF16, EPI_VT, EPI_RES, EPI_RELU2, EPI_ACC };
constexpr int LSTR = 72;

template <int EPI>
DI void gemm_epilogue(const Params& p, f32x4 (&acc)[4][4], int m0, int n0, int wr, int wc, int fr, int fq, u16* Cb, int ldc) {
  const int cw = n0 + wc * 64;
#pragma unroll
  for (int m = 0; m < 4; ++m) {
    const int rb = m0 + wr * 64 + m * 16 + fq * 4;
    if (EPI == EPI_QB) {
      const int within = cw % 192;
      if (within == 128) {
#pragma unroll
        for (int n = 0; n < 2; ++n) {
          const int i = n * 16 + fr;
#pragma unroll
          for (int j = 0; j < 4; ++j) {
            const int row = rb + j;
            const float cs = p.CS[(size_t)row * 32 + i], sn = p.SN[(size_t)row * 32 + i];
            float x1 = acc[m][n][j], x2 = acc[m][n + 2][j];
            p.QB[(size_t)row * 3072 + cw + i] = f2bf(x1 * cs - x2 * sn);
            p.QB[(size_t)row * 3072 + cw + i + 32] = f2bf(x1 * sn + x2 * cs);
          }
        }
        continue;
      }
    }
#pragma unroll
    for (int n = 0; n < 4; ++n) {
      const int colt = cw + n * 16;
      const int col = colt + fr;
      if (EPI == EPI_IN) {
        if (colt >= 4096 && colt < 6144 && rb < MP) {
          u32x2 pk;
          pk[0] = cvtpk(acc[m][n][0], acc[m][n][1]);
          pk[1] = cvtpk(acc[m][n][2], acc[m][n][3]);
          *(u32x2*)(p.VAT + (size_t)(col - 4096) * MP + rb) = pk;
        }
      }
      if (EPI == EPI_VT) {
        u32x2 pk;
        pk[0] = cvtpk(acc[m][n][0], acc[m][n][1]);
        pk[1] = cvtpk(acc[m][n][2], acc[m][n][3]);
        u16* dst;
        if (rb < MP) dst = p.VBT_P + (size_t)col * MP + rb;
        else { int r2 = rb - MP; int b = r2 / SK; int s = r2 - b * SK; dst = p.VBT_S + ((size_t)b * 2048 + col) * VSS + s; }
        *(u32x2*)dst = pk;
        continue;
      }
#pragma unroll
      for (int j = 0; j < 4; ++j) {
        const int row = rb + j;
        const float v = acc[m][n][j];
        if (EPI == EPI_IN) {
          if (colt < 2048) p.AQ[(size_t)row * 2048 + col] = f2bf(v);
          else if (colt < 4096) {
            int c = col - 2048;
            if (row < MP) { p.out[O_AKP + (size_t)row * 2048 + c] = v; p.KA[(size_t)row * 2048 + c] = f2bf(v); }
            else p.out[O_AKS + (size_t)(row - MP) * 2048 + c] = v;
          } else if (colt < 6144) {
            int c = col - 4096;
            if (row < MP) p.out[O_AVP + (size_t)row * 2048 + c] = v;
            else p.out[O_AVS + (size_t)(row - MP) * 2048 + c] = v;
          } else if (colt < 7168) p.IXQ[(size_t)row * 1024 + (col - 6144)] = f2bf(v);
          else if (colt < 7232) {
            int c = col - 7168;
            if (row < MP) p.out[O_IDXP + (size_t)row * 64 + c] = v; else p.out[O_IDXS + (size_t)(row - MP) * 64 + c] = v;
            p.IXK[(size_t)krow_of(row) * 64 + c] = f2bf(v);
          } else if (colt < 7248) p.IXW[(size_t)row * 16 + (col - 7232)] = v * 0.25f;
          else if (colt < 8080) p.out[O_Y + (size_t)row * ZRW + (col - 7248)] = v;
          else if (colt < 10128) p.GA[(size_t)row * 2048 + (col - 8080)] = f2bf(1.f / (1.f + __expf(-v)));
          else if (colt < INC) p.GB[(size_t)row * 2048 + (col - 10128)] = f2bf(1.f / (1.f + __expf(-v)));
        } else if (EPI == EPI_QB || EPI == EPI_BF16) {
          Cb[(size_t)row * ldc + col] = f2bf(v);
        } else if (EPI == EPI_RES) {
          float xv = row < MP ? p.x_p[(size_t)row * 2048 + col] : p.x_s[(size_t)(row - MP) * 2048 + col];
          p.out[O_Y + (size_t)row * 2048 + col] = xv + v;
        } else if (EPI == EPI_RELU2) {
          float r = fmaxf(v, 0.f);
          p.U[(size_t)row * DFF + col] = f2bf(r * r);
        } else if (EPI == EPI_ACC) {
          p.out[O_Y + (size_t)row * 2048 + col] += v;
        }
      }
    }
  }
}

template <int EPI>
DI void gemm_tile(const Params& p, const u16* __restrict__ A, int lda, const u16* __restrict__ Bt, int ldb, int K, int m0, int n0,
                  char* smem, u16* Cb, int ldc) {
  u16* sA = (u16*)smem;
  u16* sB = sA + 2 * 128 * LSTR;
  const int tid = otid(), lane = tid & 63, w = tid >> 6;
  const int wr = w >> 1, wc = w & 1, fr = lane & 15, fq = lane >> 4;
  f32x4 acc[4][4];
#pragma unroll
  for (int m = 0; m < 4; ++m)
#pragma unroll
    for (int n = 0; n < 4; ++n) acc[m][n] = (f32x4){0.f, 0.f, 0.f, 0.f};
  u32x4 ra[4], rb[4];
  const int lr = tid >> 3, lk = (tid & 7) * 8;
  const u16* Ag = A + (size_t)(m0 + lr) * lda + lk;
  const u16* Bg = Bt + (size_t)(n0 + lr) * ldb + lk;
  const int nk = K >> 6;
  __syncthreads();
#pragma unroll
  for (int i = 0; i < 4; ++i) {
    ra[i] = *(const u32x4*)(Ag + (size_t)(i * 32) * lda);
    rb[i] = *(const u32x4*)(Bg + (size_t)(i * 32) * ldb);
  }
#pragma unroll
  for (int i = 0; i < 4; ++i) {
    *(u32x4*)(sA + (lr + i * 32) * LSTR + lk) = ra[i];
    *(u32x4*)(sB + (lr + i * 32) * LSTR + lk) = rb[i];
  }
  __syncthreads();
  for (int kt = 0; kt < nk; ++kt) {
    const int buf = kt & 1;
    const bool more = kt + 1 < nk;
    if (more) {
      const int k0 = (kt + 1) << 6;
#pragma unroll
      for (int i = 0; i < 4; ++i) {
        ra[i] = *(const u32x4*)(Ag + (size_t)(i * 32) * lda + k0);
        rb[i] = *(const u32x4*)(Bg + (size_t)(i * 32) * ldb + k0);
      }
    }
    const u16* cA = sA + buf * 128 * LSTR + (wr * 64 + fr) * LSTR + fq * 8;
    const u16* cB = sB + buf * 128 * LSTR + (wc * 64 + fr) * LSTR + fq * 8;
#pragma unroll
    for (int ks = 0; ks < 2; ++ks) {
      bf16x8 af[4], bfr[4];
#pragma unroll
      for (int m = 0; m < 4; ++m) af[m] = *(const bf16x8*)(cA + m * 16 * LSTR + ks * 32);
#pragma unroll
      for (int n = 0; n < 4; ++n) bfr[n] = *(const bf16x8*)(cB + n * 16 * LSTR + ks * 32);
#pragma unroll
      for (int m = 0; m < 4; ++m)
#pragma unroll
        for (int n = 0; n < 4; ++n) acc[m][n] = __builtin_amdgcn_mfma_f32_16x16x32_bf16(af[m], bfr[n], acc[m][n], 0, 0, 0);
    }
    if (more) {
      u16* dA = sA + (buf ^ 1) * 128 * LSTR;
      u16* dB = sB + (buf ^ 1) * 128 * LSTR;
#pragma unroll
      for (int i = 0; i < 4; ++i) {
        *(u32x4*)(dA + (lr + i * 32) * LSTR + lk) = ra[i];
        *(u32x4*)(dB + (lr + i * 32) * LSTR + lk) = rb[i];
      }
    }
    __syncthreads();
  }
  gemm_epilogue<EPI>(p, acc, m0, n0, wr, wc, fr, fq, Cb, ldc);
}

template <int EPI>
DI void gemm_phase(const Params& p, const u16* A, int lda, const u16* Bt, int ldb, int K, int mtiles, int ntiles, char* smem, u16* Cb, int ldc,
                   int start, int stride) {
  const int total = mtiles * ntiles;
  const int GM = 8;
  for (int id = start; id < total; id += stride) {
    const int per = GM * ntiles;
    const int g = id / per, rem = id - g * per;
    const int fm = g * GM;
    const int gsz = min(GM, mtiles - fm);
    const int mt = fm + rem % gsz, nt = rem / gsz;
    gemm_tile<EPI>(p, A, lda, Bt, ldb, K, mt * 128, nt * 128, smem, Cb, ldc);
  }
}

DI void post_row(const Params& p, int t, int lane) {
  const float* zr = p.out + O_Y + (size_t)t * ZRW;
  {
    f32x4 a = *(const f32x4*)(zr + lane * 4), b = *(const f32x4*)(zr + 256 + lane * 4);
    float ss = a[0] * a[0] + a[1] * a[1] + a[2] * a[2] + a[3] * a[3] + b[0] * b[0] + b[1] * b[1] + b[2] * b[2] + b[3] * b[3];
    ss = wave_sum(ss);
    float r = rsqrtf(ss * (1.f / 512.f) + 1e-6f);
    f32x4 ga = *(const f32x4*)(p.g_q + lane * 4), gb = *(const f32x4*)(p.g_q + 256 + lane * 4);
    u32x2 o;
    o[0] = cvtpk(a[0] * r * ga[0], a[1] * r * ga[1]); o[1] = cvtpk(a[2] * r * ga[2], a[3] * r * ga[3]);
    *(u32x2*)(p.CQ + (size_t)t * 512 + lane * 4) = o;
    o[0] = cvtpk(b[0] * r * gb[0], b[1] * r * gb[1]); o[1] = cvtpk(b[2] * r * gb[2], b[3] * r * gb[3]);
    *(u32x2*)(p.CQ + (size_t)t * 512 + 256 + lane * 4) = o;
  }
  const int kr_row = krow_of(t);
  {
    f32x4 a = *(const f32x4*)(zr + 512 + lane * 4);
    float ss = a[0] * a[0] + a[1] * a[1] + a[2] * a[2] + a[3] * a[3];
    ss = wave_sum(ss);
    float r = rsqrtf(ss * (1.f / 256.f) + 1e-6f);
    f32x4 g = *(const f32x4*)(p.g_kv + lane * 4);
    f32x4 o = {a[0] * r * g[0], a[1] * r * g[1], a[2] * r * g[2], a[3] * r * g[3]};
    float* od = t < MP ? p.out + O_CKVP + (size_t)t * 256 : p.out + O_CKVS + (size_t)(t - MP) * 256;
    *(f32x4*)(od + lane * 4) = o;
    u32x2 ob; ob[0] = cvtpk(o[0], o[1]); ob[1] = cvtpk(o[2], o[3]);
    *(u32x2*)(p.CKV + (size_t)kr_row * 256 + lane * 4) = ob;
  }
  if (lane < 32) {
    float x1 = zr[768 + lane], x2 = zr[768 + 32 + lane];
    float ang = (float)qpos_of(t) * inv_freq(lane);
    float cs = cosf(ang), sn = sinf(ang);
    p.CS[(size_t)t * 32 + lane] = cs; p.SN[(size_t)t * 32 + lane] = sn;
    float o1 = x1 * cs - x2 * sn, o2 = x1 * sn + x2 * cs;
    float* od = t < MP ? p.out + O_KRP + (size_t)t * 64 : p.out + O_KRS + (size_t)(t - MP) * 64;
    od[lane] = o1; od[lane + 32] = o2;
    p.KR[(size_t)kr_row * 64 + lane] = f2bf(o1);
    p.KR[(size_t)kr_row * 64 + lane + 32] = f2bf(o2);
  }
}

DI unsigned fkey(float f) { unsigned u = __float_as_uint(f); return (u & 0x80000000u) ? ~u : (u | 0x80000000u); }

DI void topk_query(const Params& p, int t, char* smem) {
  unsigned* sc = (unsigned*)smem;
  int* hist = (int*)(smem + 65536);
  int* misc = hist + 2048;
  const int tid = otid(), lane = tid & 63, w = tid >> 6, fr = lane & 15, fq = lane >> 4;
  int n; const u16* ixk;
  if (t < MP) { n = 64 * ((t >> 6) + 1); ixk = p.IXK; }
  else { int b = (t - MP) >> 4; n = SK; ixk = p.IXK + (size_t)(MP + b * SK) * 64; }
  unsigned long long* sel = p.SEL + (size_t)t * 256;
  __syncthreads();
  if (n <= 256) {
    if (tid < 4) sel[tid] = (tid < (n >> 6)) ? ~0ull : 0ull;
    return;
  }
  {
    const u16* q = p.IXQ + (size_t)t * 1024 + fr * 64 + fq * 8;
    const bf16x8 a0 = *(const bf16x8*)q, a1 = *(const bf16x8*)(q + 32);
    const f32x4 wv = *(const f32x4*)(p.IXW + (size_t)t * 16 + fq * 4);
    const int ntile = n >> 4;
    for (int kt0 = w; kt0 < ntile; kt0 += 16) {
      bf16x8 b0[4], b1[4];
#pragma unroll
      for (int g = 0; g < 4; ++g) {
        const int kt = min(kt0 + g * 4, ntile - 1);
        const u16* kp = ixk + (size_t)(kt * 16 + fr) * 64 + fq * 8;
        b0[g] = *(const bf16x8*)kp; b1[g] = *(const bf16x8*)(kp + 32);
      }
#pragma unroll
      for (int g = 0; g < 4; ++g) {
        f32x4 c = {0.f, 0.f, 0.f, 0.f};
        c = __builtin_amdgcn_mfma_f32_16x16x32_bf16(a0, b0[g], c, 0, 0, 0);
        c = __builtin_amdgcn_mfma_f32_16x16x32_bf16(a1, b1[g], c, 0, 0, 0);
        float s = fmaxf(c[0], 0.f) * wv[0] + fmaxf(c[1], 0.f) * wv[1] + fmaxf(c[2], 0.f) * wv[2] + fmaxf(c[3], 0.f) * wv[3];
        s += __shfl_xor(s, 16);
        s += __shfl_xor(s, 32);
        const int kt = kt0 + g * 4;
        if (fq == 0 && kt < ntile) sc[kt * 16 + fr] = fkey(s);
      }
    }
  }
  __syncthreads();
  unsigned prefix = 0;
  int remaining = 256;
#pragma unroll 1
  for (int pass = 0; pass < 3; ++pass) {
    const int shift = pass == 0 ? 21 : (pass == 1 ? 10 : 0);
    const int bits = pass == 2 ? 10 : 11;
    const unsigned bmask = (1u << bits) - 1u;
    for (int i = tid; i < 2048; i += NTHREADS) hist[i] = 0;
    __syncthreads();
    const int hs = shift + bits;
    for (int i = tid; i < n; i += NTHREADS) {
      unsigned u = sc[i];
      bool match = (pass == 0) || ((u >> hs) == (prefix >> hs));
      if (match) atomicAdd(&hist[(u >> shift) & bmask], 1);
    }
    __syncthreads();
    const int4 h0 = *(const int4*)&hist[tid * 8], h1 = *(const int4*)&hist[tid * 8 + 4];
    const int s8 = h0.x + h0.y + h0.z + h0.w + h1.x + h1.y + h1.z + h1.w;
    int suf = s8;
#pragma unroll
    for (int d = 1; d < 64; d <<= 1) { int v = __shfl_down(suf, d); if (lane + d < 64) suf += v; }
    if (lane == 0) misc[w] = suf;
    __syncthreads();
    int above = 0;
    for (int ww = w + 1; ww < 4; ++ww) above += misc[ww];
    const int excl = above + suf - s8;
    if (excl < remaining && remaining <= excl + s8) {
      int c = excl, bin = 0, nrem = 0;
#define TK_STEP(val, idx) if (c < remaining && remaining <= c + (val)) { bin = tid * 8 + (idx); nrem = remaining - c; } c += (val);
      TK_STEP(h1.w, 7) TK_STEP(h1.z, 6) TK_STEP(h1.y, 5) TK_STEP(h1.x, 4) TK_STEP(h0.w, 3) TK_STEP(h0.z, 2) TK_STEP(h0.y, 1) TK_STEP(h0.x, 0)
#undef TK_STEP
      misc[4] = bin; misc[5] = nrem;
    }
    __syncthreads();
    prefix |= ((unsigned)misc[4]) << shift;
    remaining = misc[5];
    __syncthreads();
  }
  const unsigned T = prefix;
  const int seg = ((n + 255) >> 8) << 6;
  const int beg = w * seg;
  int ceq = 0;
  for (int i = beg + lane; i < beg + seg; i += 64) {
    bool in = i < n; unsigned u = in ? sc[i] : 0u;
    ceq += __popcll(__ballot(in && u == T));
  }
  if (lane == 0) misc[12 + w] = ceq;
  __syncthreads();
  int oe = 0;
  for (int ww = 0; ww < w; ++ww) oe += misc[12 + ww];
  const unsigned long long lt = (1ull << lane) - 1ull;
  for (int i0 = beg; i0 < beg + seg; i0 += 64) {
    const int i = i0 + lane;
    bool in = i < n; unsigned u = in ? sc[i] : 0u;
    bool g = in && u > T, e = in && u == T;
    unsigned long long be = __ballot(e);
    int pe = oe + __popcll(be & lt);
    unsigned long long sm = __ballot(g || (e && pe < remaining));
    if (lane == 0 && i0 < n) sel[i0 >> 6] = sm;
    oe += __popcll(be);
  }
}

constexpr int KSTR = 200;
constexpr int VSTR = 72;

template <int MODE>
DI void attn_item(const Params& p, int item, char* smem, u16* gdst) {
  constexpr int NKS = MODE == 0 ? 6 : 4;
  u16* sK = (u16*)smem;
  u16* sV = sK + 64 * KSTR;
  float* sBias = (float*)(sV + 128 * VSTR);
  const int tid = otid(), lane = tid & 63, w = tid >> 6, fr = lane & 15, fq = lane >> 4;
  int h, q0, nq, krow0, nkeys, ntiles, myt, b = 0, qpos0;
  const u16* vt; size_t vstride;
  const bool sample = item >= 2048;
  if (!sample) {
    const int i = 127 - (item >> 4);
    h = item & 15; q0 = i * 128; nq = 128; krow0 = 0; nkeys = q0 + 128; ntiles = 2 * i + 2; qpos0 = q0;
    vt = (MODE == 0 ? p.VBT_P : p.VAT) + (size_t)h * 128 * MP; vstride = MP;
    myt = (w < 2) ? ntiles - 1 : ntiles;
  } else {
    const int j = item - 2048; b = j >> 4;
    h = j & 15; q0 = MP + b * 16; nq = 16; krow0 = MP + b * SK; nkeys = SK; ntiles = 17; qpos0 = 1024;
    vt = p.VBT_S + ((size_t)b * 2048 + h * 128) * VSS; vstride = VSS;
    myt = ntiles;
  }
  const int wq0 = w * 32;
  const bool active = wq0 < nq;
  if (MODE == 1) {
    __syncthreads();
    for (int i = tid; i < 257; i += NTHREADS) {
      int rel = i - 128;
      int ret = rel > 0 ? 16 : 0;
      int n = rel < 0 ? -rel : rel;
      float lf = logf((float)max(n, 1) / 8.0f) / 2.772588722239781f * 8.0f;
      int large = min(8 + (int)lf, 15);
      int bk = ret + (n < 8 ? n : large);
      sBias[i] = p.rel[bk * 16 + h] * 1.4426950408889634f;
    }
  }
  bf16x8 qf[2][NKS];
  int qrow[2];
#pragma unroll
  for (int qt = 0; qt < 2; ++qt) {
    const int qr = min(wq0 + qt * 16 + fr, nq - 1);
    qrow[qt] = qr;
    const u16* qp = (MODE == 0) ? p.QB + (size_t)(q0 + qr) * 3072 + h * 192 + fq * 8 : p.AQ + (size_t)(q0 + qr) * 2048 + h * 128 + fq * 8;
#pragma unroll
    for (int ks = 0; ks < NKS; ++ks) qf[qt][ks] = *(const bf16x8*)(qp + ks * 32);
  }
  f32x4 o[2][8];
#pragma unroll
  for (int qt = 0; qt < 2; ++qt)
#pragma unroll
    for (int dt = 0; dt < 8; ++dt) o[qt][dt] = (f32x4){0.f, 0.f, 0.f, 0.f};
  float mrow[2] = {-1e30f, -1e30f}, lrow[2] = {0.f, 0.f};
  const float SC = (MODE == 0 ? 0.07216878364870322f : 0.08838834764831845f) * 1.4426950408889634f;

  for (int jt = 0; jt < ntiles; ++jt) {
    const int key0 = jt * 64;
    unsigned long long mq[2] = {0ull, 0ull};
    if (MODE == 1) {
#pragma unroll
      for (int qt = 0; qt < 2; ++qt) mq[qt] = p.SEL[(size_t)(q0 + qrow[qt]) * 256 + jt];
    }
    __syncthreads();
    if (MODE == 0) {
#pragma unroll
      for (int i = 0; i < 6; ++i) {
        const int c = tid + i * 256;
        const int key = c / 24, part = c - key * 24;
        const size_t kk = (size_t)(min(key0 + key, nkeys - 1) + krow0);
        u32x4 v;
        if (part < 16) v = *(const u32x4*)(p.KB + kk * 2048 + h * 128 + part * 8);
        else v = *(const u32x4*)(p.KR + kk * 64 + (part - 16) * 8);
        *(u32x4*)(sK + key * KSTR + part * 8) = v;
      }
    } else if (!sample) {
#pragma unroll
      for (int i = 0; i < 4; ++i) {
        const int c = tid + i * 256;
        const int key = c >> 4, part = c & 15;
        u32x4 v = *(const u32x4*)(p.KA + (size_t)(key0 + key) * 2048 + h * 128 + part * 8);
        *(u32x4*)(sK + key * KSTR + part * 8) = v;
      }
    }
    if (MODE == 0 || !sample) {
      __builtin_amdgcn_sched_barrier(0);
#pragma unroll
      for (int i = 0; i < 4; ++i) {
        const int c = tid + i * 256;
        const int d = c >> 3, part = c & 7;
        u32x4 v = *(const u32x4*)(vt + (size_t)d * vstride + key0 + part * 8);
        *(u32x4*)(sV + d * VSTR + part * 8) = v;
      }
    } else {
#pragma unroll 2
      for (int i = 0; i < 8; ++i) {
        const int c = tid + i * 256;
        const int key = c >> 5, part = c & 31;
        const int s = key0 + key;
        const int sc_ = min(s, SK - 1);
        const size_t o1 = sc_ < 1024 ? ((size_t)b * 1024 + sc_) * 2048 : ((size_t)b * 16 + (sc_ - 1024)) * 2048;
        const float* kp = (sc_ < 1024 ? p.c_ak : p.out + O_AKS) + o1 + h * 128 + part * 4;
        const float* vp = (sc_ < 1024 ? p.c_av : p.out + O_AVS) + o1 + h * 128 + part * 4;
        f32x4 kv = *(const f32x4*)kp, vv = *(const f32x4*)vp;
        u32x2 kk; kk[0] = cvtpk(kv[0], kv[1]); kk[1] = cvtpk(kv[2], kv[3]);
        *(u32x2*)(sK + key * KSTR + part * 4) = kk;
        const bool ok = s < SK;
#pragma unroll
        for (int e = 0; e < 4; ++e) sV[(part * 4 + e) * VSTR + key] = ok ? f2bf(vv[e]) : (u16)0;
      }
    }
    __syncthreads();
    if (active && jt < myt) {
      f32x4 s[2][4];
#pragma unroll
      for (int qt = 0; qt < 2; ++qt)
#pragma unroll
        for (int kt = 0; kt < 4; ++kt) s[qt][kt] = (f32x4){0.f, 0.f, 0.f, 0.f};
#pragma unroll
      for (int kt = 0; kt < 4; ++kt) {
#pragma unroll
        for (int ks = 0; ks < NKS; ++ks) {
          bf16x8 kf = *(const bf16x8*)(sK + (kt * 16 + fr) * KSTR + ks * 32 + fq * 8);
          s[0][kt] = __builtin_amdgcn_mfma_f32_16x16x32_bf16(kf, qf[0][ks], s[0][kt], 0, 0, 0);
          s[1][kt] = __builtin_amdgcn_mfma_f32_16x16x32_bf16(kf, qf[1][ks], s[1][kt], 0, 0, 0);
        }
      }
      if (MODE == 0) {
#pragma unroll
        for (int qt = 0; qt < 2; ++qt)
#pragma unroll
          for (int kt = 0; kt < 4; ++kt) s[qt][kt] *= SC;
        if (key0 + 64 > nkeys) {
#pragma unroll
          for (int kt = 0; kt < 4; ++kt)
#pragma unroll
            for (int j = 0; j < 4; ++j)
              if (key0 + kt * 16 + fq * 4 + j >= nkeys) { s[0][kt][j] = -1e30f; s[1][kt][j] = -1e30f; }
        }
      } else {
        const bool far = (key0 + 63) - (qpos0 + wq0) <= -128;
        if (far) {
          const float bz = sBias[0];
#pragma unroll
          for (int qt = 0; qt < 2; ++qt)
#pragma unroll
            for (int kt = 0; kt < 4; ++kt) s[qt][kt] = s[qt][kt] * SC + bz;
        } else {
#pragma unroll
          for (int qt = 0; qt < 2; ++qt) {
            const int rb = key0 + fq * 4 - (qpos0 + qrow[qt]) + 128;
#pragma unroll
            for (int kt = 0; kt < 4; ++kt)
#pragma unroll
              for (int j = 0; j < 4; ++j) {
                int r = min(max(rb + kt * 16 + j, 0), 256);
                s[qt][kt][j] = s[qt][kt][j] * SC + sBias[r];
              }
          }
        }
#pragma unroll
        for (int qt = 0; qt < 2; ++qt) {
          const unsigned long long mm = mq[qt] >> (fq * 4);
          const unsigned mlo = (unsigned)mm, mhi = (unsigned)(mm >> 32);
#pragma unroll
          for (int kt = 0; kt < 4; ++kt)
#pragma unroll
            for (int j = 0; j < 4; ++j) {
              const unsigned word = kt < 2 ? mlo : mhi;
              const bool keep = (word >> ((kt & 1) * 16 + j)) & 1u;
              if (!keep) s[qt][kt][j] = -1e30f;
            }
        }
      }
      bf16x8 pf[2][2];
#pragma unroll
      for (int qt = 0; qt < 2; ++qt) {
        float mx = -1e30f;
#pragma unroll
        for (int kt = 0; kt < 4; ++kt)
#pragma unroll
          for (int j = 0; j < 4; ++j) mx = fmaxf(mx, s[qt][kt][j]);
        mx = fmaxf(mx, __shfl_xor(mx, 16));
        mx = fmaxf(mx, __shfl_xor(mx, 32));
        const float mn = fmaxf(mrow[qt], mx);
        const float alpha = exp2f(mrow[qt] - mn);
        mrow[qt] = mn;
        float rs = 0.f;
#pragma unroll
        for (int kt = 0; kt < 4; ++kt)
#pragma unroll
          for (int j = 0; j < 4; ++j) {
            float pv = exp2f(s[qt][kt][j] - mn);
            if (MODE == 1) pv = s[qt][kt][j] > -1e29f ? pv : 0.f;
            s[qt][kt][j] = pv; rs += pv;
          }
        rs += __shfl_xor(rs, 16);
        rs += __shfl_xor(rs, 32);
        lrow[qt] = lrow[qt] * alpha + rs;
#pragma unroll
        for (int dt = 0; dt < 8; ++dt) o[qt][dt] *= alpha;
#pragma unroll
        for (int s2 = 0; s2 < 2; ++s2) {
          u32x4 pk;
          pk[0] = cvtpk(s[qt][2 * s2][0], s[qt][2 * s2][1]);
          pk[1] = cvtpk(s[qt][2 * s2][2], s[qt][2 * s2][3]);
          pk[2] = cvtpk(s[qt][2 * s2 + 1][0], s[qt][2 * s2 + 1][1]);
          pk[3] = cvtpk(s[qt][2 * s2 + 1][2], s[qt][2 * s2 + 1][3]);
          pf[qt][s2] = __builtin_bit_cast(bf16x8, pk);
        }
      }
#pragma unroll
      for (int dt = 0; dt < 8; ++dt) {
#pragma unroll
        for (int s2 = 0; s2 < 2; ++s2) {
          const u16* vp = sV + (dt * 16 + fr) * VSTR + fq * 4;
          u32x2 v0 = *(const u32x2*)(vp + (2 * s2) * 16);
          u32x2 v1 = *(const u32x2*)(vp + (2 * s2 + 1) * 16);
          u32x4 vv = {v0[0], v0[1], v1[0], v1[1]};
          bf16x8 vf = __builtin_bit_cast(bf16x8, vv);
          o[0][dt] = __builtin_amdgcn_mfma_f32_16x16x32_bf16(vf, pf[0][s2], o[0][dt], 0, 0, 0);
          o[1][dt] = __builtin_amdgcn_mfma_f32_16x16x32_bf16(vf, pf[1][s2], o[1][dt], 0, 0, 0);
        }
      }
    }
  }
  if (active) {
#pragma unroll
    for (int qt = 0; qt < 2; ++qt) {
      const int qr = wq0 + qt * 16 + fr;
      if (qr < nq) {
        const float inv = 1.f / lrow[qt];
        const size_t row = (size_t)(q0 + qr);
#pragma unroll
        for (int dt = 0; dt < 8; ++dt) {
          const size_t off = row * 2048 + h * 128 + dt * 16 + fq * 4;
          u32x2 ga = *(const u32x2*)(p.GA + off);
          u32x2 r;
          if (MODE == 0) {
            u32x2 gb = *(const u32x2*)(p.GB + off);
            r[0] = cvtpk(bflo(gb[0]) * o[qt][dt][0] * inv + bflo(ga[0]), bfhi(gb[0]) * o[qt][dt][1] * inv + bfhi(ga[0]));
            r[1] = cvtpk(bflo(gb[1]) * o[qt][dt][2] * inv + bflo(ga[1]), bfhi(gb[1]) * o[qt][dt][3] * inv + bfhi(ga[1]));
          } else {
            r[0] = cvtpk(bflo(ga[0]) * o[qt][dt][0] * inv, bfhi(ga[0]) * o[qt][dt][1] * inv);
            r[1] = cvtpk(bflo(ga[1]) * o[qt][dt][2] * inv, bfhi(ga[1]) * o[qt][dt][3] * inv);
          }
          *(u32x2*)(gdst + off) = r;
        }
      }
    }
  }
}

__global__ void __launch_bounds__(NTHREADS, 2) fwd_megakernel(Params p) {
  extern __shared__ __attribute__((aligned(16))) char smem[];
  cg::grid_group grid = cg::this_grid();
#define IDS const int tid = otid(); const int lane = tid & 63, w = tid >> 6; const int bid = blockIdx.x, nb = gridDim.x; \
  const int gw = bid * 4 + w, ngw = nb * 4; (void)tid; (void)lane; (void)gw; (void)ngw; (void)bid; (void)nb;

#if PH & (1 << 0)
  { IDS
  {
    float* st = (float*)smem;
    for (int t = bid; t < 32 * 192; t += nb) transpose_tile(p.w_in, 2048, INC, p.WT_IN, t, st);
    for (int t = bid; t < 8 * 48; t += nb) transpose_tile(p.w_uq, 512, 3072, p.WT_UQ, t, st);
    for (int t = bid; t < 4 * 32; t += nb) transpose_tile(p.w_uk, 256, 2048, p.WT_UK, t, st);
    for (int t = bid; t < 4 * 32; t += nb) transpose_tile(p.w_uv, 256, 2048, p.WT_UV, t, st);
    for (int t = bid; t < 32 * 32; t += nb) transpose_tile(p.w_out, 2048, 2048, p.WT_OUT, t, st);
    for (int t = bid; t < 32 * 128; t += nb) transpose_tile(p.w_up, 2048, 8192, p.WT_UP, t, st);
    for (int t = bid; t < 128 * 32; t += nb) transpose_tile(p.w_down, 8192, 2048, p.WT_DOWN, t, st);
    for (int r = gw; r < MT; r += ngw) {
      const float* x = r < MP ? p.x_p + (size_t)r * 2048 : p.x_s + (size_t)(r - MP) * 2048;
      rms_row_2048(x, p.g_mix, p.H + (size_t)r * 2048, lane);
    }
    const int gt = bid * NTHREADS + tid, ngt = nb * NTHREADS;
    for (int i = gt; i < 16 * 1024 * 64 / 4; i += ngt) {
      int e = i * 4; int b = e >> 16; int rem = e & 65535; int s = rem >> 6, c = rem & 63;
      size_t dst = (size_t)(MP + b * SK + s) * 64 + c;
      f32x4 a = *(const f32x4*)(p.c_idx + e), k = *(const f32x4*)(p.c_kr + e);
      u32x2 o; o[0] = cvtpk(a[0], a[1]); o[1] = cvtpk(a[2], a[3]);
      *(u32x2*)(p.IXK + dst) = o;
      o[0] = cvtpk(k[0], k[1]); o[1] = cvtpk(k[2], k[3]);
      *(u32x2*)(p.KR + dst) = o;
    }
    for (int i = gt; i < 16 * 1024 * 256 / 4; i += ngt) {
      int e = i * 4; int b = e >> 18; int rem = e & 262143; int s = rem >> 8, c = rem & 255;
      size_t dst = (size_t)(MP + b * SK + s) * 256 + c;
      f32x4 a = *(const f32x4*)(p.c_ckv + e);
      u32x2 o; o[0] = cvtpk(a[0], a[1]); o[1] = cvtpk(a[2], a[3]);
      *(u32x2*)(p.CKV + dst) = o;
    }
  }
  }
#endif
  grid.sync();
#if PH & (1 << 1)
  { IDS
  for (int rep = 0; rep < NREP(1); ++rep) gemm_phase<EPI_IN>(p, p.H, 2048, p.WT_IN, 2048, 2048, MT / 128, INP / 128, smem, nullptr, 0, bid, nb);
  }
#endif
  grid.sync();
#if PH & (1 << 2)
  { IDS
  for (int t = gw; t < MT; t += ngw) post_row(p, t, lane);
  for (int rep = 0; rep < NREP(2); ++rep) for (int t = bid; t < MT; t += nb) topk_query(p, t, smem);
  }
#endif
  grid.sync();
#if PH & (1 << 3)
  { IDS
    const int total = 2048 + 256;
    for (int rep = 0; rep < NREP(3); ++rep) {
      u16* gdst = (rep + 1 < NREP(3)) ? (u16*)(p.out + O_Y) : p.GA;
      for (int r = 0;; ++r) {
        int id = (r & 1) ? r * nb + (nb - 1 - bid) : r * nb + bid;
        if (r * nb >= total) break;
        if (id < total) attn_item<1>(p, id, smem, gdst);
      }
    }
  }
#endif
  grid.sync();
#if PH & (1 << 4)
  { IDS
  {
    const int nqb = (MT / 128) * 24, nkb = (KROWS / 128) * 16;
    const int gt = bid * NTHREADS + tid, ngt = nb * NTHREADS;
    for (int i = gt; i < 16 * 2048 * 6; i += ngt) {
      int r = i / 6, c = i - r * 6;
      *(u32x4*)(p.VBT_S + (size_t)r * VSS + SK + c * 8) = (u32x4){0u, 0u, 0u, 0u};
    }
    const int total = nqb + 2 * nkb;
    for (int id = bid; id < total; id += nb) {
      if (id < nqb) gemm_phase<EPI_QB>(p, p.CQ, 512, p.WT_UQ, 512, 512, MT / 128, 24, smem, p.QB, 3072, id, 1 << 30);
      else if (id < nqb + nkb) gemm_phase<EPI_BF16>(p, p.CKV, 256, p.WT_UK, 256, 256, KROWS / 128, 16, smem, p.KB, 2048, id - nqb, 1 << 30);
      else gemm_phase<EPI_VT>(p, p.CKV, 256, p.WT_UV, 256, 256, KROWS / 128, 16, smem, nullptr, 0, id - nqb - nkb, 1 << 30);
    }
  }
  }
#endif
  grid.sync();
#if PH & (1 << 5)
  { IDS
  {
    const int total = 2048 + 256;
    for (int rep = 0; rep < NREP(5); ++rep) {
      u16* gdst = (rep + 1 < NREP(5)) ? (u16*)(p.out + O_Y) : p.GB;
      for (int r = 0;; ++r) {
        int id = (r & 1) ? r * nb + (nb - 1 - bid) : r * nb + bid;
        if (r * nb >= total) break;
        if (id < total) attn_item<0>(p, id, smem, gdst);
      }
    }
  }
  }
#endif
  grid.sync();
#if PH & (1 << 6)
  { IDS
  gemm_phase<EPI_RES>(p, p.GB, 2048, p.WT_OUT, 2048, 2048, MT / 128, 16, smem, nullptr, 0, bid, nb);
  }
#endif
  grid.sync();
#if PH & (1 << 7)
  { IDS
  for (int r = gw; r < MT; r += ngw) rms_row_2048(p.out + O_Y + (size_t)r * 2048, p.g_ffn, p.H2 + (size_t)r * 2048, lane);
  }
#endif
  grid.sync();
#if PH & (1 << 8)
  { IDS
  gemm_phase<EPI_RELU2>(p, p.H2, 2048, p.WT_UP, 2048, 2048, MT / 128, 64, smem, nullptr, 0, bid, nb);
  }
#endif
  grid.sync();
#if PH & (1 << 9)
  { IDS
  gemm_phase<EPI_ACC>(p, p.U, DFF, p.WT_DOWN, DFF, DFF, MT / 128, 16, smem, nullptr, 0, bid, nb);
  }
#endif
  grid.sync();
#if PH & (1 << 10)
  { IDS
  for (int r = gw; r < MT; r += ngw) {
    float* x = p.out + O_Y + (size_t)r * 2048;
    f32x4 v[8];
    float ss = 0.f;
#pragma unroll
    for (int i = 0; i < 8; ++i) {
      v[i] = *(const f32x4*)(x + i * 256 + lane * 4);
      ss += v[i][0] * v[i][0] + v[i][1] * v[i][1] + v[i][2] * v[i][2] + v[i][3] * v[i][3];
    }
    ss = wave_sum(ss);
    float rr = rsqrtf(ss * (1.f / 2048.f) + 1e-6f);
#pragma unroll
    for (int i = 0; i < 8; ++i) {
      f32x4 gg = *(const f32x4*)(p.g_fin + i * 256 + lane * 4);
      f32x4 o = {v[i][0] * rr * gg[0], v[i][1] * rr * gg[1], v[i][2] * rr * gg[2], v[i][3] * rr * gg[3]};
      *(f32x4*)(x + i * 256 + lane * 4) = o;
    }
  }
  }
#endif
}

extern "C" void kernel_launch(void* const* d_in, const int* in_sizes, int n_in, void* d_out, int out_size, void* d_ws, size_t ws_size,
                              hipStream_t stream) {
  static int grid_blocks = 0;
  if (!grid_blocks) {
    int dev = 0, cus = 0, per_cu = 0;
    hipGetDevice(&dev);
    hipDeviceGetAttribute(&cus, hipDeviceAttributeMultiprocessorCount, dev);
    if (hipFuncSetAttribute((const void*)fwd_megakernel, hipFuncAttributeMaxDynamicSharedMemorySize, LDS_BYTES) != hipSuccess)
      fprintf(stderr, "kernel_launch: hipFuncSetAttribute failed\n");
    hipOccupancyMaxActiveBlocksPerMultiprocessor(&per_cu, (const void*)fwd_megakernel, NTHREADS, LDS_BYTES);
    if (per_cu < 1) per_cu = 1;
    if (per_cu > 2) per_cu = 2;
    grid_blocks = cus * per_cu;
  }
  Params p{};
  const float* const* in = (const float* const*)d_in;
  p.x_p = in[0]; p.x_s = in[1]; p.c_ak = in[2]; p.c_av = in[3]; p.c_idx = in[4]; p.c_ckv = in[5]; p.c_kr = in[6]; p.rel = in[7];
  p.g_mix = in[8]; p.w_in = in[9]; p.g_q = in[10]; p.w_uq = in[11]; p.g_kv = in[12]; p.w_uk = in[13]; p.w_uv = in[14]; p.w_out = in[15];
  p.g_ffn = in[16]; p.w_up = in[17]; p.w_down = in[18]; p.g_fin = in[19];
  p.out = (float*)d_out;
  char* ws = (char*)d_ws;
  size_t off = 0;
  auto alloc = [&](size_t bytes) { char* r = ws + off; off += (bytes + 255) & ~(size_t)255; return r; };
  p.WT_UQ = (u16*)alloc((size_t)3072 * 512 * 2);
  p.WT_UK = (u16*)alloc((size_t)2048 * 256 * 2);
  p.WT_UV = (u16*)alloc((size_t)2048 * 256 * 2);
  p.WT_OUT = (u16*)alloc((size_t)2048 * 2048 * 2);
  p.WT_UP = (u16*)alloc((size_t)8192 * 2048 * 2);
  p.WT_DOWN = (u16*)alloc((size_t)2048 * 8192 * 2);
  p.CQ = (u16*)alloc((size_t)MT * 512 * 2);
  p.CKV = (u16*)alloc((size_t)KROWS * 256 * 2);
  p.KR = (u16*)alloc((size_t)KROWS * 64 * 2);
  p.GA = (u16*)alloc((size_t)MT * 2048 * 2);
  p.GB = (u16*)alloc((size_t)MT * 2048 * 2);
  p.CS = (float*)alloc((size_t)MT * 32 * 4);
  p.SN = (float*)alloc((size_t)MT * 32 * 4);
  const size_t ubase = off;
  p.WT_IN = (u16*)alloc((size_t)INP * 2048 * 2);
  p.H = (u16*)alloc((size_t)MT * 2048 * 2);
  p.AQ = (u16*)alloc((size_t)MT * 2048 * 2);
  p.KA = (u16*)alloc((size_t)MP * 2048 * 2);
  p.VAT = (u16*)alloc((size_t)MP * 2048 * 2);
  p.IXQ = (u16*)alloc((size_t)MT * 1024 * 2);
  p.IXK = (u16*)alloc((size_t)KROWS * 64 * 2);
  p.SEL = (unsigned long long*)alloc((size_t)MT * 256 * 8);
  p.IXW = (float*)alloc((size_t)MT * 16 * 4);
  const size_t endA = off;
  off = ubase;
  p.QB = (u16*)alloc((size_t)MT * 3072 * 2);
  p.KB = (u16*)alloc((size_t)KROWS * 2048 * 2);
  p.VBT_P = (u16*)alloc((size_t)2048 * MP * 2);
  p.VBT_S = (u16*)alloc((size_t)16 * 2048 * VSS * 2);
  const size_t endB = off;
  off = ubase;
  p.H2 = (u16*)alloc((size_t)MT * 2048 * 2);
  p.U = (u16*)alloc((size_t)MT * DFF * 2);
  const size_t endC = off;
  size_t need = endA > endB ? endA : endB;
  if (endC > need) need = endC;
  if (need > ws_size) { fprintf(stderr, "kernel_launch: workspace too small: need %zu have %zu\n", need, ws_size); return; }
  void* args[] = {&p};
  hipError_t e = hipLaunchCooperativeKernel((const void*)fwd_megakernel, dim3(grid_blocks), dim3(NTHREADS), args, LDS_BYTES, stream);
  if (e != hipSuccess) fprintf(stderr, "cooperative launch failed: %s (grid %d)\n", hipGetErrorString(e), grid_blocks);
}
```

```cpp
#include <hip/hip_runtime.h>
#include <hip/hip_cooperative_groups.h>
#include <cstdio>
#include <cstdint>
namespace cg = cooperative_groups;

typedef unsigned short u16;
typedef __attribute__((ext_vector_type(8))) short bf16x8;
typedef __attribute__((ext_vector_type(4))) short bf16x4;
typedef __attribute__((ext_vector_type(4))) float f32x4;
typedef __attribute__((ext_vector_type(2))) float f32x2;
typedef __attribute__((ext_vector_type(2))) __bf16 bf16x2_t;
typedef __attribute__((ext_vector_type(4))) unsigned u32x4;
typedef __attribute__((ext_vector_type(2))) unsigned u32x2;

#define DI __device__ __forceinline__

constexpr int MP = 16384;
constexpr int MS = 256;
constexpr int MT = MP + MS;
constexpr int DM = 2048;
constexpr int INC = 12176;
constexpr int INP = 12288;
constexpr int SK = 1040;
constexpr int KROWS = MP + 16 * SK;
constexpr int VSS = 1088;
constexpr int DFF = 8192;
constexpr int ZRW = 832;
#ifndef PH
#define PH 0x7ff
#endif
#ifndef REP
#define REP 0
#endif
#define NREP(k) (((REP >> (k)) & 1) + 1)
constexpr int NTHREADS = 256;
constexpr int LDS_BYTES = 75776;

constexpr size_t O_Y = 0;
constexpr size_t O_AKP = 34078720;
constexpr size_t O_AVP = 67633152;
constexpr size_t O_IDXP = 101187584;
constexpr size_t O_CKVP = 102236160;
constexpr size_t O_KRP = 106430464;
constexpr size_t O_AKS = 107479040;
constexpr size_t O_AVS = 108003328;
constexpr size_t O_IDXS = 108527616;
constexpr size_t O_CKVS = 108544000;
constexpr size_t O_KRS = 108609536;

struct Params {
  const float *x_p, *x_s, *c_ak, *c_av, *c_idx, *c_ckv, *c_kr, *rel, *g_mix, *w_in, *g_q, *w_uq, *g_kv, *w_uk, *w_uv, *w_out, *g_ffn, *w_up, *w_down, *g_fin;
  float* out;
  u16 *WT_UQ, *WT_UK, *WT_UV, *WT_OUT, *WT_UP, *WT_DOWN, *CQ, *CKV, *KR, *GA, *GB;
  float *CS, *SN;
  u16 *WT_IN, *H, *AQ, *KA, *VAT, *IXQ, *IXK;
  float* IXW;
  unsigned long long* SEL;
  u16 *QB, *KB, *VBT_P, *VBT_S;
  u16 *H2, *U;
};

DI int otid() { int t = threadIdx.x; asm volatile("" : "+v"(t)); return t; }
DI unsigned cvtpk(float lo, float hi) {
  f32x2 v = {lo, hi};
  bf16x2_t b = __builtin_convertvector(v, bf16x2_t);
  return __builtin_bit_cast(unsigned, b);
}
DI u16 f2bf(float x) { return (u16)(cvtpk(x, 0.f) & 0xffffu); }
DI float bf2f(u16 b) { return __uint_as_float(((unsigned)b) << 16); }
DI float bflo(unsigned w) { return __uint_as_float(w << 16); }
DI float bfhi(unsigned w) { return __uint_as_float(w & 0xffff0000u); }
DI float dot2bf(unsigned a, unsigned b, float c) {
  return __builtin_amdgcn_fdot2_f32_bf16(__builtin_bit_cast(bf16x2_t, a), __builtin_bit_cast(bf16x2_t, b), c, false);
}
DI float wave_sum(float v) {
#pragma unroll
  for (int o = 32; o > 0; o >>= 1) v += __shfl_xor(v, o);
  return v;
}
DI int qpos_of(int t) { return t < MP ? t : 1024 + ((t - MP) & 15); }
DI int krow_of(int t) { return t < MP ? t : MP + ((t - MP) >> 4) * SK + 1024 + ((t - MP) & 15); }
DI float inv_freq(int i) { return exp2f(-(float)i * 0.41524101186092029f); }

DI void transpose_tile(const float* __restrict__ W, int K, int N, u16* __restrict__ Wt, int tile, float* s  ) {
  const int nkt = K >> 6;
  const int kt = tile % nkt, nt = tile / nkt;
  const int k0 = kt << 6, n0 = nt << 6;
  const int tid = otid();
  const int c = tid & 63, r0 = tid >> 6;
  __syncthreads();
#pragma unroll
  for (int i = 0; i < 16; ++i) {
    int r = i * 4 + r0;
    float v = (n0 + c < N) ? W[(size_t)(k0 + r) * N + n0 + c] : 0.f;
    s[r * 65 + c] = v;
  }
  __syncthreads();
  const int kp = (tid & 31) * 2, rr0 = tid >> 5;
#pragma unroll
  for (int i = 0; i < 8; ++i) {
    int rr = i * 8 + rr0;
    unsigned pk = cvtpk(s[kp * 65 + rr], s[(kp + 1) * 65 + rr]);
    *(unsigned*)(Wt + (size_t)(n0 + rr) * K + k0 + kp) = pk;
  }
}

DI void rms_row_2048(const float* __restrict__ x, const float* __restrict__ g, u16* __restrict__ out, int lane) {
  f32x4 v[8];
  float ss = 0.f;
#pragma unroll
  for (int i = 0; i < 8; ++i) {
    v[i] = *(const f32x4*)(x + i * 256 + lane * 4);
    ss += v[i][0] * v[i][0] + v[i][1] * v[i][1] + v[i][2] * v[i][2] + v[i][3] * v[i][3];
  }
  ss = wave_sum(ss);
  float r = rsqrtf(ss * (1.f / 2048.f) + 1e-6f);
#pragma unroll
  for (int i = 0; i < 8; ++i) {
    f32x4 gg = *(const f32x4*)(g + i * 256 + lane * 4);
    u32x2 o;
    o[0] = cvtpk(v[i][0] * r * gg[0], v[i][1] * r * gg[1]);
    o[1] = cvtpk(v[i][2] * r * gg[2], v[i][3] * r * gg[3]);
    *(u32x2*)(out + i * 256 + lane * 4) = o;
  }
}

enum { EPI_IN = 0, EPI_QB, EPI_BF16, EPI_VT, EPI_RES, EPI_RELU2, EPI_ACC };
constexpr int LSTR = 72;

template <int EPI>
DI void gemm_epilogue(const Params& p, f32x4 (&acc)[8][4], int m0, int n0, int wr, int wc, int fr, int fq, u16* Cb, int ldc) {
  const int cw = n0 + wc * 64;
#pragma clang loop unroll(full)
  for (int m = 0; m < 8; ++m) {
    const int rb = m0 + wr * 128 + m * 16 + fq * 4;
    if (EPI == EPI_QB) {
      const int within = cw % 192;
      if (within == 128) {
#pragma clang loop unroll(full)
        for (int n = 0; n < 2; ++n) {
          const int i = n * 16 + fr;
#pragma clang loop unroll(full)
          for (int j = 0; j < 4; ++j) {
            const int row = rb + j;
            const float cs = p.CS[(size_t)row * 32 + i], sn = p.SN[(size_t)row * 32 + i];
            float x1 = acc[m][n][j], x2 = acc[m][n + 2][j];
            p.QB[(size_t)row * 3072 + cw + i] = f2bf(x1 * cs - x2 * sn);
            p.QB[(size_t)row * 3072 + cw + i + 32] = f2bf(x1 * sn + x2 * cs);
          }
        }
        continue;
      }
    }
#pragma clang loop unroll(full)
    for (int n = 0; n < 4; ++n) {
      const int colt = cw + n * 16;
      const int col = colt + fr;
      if (EPI == EPI_IN) {
        if (colt >= 4096 && colt < 6144 && rb < MP) {
          u32x2 pk;
          pk[0] = cvtpk(acc[m][n][0], acc[m][n][1]);
          pk[1] = cvtpk(acc[m][n][2], acc[m][n][3]);
          *(u32x2*)(p.VAT + (size_t)(col - 4096) * MP + rb) = pk;
        }
      }
      if (EPI == EPI_VT) {
        u32x2 pk;
        pk[0] = cvtpk(acc[m][n][0], acc[m][n][1]);
        pk[1] = cvtpk(acc[m][n][2], acc[m][n][3]);
        u16* dst;
        if (rb < MP) dst = p.VBT_P + (size_t)col * MP + rb;
        else { int r2 = rb - MP; int b = r2 / SK; int s = r2 - b * SK; dst = p.VBT_S + ((size_t)b * 2048 + col) * VSS + s; }
        *(u32x2*)dst = pk;
        continue;
      }
#pragma clang loop unroll(full)
      for (int j = 0; j < 4; ++j) {
        const int row = rb + j;
        const float v = acc[m][n][j];
        if (EPI == EPI_IN) {
          if (colt < 2048) p.AQ[(size_t)row * 2048 + col] = f2bf(v);
          else if (colt < 4096) {
            int c = col - 2048;
            if (row < MP) { p.out[O_AKP + (size_t)row * 2048 + c] = v; p.KA[(size_t)row * 2048 + c] = f2bf(v); }
            else p.out[O_AKS + (size_t)(row - MP) * 2048 + c] = v;
          } else if (colt < 6144) {
            int c = col - 4096;
            if (row < MP) p.out[O_AVP + (size_t)row * 2048 + c] = v;
            else p.out[O_AVS + (size_t)(row - MP) * 2048 + c] = v;
          } else if (colt < 7168) p.IXQ[(size_t)row * 1024 + (col - 6144)] = f2bf(v);
          else if (colt < 7232) {
            int c = col - 7168;
            if (row < MP) p.out[O_IDXP + (size_t)row * 64 + c] = v; else p.out[O_IDXS + (size_t)(row - MP) * 64 + c] = v;
            p.IXK[(size_t)krow_of(row) * 64 + c] = f2bf(v);
          } else if (colt < 7248) p.IXW[(size_t)row * 16 + (col - 7232)] = v * 0.25f;
          else if (colt < 8080) p.out[O_Y + (size_t)row * ZRW + (col - 7248)] = v;
          else if (colt < 10128) p.GA[(size_t)row * 2048 + (col - 8080)] = f2bf(1.f / (1.f + __expf(-v)));
          else if (colt < INC) p.GB[(size_t)row * 2048 + (col - 10128)] = f2bf(1.f / (1.f + __expf(-v)));
        } else if (EPI == EPI_QB || EPI == EPI_BF16) {
          Cb[(size_t)row * ldc + col] = f2bf(v);
        } else if (EPI == EPI_RES) {
          float xv = row < MP ? p.x_p[(size_t)row * 2048 + col] : p.x_s[(size_t)(row - MP) * 2048 + col];
          p.out[O_Y + (size_t)row * 2048 + col] = xv + v;
        } else if (EPI == EPI_RELU2) {
          float r = fmaxf(v, 0.f);
          p.U[(size_t)row * DFF + col] = f2bf(r * r);
        } else if (EPI == EPI_ACC) {
          p.out[O_Y + (size_t)row * 2048 + col] += v;
        }
      }
    }
  }
}

template <int EPI>
DI void gemm_tile(const Params& p, const u16* __restrict__ A, int lda, const u16* __restrict__ Bt, int ldb, int K, int m0, int n0,
                  char* smem, u16* Cb, int ldc) {
  u16* sA = (u16*)smem;
  u16* sB = sA + 256 * LSTR;
  const int tid = otid(), lane = tid & 63, w = tid >> 6;
  const int wr = w >> 1, wc = w & 1, fr = lane & 15, fq = lane >> 4;
  f32x4 acc[8][4];
#pragma unroll
  for (int m = 0; m < 8; ++m)
#pragma unroll
    for (int n = 0; n < 4; ++n) acc[m][n] = (f32x4){0.f, 0.f, 0.f, 0.f};
  const int lr = tid >> 3, lk = (tid & 7) * 8;
  const u16* Ag = A + (size_t)(m0 + lr) * lda + lk;
  const u16* Bg = Bt + (size_t)(n0 + lr) * ldb + lk;
  const int nk = K >> 6;
  const u16* cA = sA + (wr * 128 + fr) * LSTR + fq * 8;
  const u16* cB = sB + (wc * 64 + fr) * LSTR + fq * 8;
  for (int kt = 0; kt < nk; ++kt) {
    const int k0 = kt << 6;
    __syncthreads();
    {
      u32x4 ra[8], rb[4];
#pragma unroll
      for (int i = 0; i < 8; ++i) ra[i] = *(const u32x4*)(Ag + (size_t)(i * 32) * lda + k0);
#pragma unroll
      for (int i = 0; i < 4; ++i) rb[i] = *(const u32x4*)(Bg + (size_t)(i * 32) * ldb + k0);
#pragma unroll
      for (int i = 0; i < 8; ++i) *(u32x4*)(sA + (lr + i * 32) * LSTR + lk) = ra[i];
#pragma unroll
      for (int i = 0; i < 4; ++i) *(u32x4*)(sB + (lr + i * 32) * LSTR + lk) = rb[i];
    }
    __syncthreads();
#pragma unroll
    for (int ks = 0; ks < 2; ++ks) {
      bf16x8 bfr[4];
#pragma unroll
      for (int n = 0; n < 4; ++n) bfr[n] = *(const bf16x8*)(cB + n * 16 * LSTR + ks * 32);
#pragma unroll
      for (int mh = 0; mh < 2; ++mh) {
        bf16x8 af[4];
#pragma unroll
        for (int m = 0; m < 4; ++m) af[m] = *(const bf16x8*)(cA + (mh * 4 + m) * 16 * LSTR + ks * 32);
#pragma unroll
        for (int m = 0; m < 4; ++m)
#pragma unroll
          for (int n = 0; n < 4; ++n)
            acc[mh * 4 + m][n] = __builtin_amdgcn_mfma_f32_16x16x32_bf16(af[m], bfr[n], acc[mh * 4 + m][n], 0, 0, 0);
      }
    }
  }
  gemm_epilogue<EPI>(p, acc, m0, n0, wr, wc, fr, fq, Cb, ldc);
}

template <int EPI>
DI void gemm_phase(const Params& p, const u16* A, int lda, const u16* Bt, int ldb, int K, int mtiles, int ntiles, char* smem, u16* Cb, int ldc,
                   int start, int stride) {
  const int total = mtiles * ntiles;
  const int GM = 8;
  for (int id = start; id < total; id += stride) {
    const int per = GM * ntiles;
    const int g = id / per, rem = id - g * per;
    const int fm = g * GM;
    const int gsz = min(GM, mtiles - fm);
    const int mt = fm + rem % gsz, nt = rem / gsz;
    gemm_tile<EPI>(p, A, lda, Bt, ldb, K, mt * 256, nt * 128, smem, Cb, ldc);
  }
}

DI void post_row(const Params& p, int t, int lane) {
  const float* zr = p.out + O_Y + (size_t)t * ZRW;
  {
    f32x4 a = *(const f32x4*)(zr + lane * 4), b = *(const f32x4*)(zr + 256 + lane * 4);
    float ss = a[0] * a[0] + a[1] * a[1] + a[2] * a[2] + a[3] * a[3] + b[0] * b[0] + b[1] * b[1] + b[2] * b[2] + b[3] * b[3];
    ss = wave_sum(ss);
    float r = rsqrtf(ss * (1.f / 512.f) + 1e-6f);
    f32x4 ga = *(const f32x4*)(p.g_q + lane * 4), gb = *(const f32x4*)(p.g_q + 256 + lane * 4);
    u32x2 o;
    o[0] = cvtpk(a[0] * r * ga[0], a[1] * r * ga[1]); o[1] = cvtpk(a[2] * r * ga[2], a[3] * r * ga[3]);
    *(u32x2*)(p.CQ + (size_t)t * 512 + lane * 4) = o;
    o[0] = cvtpk(b[0] * r * gb[0], b[1] * r * gb[1]); o[1] = cvtpk(b[2] * r * gb[2], b[3] * r * gb[3]);
    *(u32x2*)(p.CQ + (size_t)t * 512 + 256 + lane * 4) = o;
  }
  const int kr_row = krow_of(t);
  {
    f32x4 a = *(const f32x4*)(zr + 512 + lane * 4);
    float ss = a[0] * a[0] + a[1] * a[1] + a[2] * a[2] + a[3] * a[3];
    ss = wave_sum(ss);
    float r = rsqrtf(ss * (1.f / 256.f) + 1e-6f);
    f32x4 g = *(const f32x4*)(p.g_kv + lane * 4);
    f32x4 o = {a[0] * r * g[0], a[1] * r * g[1], a[2] * r * g[2], a[3] * r * g[3]};
    float* od = t < MP ? p.out + O_CKVP + (size_t)t * 256 : p.out + O_CKVS + (size_t)(t - MP) * 256;
    *(f32x4*)(od + lane * 4) = o;
    u32x2 ob; ob[0] = cvtpk(o[0], o[1]); ob[1] = cvtpk(o[2], o[3]);
    *(u32x2*)(p.CKV + (size_t)kr_row * 256 + lane * 4) = ob;
  }
  if (lane < 32) {
    float x1 = zr[768 + lane], x2 = zr[768 + 32 + lane];
    float ang = (float)qpos_of(t) * inv_freq(lane);
    float cs = cosf(ang), sn = sinf(ang);
    p.CS[(size_t)t * 32 + lane] = cs; p.SN[(size_t)t * 32 + lane] = sn;
    float o1 = x1 * cs - x2 * sn, o2 = x1 * sn + x2 * cs;
    float* od = t < MP ? p.out + O_KRP + (size_t)t * 64 : p.out + O_KRS + (size_t)(t - MP) * 64;
    od[lane] = o1; od[lane + 32] = o2;
    p.KR[(size_t)kr_row * 64 + lane] = f2bf(o1);
    p.KR[(size_t)kr_row * 64 + lane + 32] = f2bf(o2);
  }
}

template <int CTRL> DI float dpp_add(float v) {
  int sft = __builtin_amdgcn_update_dpp(0, __float_as_int(v), CTRL, 0xf, 0xf, true);
  return v + __int_as_float(sft);
}
DI float row16_sum(float v) { v = dpp_add<0x111>(v); v = dpp_add<0x112>(v); v = dpp_add<0x114>(v); v = dpp_add<0x118>(v); return v; }
DI unsigned fkey(float f) { unsigned u = __float_as_uint(f); return (u & 0x80000000u) ? ~u : (u | 0x80000000u); }

DI void topk_query(const Params& p, int t, char* smem) {
  unsigned* sc = (unsigned*)smem;
  int* hist = (int*)(smem + 65536);
  int* misc = hist + 2048;
  const int tid = otid(), lane = tid & 63, w = tid >> 6, fr = lane & 15, fq = lane >> 4;
  int n; const u16* ixk;
  if (t < MP) { n = 64 * ((t >> 6) + 1); ixk = p.IXK; }
  else { int b = (t - MP) >> 4; n = SK; ixk = p.IXK + (size_t)(MP + b * SK) * 64; }
  unsigned long long* sel = p.SEL + (size_t)t * 256;
  __syncthreads();
  if (n <= 256) {
    if (tid < 4) sel[tid] = (tid < (n >> 6)) ? ~0ull : 0ull;
    return;
  }
  *(int4*)&hist[tid * 8] = make_int4(0, 0, 0, 0);
  *(int4*)&hist[tid * 8 + 4] = make_int4(0, 0, 0, 0);
  __syncthreads();
  {
    const u16* q = p.IXQ + (size_t)t * 1024 + fr * 64 + fq * 8;
    const bf16x8 a0 = *(const bf16x8*)q, a1 = *(const bf16x8*)(q + 32);
    const f32x4 wv = *(const f32x4*)(p.IXW + (size_t)t * 16 + fq * 4);
    const int ntile = n >> 4;
    for (int kt0 = w; kt0 < ntile; kt0 += 32) {
      bf16x8 b0[8], b1[8];
#pragma unroll
      for (int g = 0; g < 8; ++g) {
        const int kt = min(kt0 + g * 4, ntile - 1);
        const u16* kp = ixk + (size_t)(kt * 16 + fr) * 64 + fq * 8;
        b0[g] = *(const bf16x8*)kp; b1[g] = *(const bf16x8*)(kp + 32);
      }
      float pt[8];
#pragma unroll
      for (int g = 0; g < 8; ++g) {
        f32x4 c = {0.f, 0.f, 0.f, 0.f};
        c = __builtin_amdgcn_mfma_f32_16x16x32_bf16(a0, b0[g], c, 0, 0, 0);
        c = __builtin_amdgcn_mfma_f32_16x16x32_bf16(a1, b1[g], c, 0, 0, 0);
        pt[g] = fmaxf(c[0], 0.f) * wv[0] + fmaxf(c[1], 0.f) * wv[1] + fmaxf(c[2], 0.f) * wv[2] + fmaxf(c[3], 0.f) * wv[3];
      }
#pragma unroll
      for (int g = 0; g < 8; g += 2) {
        auto r32 = __builtin_amdgcn_permlane32_swap(__float_as_uint(pt[g]), __float_as_uint(pt[g + 1]), false, false);
        float s2 = __uint_as_float(r32[0]) + __uint_as_float(r32[1]);
        auto r16 = __builtin_amdgcn_permlane16_swap(__float_as_uint(s2), __float_as_uint(s2), false, false);
        float sv = __uint_as_float(r16[0]) + __uint_as_float(r16[1]);
        const int kt = kt0 + (g + (lane >> 5)) * 4;
        if ((lane & 16) == 0 && kt < ntile) {
          unsigned u = fkey(sv);
          sc[kt * 16 + fr] = u;
          atomicAdd(&hist[u >> 21], 1);
        }
      }
    }
  }
  __syncthreads();
  unsigned prefix = 0;
  int remaining = 256;
#pragma unroll 1
  for (int pass = 0; pass < 3; ++pass) {
    const int shift = pass == 0 ? 21 : (pass == 1 ? 10 : 0);
    const int bits = pass == 2 ? 10 : 11;
    const unsigned bmask = (1u << bits) - 1u;
    if (pass > 0) {
      *(int4*)&hist[tid * 8] = make_int4(0, 0, 0, 0);
      *(int4*)&hist[tid * 8 + 4] = make_int4(0, 0, 0, 0);
      __syncthreads();
      const int hs = shift + bits;
      const unsigned want = prefix >> hs;
      for (int i = tid * 4; i < n; i += NTHREADS * 4) {
        const u32x4 u4 = *(const u32x4*)(sc + i);
#pragma unroll
        for (int e = 0; e < 4; ++e)
          if ((u4[e] >> hs) == want) atomicAdd(&hist[(u4[e] >> shift) & bmask], 1);
      }
      __syncthreads();
    }
    const int4 h0 = *(const int4*)&hist[tid * 8], h1 = *(const int4*)&hist[tid * 8 + 4];
    const int s8 = h0.x + h0.y + h0.z + h0.w + h1.x + h1.y + h1.z + h1.w;
    int suf = s8;
#pragma unroll
    for (int d = 1; d < 64; d <<= 1) { int v = __shfl_down(suf, d); if (lane + d < 64) suf += v; }
    if (lane == 0) misc[w] = suf;
    __syncthreads();
    int above = 0;
    for (int ww = w + 1; ww < 4; ++ww) above += misc[ww];
    const int excl = above + suf - s8;
    if (excl < remaining && remaining <= excl + s8) {
      int c = excl, bin = 0, nrem = 0;
#define TK_STEP(val, idx) if (c < remaining && remaining <= c + (val)) { bin = tid * 8 + (idx); nrem = remaining - c; } c += (val);
      TK_STEP(h1.w, 7) TK_STEP(h1.z, 6) TK_STEP(h1.y, 5) TK_STEP(h1.x, 4) TK_STEP(h0.w, 3) TK_STEP(h0.z, 2) TK_STEP(h0.y, 1) TK_STEP(h0.x, 0)
#undef TK_STEP
      misc[4] = bin; misc[5] = nrem;
    }
    __syncthreads();
    prefix |= ((unsigned)misc[4]) << shift;
    remaining = misc[5];
    __syncthreads();
  }
  const unsigned T = prefix;
  const int seg = ((n + 255) >> 8) << 6;
  const int beg = w * seg;
  int ceq = 0;
  for (int i = beg + lane; i < beg + seg; i += 64) {
    bool in = i < n; unsigned u = in ? sc[i] : 0u;
    ceq += __popcll(__ballot(in && u == T));
  }
  if (lane == 0) misc[12 + w] = ceq;
  __syncthreads();
  int oe = 0;
  for (int ww = 0; ww < w; ++ww) oe += misc[12 + ww];
  const unsigned long long lt = (1ull << lane) - 1ull;
  for (int i0 = beg; i0 < beg + seg; i0 += 64) {
    const int i = i0 + lane;
    bool in = i < n; unsigned u = in ? sc[i] : 0u;
    bool g = in && u > T, e = in && u == T;
    unsigned long long be = __ballot(e);
    int pe = oe + __popcll(be & lt);
    unsigned long long sm = __ballot(g || (e && pe < remaining));
    if (lane == 0 && i0 < n) sel[i0 >> 6] = sm;
    oe += __popcll(be);
  }
}

constexpr int KSTR = 200;
constexpr int VSTR = 72;

template <int MODE>
DI void attn_item(const Params& p, int item, char* smem, u16* gdst) {
  constexpr int NKS = MODE == 0 ? 6 : 4;
  u16* sK = (u16*)smem;
  u16* sV = sK + 64 * KSTR;
  float* sBias = (float*)(sV + 128 * VSTR);
  const int tid = otid(), lane = tid & 63, w = tid >> 6, fr = lane & 15, fq = lane >> 4;
  int h, q0, nq, krow0, nkeys, ntiles, myt, b = 0, qpos0;
  const u16* vt; size_t vstride;
  const bool sample = item >= 2048;
  if (!sample) {
    const int i = 127 - (item >> 4);
    h = item & 15; q0 = i * 128; nq = 128; krow0 = 0; nkeys = q0 + 128; ntiles = 2 * i + 2; qpos0 = q0;
    vt = (MODE == 0 ? p.VBT_P : p.VAT) + (size_t)h * 128 * MP; vstride = MP;
    myt = (w < 2) ? ntiles - 1 : ntiles;
  } else {
    const int j = item - 2048; b = j >> 4;
    h = j & 15; q0 = MP + b * 16; nq = 16; krow0 = MP + b * SK; nkeys = SK; ntiles = 17; qpos0 = 1024;
    vt = p.VBT_S + ((size_t)b * 2048 + h * 128) * VSS; vstride = VSS;
    myt = ntiles;
  }
  const int wq0 = w * 32;
  const bool active = wq0 < nq;
  if (MODE == 1) {
    __syncthreads();
    for (int i = tid; i < 257; i += NTHREADS) {
      int rel = i - 128;
      int ret = rel > 0 ? 16 : 0;
      int n = rel < 0 ? -rel : rel;
      float lf = logf((float)max(n, 1) / 8.0f) / 2.772588722239781f * 8.0f;
      int large = min(8 + (int)lf, 15);
      int bk = ret + (n < 8 ? n : large);
      sBias[i] = p.rel[bk * 16 + h] * 1.4426950408889634f;
    }
  }
  bf16x8 qf[2][NKS];
  int qrow[2];
#pragma unroll
  for (int qt = 0; qt < 2; ++qt) {
    const int qr = min(wq0 + qt * 16 + fr, nq - 1);
    qrow[qt] = qr;
    const u16* qp = (MODE == 0) ? p.QB + (size_t)(q0 + qr) * 3072 + h * 192 + fq * 8 : p.AQ + (size_t)(q0 + qr) * 2048 + h * 128 + fq * 8;
#pragma unroll
    for (int ks = 0; ks < NKS; ++ks) qf[qt][ks] = *(const bf16x8*)(qp + ks * 32);
  }
  f32x4 o[2][8];
#pragma unroll
  for (int qt = 0; qt < 2; ++qt)
#pragma unroll
    for (int dt = 0; dt < 8; ++dt) o[qt][dt] = (f32x4){0.f, 0.f, 0.f, 0.f};
  float mrow[2] = {-1e30f, -1e30f}, lrow[2] = {0.f, 0.f};
  const float SC = (MODE == 0 ? 0.07216878364870322f : 0.08838834764831845f) * 1.4426950408889634f;

  unsigned long long mqn[2] = {0ull, 0ull};
  if (MODE == 1) {
#pragma unroll
    for (int qt = 0; qt < 2; ++qt) mqn[qt] = p.SEL[(size_t)(q0 + qrow[qt]) * 256];
  }
  for (int jt = 0; jt < ntiles; ++jt) {
    const int key0 = jt * 64;
    unsigned long long mq[2] = {mqn[0], mqn[1]};
    if (MODE == 1) {
      const int jn = min(jt + 1, ntiles - 1);
#pragma unroll
      for (int qt = 0; qt < 2; ++qt) mqn[qt] = p.SEL[(size_t)(q0 + qrow[qt]) * 256 + jn];
    }
    __syncthreads();
    if (MODE == 0) {
#pragma unroll
      for (int i = 0; i < 6; ++i) {
        const int c = tid + i * 256;
        const int key = c / 24, part = c - key * 24;
        const size_t kk = (size_t)(min(key0 + key, nkeys - 1) + krow0);
        u32x4 v;
        if (part < 16) v = *(const u32x4*)(p.KB + kk * 2048 + h * 128 + part * 8);
        else v = *(const u32x4*)(p.KR + kk * 64 + (part - 16) * 8);
        *(u32x4*)(sK + key * KSTR + part * 8) = v;
      }
    } else if (!sample) {
#pragma unroll
      for (int i = 0; i < 4; ++i) {
        const int c = tid + i * 256;
        const int key = c >> 4, part = c & 15;
        u32x4 v = *(const u32x4*)(p.KA + (size_t)(key0 + key) * 2048 + h * 128 + part * 8);
        *(u32x4*)(sK + key * KSTR + part * 8) = v;
      }
    }
    if (MODE == 0 || !sample) {
      __builtin_amdgcn_sched_barrier(0);
#pragma unroll
      for (int i = 0; i < 4; ++i) {
        const int c = tid + i * 256;
        const int d = c >> 3, part = c & 7;
        u32x4 v = *(const u32x4*)(vt + (size_t)d * vstride + key0 + part * 8);
        *(u32x4*)(sV + d * VSTR + part * 8) = v;
      }
    } else {
#pragma unroll 2
      for (int i = 0; i < 8; ++i) {
        const int c = tid + i * 256;
        const int key = c >> 5, part = c & 31;
        const int s = key0 + key;
        const int sc_ = min(s, SK - 1);
        const size_t o1 = sc_ < 1024 ? ((size_t)b * 1024 + sc_) * 2048 : ((size_t)b * 16 + (sc_ - 1024)) * 2048;
        const float* kp = (sc_ < 1024 ? p.c_ak : p.out + O_AKS) + o1 + h * 128 + part * 4;
        const float* vp = (sc_ < 1024 ? p.c_av : p.out + O_AVS) + o1 + h * 128 + part * 4;
        f32x4 kv = *(const f32x4*)kp, vv = *(const f32x4*)vp;
        u32x2 kk; kk[0] = cvtpk(kv[0], kv[1]); kk[1] = cvtpk(kv[2], kv[3]);
        *(u32x2*)(sK + key * KSTR + part * 4) = kk;
        const bool ok = s < SK;
#pragma unroll
        for (int e = 0; e < 4; ++e) sV[(part * 4 + e) * VSTR + key] = ok ? f2bf(vv[e]) : (u16)0;
      }
    }
    __syncthreads();
    if (active && jt < myt) {
      f32x4 s[2][4];
#pragma unroll
      for (int qt = 0; qt < 2; ++qt)
#pragma unroll
        for (int kt = 0; kt < 4; ++kt) s[qt][kt] = (f32x4){0.f, 0.f, 0.f, 0.f};
#pragma unroll
      for (int kt = 0; kt < 4; ++kt) {
#pragma unroll
        for (int ks = 0; ks < NKS; ++ks) {
          bf16x8 kf = *(const bf16x8*)(sK + (kt * 16 + fr) * KSTR + ks * 32 + fq * 8);
          s[0][kt] = __builtin_amdgcn_mfma_f32_16x16x32_bf16(kf, qf[0][ks], s[0][kt], 0, 0, 0);
          s[1][kt] = __builtin_amdgcn_mfma_f32_16x16x32_bf16(kf, qf[1][ks], s[1][kt], 0, 0, 0);
        }
      }
      if (MODE == 0) {
#pragma unroll
        for (int qt = 0; qt < 2; ++qt)
#pragma unroll
          for (int kt = 0; kt < 4; ++kt) s[qt][kt] *= SC;
        if (key0 + 64 > nkeys) {
#pragma unroll
          for (int kt = 0; kt < 4; ++kt)
#pragma unroll
            for (int j = 0; j < 4; ++j)
              if (key0 + kt * 16 + fq * 4 + j >= nkeys) { s[0][kt][j] = -1e30f; s[1][kt][j] = -1e30f; }
        }
      } else {
        const bool far = (key0 + 63) - (qpos0 + wq0) <= -128;
        if (far) {
          const float bz = sBias[0];
#pragma unroll
          for (int qt = 0; qt < 2; ++qt)
#pragma unroll
            for (int kt = 0; kt < 4; ++kt) s[qt][kt] = s[qt][kt] * SC + bz;
        } else {
#pragma unroll
          for (int qt = 0; qt < 2; ++qt) {
            const int rb = key0 + fq * 4 - (qpos0 + qrow[qt]) + 128;
#pragma unroll
            for (int kt = 0; kt < 4; ++kt)
#pragma unroll
              for (int j = 0; j < 4; ++j) {
                int r = min(max(rb + kt * 16 + j, 0), 256);
                s[qt][kt][j] = s[qt][kt][j] * SC + sBias[r];
              }
          }
        }
#pragma unroll
        for (int qt = 0; qt < 2; ++qt) {
          const unsigned long long mm = mq[qt] >> (fq * 4);
          const unsigned mlo = (unsigned)mm, mhi = (unsigned)(mm >> 32);
#pragma unroll
          for (int kt = 0; kt < 4; ++kt)
#pragma unroll
            for (int j = 0; j < 4; ++j) {
              const unsigned word = kt < 2 ? mlo : mhi;
              const bool keep = (word >> ((kt & 1) * 16 + j)) & 1u;
              if (!keep) s[qt][kt][j] = -1e30f;
            }
        }
      }
      bf16x8 pf[2][2];
#pragma unroll
      for (int qt = 0; qt < 2; ++qt) {
        float mx = -1e30f;
#pragma unroll
        for (int kt = 0; kt < 4; ++kt)
#pragma unroll
          for (int j = 0; j < 4; ++j) mx = fmaxf(mx, s[qt][kt][j]);
        mx = fmaxf(mx, __shfl_xor(mx, 16));
        mx = fmaxf(mx, __shfl_xor(mx, 32));
        const float mn = fmaxf(mrow[qt], mx);
        const float alpha = exp2f(mrow[qt] - mn);
        mrow[qt] = mn;
        float rs = 0.f;
#pragma unroll
        for (int kt = 0; kt < 4; ++kt)
#pragma unroll
          for (int j = 0; j < 4; ++j) {
            float pv = exp2f(s[qt][kt][j] - mn);
            if (MODE == 1) pv = s[qt][kt][j] > -1e29f ? pv : 0.f;
            s[qt][kt][j] = pv; rs += pv;
          }
        rs += __shfl_xor(rs, 16);
        rs += __shfl_xor(rs, 32);
        lrow[qt] = lrow[qt] * alpha + rs;
#pragma unroll
        for (int dt = 0; dt < 8; ++dt) o[qt][dt] *= alpha;
#pragma unroll
        for (int s2 = 0; s2 < 2; ++s2) {
          u32x4 pk;
          pk[0] = cvtpk(s[qt][2 * s2][0], s[qt][2 * s2][1]);
          pk[1] = cvtpk(s[qt][2 * s2][2], s[qt][2 * s2][3]);
          pk[2] = cvtpk(s[qt][2 * s2 + 1][0], s[qt][2 * s2 + 1][1]);
          pk[3] = cvtpk(s[qt][2 * s2 + 1][2], s[qt][2 * s2 + 1][3]);
          pf[qt][s2] = __builtin_bit_cast(bf16x8, pk);
        }
      }
#pragma unroll
      for (int dt = 0; dt < 8; ++dt) {
#pragma unroll
        for (int s2 = 0; s2 < 2; ++s2) {
          const u16* vp = sV + (dt * 16 + fr) * VSTR + fq * 4;
          u32x2 v0 = *(const u32x2*)(vp + (2 * s2) * 16);
          u32x2 v1 = *(const u32x2*)(vp + (2 * s2 + 1) * 16);
          u32x4 vv = {v0[0], v0[1], v1[0], v1[1]};
          bf16x8 vf = __builtin_bit_cast(bf16x8, vv);
          o[0][dt] = __builtin_amdgcn_mfma_f32_16x16x32_bf16(vf, pf[0][s2], o[0][dt], 0, 0, 0);
          o[1][dt] = __builtin_amdgcn_mfma_f32_16x16x32_bf16(vf, pf[1][s2], o[1][dt], 0, 0, 0);
        }
      }
    }
  }
  if (active) {
#pragma unroll
    for (int qt = 0; qt < 2; ++qt) {
      const int qr = wq0 + qt * 16 + fr;
      if (qr < nq) {
        const float inv = 1.f / lrow[qt];
        const size_t row = (size_t)(q0 + qr);
#pragma unroll
        for (int dt = 0; dt < 8; ++dt) {
          const size_t off = row * 2048 + h * 128 + dt * 16 + fq * 4;
          u32x2 ga = *(const u32x2*)(p.GA + off);
          u32x2 r;
          if (MODE == 0) {
            u32x2 gb = *(const u32x2*)(p.GB + off);
            r[0] = cvtpk(bflo(gb[0]) * o[qt][dt][0] * inv + bflo(ga[0]), bfhi(gb[0]) * o[qt][dt][1] * inv + bfhi(ga[0]));
            r[1] = cvtpk(bflo(gb[1]) * o[qt][dt][2] * inv + bflo(ga[1]), bfhi(gb[1]) * o[qt][dt][3] * inv + bfhi(ga[1]));
          } else {
            r[0] = cvtpk(bflo(ga[0]) * o[qt][dt][0] * inv, bfhi(ga[0]) * o[qt][dt][1] * inv);
            r[1] = cvtpk(bflo(ga[1]) * o[qt][dt][2] * inv, bfhi(ga[1]) * o[qt][dt][3] * inv);
          }
          *(u32x2*)(gdst + off) = r;
        }
      }
    }
  }
}

__global__ void __launch_bounds__(NTHREADS, 2) fwd_megakernel(Params p) {
  extern __shared__ __attribute__((aligned(16))) char smem[];
  cg::grid_group grid = cg::this_grid();
#define IDS const int tid = otid(); const int lane = tid & 63, w = tid >> 6; const int bid = blockIdx.x, nb = gridDim.x; \
  const int gw = bid * 4 + w, ngw = nb * 4; (void)tid; (void)lane; (void)gw; (void)ngw; (void)bid; (void)nb;

#if PH & (1 << 0)
  { IDS
  {
    float* st = (float*)smem;
    for (int t = bid; t < 32 * 192; t += nb) transpose_tile(p.w_in, 2048, INC, p.WT_IN, t, st);
    for (int t = bid; t < 8 * 48; t += nb) transpose_tile(p.w_uq, 512, 3072, p.WT_UQ, t, st);
    for (int t = bid; t < 4 * 32; t += nb) transpose_tile(p.w_uk, 256, 2048, p.WT_UK, t, st);
    for (int t = bid; t < 4 * 32; t += nb) transpose_tile(p.w_uv, 256, 2048, p.WT_UV, t, st);
    for (int t = bid; t < 32 * 32; t += nb) transpose_tile(p.w_out, 2048, 2048, p.WT_OUT, t, st);
    for (int t = bid; t < 32 * 128; t += nb) transpose_tile(p.w_up, 2048, 8192, p.WT_UP, t, st);
    for (int t = bid; t < 128 * 32; t += nb) transpose_tile(p.w_down, 8192, 2048, p.WT_DOWN, t, st);
    for (int r = gw; r < MT; r += ngw) {
      const float* x = r < MP ? p.x_p + (size_t)r * 2048 : p.x_s + (size_t)(r - MP) * 2048;
      rms_row_2048(x, p.g_mix, p.H + (size_t)r * 2048, lane);
    }
    const int gt = bid * NTHREADS + tid, ngt = nb * NTHREADS;
    for (int i = gt; i < 16 * 1024 * 64 / 4; i += ngt) {
      int e = i * 4; int b = e >> 16; int rem = e & 65535; int s = rem >> 6, c = rem & 63;
      size_t dst = (size_t)(MP + b * SK + s) * 64 + c;
      f32x4 a = *(const f32x4*)(p.c_idx + e), k = *(const f32x4*)(p.c_kr + e);
      u32x2 o; o[0] = cvtpk(a[0], a[1]); o[1] = cvtpk(a[2], a[3]);
      *(u32x2*)(p.IXK + dst) = o;
      o[0] = cvtpk(k[0], k[1]); o[1] = cvtpk(k[2], k[3]);
      *(u32x2*)(p.KR + dst) = o;
    }
    for (int i = gt; i < 16 * 1024 * 256 / 4; i += ngt) {
      int e = i * 4; int b = e >> 18; int rem = e & 262143; int s = rem >> 8, c = rem & 255;
      size_t dst = (size_t)(MP + b * SK + s) * 256 + c;
      f32x4 a = *(const f32x4*)(p.c_ckv + e);
      u32x2 o; o[0] = cvtpk(a[0], a[1]); o[1] = cvtpk(a[2], a[3]);
      *(u32x2*)(p.CKV + dst) = o;
    }
  }
  }
#endif
  grid.sync();
#if PH & (1 << 1)
  { IDS
  for (int rep = 0; rep < NREP(1); ++rep) gemm_phase<EPI_IN>(p, p.H, 2048, p.WT_IN, 2048, 2048, MT / 256, INP / 128, smem, nullptr, 0, bid, nb);
  }
#endif
  grid.sync();
#if PH & (1 << 2)
  { IDS
  for (int t = gw; t < MT; t += ngw) post_row(p, t, lane);
  for (int rep = 0; rep < NREP(2); ++rep) for (int t = bid; t < MT; t += nb) topk_query(p, t, smem);
  }
#endif
  grid.sync();
#if PH & (1 << 3)
  { IDS
    const int total = 2048 + 256;
    for (int rep = 0; rep < NREP(3); ++rep) {
      u16* gdst = (rep + 1 < NREP(3)) ? (u16*)(p.out + O_Y) : p.GA;
      for (int r = 0;; ++r) {
        int id = (r & 1) ? r * nb + (nb - 1 - bid) : r * nb + bid;
        if (r * nb >= total) break;
        if (id < total) attn_item<1>(p, id, smem, gdst);
      }
    }
  }
#endif
  grid.sync();
#if PH & (1 << 4)
  { IDS
  {
    const int gt = bid * NTHREADS + tid, ngt = nb * NTHREADS;
    for (int i = gt; i < 16 * 2048 * 6; i += ngt) {
      int r = i / 6, c = i - r * 6;
      *(u32x4*)(p.VBT_S + (size_t)r * VSS + SK + c * 8) = (u32x4){0u, 0u, 0u, 0u};
    }
    const int nqb = (MT / 256) * 24, nkb = (KROWS / 256) * 16;
    const int total = nqb + 2 * nkb;
    for (int id = bid; id < total; id += nb) {
      if (id < nqb) gemm_phase<EPI_QB>(p, p.CQ, 512, p.WT_UQ, 512, 512, MT / 256, 24, smem, p.QB, 3072, id, 1 << 30);
      else if (id < nqb + nkb) gemm_phase<EPI_BF16>(p, p.CKV, 256, p.WT_UK, 256, 256, KROWS / 256, 16, smem, p.KB, 2048, id - nqb, 1 << 30);
      else gemm_phase<EPI_VT>(p, p.CKV, 256, p.WT_UV, 256, 256, KROWS / 256, 16, smem, nullptr, 0, id - nqb - nkb, 1 << 30);
    }
  }
  }
#endif
  grid.sync();
#if PH & (1 << 5)
  { IDS
  {
    const int total = 2048 + 256;
    for (int rep = 0; rep < NREP(5); ++rep) {
      u16* gdst = (rep + 1 < NREP(5)) ? (u16*)(p.out + O_Y) : p.GB;
      for (int r = 0;; ++r) {
        int id = (r & 1) ? r * nb + (nb - 1 - bid) : r * nb + bid;
        if (r * nb >= total) break;
        if (id < total) attn_item<0>(p, id, smem, gdst);
      }
    }
  }
  }
#endif
  grid.sync();
#if PH & (1 << 6)
  { IDS
  gemm_phase<EPI_RES>(p, p.GB, 2048, p.WT_OUT, 2048, 2048, MT / 256, 16, smem, nullptr, 0, bid, nb);
  }
#endif
  grid.sync();
#if PH & (1 << 7)
  { IDS
  for (int r = gw; r < MT; r += ngw) rms_row_2048(p.out + O_Y + (size_t)r * 2048, p.g_ffn, p.H2 + (size_t)r * 2048, lane);
  }
#endif
  grid.sync();
#if PH & (1 << 8)
  { IDS
  gemm_phase<EPI_RELU2>(p, p.H2, 2048, p.WT_UP, 2048, 2048, MT / 256, 64, smem, nullptr, 0, bid, nb);
  }
#endif
  grid.sync();
#if PH & (1 << 9)
  { IDS
  gemm_phase<EPI_ACC>(p, p.U, DFF, p.WT_DOWN, DFF, DFF, MT / 256, 16, smem, nullptr, 0, bid, nb);
  }
#endif
  grid.sync();
#if PH & (1 << 10)
  { IDS
  for (int r = gw; r < MT; r += ngw) {
    float* x = p.out + O_Y + (size_t)r * 2048;
    f32x4 v[8];
    float ss = 0.f;
#pragma unroll
    for (int i = 0; i < 8; ++i) {
      v[i] = *(const f32x4*)(x + i * 256 + lane * 4);
      ss += v[i][0] * v[i][0] + v[i][1] * v[i][1] + v[i][2] * v[i][2] + v[i][3] * v[i][3];
    }
    ss = wave_sum(ss);
    float rr = rsqrtf(ss * (1.f / 2048.f) + 1e-6f);
#pragma unroll
    for (int i = 0; i < 8; ++i) {
      f32x4 gg = *(const f32x4*)(p.g_fin + i * 256 + lane * 4);
      f32x4 o = {v[i][0] * rr * gg[0], v[i][1] * rr * gg[1], v[i][2] * rr * gg[2], v[i][3] * rr * gg[3]};
      *(f32x4*)(x + i * 256 + lane * 4) = o;
    }
  }
  }
#endif
}

extern "C" void kernel_launch(void* const* d_in, const int* in_sizes, int n_in, void* d_out, int out_size, void* d_ws, size_t ws_size,
                              hipStream_t stream) {
  static int grid_blocks = 0;
  if (!grid_blocks) {
    int dev = 0, cus = 0, per_cu = 0;
    hipGetDevice(&dev);
    hipDeviceGetAttribute(&cus, hipDeviceAttributeMultiprocessorCount, dev);
    if (hipFuncSetAttribute((const void*)fwd_megakernel, hipFuncAttributeMaxDynamicSharedMemorySize, LDS_BYTES) != hipSuccess)
      fprintf(stderr, "kernel_launch: hipFuncSetAttribute failed\n");
    hipOccupancyMaxActiveBlocksPerMultiprocessor(&per_cu, (const void*)fwd_megakernel, NTHREADS, LDS_BYTES);
    if (per_cu < 1) per_cu = 1;
    if (per_cu > 2) per_cu = 2;
    grid_blocks = cus * per_cu;
  }
  Params p{};
  const float* const* in = (const float* const*)d_in;
  p.x_p = in[0]; p.x_s = in[1]; p.c_ak = in[2]; p.c_av = in[3]; p.c_idx = in[4]; p.c_ckv = in[5]; p.c_kr = in[6]; p.rel = in[7];
  p.g_mix = in[8]; p.w_in = in[9]; p.g_q = in[10]; p.w_uq = in[11]; p.g_kv = in[12]; p.w_uk = in[13]; p.w_uv = in[14]; p.w_out = in[15];
  p.g_ffn = in[16]; p.w_up = in[17]; p.w_down = in[18]; p.g_fin = in[19];
  p.out = (float*)d_out;
  char* ws = (char*)d_ws;
  size_t off = 0;
  auto alloc = [&](size_t bytes) { char* r = ws + off; off += (bytes + 255) & ~(size_t)255; return r; };
  p.WT_UQ = (u16*)alloc((size_t)3072 * 512 * 2);
  p.WT_UK = (u16*)alloc((size_t)2048 * 256 * 2);
  p.WT_UV = (u16*)alloc((size_t)2048 * 256 * 2);
  p.WT_OUT = (u16*)alloc((size_t)2048 * 2048 * 2);
  p.WT_UP = (u16*)alloc((size_t)8192 * 2048 * 2);
  p.WT_DOWN = (u16*)alloc((size_t)2048 * 8192 * 2);
  p.CQ = (u16*)alloc((size_t)MT * 512 * 2);
  p.CKV = (u16*)alloc((size_t)KROWS * 256 * 2);
  p.KR = (u16*)alloc((size_t)KROWS * 64 * 2);
  p.GA = (u16*)alloc((size_t)MT * 2048 * 2);
  p.GB = (u16*)alloc((size_t)MT * 2048 * 2);
  p.CS = (float*)alloc((size_t)MT * 32 * 4);
  p.SN = (float*)alloc((size_t)MT * 32 * 4);
  const size_t ubase = off;
  p.WT_IN = (u16*)alloc((size_t)INP * 2048 * 2);
  p.H = (u16*)alloc((size_t)MT * 2048 * 2);
  p.AQ = (u16*)alloc((size_t)MT * 2048 * 2);
  p.KA = (u16*)alloc((size_t)MP * 2048 * 2);
  p.VAT = (u16*)alloc((size_t)MP * 2048 * 2);
  p.IXQ = (u16*)alloc((size_t)MT * 1024 * 2);
  p.IXK = (u16*)alloc((size_t)KROWS * 64 * 2);
  p.SEL = (unsigned long long*)alloc((size_t)MT * 256 * 8);
  p.IXW = (float*)alloc((size_t)MT * 16 * 4);
  const size_t endA = off;
  off = ubase;
  p.QB = (u16*)alloc((size_t)MT * 3072 * 2);
  p.KB = (u16*)alloc((size_t)KROWS * 2048 * 2);
  p.VBT_P = (u16*)alloc((size_t)2048 * MP * 2);
  p.VBT_S = (u16*)alloc((size_t)16 * 2048 * VSS * 2);
  const size_t endB = off;
  off = ubase;
  p.H2 = (u16*)alloc((size_t)MT * 2048 * 2);
  p.U = (u16*)alloc((size_t)MT * DFF * 2);
  const size_t endC = off;
  size_t need = endA > endB ? endA : endB;
  if (endC > need) need = endC;
  if (need > ws_size) { fprintf(stderr, "kernel_launch: workspace too small: need %zu have %zu\n", need, ws_size); return; }
  void* args[] = {&p};
  hipError_t e = hipLaunchCooperativeKernel((const void*)fwd_megakernel, dim3(grid_blocks), dim3(NTHREADS), args, LDS_BYTES, stream);
  if (e != hipSuccess) fprintf(stderr, "cooperative launch failed: %s (grid %d)\n", hipGetErrorString(e), grid_blocks);
}
```

```cpp
#include <hip/hip_runtime.h>
#include <hip/hip_cooperative_groups.h>
#include <cstdio>
#include <cstdint>
namespace cg = cooperative_groups;

typedef unsigned short u16;
typedef __attribute__((ext_vector_type(8))) short bf16x8;
typedef __attribute__((ext_vector_type(4))) short bf16x4;
typedef __attribute__((ext_vector_type(4))) float f32x4;
typedef __attribute__((ext_vector_type(2))) float f32x2;
typedef __attribute__((ext_vector_type(2))) __bf16 bf16x2_t;
typedef __attribute__((ext_vector_type(4))) unsigned u32x4;
typedef __attribute__((ext_vector_type(2))) unsigned u32x2;

#define DI __device__ __forceinline__

constexpr int MP = 16384;
constexpr int MS = 256;
constexpr int MT = MP + MS;
constexpr int DM = 2048;
constexpr int INC = 12176;
constexpr int INP = 12288;
constexpr int SK = 1040;
constexpr int KROWS = MP + 16 * SK;
constexpr int VSS = 1088;
constexpr int DFF = 8192;
constexpr int ZRW = 832;
#ifndef PH
#define PH 0x7ff
#endif
#ifndef REP
#define REP 0
#endif
#define NREP(k) (((REP >> (k)) & 1) + 1)
constexpr int NTHREADS = 256;
constexpr int LDS_BYTES = 75776;

constexpr size_t O_Y = 0;
constexpr size_t O_AKP = 34078720;
constexpr size_t O_AVP = 67633152;
constexpr size_t O_IDXP = 101187584;
constexpr size_t O_CKVP = 102236160;
constexpr size_t O_KRP = 106430464;
constexpr size_t O_AKS = 107479040;
constexpr size_t O_AVS = 108003328;
constexpr size_t O_IDXS = 108527616;
constexpr size_t O_CKVS = 108544000;
constexpr size_t O_KRS = 108609536;

struct Params {
  const float *x_p, *x_s, *c_ak, *c_av, *c_idx, *c_ckv, *c_kr, *rel, *g_mix, *w_in, *g_q, *w_uq, *g_kv, *w_uk, *w_uv, *w_out, *g_ffn, *w_up, *w_down, *g_fin;
  float* out;
  u16 *WT_UQ, *WT_UK, *WT_UV, *WT_OUT, *WT_UP, *WT_DOWN, *CQ, *CKV, *KR, *GA, *GB;
  float *CS, *SN;
  u16 *WT_IN, *H, *AQ, *KA, *VAT, *IXQ, *IXK;
  float* IXW;
  unsigned long long* SEL;
  u16 *QB, *KB, *VBT_P, *VBT_S;
  u16 *H2, *U;
};

DI int otid() { int t = threadIdx.x; asm volatile("" : "+v"(t)); return t; }
DI unsigned cvtpk(float lo, float hi) {
  f32x2 v = {lo, hi};
  bf16x2_t b = __builtin_convertvector(v, bf16x2_t);
  return __builtin_bit_cast(unsigned, b);
}
DI u16 f2bf(float x) { return (u16)(cvtpk(x, 0.f) & 0xffffu); }
DI float bf2f(u16 b) { return __uint_as_float(((unsigned)b) << 16); }
DI float bflo(unsigned w) { return __uint_as_float(w << 16); }
DI float bfhi(unsigned w) { return __uint_as_float(w & 0xffff0000u); }
DI float dot2bf(unsigned a, unsigned b, float c) {
  return __builtin_amdgcn_fdot2_f32_bf16(__builtin_bit_cast(bf16x2_t, a), __builtin_bit_cast(bf16x2_t, b), c, false);
}
DI float wave_sum(float v) {
#pragma unroll
  for (int o = 32; o > 0; o >>= 1) v += __shfl_xor(v, o);
  return v;
}
DI int qpos_of(int t) { return t < MP ? t : 1024 + ((t - MP) & 15); }
DI int krow_of(int t) { return t < MP ? t : MP + ((t - MP) >> 4) * SK + 1024 + ((t - MP) & 15); }
DI float inv_freq(int i) { return exp2f(-(float)i * 0.41524101186092029f); }

DI void transpose_tile(const float* __restrict__ W, int K, int N, u16* __restrict__ Wt, int tile, float* s  ) {
  const int nkt = K >> 6;
  const int kt = tile % nkt, nt = tile / nkt;
  const int k0 = kt << 6, n0 = nt << 6;
  const int tid = otid();
  const int c = tid & 63, r0 = tid >> 6;
  __syncthreads();
#pragma unroll
  for (int i = 0; i < 16; ++i) {
    int r = i * 4 + r0;
    float v = (n0 + c < N) ? W[(size_t)(k0 + r) * N + n0 + c] : 0.f;
    s[r * 65 + c] = v;
  }
  __syncthreads();
  const int kp = (tid & 31) * 2, rr0 = tid >> 5;
#pragma unroll
  for (int i = 0; i < 8; ++i) {
    int rr = i * 8 + rr0;
    unsigned pk = cvtpk(s[kp * 65 + rr], s[(kp + 1) * 65 + rr]);
    *(unsigned*)(Wt + (size_t)(n0 + rr) * K + k0 + kp) = pk;
  }
}

DI void rms_row_2048(const float* __restrict__ x, const float* __restrict__ g, u16* __restrict__ out, int lane) {
  f32x4 v[8];
  float ss = 0.f;
#pragma unroll
  for (int i = 0; i < 8; ++i) {
    v[i] = *(const f32x4*)(x + i * 256 + lane * 4);
    ss += v[i][0] * v[i][0] + v[i][1] * v[i][1] + v[i][2] * v[i][2] + v[i][3] * v[i][3];
  }
  ss = wave_sum(ss);
  float r = rsqrtf(ss * (1.f / 2048.f) + 1e-6f);
#pragma unroll
  for (int i = 0; i < 8; ++i) {
    f32x4 gg = *(const f32x4*)(g + i * 256 + lane * 4);
    u32x2 o;
    o[0] = cvtpk(v[i][0] * r * gg[0], v[i][1] * r * gg[1]);
    o[1] = cvtpk(v[i][2] * r * gg[2], v[i][3] * r * gg[3]);
    *(u32x2*)(out + i * 256 + lane * 4) = o;
  }
}

enum { EPI_IN = 0, EPI_QB, EPI_BF16, EPI_VT, EPI_RES, EPI_RELU2, EPI_ACC };
constexpr float QSC = 0.07216878364870322f * 1.4426950408889634f;
constexpr int LSTR = 72;

template <int EPI>
DI void gemm_epilogue(const Params& p, f32x4 (&acc)[8][4], int m0, int n0, int wr, int wc, int fr, int fq, u16* Cb, int ldc) {
  const int cw = n0 + wc * 64;
#pragma clang loop unroll(full)
  for (int m = 0; m < 8; ++m) {
    const int rb = m0 + wr * 128 + m * 16 + fq * 4;
    if (EPI == EPI_QB) {
      const int within = cw % 192;
      if (within == 128) {
#pragma clang loop unroll(full)
        for (int n = 0; n < 2; ++n) {
          const int i = n * 16 + fr;
#pragma clang loop unroll(full)
          for (int j = 0; j < 4; ++j) {
            const int row = rb + j;
            const float cs = p.CS[(size_t)row * 32 + i], sn = p.SN[(size_t)row * 32 + i];
            float x1 = acc[m][n][j] * QSC, x2 = acc[m][n + 2][j] * QSC;
            p.QB[(size_t)row * 3072 + cw + i] = f2bf(x1 * cs - x2 * sn);
            p.QB[(size_t)row * 3072 + cw + i + 32] = f2bf(x1 * sn + x2 * cs);
          }
        }
        continue;
      }
    }
#pragma clang loop unroll(full)
    for (int n = 0; n < 4; ++n) {
      const int colt = cw + n * 16;
      const int col = colt + fr;
      if (EPI == EPI_IN) {
        if (colt >= 4096 && colt < 6144 && rb < MP) {
          u32x2 pk;
          pk[0] = cvtpk(acc[m][n][0], acc[m][n][1]);
          pk[1] = cvtpk(acc[m][n][2], acc[m][n][3]);
          *(u32x2*)(p.VAT + (size_t)(col - 4096) * MP + rb) = pk;
        }
      }
      if (EPI == EPI_VT) {
        u32x2 pk;
        pk[0] = cvtpk(acc[m][n][0], acc[m][n][1]);
        pk[1] = cvtpk(acc[m][n][2], acc[m][n][3]);
        u16* dst;
        if (rb < MP) dst = p.VBT_P + (size_t)col * MP + rb;
        else { int r2 = rb - MP; int b = r2 / SK; int s = r2 - b * SK; dst = p.VBT_S + ((size_t)b * 2048 + col) * VSS + s; }
        *(u32x2*)dst = pk;
        continue;
      }
#pragma clang loop unroll(full)
      for (int j = 0; j < 4; ++j) {
        const int row = rb + j;
        const float v = acc[m][n][j];
        if (EPI == EPI_IN) {
          if (colt < 2048) p.AQ[(size_t)row * 2048 + col] = f2bf(v * (0.08838834764831845f * 1.4426950408889634f));
          else if (colt < 4096) {
            int c = col - 2048;
            if (row < MP) { p.out[O_AKP + (size_t)row * 2048 + c] = v; p.KA[(size_t)row * 2048 + c] = f2bf(v); }
            else p.out[O_AKS + (size_t)(row - MP) * 2048 + c] = v;
          } else if (colt < 6144) {
            int c = col - 4096;
            if (row < MP) p.out[O_AVP + (size_t)row * 2048 + c] = v;
            else p.out[O_AVS + (size_t)(row - MP) * 2048 + c] = v;
          } else if (colt < 7168) p.IXQ[(size_t)row * 1024 + (col - 6144)] = f2bf(v);
          else if (colt < 7232) {
            int c = col - 7168;
            if (row < MP) p.out[O_IDXP + (size_t)row * 64 + c] = v; else p.out[O_IDXS + (size_t)(row - MP) * 64 + c] = v;
            p.IXK[(size_t)krow_of(row) * 64 + c] = f2bf(v);
          } else if (colt < 7248) p.IXW[(size_t)row * 16 + (col - 7232)] = v * 0.25f;
          else if (colt < 8080) p.out[O_Y + (size_t)row * ZRW + (col - 7248)] = v;
          else if (colt < 10128) p.GA[(size_t)row * 2048 + (col - 8080)] = f2bf(1.f / (1.f + __expf(-v)));
          else if (colt < INC) p.GB[(size_t)row * 2048 + (col - 10128)] = f2bf(1.f / (1.f + __expf(-v)));
        } else if (EPI == EPI_QB) {
          Cb[(size_t)row * ldc + col] = f2bf(v * QSC);
        } else if (EPI == EPI_BF16) {
          Cb[(size_t)row * ldc + col] = f2bf(v);
        } else if (EPI == EPI_RES) {
          float xv = row < MP ? p.x_p[(size_t)row * 2048 + col] : p.x_s[(size_t)(row - MP) * 2048 + col];
          p.out[O_Y + (size_t)row * 2048 + col] = xv + v;
        } else if (EPI == EPI_RELU2) {
          float r = fmaxf(v, 0.f);
          p.U[(size_t)row * DFF + col] = f2bf(r * r);
        } else if (EPI == EPI_ACC) {
          p.out[O_Y + (size_t)row * 2048 + col] += v;
        }
      }
    }
  }
}

template <int EPI>
DI void gemm_tile(const Params& p, const u16* __restrict__ A, int lda, const u16* __restrict__ Bt, int ldb, int K, int m0, int n0,
                  char* smem, u16* Cb, int ldc) {
  u16* sA = (u16*)smem;
  u16* sB = sA + 256 * LSTR;
  const int tid = otid(), lane = tid & 63, w = tid >> 6;
  const int wr = w >> 1, wc = w & 1, fr = lane & 15, fq = lane >> 4;
  f32x4 acc[8][4];
#pragma unroll
  for (int m = 0; m < 8; ++m)
#pragma unroll
    for (int n = 0; n < 4; ++n) acc[m][n] = (f32x4){0.f, 0.f, 0.f, 0.f};
  const int lr = tid >> 3, lk = (tid & 7) * 8;
  const u16* Ag = A + (size_t)(m0 + lr) * lda + lk;
  const u16* Bg = Bt + (size_t)(n0 + lr) * ldb + lk;
  const int nk = K >> 6;
  const u16* cA = sA + (wr * 128 + fr) * LSTR + fq * 8;
  const u16* cB = sB + (wc * 64 + fr) * LSTR + fq * 8;
  for (int kt = 0; kt < nk; ++kt) {
    const int k0 = kt << 6;
    __syncthreads();
    {
      u32x4 ra[8], rb[4];
#pragma unroll
      for (int i = 0; i < 8; ++i) ra[i] = *(const u32x4*)(Ag + (size_t)(i * 32) * lda + k0);
#pragma unroll
      for (int i = 0; i < 4; ++i) rb[i] = *(const u32x4*)(Bg + (size_t)(i * 32) * ldb + k0);
#pragma unroll
      for (int i = 0; i < 8; ++i) *(u32x4*)(sA + (lr + i * 32) * LSTR + lk) = ra[i];
#pragma unroll
      for (int i = 0; i < 4; ++i) *(u32x4*)(sB + (lr + i * 32) * LSTR + lk) = rb[i];
    }
    __syncthreads();
#pragma unroll
    for (int ks = 0; ks < 2; ++ks) {
      bf16x8 bfr[4];
#pragma unroll
      for (int n = 0; n < 4; ++n) bfr[n] = *(const bf16x8*)(cB + n * 16 * LSTR + ks * 32);
#pragma unroll
      for (int mh = 0; mh < 2; ++mh) {
        bf16x8 af[4];
#pragma unroll
        for (int m = 0; m < 4; ++m) af[m] = *(const bf16x8*)(cA + (mh * 4 + m) * 16 * LSTR + ks * 32);
#pragma unroll
        for (int m = 0; m < 4; ++m)
#pragma unroll
          for (int n = 0; n < 4; ++n)
            acc[mh * 4 + m][n] = __builtin_amdgcn_mfma_f32_16x16x32_bf16(af[m], bfr[n], acc[mh * 4 + m][n], 0, 0, 0);
      }
    }
  }
  gemm_epilogue<EPI>(p, acc, m0, n0, wr, wc, fr, fq, Cb, ldc);
}

template <int EPI>
DI void gemm_phase(const Params& p, const u16* A, int lda, const u16* Bt, int ldb, int K, int mtiles, int ntiles, char* smem, u16* Cb, int ldc,
                   int start, int stride) {
  const int total = mtiles * ntiles;
  const int GM = 8;
  for (int id = start; id < total; id += stride) {
    const int per = GM * ntiles;
    const int g = id / per, rem = id - g * per;
    const int fm = g * GM;
    const int gsz = min(GM, mtiles - fm);
    const int mt = fm + rem % gsz, nt = rem / gsz;
    gemm_tile<EPI>(p, A, lda, Bt, ldb, K, mt * 256, nt * 128, smem, Cb, ldc);
  }
}

DI void post_row(const Params& p, int t, int lane) {
  const float* zr = p.out + O_Y + (size_t)t * ZRW;
  {
    f32x4 a = *(const f32x4*)(zr + lane * 4), b = *(const f32x4*)(zr + 256 + lane * 4);
    float ss = a[0] * a[0] + a[1] * a[1] + a[2] * a[2] + a[3] * a[3] + b[0] * b[0] + b[1] * b[1] + b[2] * b[2] + b[3] * b[3];
    ss = wave_sum(ss);
    float r = rsqrtf(ss * (1.f / 512.f) + 1e-6f);
    f32x4 ga = *(const f32x4*)(p.g_q + lane * 4), gb = *(const f32x4*)(p.g_q + 256 + lane * 4);
    u32x2 o;
    o[0] = cvtpk(a[0] * r * ga[0], a[1] * r * ga[1]); o[1] = cvtpk(a[2] * r * ga[2], a[3] * r * ga[3]);
    *(u32x2*)(p.CQ + (size_t)t * 512 + lane * 4) = o;
    o[0] = cvtpk(b[0] * r * gb[0], b[1] * r * gb[1]); o[1] = cvtpk(b[2] * r * gb[2], b[3] * r * gb[3]);
    *(u32x2*)(p.CQ + (size_t)t * 512 + 256 + lane * 4) = o;
  }
  const int kr_row = krow_of(t);
  {
    f32x4 a = *(const f32x4*)(zr + 512 + lane * 4);
    float ss = a[0] * a[0] + a[1] * a[1] + a[2] * a[2] + a[3] * a[3];
    ss = wave_sum(ss);
    float r = rsqrtf(ss * (1.f / 256.f) + 1e-6f);
    f32x4 g = *(const f32x4*)(p.g_kv + lane * 4);
    f32x4 o = {a[0] * r * g[0], a[1] * r * g[1], a[2] * r * g[2], a[3] * r * g[3]};
    float* od = t < MP ? p.out + O_CKVP + (size_t)t * 256 : p.out + O_CKVS + (size_t)(t - MP) * 256;
    *(f32x4*)(od + lane * 4) = o;
    u32x2 ob; ob[0] = cvtpk(o[0], o[1]); ob[1] = cvtpk(o[2], o[3]);
    *(u32x2*)(p.CKV + (size_t)kr_row * 256 + lane * 4) = ob;
  }
  if (lane < 32) {
    float x1 = zr[768 + lane], x2 = zr[768 + 32 + lane];
    float ang = (float)qpos_of(t) * inv_freq(lane);
    float cs = cosf(ang), sn = sinf(ang);
    p.CS[(size_t)t * 32 + lane] = cs; p.SN[(size_t)t * 32 + lane] = sn;
    float o1 = x1 * cs - x2 * sn, o2 = x1 * sn + x2 * cs;
    float* od = t < MP ? p.out + O_KRP + (size_t)t * 64 : p.out + O_KRS + (size_t)(t - MP) * 64;
    od[lane] = o1; od[lane + 32] = o2;
    p.KR[(size_t)kr_row * 64 + lane] = f2bf(o1);
    p.KR[(size_t)kr_row * 64 + lane + 32] = f2bf(o2);
  }
}

template <int CTRL> DI float dpp_add(float v) {
  int sft = __builtin_amdgcn_update_dpp(0, __float_as_int(v), CTRL, 0xf, 0xf, true);
  return v + __int_as_float(sft);
}
DI float row16_sum(float v) { v = dpp_add<0x111>(v); v = dpp_add<0x112>(v); v = dpp_add<0x114>(v); v = dpp_add<0x118>(v); return v; }
DI unsigned fkey(float f) { unsigned u = __float_as_uint(f); return (u & 0x80000000u) ? ~u : (u | 0x80000000u); }

DI void radix_select(unsigned* sc, int* hist, int* misc, int n, unsigned long long* sel, int tid, int lane, int w) {
  __syncthreads();
  unsigned prefix = 0;
  int remaining = 256;
#pragma unroll 1
  for (int pass = 0; pass < 3; ++pass) {
    const int shift = pass == 0 ? 21 : (pass == 1 ? 10 : 0);
    const int bits = pass == 2 ? 10 : 11;
    const unsigned bmask = (1u << bits) - 1u;
    if (pass > 0) {
      *(int4*)&hist[tid * 8] = make_int4(0, 0, 0, 0);
      *(int4*)&hist[tid * 8 + 4] = make_int4(0, 0, 0, 0);
      __syncthreads();
      const int hs = shift + bits;
      const unsigned want = prefix >> hs;
      for (int i = tid * 4; i < n; i += NTHREADS * 4) {
        const u32x4 u4 = *(const u32x4*)(sc + i);
#pragma unroll
        for (int e = 0; e < 4; ++e)
          if ((u4[e] >> hs) == want) atomicAdd(&hist[(u4[e] >> shift) & bmask], 1);
      }
      __syncthreads();
    }
    const int4 h0 = *(const int4*)&hist[tid * 8], h1 = *(const int4*)&hist[tid * 8 + 4];
    const int s8 = h0.x + h0.y + h0.z + h0.w + h1.x + h1.y + h1.z + h1.w;
    int suf = s8;
#pragma unroll
    for (int d = 1; d < 64; d <<= 1) { int v = __shfl_down(suf, d); if (lane + d < 64) suf += v; }
    if (lane == 0) misc[w] = suf;
    __syncthreads();
    int above = 0;
    for (int ww = w + 1; ww < 4; ++ww) above += misc[ww];
    const int excl = above + suf - s8;
    if (excl < remaining && remaining <= excl + s8) {
      int c = excl, bin = 0, nrem = 0;
#define TK_STEP(val, idx) if (c < remaining && remaining <= c + (val)) { bin = tid * 8 + (idx); nrem = remaining - c; } c += (val);
      TK_STEP(h1.w, 7) TK_STEP(h1.z, 6) TK_STEP(h1.y, 5) TK_STEP(h1.x, 4) TK_STEP(h0.w, 3) TK_STEP(h0.z, 2) TK_STEP(h0.y, 1) TK_STEP(h0.x, 0)
#undef TK_STEP
      misc[4] = bin; misc[5] = nrem;
    }
    __syncthreads();
    prefix |= ((unsigned)misc[4]) << shift;
    remaining = misc[5];
    __syncthreads();
  }
  const unsigned T = prefix;
  const int seg = ((n + 255) >> 8) << 6;
  const int beg = w * seg;
  int ceq = 0;
  for (int i = beg + lane; i < beg + seg; i += 64) {
    bool in = i < n; unsigned u = in ? sc[i] : 0u;
    ceq += __popcll(__ballot(in && u == T));
  }
  if (lane == 0) misc[12 + w] = ceq;
  __syncthreads();
  int oe = 0;
  for (int ww = 0; ww < w; ++ww) oe += misc[12 + ww];
  const unsigned long long lt = (1ull << lane) - 1ull;
  for (int i0 = beg; i0 < beg + seg; i0 += 64) {
    const int i = i0 + lane;
    bool in = i < n; unsigned u = in ? sc[i] : 0u;
    bool g = in && u > T, e = in && u == T;
    unsigned long long be = __ballot(e);
    int pe = oe + __popcll(be & lt);
    unsigned long long sm = __ballot(g || (e && pe < remaining));
    if (lane == 0 && i0 < n) sel[i0 >> 6] = sm;
    oe += __popcll(be);
  }
}

constexpr int NQ = 4;
DI void topk_group(const Params& p, int t, char* smem, unsigned* scr1, unsigned* scr2, unsigned* scr3) {
  unsigned* sc = (unsigned*)smem;
  int* hist = (int*)(smem + 65536);
  int* misc = hist + 2048;
  const int tid = otid(), lane = tid & 63, w = tid >> 6, fr = lane & 15, fq = lane >> 4;
  int n; const u16* ixk;
  if (t < MP) { n = 64 * ((t >> 6) + 1); ixk = p.IXK; }
  else { int b = (t - MP) >> 4; n = SK; ixk = p.IXK + (size_t)(MP + b * SK) * 64; }
  unsigned long long* sel = p.SEL + (size_t)t * 256;
  __syncthreads();
  if (n <= 256) {
    if (tid < 4) {
      unsigned long long v = (tid < (n >> 6)) ? ~0ull : 0ull;
#pragma unroll
      for (int qi = 0; qi < NQ; ++qi) sel[qi * 256 + tid] = v;
    }
    return;
  }
  *(int4*)&hist[tid * 8] = make_int4(0, 0, 0, 0);
  *(int4*)&hist[tid * 8 + 4] = make_int4(0, 0, 0, 0);
  __syncthreads();
  {
    const u16* q = p.IXQ + (size_t)t * 1024 + fr * 64 + fq * 8;
    bf16x8 a0[NQ], a1[NQ];
    f32x4 wv[NQ];
#pragma unroll
    for (int qi = 0; qi < NQ; ++qi) {
      a0[qi] = *(const bf16x8*)(q + qi * 1024); a1[qi] = *(const bf16x8*)(q + qi * 1024 + 32);
      wv[qi] = *(const f32x4*)(p.IXW + (size_t)(t + qi) * 16 + fq * 4);
    }
    const int ntile = n >> 4;
    for (int kt0 = w; kt0 < ntile; kt0 += 32) {
      bf16x8 b0[8], b1[8];
#pragma unroll
      for (int g = 0; g < 8; ++g) {
        const int kt = min(kt0 + g * 4, ntile - 1);
        const u16* kp = ixk + (size_t)(kt * 16 + fr) * 64 + fq * 8;
        b0[g] = *(const bf16x8*)kp; b1[g] = *(const bf16x8*)(kp + 32);
      }
      float pt[NQ][8];
#pragma unroll
      for (int g = 0; g < 8; ++g) {
#pragma unroll
        for (int qi = 0; qi < NQ; ++qi) {
          f32x4 c = {0.f, 0.f, 0.f, 0.f};
          c = __builtin_amdgcn_mfma_f32_16x16x32_bf16(a0[qi], b0[g], c, 0, 0, 0);
          c = __builtin_amdgcn_mfma_f32_16x16x32_bf16(a1[qi], b1[g], c, 0, 0, 0);
          pt[qi][g] = fmaxf(c[0], 0.f) * wv[qi][0] + fmaxf(c[1], 0.f) * wv[qi][1] + fmaxf(c[2], 0.f) * wv[qi][2] + fmaxf(c[3], 0.f) * wv[qi][3];
        }
      }
#pragma unroll
      for (int g = 0; g < 8; g += 2) {
        const int kt = kt0 + (g + (lane >> 5)) * 4;
        const bool st = (lane & 16) == 0 && kt < ntile;
#pragma unroll
        for (int qi = 0; qi < NQ; ++qi) {
          auto r32 = __builtin_amdgcn_permlane32_swap(__float_as_uint(pt[qi][g]), __float_as_uint(pt[qi][g + 1]), false, false);
          float s2 = __uint_as_float(r32[0]) + __uint_as_float(r32[1]);
          auto r16 = __builtin_amdgcn_permlane16_swap(__float_as_uint(s2), __float_as_uint(s2), false, false);
          float sv = __uint_as_float(r16[0]) + __uint_as_float(r16[1]);
          if (st) {
            unsigned u = fkey(sv);
            if (qi == 0) { sc[kt * 16 + fr] = u; atomicAdd(&hist[u >> 21], 1); }
            else if (qi == 1) scr1[kt * 16 + fr] = u;
            else if (qi == 2) scr2[kt * 16 + fr] = u;
            else scr3[kt * 16 + fr] = u;
          }
        }
      }
    }
  }
  radix_select(sc, hist, misc, n, sel, tid, lane, w);
#pragma unroll 1
  for (int qi = 1; qi < NQ; ++qi) {
    const unsigned* scr = qi == 1 ? scr1 : (qi == 2 ? scr2 : scr3);
    __syncthreads();
    *(int4*)&hist[tid * 8] = make_int4(0, 0, 0, 0);
    *(int4*)&hist[tid * 8 + 4] = make_int4(0, 0, 0, 0);
    __syncthreads();
    for (int i = tid * 4; i < n; i += NTHREADS * 4) {
      const u32x4 u4 = *(const u32x4*)(scr + i);
      *(u32x4*)(sc + i) = u4;
#pragma unroll
      for (int e = 0; e < 4; ++e) atomicAdd(&hist[u4[e] >> 21], 1);
    }
    radix_select(sc, hist, misc, n, sel + qi * 256, tid, lane, w);
  }
}

constexpr int KSTR = 200;
constexpr int VSTR = 72;

template <int MODE>
DI void attn_item(const Params& p, int item, char* smem, u16* gdst) {
  constexpr int NKS = MODE == 0 ? 6 : 4;
  u16* sK = (u16*)smem;
  u16* sV = sK + 64 * KSTR;
  float* sBias = (float*)(sV + 128 * VSTR);
  const int tid = otid(), lane = tid & 63, w = tid >> 6, fr = lane & 15, fq = lane >> 4;
  int h, q0, nq, krow0, nkeys, ntiles, myt, b = 0, qpos0;
  const u16* vt; size_t vstride;
  const bool sample = item >= 2048;
  if (!sample) {
    const int i = 127 - (item >> 4);
    h = item & 15; q0 = i * 128; nq = 128; krow0 = 0; nkeys = q0 + 128; ntiles = 2 * i + 2; qpos0 = q0;
    vt = (MODE == 0 ? p.VBT_P : p.VAT) + (size_t)h * 128 * MP; vstride = MP;
    myt = (w < 2) ? ntiles - 1 : ntiles;
  } else {
    const int j = item - 2048; b = j >> 4;
    h = j & 15; q0 = MP + b * 16; nq = 16; krow0 = MP + b * SK; nkeys = SK; ntiles = 17; qpos0 = 1024;
    vt = p.VBT_S + ((size_t)b * 2048 + h * 128) * VSS; vstride = VSS;
    myt = ntiles;
  }
  const int wq0 = w * 32;
  const bool active = wq0 < nq;
  if (MODE == 1) {
    __syncthreads();
    for (int i = tid; i < 257; i += NTHREADS) {
      int rel = i - 128;
      int ret = rel > 0 ? 16 : 0;
      int n = rel < 0 ? -rel : rel;
      float lf = logf((float)max(n, 1) / 8.0f) / 2.772588722239781f * 8.0f;
      int large = min(8 + (int)lf, 15);
      int bk = ret + (n < 8 ? n : large);
      sBias[i] = (p.rel[bk * 16 + h] - p.rel[15 * 16 + h]) * 1.4426950408889634f;
    }
  }
  bf16x8 qf[2][NKS];
  int qrow[2];
#pragma unroll
  for (int qt = 0; qt < 2; ++qt) {
    const int qr = min(wq0 + qt * 16 + fr, nq - 1);
    qrow[qt] = qr;
    const u16* qp = (MODE == 0) ? p.QB + (size_t)(q0 + qr) * 3072 + h * 192 + fq * 8 : p.AQ + (size_t)(q0 + qr) * 2048 + h * 128 + fq * 8;
#pragma unroll
    for (int ks = 0; ks < NKS; ++ks) qf[qt][ks] = *(const bf16x8*)(qp + ks * 32);
  }
  f32x4 o[2][8];
#pragma unroll
  for (int qt = 0; qt < 2; ++qt)
#pragma unroll
    for (int dt = 0; dt < 8; ++dt) o[qt][dt] = (f32x4){0.f, 0.f, 0.f, 0.f};
  float mrow[2] = {-1e30f, -1e30f}, lrow[2] = {0.f, 0.f};
  const float SC = (MODE == 0 ? 0.07216878364870322f : 0.08838834764831845f) * 1.4426950408889634f;

  unsigned long long mqn[2] = {0ull, 0ull};
  if (MODE == 1) {
#pragma unroll
    for (int qt = 0; qt < 2; ++qt) mqn[qt] = p.SEL[(size_t)(q0 + qrow[qt]) * 256];
  }
  for (int jt = 0; jt < ntiles; ++jt) {
    const int key0 = jt * 64;
    unsigned long long mq[2] = {mqn[0], mqn[1]};
    if (MODE == 1) {
      const int jn = min(jt + 1, ntiles - 1);
#pragma unroll
      for (int qt = 0; qt < 2; ++qt) mqn[qt] = p.SEL[(size_t)(q0 + qrow[qt]) * 256 + jn];
    }
    __syncthreads();
    if (MODE == 0) {
#pragma unroll
      for (int i = 0; i < 6; ++i) {
        const int c = tid + i * 256;
        const int key = c / 24, part = c - key * 24;
        const size_t kk = (size_t)(min(key0 + key, nkeys - 1) + krow0);
        u32x4 v;
        if (part < 16) v = *(const u32x4*)(p.KB + kk * 2048 + h * 128 + part * 8);
        else v = *(const u32x4*)(p.KR + kk * 64 + (part - 16) * 8);
        *(u32x4*)(sK + key * KSTR + part * 8) = v;
      }
    } else if (!sample) {
#pragma unroll
      for (int i = 0; i < 4; ++i) {
        const int c = tid + i * 256;
        const int key = c >> 4, part = c & 15;
        u32x4 v = *(const u32x4*)(p.KA + (size_t)(key0 + key) * 2048 + h * 128 + part * 8);
        *(u32x4*)(sK + key * KSTR + part * 8) = v;
      }
    }
    if (MODE == 0 || !sample) {
      __builtin_amdgcn_sched_barrier(0);
#pragma unroll
      for (int i = 0; i < 4; ++i) {
        const int c = tid + i * 256;
        const int d = c >> 3, part = c & 7;
        u32x4 v = *(const u32x4*)(vt + (size_t)d * vstride + key0 + part * 8);
        *(u32x4*)(sV + d * VSTR + part * 8) = v;
      }
    } else {
#pragma unroll 2
      for (int i = 0; i < 8; ++i) {
        const int c = tid + i * 256;
        const int key = c >> 5, part = c & 31;
        const int s = key0 + key;
        const int sc_ = min(s, SK - 1);
        const size_t o1 = sc_ < 1024 ? ((size_t)b * 1024 + sc_) * 2048 : ((size_t)b * 16 + (sc_ - 1024)) * 2048;
        const float* kp = (sc_ < 1024 ? p.c_ak : p.out + O_AKS) + o1 + h * 128 + part * 4;
        const float* vp = (sc_ < 1024 ? p.c_av : p.out + O_AVS) + o1 + h * 128 + part * 4;
        f32x4 kv = *(const f32x4*)kp, vv = *(const f32x4*)vp;
        u32x2 kk; kk[0] = cvtpk(kv[0], kv[1]); kk[1] = cvtpk(kv[2], kv[3]);
        *(u32x2*)(sK + key * KSTR + part * 4) = kk;
        const bool ok = s < SK;
#pragma unroll
        for (int e = 0; e < 4; ++e) sV[(part * 4 + e) * VSTR + key] = ok ? f2bf(vv[e]) : (u16)0;
      }
    }
    __syncthreads();
    if (active && jt < myt) {
      f32x4 s[2][4];
#pragma unroll
      for (int qt = 0; qt < 2; ++qt)
#pragma unroll
        for (int kt = 0; kt < 4; ++kt) s[qt][kt] = (f32x4){0.f, 0.f, 0.f, 0.f};
#pragma unroll
      for (int kt = 0; kt < 4; ++kt) {
#pragma unroll
        for (int ks = 0; ks < NKS; ++ks) {
          bf16x8 kf = *(const bf16x8*)(sK + (kt * 16 + fr) * KSTR + ks * 32 + fq * 8);
          s[0][kt] = __builtin_amdgcn_mfma_f32_16x16x32_bf16(kf, qf[0][ks], s[0][kt], 0, 0, 0);
          s[1][kt] = __builtin_amdgcn_mfma_f32_16x16x32_bf16(kf, qf[1][ks], s[1][kt], 0, 0, 0);
        }
      }
      unsigned mlo[2] = {0u, 0u}, mhi[2] = {0u, 0u};
      if (MODE == 0) {
        if (key0 + 64 > nkeys) {
#pragma unroll
          for (int kt = 0; kt < 4; ++kt)
#pragma unroll
            for (int j = 0; j < 4; ++j)
              if (key0 + kt * 16 + fq * 4 + j >= nkeys) { s[0][kt][j] = -1e30f; s[1][kt][j] = -1e30f; }
        }
      } else {
        const bool far = (key0 + 63) - (qpos0 + wq0) <= -128;
        if (!far) {
#pragma unroll
          for (int qt = 0; qt < 2; ++qt) {
            const int rb = key0 + fq * 4 - (qpos0 + qrow[qt]) + 128;
#pragma unroll
            for (int kt = 0; kt < 4; ++kt)
#pragma unroll
              for (int j = 0; j < 4; ++j) {
                int r = min(max(rb + kt * 16 + j, 0), 256);
                s[qt][kt][j] += sBias[r];
              }
          }
        }
#pragma unroll
        for (int qt = 0; qt < 2; ++qt) {
          const unsigned long long mm = mq[qt] >> (fq * 4);
          mlo[qt] = (unsigned)mm; mhi[qt] = (unsigned)(mm >> 32);
        }
      }
      bf16x8 pf[2][2];
#pragma unroll
      for (int qt = 0; qt < 2; ++qt) {
        float mx = -1e30f;
#pragma unroll
        for (int kt = 0; kt < 4; ++kt)
#pragma unroll
          for (int j = 0; j < 4; ++j) mx = fmaxf(mx, s[qt][kt][j]);
        mx = fmaxf(mx, __shfl_xor(mx, 16));
        mx = fmaxf(mx, __shfl_xor(mx, 32));
        const float mn = fmaxf(mrow[qt], mx);
        const float alpha = exp2f(mrow[qt] - mn);
        mrow[qt] = mn;
        float rs = 0.f;
#pragma unroll
        for (int kt = 0; kt < 4; ++kt)
#pragma unroll
          for (int j = 0; j < 4; ++j) {
            float pv = exp2f(s[qt][kt][j] - mn);
            if (MODE == 1) {
              const int keep = __builtin_amdgcn_sbfe((int)(kt < 2 ? mlo[qt] : mhi[qt]), (kt & 1) * 16 + j, 1);
              pv = __int_as_float(__float_as_int(pv) & keep);
            }
            s[qt][kt][j] = pv; rs += pv;
          }
        rs += __shfl_xor(rs, 16);
        rs += __shfl_xor(rs, 32);
        lrow[qt] = lrow[qt] * alpha + rs;
        if (__ballot(alpha != 1.f) != 0ull) {
#pragma unroll
          for (int dt = 0; dt < 8; ++dt) o[qt][dt] *= alpha;
        }
#pragma unroll
        for (int s2 = 0; s2 < 2; ++s2) {
          u32x4 pk;
          pk[0] = cvtpk(s[qt][2 * s2][0], s[qt][2 * s2][1]);
          pk[1] = cvtpk(s[qt][2 * s2][2], s[qt][2 * s2][3]);
          pk[2] = cvtpk(s[qt][2 * s2 + 1][0], s[qt][2 * s2 + 1][1]);
          pk[3] = cvtpk(s[qt][2 * s2 + 1][2], s[qt][2 * s2 + 1][3]);
          pf[qt][s2] = __builtin_bit_cast(bf16x8, pk);
        }
      }
#pragma unroll
      for (int dt = 0; dt < 8; ++dt) {
#pragma unroll
        for (int s2 = 0; s2 < 2; ++s2) {
          const u16* vp = sV + (dt * 16 + fr) * VSTR + fq * 4;
          u32x2 v0 = *(const u32x2*)(vp + (2 * s2) * 16);
          u32x2 v1 = *(const u32x2*)(vp + (2 * s2 + 1) * 16);
          u32x4 vv = {v0[0], v0[1], v1[0], v1[1]};
          bf16x8 vf = __builtin_bit_cast(bf16x8, vv);
          o[0][dt] = __builtin_amdgcn_mfma_f32_16x16x32_bf16(vf, pf[0][s2], o[0][dt], 0, 0, 0);
          o[1][dt] = __builtin_amdgcn_mfma_f32_16x16x32_bf16(vf, pf[1][s2], o[1][dt], 0, 0, 0);
        }
      }
    }
  }
  if (active) {
#pragma unroll
    for (int qt = 0; qt < 2; ++qt) {
      const int qr = wq0 + qt * 16 + fr;
      if (qr < nq) {
        const float inv = 1.f / lrow[qt];
        const size_t row = (size_t)(q0 + qr);
#pragma unroll
        for (int dt = 0; dt < 8; ++dt) {
          const size_t off = row * 2048 + h * 128 + dt * 16 + fq * 4;
          u32x2 ga = *(const u32x2*)(p.GA + off);
          u32x2 r;
          if (MODE == 0) {
            u32x2 gb = *(const u32x2*)(p.GB + off);
            r[0] = cvtpk(bflo(gb[0]) * o[qt][dt][0] * inv + bflo(ga[0]), bfhi(gb[0]) * o[qt][dt][1] * inv + bfhi(ga[0]));
            r[1] = cvtpk(bflo(gb[1]) * o[qt][dt][2] * inv + bflo(ga[1]), bfhi(gb[1]) * o[qt][dt][3] * inv + bfhi(ga[1]));
          } else {
            r[0] = cvtpk(bflo(ga[0]) * o[qt][dt][0] * inv, bfhi(ga[0]) * o[qt][dt][1] * inv);
            r[1] = cvtpk(bflo(ga[1]) * o[qt][dt][2] * inv, bfhi(ga[1]) * o[qt][dt][3] * inv);
          }
          *(u32x2*)(gdst + off) = r;
        }
      }
    }
  }
}

__global__ void __launch_bounds__(NTHREADS, 2) fwd_megakernel(Params p) {
  extern __shared__ __attribute__((aligned(16))) char smem[];
  cg::grid_group grid = cg::this_grid();
#define IDS const int tid = otid(); const int lane = tid & 63, w = tid >> 6; const int bid = blockIdx.x, nb = gridDim.x; \
  const int gw = bid * 4 + w, ngw = nb * 4; (void)tid; (void)lane; (void)gw; (void)ngw; (void)bid; (void)nb;

#if PH & (1 << 0)
  { IDS
  {
    float* st = (float*)smem;
    for (int t = bid; t < 32 * 192; t += nb) transpose_tile(p.w_in, 2048, INC, p.WT_IN, t, st);
    for (int t = bid; t < 8 * 48; t += nb) transpose_tile(p.w_uq, 512, 3072, p.WT_UQ, t, st);
    for (int t = bid; t < 4 * 32; t += nb) transpose_tile(p.w_uk, 256, 2048, p.WT_UK, t, st);
    for (int t = bid; t < 4 * 32; t += nb) transpose_tile(p.w_uv, 256, 2048, p.WT_UV, t, st);
    for (int t = bid; t < 32 * 32; t += nb) transpose_tile(p.w_out, 2048, 2048, p.WT_OUT, t, st);
    for (int t = bid; t < 32 * 128; t += nb) transpose_tile(p.w_up, 2048, 8192, p.WT_UP, t, st);
    for (int t = bid; t < 128 * 32; t += nb) transpose_tile(p.w_down, 8192, 2048, p.WT_DOWN, t, st);
    for (int r = gw; r < MT; r += ngw) {
      const float* x = r < MP ? p.x_p + (size_t)r * 2048 : p.x_s + (size_t)(r - MP) * 2048;
      rms_row_2048(x, p.g_mix, p.H + (size_t)r * 2048, lane);
    }
    const int gt = bid * NTHREADS + tid, ngt = nb * NTHREADS;
    for (int i = gt; i < 16 * 1024 * 64 / 4; i += ngt) {
      int e = i * 4; int b = e >> 16; int rem = e & 65535; int s = rem >> 6, c = rem & 63;
      size_t dst = (size_t)(MP + b * SK + s) * 64 + c;
      f32x4 a = *(const f32x4*)(p.c_idx + e), k = *(const f32x4*)(p.c_kr + e);
      u32x2 o; o[0] = cvtpk(a[0], a[1]); o[1] = cvtpk(a[2], a[3]);
      *(u32x2*)(p.IXK + dst) = o;
      o[0] = cvtpk(k[0], k[1]); o[1] = cvtpk(k[2], k[3]);
      *(u32x2*)(p.KR + dst) = o;
    }
    for (int i = gt; i < 16 * 1024 * 256 / 4; i += ngt) {
      int e = i * 4; int b = e >> 18; int rem = e & 262143; int s = rem >> 8, c = rem & 255;
      size_t dst = (size_t)(MP + b * SK + s) * 256 + c;
      f32x4 a = *(const f32x4*)(p.c_ckv + e);
      u32x2 o; o[0] = cvtpk(a[0], a[1]); o[1] = cvtpk(a[2], a[3]);
      *(u32x2*)(p.CKV + dst) = o;
    }
  }
  }
#endif
  grid.sync();
#if PH & (1 << 1)
  { IDS
  for (int rep = 0; rep < NREP(1); ++rep) gemm_phase<EPI_IN>(p, p.H, 2048, p.WT_IN, 2048, 2048, MT / 256, INP / 128, smem, nullptr, 0, bid, nb);
  }
#endif
  grid.sync();
#if PH & (1 << 2)
  { IDS
  for (int t = gw; t < MT; t += ngw) post_row(p, t, lane);
  for (int rep = 0; rep < NREP(2); ++rep) for (int t = bid * NQ; t < MT; t += nb * NQ)
    topk_group(p, t, smem, (unsigned*)(p.out + O_Y + 14000000) + (size_t)bid * 16384, (unsigned*)(p.out + O_Y + 14000000) + (size_t)(512 + bid) * 16384,
               (unsigned*)p.H + (size_t)bid * 16384);
  }
#endif
  grid.sync();
#if PH & (1 << 3)
  { IDS
    const int total = 2048 + 256;
    for (int rep = 0; rep < NREP(3); ++rep) {
      u16* gdst = (rep + 1 < NREP(3)) ? (u16*)(p.out + O_Y) : p.GA;
      for (int r = 0;; ++r) {
        int id = (r & 1) ? r * nb + (nb - 1 - bid) : r * nb + bid;
        if (r * nb >= total) break;
        if (id < total) attn_item<1>(p, id, smem, gdst);
      }
    }
  }
#endif
  grid.sync();
#if PH & (1 << 4)
  { IDS
  {
    const int gt = bid * NTHREADS + tid, ngt = nb * NTHREADS;
    for (int i = gt; i < 16 * 2048 * 6; i += ngt) {
      int r = i / 6, c = i - r * 6;
      *(u32x4*)(p.VBT_S + (size_t)r * VSS + SK + c * 8) = (u32x4){0u, 0u, 0u, 0u};
    }
    const int nqb = (MT / 256) * 24, nkb = (KROWS / 256) * 16;
    const int total = nqb + 2 * nkb;
    for (int id = bid; id < total; id += nb) {
      if (id < nqb) gemm_phase<EPI_QB>(p, p.CQ, 512, p.WT_UQ, 512, 512, MT / 256, 24, smem, p.QB, 3072, id, 1 << 30);
      else if (id < nqb + nkb) gemm_phase<EPI_BF16>(p, p.CKV, 256, p.WT_UK, 256, 256, KROWS / 256, 16, smem, p.KB, 2048, id - nqb, 1 << 30);
      else gemm_phase<EPI_VT>(p, p.CKV, 256, p.WT_UV, 256, 256, KROWS / 256, 16, smem, nullptr, 0, id - nqb - nkb, 1 << 30);
    }
  }
  }
#endif
  grid.sync();
#if PH & (1 << 5)
  { IDS
  {
    const int total = 2048 + 256;
    for (int rep = 0; rep < NREP(5); ++rep) {
      u16* gdst = (rep + 1 < NREP(5)) ? (u16*)(p.out + O_Y) : p.GB;
      for (int r = 0;; ++r) {
        int id = (r & 1) ? r * nb + (nb - 1 - bid) : r * nb + bid;
        if (r * nb >= total) break;
        if (id < total) attn_item<0>(p, id, smem, gdst);
      }
    }
  }
  }
#endif
  grid.sync();
#if PH & (1 << 6)
  { IDS
  gemm_phase<EPI_RES>(p, p.GB, 2048, p.WT_OUT, 2048, 2048, MT / 256, 16, smem, nullptr, 0, bid, nb);
  }
#endif
  grid.sync();
#if PH & (1 << 7)
  { IDS
  for (int r = gw; r < MT; r += ngw) rms_row_2048(p.out + O_Y + (size_t)r * 2048, p.g_ffn, p.H2 + (size_t)r * 2048, lane);
  }
#endif
  grid.sync();
#if PH & (1 << 8)
  { IDS
  gemm_phase<EPI_RELU2>(p, p.H2, 2048, p.WT_UP, 2048, 2048, MT / 256, 64, smem, nullptr, 0, bid, nb);
  }
#endif
  grid.sync();
#if PH & (1 << 9)
  { IDS
  gemm_phase<EPI_ACC>(p, p.U, DFF, p.WT_DOWN, DFF, DFF, MT / 256, 16, smem, nullptr, 0, bid, nb);
  }
#endif
  grid.sync();
#if PH & (1 << 10)
  { IDS
  for (int r = gw; r < MT; r += ngw) {
    float* x = p.out + O_Y + (size_t)r * 2048;
    f32x4 v[8];
    float ss = 0.f;
#pragma unroll
    for (int i = 0; i < 8; ++i) {
      v[i] = *(const f32x4*)(x + i * 256 + lane * 4);
      ss += v[i][0] * v[i][0] + v[i][1] * v[i][1] + v[i][2] * v[i][2] + v[i][3] * v[i][3];
    }
    ss = wave_sum(ss);
    float rr = rsqrtf(ss * (1.f / 2048.f) + 1e-6f);
#pragma unroll
    for (int i = 0; i < 8; ++i) {
      f32x4 gg = *(const f32x4*)(p.g_fin + i * 256 + lane * 4);
      f32x4 o = {v[i][0] * rr * gg[0], v[i][1] * rr * gg[1], v[i][2] * rr * gg[2], v[i][3] * rr * gg[3]};
      *(f32x4*)(x + i * 256 + lane * 4) = o;
    }
  }
  }
#endif
}

extern "C" void kernel_launch(void* const* d_in, const int* in_sizes, int n_in, void* d_out, int out_size, void* d_ws, size_t ws_size,
                              hipStream_t stream) {
  static int grid_blocks = 0;
  if (!grid_blocks) {
    int dev = 0, cus = 0, per_cu = 0;
    hipGetDevice(&dev);
    hipDeviceGetAttribute(&cus, hipDeviceAttributeMultiprocessorCount, dev);
    if (hipFuncSetAttribute((const void*)fwd_megakernel, hipFuncAttributeMaxDynamicSharedMemorySize, LDS_BYTES) != hipSuccess)
      fprintf(stderr, "kernel_launch: hipFuncSetAttribute failed\n");
    hipOccupancyMaxActiveBlocksPerMultiprocessor(&per_cu, (const void*)fwd_megakernel, NTHREADS, LDS_BYTES);
    if (per_cu < 1) per_cu = 1;
    if (per_cu > 2) per_cu = 2;
    grid_blocks = cus * per_cu;
  }
  Params p{};
  const float* const* in = (const float* const*)d_in;
  p.x_p = in[0]; p.x_s = in[1]; p.c_ak = in[2]; p.c_av = in[3]; p.c_idx = in[4]; p.c_ckv = in[5]; p.c_kr = in[6]; p.rel = in[7];
  p.g_mix = in[8]; p.w_in = in[9]; p.g_q = in[10]; p.w_uq = in[11]; p.g_kv = in[12]; p.w_uk = in[13]; p.w_uv = in[14]; p.w_out = in[15];
  p.g_ffn = in[16]; p.w_up = in[17]; p.w_down = in[18]; p.g_fin = in[19];
  p.out = (float*)d_out;
  char* ws = (char*)d_ws;
  size_t off = 0;
  auto alloc = [&](size_t bytes) { char* r = ws + off; off += (bytes + 255) & ~(size_t)255; return r; };
  p.WT_UQ = (u16*)alloc((size_t)3072 * 512 * 2);
  p.WT_UK = (u16*)alloc((size_t)2048 * 256 * 2);
  p.WT_UV = (u16*)alloc((size_t)2048 * 256 * 2);
  p.WT_OUT = (u16*)alloc((size_t)2048 * 2048 * 2);
  p.WT_UP = (u16*)alloc((size_t)8192 * 2048 * 2);
  p.WT_DOWN = (u16*)alloc((size_t)2048 * 8192 * 2);
  p.CQ = (u16*)alloc((size_t)MT * 512 * 2);
  p.CKV = (u16*)alloc((size_t)KROWS * 256 * 2);
  p.KR = (u16*)alloc((size_t)KROWS * 64 * 2);
  p.GA = (u16*)alloc((size_t)MT * 2048 * 2);
  p.GB = (u16*)alloc((size_t)MT * 2048 * 2);
  p.CS = (float*)alloc((size_t)MT * 32 * 4);
  p.SN = (float*)alloc((size_t)MT * 32 * 4);
  const size_t ubase = off;
  p.WT_IN = (u16*)alloc((size_t)INP * 2048 * 2);
  p.H = (u16*)alloc((size_t)MT * 2048 * 2);
  p.AQ = (u16*)alloc((size_t)MT * 2048 * 2);
  p.KA = (u16*)alloc((size_t)MP * 2048 * 2);
  p.VAT = (u16*)alloc((size_t)MP * 2048 * 2);
  p.IXQ = (u16*)alloc((size_t)MT * 1024 * 2);
  p.IXK = (u16*)alloc((size_t)KROWS * 64 * 2);
  p.SEL = (unsigned long long*)alloc((size_t)MT * 256 * 8);
  p.IXW = (float*)alloc((size_t)MT * 16 * 4);
  const size_t endA = off;
  off = ubase;
  p.QB = (u16*)alloc((size_t)MT * 3072 * 2);
  p.KB = (u16*)alloc((size_t)KROWS * 2048 * 2);
  p.VBT_P = (u16*)alloc((size_t)2048 * MP * 2);
  p.VBT_S = (u16*)alloc((size_t)16 * 2048 * VSS * 2);
  const size_t endB = off;
  off = ubase;
  p.H2 = (u16*)alloc((size_t)MT * 2048 * 2);
  p.U = (u16*)alloc((size_t)MT * DFF * 2);
  const size_t endC = off;
  size_t need = endA > endB ? endA : endB;
  if (endC > need) need = endC;
  if (need > ws_size) { fprintf(stderr, "kernel_launch: workspace too small: need %zu have %zu\n", need, ws_size); return; }
  void* args[] = {&p};
  hipError_t e = hipLaunchCooperativeKernel((const void*)fwd_megakernel, dim3(grid_blocks), dim3(NTHREADS), args, LDS_BYTES, stream);
  if (e != hipSuccess) fprintf(stderr, "cooperative launch failed: %s (grid %d)\n", hipGetErrorString(e), grid_blocks);
}
```

```cpp
#include <hip/hip_runtime.h>
#include <hip/hip_cooperative_groups.h>
#include <cstdio>
#include <cstdint>
namespace cg = cooperative_groups;

typedef unsigned short u16;
typedef __attribute__((ext_vector_type(8))) short bf16x8;
typedef __attribute__((ext_vector_type(4))) short bf16x4;
typedef __attribute__((ext_vector_type(4))) float f32x4;
typedef __attribute__((ext_vector_type(2))) float f32x2;
typedef __attribute__((ext_vector_type(2))) __bf16 bf16x2_t;
typedef __attribute__((ext_vector_type(4))) unsigned u32x4;
typedef __attribute__((ext_vector_type(2))) unsigned u32x2;

#define DI __device__ __forceinline__

constexpr int MP = 16384;
constexpr int MS = 256;
constexpr int MT = MP + MS;
constexpr int DM = 2048;
constexpr int INC = 12176;
constexpr int INP = 12288;
constexpr int SK = 1040;
constexpr int KROWS = MP + 16 * SK;
constexpr int VSS = 1088;
constexpr int DFF = 8192;
constexpr int ZRW = 832;
#ifndef PH
#define PH 0x7ff
#endif
#ifndef REP
#define REP 0
#endif
#define NREP(k) (((REP >> (k)) & 1) + 1)
constexpr int NTHREADS = 256;
constexpr int LDS_BYTES = 75776;

constexpr size_t O_Y = 0;
constexpr size_t O_AKP = 34078720;
constexpr size_t O_AVP = 67633152;
constexpr size_t O_IDXP = 101187584;
constexpr size_t O_CKVP = 102236160;
constexpr size_t O_KRP = 106430464;
constexpr size_t O_AKS = 107479040;
constexpr size_t O_AVS = 108003328;
constexpr size_t O_IDXS = 108527616;
constexpr size_t O_CKVS = 108544000;
constexpr size_t O_KRS = 108609536;

struct Params {
  const float *x_p, *x_s, *c_ak, *c_av, *c_idx, *c_ckv, *c_kr, *rel, *g_mix, *w_in, *g_q, *w_uq, *g_kv, *w_uk, *w_uv, *w_out, *g_ffn, *w_up, *w_down, *g_fin;
  float* out;
  u16 *WT_UQ, *WT_UK, *WT_UV, *WT_OUT, *WT_UP, *WT_DOWN, *CQ, *CKV, *KR, *GA, *GB;
  float *CS, *SN;
  u16 *WT_IN, *H, *AQ, *KA, *VAT, *IXQ, *IXK;
  float* IXW;
  unsigned long long* SEL;
  u16 *QB, *KB, *VBT_P, *VBT_S;
  u16 *H2, *U;
};

DI int otid() { int t = threadIdx.x; asm volatile("" : "+v"(t)); return t; }
DI unsigned cvtpk(float lo, float hi) {
  f32x2 v = {lo, hi};
  bf16x2_t b = __builtin_convertvector(v, bf16x2_t);
  return __builtin_bit_cast(unsigned, b);
}
DI u16 f2bf(float x) { return (u16)(cvtpk(x, 0.f) & 0xffffu); }
DI float bf2f(u16 b) { return __uint_as_float(((unsigned)b) << 16); }
DI float bflo(unsigned w) { return __uint_as_float(w << 16); }
DI float bfhi(unsigned w) { return __uint_as_float(w & 0xffff0000u); }
DI float dot2bf(unsigned a, unsigned b, float c) {
  return __builtin_amdgcn_fdot2_f32_bf16(__builtin_bit_cast(bf16x2_t, a), __builtin_bit_cast(bf16x2_t, b), c, false);
}
DI float wave_sum(float v) {
#pragma unroll
  for (int o = 32; o > 0; o >>= 1) v += __shfl_xor(v, o);
  return v;
}
DI int qpos_of(int t) { return t < MP ? t : 1024 + ((t - MP) & 15); }
DI int krow_of(int t) { return t < MP ? t : MP + ((t - MP) >> 4) * SK + 1024 + ((t - MP) & 15); }
DI float inv_freq(int i) { return exp2f(-(float)i * 0.41524101186092029f); }

DI void transpose_tile(const float* __restrict__ W, int K, int N, u16* __restrict__ Wt, int tile, float* s  ) {
  const int nkt = K >> 6;
  const int kt = tile % nkt, nt = tile / nkt;
  const int k0 = kt << 6, n0 = nt << 6;
  const int tid = otid();
  const int c = tid & 63, r0 = tid >> 6;
  __syncthreads();
#pragma unroll
  for (int i = 0; i < 16; ++i) {
    int r = i * 4 + r0;
    float v = (n0 + c < N) ? W[(size_t)(k0 + r) * N + n0 + c] : 0.f;
    s[r * 65 + c] = v;
  }
  __syncthreads();
  const int kp = (tid & 31) * 2, rr0 = tid >> 5;
#pragma unroll
  for (int i = 0; i < 8; ++i) {
    int rr = i * 8 + rr0;
    unsigned pk = cvtpk(s[kp * 65 + rr], s[(kp + 1) * 65 + rr]);
    *(unsigned*)(Wt + (size_t)(n0 + rr) * K + k0 + kp) = pk;
  }
}

DI void rms_row_2048(const float* __restrict__ x, const float* __restrict__ g, u16* __restrict__ out, int lane) {
  f32x4 v[8];
  float ss = 0.f;
#pragma unroll
  for (int i = 0; i < 8; ++i) {
    v[i] = *(const f32x4*)(x + i * 256 + lane * 4);
    ss += v[i][0] * v[i][0] + v[i][1] * v[i][1] + v[i][2] * v[i][2] + v[i][3] * v[i][3];
  }
  ss = wave_sum(ss);
  float r = rsqrtf(ss * (1.f / 2048.f) + 1e-6f);
#pragma unroll
  for (int i = 0; i < 8; ++i) {
    f32x4 gg = *(const f32x4*)(g + i * 256 + lane * 4);
    u32x2 o;
    o[0] = cvtpk(v[i][0] * r * gg[0], v[i][1] * r * gg[1]);
    o[1] = cvtpk(v[i][2] * r * gg[2], v[i][3] * r * gg[3]);
    *(u32x2*)(out + i * 256 + lane * 4) = o;
  }
}

enum { EPI_IN = 0, EPI_QB, EPI_BF16, EPI_VT, EPI_RES, EPI_RELU2, EPI_ACC };
constexpr float QSC = 0.07216878364870322f * 1.4426950408889634f;
constexpr int LSTR = 72;

template <int EPI>
DI void gemm_epilogue(const Params& p, f32x4 (&acc)[8][4], int m0, int n0, int wr, int wc, int fr, int fq, u16* Cb, int ldc) {
  const int cw = n0 + wc * 64;
#pragma clang loop unroll(full)
  for (int m = 0; m < 8; ++m) {
    const int rb = m0 + wr * 128 + m * 16 + fq * 4;
    if (EPI == EPI_QB) {
      const int within = cw % 192;
      if (within == 128) {
#pragma clang loop unroll(full)
        for (int n = 0; n < 2; ++n) {
          const int i = n * 16 + fr;
#pragma clang loop unroll(full)
          for (int j = 0; j < 4; ++j) {
            const int row = rb + j;
            const float cs = p.CS[(size_t)row * 32 + i], sn = p.SN[(size_t)row * 32 + i];
            float x1 = acc[m][n][j] * QSC, x2 = acc[m][n + 2][j] * QSC;
            p.QB[(size_t)row * 3072 + cw + i] = f2bf(x1 * cs - x2 * sn);
            p.QB[(size_t)row * 3072 + cw + i + 32] = f2bf(x1 * sn + x2 * cs);
          }
        }
        continue;
      }
    }
#pragma clang loop unroll(full)
    for (int n = 0; n < 4; ++n) {
      const int colt = cw + n * 16;
      const int col = colt + fr;
      if (EPI == EPI_IN) {
        if (colt >= 4096 && colt < 6144 && rb < MP) {
          u32x2 pk;
          pk[0] = cvtpk(acc[m][n][0], acc[m][n][1]);
          pk[1] = cvtpk(acc[m][n][2], acc[m][n][3]);
          *(u32x2*)(p.VAT + (size_t)(col - 4096) * MP + rb) = pk;
        }
      }
      if (EPI == EPI_VT) {
        u32x2 pk;
        pk[0] = cvtpk(acc[m][n][0], acc[m][n][1]);
        pk[1] = cvtpk(acc[m][n][2], acc[m][n][3]);
        u16* dst;
        if (rb < MP) dst = p.VBT_P + (size_t)col * MP + rb;
        else { int r2 = rb - MP; int b = r2 / SK; int s = r2 - b * SK; dst = p.VBT_S + ((size_t)b * 2048 + col) * VSS + s; }
        *(u32x2*)dst = pk;
        continue;
      }
#pragma clang loop unroll(full)
      for (int j = 0; j < 4; ++j) {
        const int row = rb + j;
        const float v = acc[m][n][j];
        if (EPI == EPI_IN) {
          if (colt < 2048) p.AQ[(size_t)row * 2048 + col] = f2bf(v * (0.08838834764831845f * 1.4426950408889634f));
          else if (colt < 4096) {
            int c = col - 2048;
            if (row < MP) { p.out[O_AKP + (size_t)row * 2048 + c] = v; p.KA[(size_t)row * 2048 + c] = f2bf(v); }
            else p.out[O_AKS + (size_t)(row - MP) * 2048 + c] = v;
          } else if (colt < 6144) {
            int c = col - 4096;
            if (row < MP) p.out[O_AVP + (size_t)row * 2048 + c] = v;
            else p.out[O_AVS + (size_t)(row - MP) * 2048 + c] = v;
          } else if (colt < 7168) p.IXQ[(size_t)row * 1024 + (col - 6144)] = f2bf(v);
          else if (colt < 7232) {
            int c = col - 7168;
            if (row < MP) p.out[O_IDXP + (size_t)row * 64 + c] = v; else p.out[O_IDXS + (size_t)(row - MP) * 64 + c] = v;
            p.IXK[(size_t)krow_of(row) * 64 + c] = f2bf(v);
          } else if (colt < 7248) p.IXW[(size_t)row * 16 + (col - 7232)] = v * 0.25f;
          else if (colt < 8080) p.out[O_Y + (size_t)row * ZRW + (col - 7248)] = v;
          else if (colt < 10128) p.GA[(size_t)row * 2048 + (col - 8080)] = f2bf(1.f / (1.f + __expf(-v)));
          else if (colt < INC) p.GB[(size_t)row * 2048 + (col - 10128)] = f2bf(1.f / (1.f + __expf(-v)));
        } else if (EPI == EPI_QB) {
          Cb[(size_t)row * ldc + col] = f2bf(v * QSC);
        } else if (EPI == EPI_BF16) {
          Cb[(size_t)row * ldc + col] = f2bf(v);
        } else if (EPI == EPI_RES) {
          float xv = row < MP ? p.x_p[(size_t)row * 2048 + col] : p.x_s[(size_t)(row - MP) * 2048 + col];
          p.out[O_Y + (size_t)row * 2048 + col] = xv + v;
        } else if (EPI == EPI_RELU2) {
          float r = fmaxf(v, 0.f);
          p.U[(size_t)row * DFF + col] = f2bf(r * r);
        } else if (EPI == EPI_ACC) {
          p.out[O_Y + (size_t)row * 2048 + col] += v;
        }
      }
    }
  }
}

template <int EPI>
DI void gemm_tile(const Params& p, const u16* __restrict__ A, int lda, const u16* __restrict__ Bt, int ldb, int K, int m0, int n0,
                  char* smem, u16* Cb, int ldc) {
  u16* sA = (u16*)smem;
  u16* sB = sA + 256 * LSTR;
  const int tid = otid(), lane = tid & 63, w = tid >> 6;
  const int wr = w >> 1, wc = w & 1, fr = lane & 15, fq = lane >> 4;
  f32x4 acc[8][4];
#pragma unroll
  for (int m = 0; m < 8; ++m)
#pragma unroll
    for (int n = 0; n < 4; ++n) acc[m][n] = (f32x4){0.f, 0.f, 0.f, 0.f};
  const int lr = tid >> 3, lk = (tid & 7) * 8;
  const u16* Ag = A + (size_t)(m0 + lr) * lda + lk;
  const u16* Bg = Bt + (size_t)(n0 + lr) * ldb + lk;
  const int nk = K >> 6;
  const u16* cA = sA + (wr * 128 + fr) * LSTR + fq * 8;
  const u16* cB = sB + (wc * 64 + fr) * LSTR + fq * 8;
  for (int kt = 0; kt < nk; ++kt) {
    const int k0 = kt << 6;
    __syncthreads();
    {
      u32x4 ra[8], rb[4];
#pragma unroll
      for (int i = 0; i < 8; ++i) ra[i] = *(const u32x4*)(Ag + (size_t)(i * 32) * lda + k0);
#pragma unroll
      for (int i = 0; i < 4; ++i) rb[i] = *(const u32x4*)(Bg + (size_t)(i * 32) * ldb + k0);
#pragma unroll
      for (int i = 0; i < 8; ++i) *(u32x4*)(sA + (lr + i * 32) * LSTR + lk) = ra[i];
#pragma unroll
      for (int i = 0; i < 4; ++i) *(u32x4*)(sB + (lr + i * 32) * LSTR + lk) = rb[i];
    }
    __syncthreads();
#pragma unroll
    for (int ks = 0; ks < 2; ++ks) {
      bf16x8 bfr[4];
#pragma unroll
      for (int n = 0; n < 4; ++n) bfr[n] = *(const bf16x8*)(cB + n * 16 * LSTR + ks * 32);
#pragma unroll
      for (int mh = 0; mh < 2; ++mh) {
        bf16x8 af[4];
#pragma unroll
        for (int m = 0; m < 4; ++m) af[m] = *(const bf16x8*)(cA + (mh * 4 + m) * 16 * LSTR + ks * 32);
#pragma unroll
        for (int m = 0; m < 4; ++m)
#pragma unroll
          for (int n = 0; n < 4; ++n)
            acc[mh * 4 + m][n] = __builtin_amdgcn_mfma_f32_16x16x32_bf16(af[m], bfr[n], acc[mh * 4 + m][n], 0, 0, 0);
      }
    }
  }
  gemm_epilogue<EPI>(p, acc, m0, n0, wr, wc, fr, fq, Cb, ldc);
}

template <int EPI>
DI void gemm_phase(const Params& p, const u16* A, int lda, const u16* Bt, int ldb, int K, int mtiles, int ntiles, char* smem, u16* Cb, int ldc,
                   int start, int stride) {
  const int total = mtiles * ntiles;
  const int GM = 8;
  for (int id = start; id < total; id += stride) {
    const int per = GM * ntiles;
    const int g = id / per, rem = id - g * per;
    const int fm = g * GM;
    const int gsz = min(GM, mtiles - fm);
    const int mt = fm + rem % gsz, nt = rem / gsz;
    gemm_tile<EPI>(p, A, lda, Bt, ldb, K, mt * 256, nt * 128, smem, Cb, ldc);
  }
}

DI void post_row(const Params& p, int t, int lane) {
  const float* zr = p.out + O_Y + (size_t)t * ZRW;
  {
    f32x4 a = *(const f32x4*)(zr + lane * 4), b = *(const f32x4*)(zr + 256 + lane * 4);
    float ss = a[0] * a[0] + a[1] * a[1] + a[2] * a[2] + a[3] * a[3] + b[0] * b[0] + b[1] * b[1] + b[2] * b[2] + b[3] * b[3];
    ss = wave_sum(ss);
    float r = rsqrtf(ss * (1.f / 512.f) + 1e-6f);
    f32x4 ga = *(const f32x4*)(p.g_q + lane * 4), gb = *(const f32x4*)(p.g_q + 256 + lane * 4);
    u32x2 o;
    o[0] = cvtpk(a[0] * r * ga[0], a[1] * r * ga[1]); o[1] = cvtpk(a[2] * r * ga[2], a[3] * r * ga[3]);
    *(u32x2*)(p.CQ + (size_t)t * 512 + lane * 4) = o;
    o[0] = cvtpk(b[0] * r * gb[0], b[1] * r * gb[1]); o[1] = cvtpk(b[2] * r * gb[2], b[3] * r * gb[3]);
    *(u32x2*)(p.CQ + (size_t)t * 512 + 256 + lane * 4) = o;
  }
  const int kr_row = krow_of(t);
  {
    f32x4 a = *(const f32x4*)(zr + 512 + lane * 4);
    float ss = a[0] * a[0] + a[1] * a[1] + a[2] * a[2] + a[3] * a[3];
    ss = wave_sum(ss);
    float r = rsqrtf(ss * (1.f / 256.f) + 1e-6f);
    f32x4 g = *(const f32x4*)(p.g_kv + lane * 4);
    f32x4 o = {a[0] * r * g[0], a[1] * r * g[1], a[2] * r * g[2], a[3] * r * g[3]};
    float* od = t < MP ? p.out + O_CKVP + (size_t)t * 256 : p.out + O_CKVS + (size_t)(t - MP) * 256;
    *(f32x4*)(od + lane * 4) = o;
    u32x2 ob; ob[0] = cvtpk(o[0], o[1]); ob[1] = cvtpk(o[2], o[3]);
    *(u32x2*)(p.CKV + (size_t)kr_row * 256 + lane * 4) = ob;
  }
  if (lane < 32) {
    float x1 = zr[768 + lane], x2 = zr[768 + 32 + lane];
    float ang = (float)qpos_of(t) * inv_freq(lane);
    float cs = cosf(ang), sn = sinf(ang);
    p.CS[(size_t)t * 32 + lane] = cs; p.SN[(size_t)t * 32 + lane] = sn;
    float o1 = x1 * cs - x2 * sn, o2 = x1 * sn + x2 * cs;
    float* od = t < MP ? p.out + O_KRP + (size_t)t * 64 : p.out + O_KRS + (size_t)(t - MP) * 64;
    od[lane] = o1; od[lane + 32] = o2;
    p.KR[(size_t)kr_row * 64 + lane] = f2bf(o1);
    p.KR[(size_t)kr_row * 64 + lane + 32] = f2bf(o2);
  }
}

template <int CTRL> DI float dpp_add(float v) {
  int sft = __builtin_amdgcn_update_dpp(0, __float_as_int(v), CTRL, 0xf, 0xf, true);
  return v + __int_as_float(sft);
}
DI float row16_sum(float v) { v = dpp_add<0x111>(v); v = dpp_add<0x112>(v); v = dpp_add<0x114>(v); v = dpp_add<0x118>(v); return v; }
DI unsigned fkey(float f) { unsigned u = __float_as_uint(f); return (u & 0x80000000u) ? ~u : (u | 0x80000000u); }

DI void radix_select(unsigned* sc, int* hist, int* misc, int n, unsigned long long* sel, int tid, int lane, int w) {
  __syncthreads();
  unsigned prefix = 0;
  int remaining = 256;
#pragma unroll 1
  for (int pass = 0; pass < 3; ++pass) {
    const int shift = pass == 0 ? 21 : (pass == 1 ? 10 : 0);
    const int bits = pass == 2 ? 10 : 11;
    const unsigned bmask = (1u << bits) - 1u;
    if (pass > 0) {
      *(int4*)&hist[tid * 8] = make_int4(0, 0, 0, 0);
      *(int4*)&hist[tid * 8 + 4] = make_int4(0, 0, 0, 0);
      __syncthreads();
      const int hs = shift + bits;
      const unsigned want = prefix >> hs;
      for (int i = tid * 4; i < n; i += NTHREADS * 4) {
        const u32x4 u4 = *(const u32x4*)(sc + i);
#pragma unroll
        for (int e = 0; e < 4; ++e)
          if ((u4[e] >> hs) == want) atomicAdd(&hist[(u4[e] >> shift) & bmask], 1);
      }
      __syncthreads();
    }
    const int4 h0 = *(const int4*)&hist[tid * 8], h1 = *(const int4*)&hist[tid * 8 + 4];
    const int s8 = h0.x + h0.y + h0.z + h0.w + h1.x + h1.y + h1.z + h1.w;
    int suf = s8;
#pragma unroll
    for (int d = 1; d < 64; d <<= 1) { int v = __shfl_down(suf, d); if (lane + d < 64) suf += v; }
    if (lane == 0) misc[w] = suf;
    __syncthreads();
    int above = 0;
    for (int ww = w + 1; ww < 4; ++ww) above += misc[ww];
    const int excl = above + suf - s8;
    if (excl < remaining && remaining <= excl + s8) {
      int c = excl, bin = 0, nrem = 0;
#define TK_STEP(val, idx) if (c < remaining && remaining <= c + (val)) { bin = tid * 8 + (idx); nrem = remaining - c; } c += (val);
      TK_STEP(h1.w, 7) TK_STEP(h1.z, 6) TK_STEP(h1.y, 5) TK_STEP(h1.x, 4) TK_STEP(h0.w, 3) TK_STEP(h0.z, 2) TK_STEP(h0.y, 1) TK_STEP(h0.x, 0)
#undef TK_STEP
      misc[4] = bin; misc[5] = nrem;
    }
    __syncthreads();
    prefix |= ((unsigned)misc[4]) << shift;
    remaining = misc[5];
    __syncthreads();
  }
  const unsigned T = prefix;
  const int seg = ((n + 255) >> 8) << 6;
  const int beg = w * seg;
  int ceq = 0;
  for (int i = beg + lane; i < beg + seg; i += 64) {
    bool in = i < n; unsigned u = in ? sc[i] : 0u;
    ceq += __popcll(__ballot(in && u == T));
  }
  if (lane == 0) misc[12 + w] = ceq;
  __syncthreads();
  int oe = 0;
  for (int ww = 0; ww < w; ++ww) oe += misc[12 + ww];
  const unsigned long long lt = (1ull << lane) - 1ull;
  for (int i0 = beg; i0 < beg + seg; i0 += 64) {
    const int i = i0 + lane;
    bool in = i < n; unsigned u = in ? sc[i] : 0u;
    bool g = in && u > T, e = in && u == T;
    unsigned long long be = __ballot(e);
    int pe = oe + __popcll(be & lt);
    unsigned long long sm = __ballot(g || (e && pe < remaining));
    if (lane == 0 && i0 < n) sel[i0 >> 6] = sm;
    oe += __popcll(be);
  }
}

constexpr int NQ = 4;
DI void topk_group(const Params& p, int t, char* smem, unsigned* scr1, unsigned* scr2, unsigned* scr3) {
  unsigned* sc = (unsigned*)smem;
  int* hist = (int*)(smem + 65536);
  int* misc = hist + 2048;
  const int tid = otid(), lane = tid & 63, w = tid >> 6, fr = lane & 15, fq = lane >> 4;
  int n; const u16* ixk;
  if (t < MP) { n = 64 * ((t >> 6) + 1); ixk = p.IXK; }
  else { int b = (t - MP) >> 4; n = SK; ixk = p.IXK + (size_t)(MP + b * SK) * 64; }
  unsigned long long* sel = p.SEL + (size_t)t * 256;
  __syncthreads();
  if (n <= 256) {
    if (tid < 4) {
      unsigned long long v = (tid < (n >> 6)) ? ~0ull : 0ull;
#pragma unroll
      for (int qi = 0; qi < NQ; ++qi) sel[qi * 256 + tid] = v;
    }
    return;
  }
  *(int4*)&hist[tid * 8] = make_int4(0, 0, 0, 0);
  *(int4*)&hist[tid * 8 + 4] = make_int4(0, 0, 0, 0);
  __syncthreads();
  {
    const u16* q = p.IXQ + (size_t)t * 1024 + fr * 64 + fq * 8;
    bf16x8 a0[NQ], a1[NQ];
    f32x4 wv[NQ];
#pragma unroll
    for (int qi = 0; qi < NQ; ++qi) {
      a0[qi] = *(const bf16x8*)(q + qi * 1024); a1[qi] = *(const bf16x8*)(q + qi * 1024 + 32);
      wv[qi] = *(const f32x4*)(p.IXW + (size_t)(t + qi) * 16 + fq * 4);
    }
    const int ntile = n >> 4;
    for (int kt0 = w; kt0 < ntile; kt0 += 32) {
      bf16x8 b0[8], b1[8];
#pragma unroll
      for (int g = 0; g < 8; ++g) {
        const int kt = min(kt0 + g * 4, ntile - 1);
        const u16* kp = ixk + (size_t)(kt * 16 + fr) * 64 + fq * 8;
        b0[g] = *(const bf16x8*)kp; b1[g] = *(const bf16x8*)(kp + 32);
      }
      float pt[NQ][8];
#pragma unroll
      for (int g = 0; g < 8; ++g) {
#pragma unroll
        for (int qi = 0; qi < NQ; ++qi) {
          f32x4 c = {0.f, 0.f, 0.f, 0.f};
          c = __builtin_amdgcn_mfma_f32_16x16x32_bf16(a0[qi], b0[g], c, 0, 0, 0);
          c = __builtin_amdgcn_mfma_f32_16x16x32_bf16(a1[qi], b1[g], c, 0, 0, 0);
          pt[qi][g] = fmaxf(c[0], 0.f) * wv[qi][0] + fmaxf(c[1], 0.f) * wv[qi][1] + fmaxf(c[2], 0.f) * wv[qi][2] + fmaxf(c[3], 0.f) * wv[qi][3];
        }
      }
#pragma unroll
      for (int g = 0; g < 8; g += 2) {
        const int kt = kt0 + (g + (lane >> 5)) * 4;
        const bool st = (lane & 16) == 0 && kt < ntile;
#pragma unroll
        for (int qi = 0; qi < NQ; ++qi) {
          auto r32 = __builtin_amdgcn_permlane32_swap(__float_as_uint(pt[qi][g]), __float_as_uint(pt[qi][g + 1]), false, false);
          float s2 = __uint_as_float(r32[0]) + __uint_as_float(r32[1]);
          auto r16 = __builtin_amdgcn_permlane16_swap(__float_as_uint(s2), __float_as_uint(s2), false, false);
          float sv = __uint_as_float(r16[0]) + __uint_as_float(r16[1]);
          if (st) {
            unsigned u = fkey(sv);
            if (qi == 0) { sc[kt * 16 + fr] = u; atomicAdd(&hist[u >> 21], 1); }
            else if (qi == 1) scr1[kt * 16 + fr] = u;
            else if (qi == 2) scr2[kt * 16 + fr] = u;
            else scr3[kt * 16 + fr] = u;
          }
        }
      }
    }
  }
  radix_select(sc, hist, misc, n, sel, tid, lane, w);
#pragma unroll 1
  for (int qi = 1; qi < NQ; ++qi) {
    const unsigned* scr = qi == 1 ? scr1 : (qi == 2 ? scr2 : scr3);
    __syncthreads();
    *(int4*)&hist[tid * 8] = make_int4(0, 0, 0, 0);
    *(int4*)&hist[tid * 8 + 4] = make_int4(0, 0, 0, 0);
    __syncthreads();
    for (int i = tid * 4; i < n; i += NTHREADS * 4) {
      const u32x4 u4 = *(const u32x4*)(scr + i);
      *(u32x4*)(sc + i) = u4;
#pragma unroll
      for (int e = 0; e < 4; ++e) atomicAdd(&hist[u4[e] >> 21], 1);
    }
    radix_select(sc, hist, misc, n, sel + qi * 256, tid, lane, w);
  }
}

constexpr int KSTR = 200;
constexpr int VSTR = 72;

template <int MODE>
DI void attn_item(const Params& p, int item, char* smem, u16* gdst) {
  constexpr int NKS = MODE == 0 ? 6 : 4;
  u16* sK = (u16*)smem;
  u16* sV = sK + 64 * KSTR;
  float* sBias = (float*)(sV + 128 * VSTR);
  const int tid = otid(), lane = tid & 63, w = tid >> 6, fr = lane & 15, fq = lane >> 4;
  int h, q0, nq, krow0, nkeys, ntiles, myt, b = 0, qpos0;
  const u16* vt; size_t vstride;
  const bool sample = item >= 2048;
  if (!sample) {
    const int i = 127 - (item >> 4);
    h = item & 15; q0 = i * 128; nq = 128; krow0 = 0; nkeys = q0 + 128; ntiles = 2 * i + 2; qpos0 = q0;
    vt = (MODE == 0 ? p.VBT_P : p.VAT) + (size_t)h * 128 * MP; vstride = MP;
    myt = (w < 2) ? ntiles - 1 : ntiles;
  } else {
    const int j = item - 2048; b = j >> 4;
    h = j & 15; q0 = MP + b * 16; nq = 16; krow0 = MP + b * SK; nkeys = SK; ntiles = 17; qpos0 = 1024;
    vt = p.VBT_S + ((size_t)b * 2048 + h * 128) * VSS; vstride = VSS;
    myt = ntiles;
  }
  const int wq0 = w * 32;
  const bool active = wq0 < nq;
  if (MODE == 1) {
    __syncthreads();
    for (int i = tid; i < 257; i += NTHREADS) {
      int rel = i - 128;
      int ret = rel > 0 ? 16 : 0;
      int n = rel < 0 ? -rel : rel;
      float lf = logf((float)max(n, 1) / 8.0f) / 2.772588722239781f * 8.0f;
      int large = min(8 + (int)lf, 15);
      int bk = ret + (n < 8 ? n : large);
      sBias[i] = (p.rel[bk * 16 + h] - p.rel[15 * 16 + h]) * 1.4426950408889634f;
    }
  }
  bf16x8 qf[2][NKS];
  int qrow[2];
#pragma unroll
  for (int qt = 0; qt < 2; ++qt) {
    const int qr = min(wq0 + qt * 16 + fr, nq - 1);
    qrow[qt] = qr;
    const u16* qp = (MODE == 0) ? p.QB + (size_t)(q0 + qr) * 3072 + h * 192 + fq * 8 : p.AQ + (size_t)(q0 + qr) * 2048 + h * 128 + fq * 8;
#pragma unroll
    for (int ks = 0; ks < NKS; ++ks) qf[qt][ks] = *(const bf16x8*)(qp + ks * 32);
  }
  f32x4 o[2][8];
#pragma unroll
  for (int qt = 0; qt < 2; ++qt)
#pragma unroll
    for (int dt = 0; dt < 8; ++dt) o[qt][dt] = (f32x4){0.f, 0.f, 0.f, 0.f};
  float mrow[2] = {-1e30f, -1e30f}, lrow[2] = {0.f, 0.f};
  const float SC = (MODE == 0 ? 0.07216878364870322f : 0.08838834764831845f) * 1.4426950408889634f;

  unsigned long long mqn[2] = {0ull, 0ull};
  if (MODE == 1) {
#pragma unroll
    for (int qt = 0; qt < 2; ++qt) mqn[qt] = p.SEL[(size_t)(q0 + qrow[qt]) * 256];
  }
  constexpr int NKL = MODE == 0 ? 6 : 4;
  const bool direct = (MODE == 1) && sample;
  u32x4 rk[NKL], rv[4];
#define KV_LOAD(JT) { const size_t kr0_ = (size_t)(krow0 + (JT) * 64); const u16* kb_ = (MODE == 0 ? p.KB : p.KA) + (kr0_ + (tid >> 4)) * 2048 + h * 128 + (tid & 15) * 8; \
    _Pragma("unroll") for (int i = 0; i < 4; ++i) rk[i] = *(const u32x4*)(kb_ + (size_t)i * 16 * 2048); \
    if (MODE == 0) { const u16* kr_ = p.KR + (kr0_ + (tid >> 3)) * 64 + (tid & 7) * 8; \
      _Pragma("unroll") for (int i = 0; i < 2; ++i) rk[4 + i] = *(const u32x4*)(kr_ + (size_t)i * 32 * 64); } \
    const u16* vp_ = vt + (size_t)(tid >> 3) * vstride + (JT) * 64 + (tid & 7) * 8; \
    _Pragma("unroll") for (int i = 0; i < 4; ++i) rv[i] = *(const u32x4*)(vp_ + (size_t)i * 32 * vstride); }
  if (!direct) KV_LOAD(0)
  for (int jt = 0; jt < ntiles; ++jt) {
    const int key0 = jt * 64;
    unsigned long long mq[2] = {mqn[0], mqn[1]};
    if (MODE == 1) {
      const int jn = min(jt + 1, ntiles - 1);
#pragma unroll
      for (int qt = 0; qt < 2; ++qt) mqn[qt] = p.SEL[(size_t)(q0 + qrow[qt]) * 256 + jn];
    }
    __syncthreads();
    if (!direct) {
      u16* dk = sK + (tid >> 4) * KSTR + (tid & 15) * 8;
#pragma unroll
      for (int i = 0; i < 4; ++i) *(u32x4*)(dk + i * 16 * KSTR) = rk[i];
      if (MODE == 0) {
        u16* dr = sK + (tid >> 3) * KSTR + 128 + (tid & 7) * 8;
#pragma unroll
        for (int i = 0; i < 2; ++i) *(u32x4*)(dr + i * 32 * KSTR) = rk[4 + i];
      }
      u16* dv = sV + (tid >> 3) * VSTR + (tid & 7) * 8;
#pragma unroll
      for (int i = 0; i < 4; ++i) *(u32x4*)(dv + i * 32 * VSTR) = rv[i];
    } else {
#pragma unroll 2
      for (int i = 0; i < 8; ++i) {
        const int c = tid + i * 256;
        const int key = c >> 5, part = c & 31;
        const int s = key0 + key;
        const int sc_ = min(s, SK - 1);
        const size_t o1 = sc_ < 1024 ? ((size_t)b * 1024 + sc_) * 2048 : ((size_t)b * 16 + (sc_ - 1024)) * 2048;
        const float* kp = (sc_ < 1024 ? p.c_ak : p.out + O_AKS) + o1 + h * 128 + part * 4;
        const float* vp = (sc_ < 1024 ? p.c_av : p.out + O_AVS) + o1 + h * 128 + part * 4;
        f32x4 kv = *(const f32x4*)kp, vv = *(const f32x4*)vp;
        u32x2 kk; kk[0] = cvtpk(kv[0], kv[1]); kk[1] = cvtpk(kv[2], kv[3]);
        *(u32x2*)(sK + key * KSTR + part * 4) = kk;
        const bool ok = s < SK;
#pragma unroll
        for (int e = 0; e < 4; ++e) sV[(part * 4 + e) * VSTR + key] = ok ? f2bf(vv[e]) : (u16)0;
      }
    }
    __syncthreads();
    if (!direct) KV_LOAD(min(jt + 1, ntiles - 1))
    if (active && jt < myt) {
      f32x4 s[2][4];
#pragma unroll
      for (int qt = 0; qt < 2; ++qt)
#pragma unroll
        for (int kt = 0; kt < 4; ++kt) s[qt][kt] = (f32x4){0.f, 0.f, 0.f, 0.f};
#pragma unroll
      for (int kt = 0; kt < 4; ++kt) {
#pragma unroll
        for (int ks = 0; ks < NKS; ++ks) {
          bf16x8 kf = *(const bf16x8*)(sK + (kt * 16 + fr) * KSTR + ks * 32 + fq * 8);
          s[0][kt] = __builtin_amdgcn_mfma_f32_16x16x32_bf16(kf, qf[0][ks], s[0][kt], 0, 0, 0);
          s[1][kt] = __builtin_amdgcn_mfma_f32_16x16x32_bf16(kf, qf[1][ks], s[1][kt], 0, 0, 0);
        }
      }
      unsigned mlo[2] = {0u, 0u}, mhi[2] = {0u, 0u};
      if (MODE == 0) {
        if (key0 + 64 > nkeys) {
#pragma unroll
          for (int kt = 0; kt < 4; ++kt)
#pragma unroll
            for (int j = 0; j < 4; ++j)
              if (key0 + kt * 16 + fq * 4 + j >= nkeys) { s[0][kt][j] = -1e30f; s[1][kt][j] = -1e30f; }
        }
      } else {
        const bool far = (key0 + 63) - (qpos0 + wq0) <= -128;
        if (!far) {
#pragma unroll
          for (int qt = 0; qt < 2; ++qt) {
            const int rb = key0 + fq * 4 - (qpos0 + qrow[qt]) + 128;
#pragma unroll
            for (int kt = 0; kt < 4; ++kt)
#pragma unroll
              for (int j = 0; j < 4; ++j) {
                int r = min(max(rb + kt * 16 + j, 0), 256);
                s[qt][kt][j] += sBias[r];
              }
          }
        }
#pragma unroll
        for (int qt = 0; qt < 2; ++qt) {
          const unsigned long long mm = mq[qt] >> (fq * 4);
          mlo[qt] = (unsigned)mm; mhi[qt] = (unsigned)(mm >> 32);
        }
      }
      bf16x8 pf[2][2];
#pragma unroll
      for (int qt = 0; qt < 2; ++qt) {
        float mx = -1e30f;
#pragma unroll
        for (int kt = 0; kt < 4; ++kt)
#pragma unroll
          for (int j = 0; j < 4; ++j) mx = fmaxf(mx, s[qt][kt][j]);
        mx = fmaxf(mx, __shfl_xor(mx, 16));
        mx = fmaxf(mx, __shfl_xor(mx, 32));
        const float mn = fmaxf(mrow[qt], mx);
        const float alpha = exp2f(mrow[qt] - mn);
        mrow[qt] = mn;
        float rs = 0.f;
#pragma unroll
        for (int kt = 0; kt < 4; ++kt)
#pragma unroll
          for (int j = 0; j < 4; ++j) {
            float pv = exp2f(s[qt][kt][j] - mn);
            if (MODE == 1) {
              const int keep = __builtin_amdgcn_sbfe((int)(kt < 2 ? mlo[qt] : mhi[qt]), (kt & 1) * 16 + j, 1);
              pv = __int_as_float(__float_as_int(pv) & keep);
            }
            s[qt][kt][j] = pv; rs += pv;
          }
        rs += __shfl_xor(rs, 16);
        rs += __shfl_xor(rs, 32);
        lrow[qt] = lrow[qt] * alpha + rs;
        if (__ballot(alpha != 1.f) != 0ull) {
#pragma unroll
          for (int dt = 0; dt < 8; ++dt) o[qt][dt] *= alpha;
        }
#pragma unroll
        for (int s2 = 0; s2 < 2; ++s2) {
          u32x4 pk;
          pk[0] = cvtpk(s[qt][2 * s2][0], s[qt][2 * s2][1]);
          pk[1] = cvtpk(s[qt][2 * s2][2], s[qt][2 * s2][3]);
          pk[2] = cvtpk(s[qt][2 * s2 + 1][0], s[qt][2 * s2 + 1][1]);
          pk[3] = cvtpk(s[qt][2 * s2 + 1][2], s[qt][2 * s2 + 1][3]);
          pf[qt][s2] = __builtin_bit_cast(bf16x8, pk);
        }
      }
#pragma unroll
      for (int dt = 0; dt < 8; ++dt) {
#pragma unroll
        for (int s2 = 0; s2 < 2; ++s2) {
          const u16* vp = sV + (dt * 16 + fr) * VSTR + fq * 4;
          u32x2 v0 = *(const u32x2*)(vp + (2 * s2) * 16);
          u32x2 v1 = *(const u32x2*)(vp + (2 * s2 + 1) * 16);
          u32x4 vv = {v0[0], v0[1], v1[0], v1[1]};
          bf16x8 vf = __builtin_bit_cast(bf16x8, vv);
          o[0][dt] = __builtin_amdgcn_mfma_f32_16x16x32_bf16(vf, pf[0][s2], o[0][dt], 0, 0, 0);
          o[1][dt] = __builtin_amdgcn_mfma_f32_16x16x32_bf16(vf, pf[1][s2], o[1][dt], 0, 0, 0);
        }
      }
    }
  }
  if (active) {
#pragma unroll
    for (int qt = 0; qt < 2; ++qt) {
      const int qr = wq0 + qt * 16 + fr;
      if (qr < nq) {
        const float inv = 1.f / lrow[qt];
        const size_t row = (size_t)(q0 + qr);
#pragma unroll
        for (int dt = 0; dt < 8; ++dt) {
          const size_t off = row * 2048 + h * 128 + dt * 16 + fq * 4;
          u32x2 ga = *(const u32x2*)(p.GA + off);
          u32x2 r;
          if (MODE == 0) {
            u32x2 gb = *(const u32x2*)(p.GB + off);
            r[0] = cvtpk(bflo(gb[0]) * o[qt][dt][0] * inv + bflo(ga[0]), bfhi(gb[0]) * o[qt][dt][1] * inv + bfhi(ga[0]));
            r[1] = cvtpk(bflo(gb[1]) * o[qt][dt][2] * inv + bflo(ga[1]), bfhi(gb[1]) * o[qt][dt][3] * inv + bfhi(ga[1]));
          } else {
            r[0] = cvtpk(bflo(ga[0]) * o[qt][dt][0] * inv, bfhi(ga[0]) * o[qt][dt][1] * inv);
            r[1] = cvtpk(bflo(ga[1]) * o[qt][dt][2] * inv, bfhi(ga[1]) * o[qt][dt][3] * inv);
          }
          *(u32x2*)(gdst + off) = r;
        }
      }
    }
  }
}

#undef KV_LOAD
__global__ void __launch_bounds__(NTHREADS, 2) fwd_megakernel(Params p) {
  extern __shared__ __attribute__((aligned(16))) char smem[];
  cg::grid_group grid = cg::this_grid();
#define IDS const int tid = otid(); const int lane = tid & 63, w = tid >> 6; const int bid = blockIdx.x, nb = gridDim.x; \
  const int gw = bid * 4 + w, ngw = nb * 4; (void)tid; (void)lane; (void)gw; (void)ngw; (void)bid; (void)nb;

#if PH & (1 << 0)
  { IDS
  {
    float* st = (float*)smem;
    for (int t = bid; t < 32 * 192; t += nb) transpose_tile(p.w_in, 2048, INC, p.WT_IN, t, st);
    for (int t = bid; t < 8 * 48; t += nb) transpose_tile(p.w_uq, 512, 3072, p.WT_UQ, t, st);
    for (int t = bid; t < 4 * 32; t += nb) transpose_tile(p.w_uk, 256, 2048, p.WT_UK, t, st);
    for (int t = bid; t < 4 * 32; t += nb) transpose_tile(p.w_uv, 256, 2048, p.WT_UV, t, st);
    for (int t = bid; t < 32 * 32; t += nb) transpose_tile(p.w_out, 2048, 2048, p.WT_OUT, t, st);
    for (int t = bid; t < 32 * 128; t += nb) transpose_tile(p.w_up, 2048, 8192, p.WT_UP, t, st);
    for (int t = bid; t < 128 * 32; t += nb) transpose_tile(p.w_down, 8192, 2048, p.WT_DOWN, t, st);
    for (int r = gw; r < MT; r += ngw) {
      const float* x = r < MP ? p.x_p + (size_t)r * 2048 : p.x_s + (size_t)(r - MP) * 2048;
      rms_row_2048(x, p.g_mix, p.H + (size_t)r * 2048, lane);
    }
    const int gt = bid * NTHREADS + tid, ngt = nb * NTHREADS;
    for (int i = gt; i < 16 * 1024 * 64 / 4; i += ngt) {
      int e = i * 4; int b = e >> 16; int rem = e & 65535; int s = rem >> 6, c = rem & 63;
      size_t dst = (size_t)(MP + b * SK + s) * 64 + c;
      f32x4 a = *(const f32x4*)(p.c_idx + e), k = *(const f32x4*)(p.c_kr + e);
      u32x2 o; o[0] = cvtpk(a[0], a[1]); o[1] = cvtpk(a[2], a[3]);
      *(u32x2*)(p.IXK + dst) = o;
      o[0] = cvtpk(k[0], k[1]); o[1] = cvtpk(k[2], k[3]);
      *(u32x2*)(p.KR + dst) = o;
    }
    for (int i = gt; i < 16 * 1024 * 256 / 4; i += ngt) {
      int e = i * 4; int b = e >> 18; int rem = e & 262143; int s = rem >> 8, c = rem & 255;
      size_t dst = (size_t)(MP + b * SK + s) * 256 + c;
      f32x4 a = *(const f32x4*)(p.c_ckv + e);
      u32x2 o; o[0] = cvtpk(a[0], a[1]); o[1] = cvtpk(a[2], a[3]);
      *(u32x2*)(p.CKV + dst) = o;
    }
  }
  }
#endif
  grid.sync();
#if PH & (1 << 1)
  { IDS
  for (int rep = 0; rep < NREP(1); ++rep) gemm_phase<EPI_IN>(p, p.H, 2048, p.WT_IN, 2048, 2048, MT / 256, INP / 128, smem, nullptr, 0, bid, nb);
  }
#endif
  grid.sync();
#if PH & (1 << 2)
  { IDS
  for (int t = gw; t < MT; t += ngw) post_row(p, t, lane);
  for (int rep = 0; rep < NREP(2); ++rep) for (int t = bid * NQ; t < MT; t += nb * NQ)
    topk_group(p, t, smem, (unsigned*)(p.out + O_Y + 14000000) + (size_t)bid * 16384, (unsigned*)(p.out + O_Y + 14000000) + (size_t)(512 + bid) * 16384,
               (unsigned*)p.H + (size_t)bid * 16384);
  }
#endif
  grid.sync();
#if PH & (1 << 3)
  { IDS
    const int total = 2048 + 256;
    for (int rep = 0; rep < NREP(3); ++rep) {
      u16* gdst = (rep + 1 < NREP(3)) ? (u16*)(p.out + O_Y) : p.GA;
      for (int r = 0;; ++r) {
        int id = (r & 1) ? r * nb + (nb - 1 - bid) : r * nb + bid;
        if (r * nb >= total) break;
        if (id < total) attn_item<1>(p, id, smem, gdst);
      }
    }
  }
#endif
  grid.sync();
#if PH & (1 << 4)
  { IDS
  {
    const int gt = bid * NTHREADS + tid, ngt = nb * NTHREADS;
    for (int i = gt; i < 16 * 2048 * 6; i += ngt) {
      int r = i / 6, c = i - r * 6;
      *(u32x4*)(p.VBT_S + (size_t)r * VSS + SK + c * 8) = (u32x4){0u, 0u, 0u, 0u};
    }
    const int nqb = (MT / 256) * 24, nkb = (KROWS / 256) * 16;
    const int total = nqb + 2 * nkb;
    for (int id = bid; id < total; id += nb) {
      if (id < nqb) gemm_phase<EPI_QB>(p, p.CQ, 512, p.WT_UQ, 512, 512, MT / 256, 24, smem, p.QB, 3072, id, 1 << 30);
      else if (id < nqb + nkb) gemm_phase<EPI_BF16>(p, p.CKV, 256, p.WT_UK, 256, 256, KROWS / 256, 16, smem, p.KB, 2048, id - nqb, 1 << 30);
      else gemm_phase<EPI_VT>(p, p.CKV, 256, p.WT_UV, 256, 256, KROWS / 256, 16, smem, nullptr, 0, id - nqb - nkb, 1 << 30);
    }
  }
  }
#endif
  grid.sync();
#if PH & (1 << 5)
  { IDS
  {
    const int total = 2048 + 256;
    for (int rep = 0; rep < NREP(5); ++rep) {
      u16* gdst = (rep + 1 < NREP(5)) ? (u16*)(p.out + O_Y) : p.GB;
      for (int r = 0;; ++r) {
        int id = (r & 1) ? r * nb + (nb - 1 - bid) : r * nb + bid;
        if (r * nb >= total) break;
        if (id < total) attn_item<0>(p, id, smem, gdst);
      }
    }
  }
  }
#endif
  grid.sync();
#if PH & (1 << 6)
  { IDS
  gemm_phase<EPI_RES>(p, p.GB, 2048, p.WT_OUT, 2048, 2048, MT / 256, 16, smem, nullptr, 0, bid, nb);
  }
#endif
  grid.sync();
#if PH & (1 << 7)
  { IDS
  for (int r = gw; r < MT; r += ngw) rms_row_2048(p.out + O_Y + (size_t)r * 2048, p.g_ffn, p.H2 + (size_t)r * 2048, lane);
  }
#endif
  grid.sync();
#if PH & (1 << 8)
  { IDS
  gemm_phase<EPI_RELU2>(p, p.H2, 2048, p.WT_UP, 2048, 2048, MT / 256, 64, smem, nullptr, 0, bid, nb);
  }
#endif
  grid.sync();
#if PH & (1 << 9)
  { IDS
  gemm_phase<EPI_ACC>(p, p.U, DFF, p.WT_DOWN, DFF, DFF, MT / 256, 16, smem, nullptr, 0, bid, nb);
  }
#endif
  grid.sync();
#if PH & (1 << 10)
  { IDS
  for (int r = gw; r < MT; r += ngw) {
    float* x = p.out + O_Y + (size_t)r * 2048;
    f32x4 v[8];
    float ss = 0.f;
#pragma unroll
    for (int i = 0; i < 8; ++i) {
      v[i] = *(const f32x4*)(x + i * 256 + lane * 4);
      ss += v[i][0] * v[i][0] + v[i][1] * v[i][1] + v[i][2] * v[i][2] + v[i][3] * v[i][3];
    }
    ss = wave_sum(ss);
    float rr = rsqrtf(ss * (1.f / 2048.f) + 1e-6f);
#pragma unroll
    for (int i = 0; i < 8; ++i) {
      f32x4 gg = *(const f32x4*)(p.g_fin + i * 256 + lane * 4);
      f32x4 o = {v[i][0] * rr * gg[0], v[i][1] * rr * gg[1], v[i][2] * rr * gg[2], v[i][3] * rr * gg[3]};
      *(f32x4*)(x + i * 256 + lane * 4) = o;
    }
  }
  }
#endif
}

extern "C" void kernel_launch(void* const* d_in, const int* in_sizes, int n_in, void* d_out, int out_size, void* d_ws, size_t ws_size,
                              hipStream_t stream) {
  static int grid_blocks = 0;
  if (!grid_blocks) {
    int dev = 0, cus = 0, per_cu = 0;
    hipGetDevice(&dev);
    hipDeviceGetAttribute(&cus, hipDeviceAttributeMultiprocessorCount, dev);
    if (hipFuncSetAttribute((const void*)fwd_megakernel, hipFuncAttributeMaxDynamicSharedMemorySize, LDS_BYTES) != hipSuccess)
      fprintf(stderr, "kernel_launch: hipFuncSetAttribute failed\n");
    hipOccupancyMaxActiveBlocksPerMultiprocessor(&per_cu, (const void*)fwd_megakernel, NTHREADS, LDS_BYTES);
    if (per_cu < 1) per_cu = 1;
    if (per_cu > 2) per_cu = 2;
    grid_blocks = cus * per_cu;
  }
  Params p{};
  const float* const* in = (const float* const*)d_in;
  p.x_p = in[0]; p.x_s = in[1]; p.c_ak = in[2]; p.c_av = in[3]; p.c_idx = in[4]; p.c_ckv = in[5]; p.c_kr = in[6]; p.rel = in[7];
  p.g_mix = in[8]; p.w_in = in[9]; p.g_q = in[10]; p.w_uq = in[11]; p.g_kv = in[12]; p.w_uk = in[13]; p.w_uv = in[14]; p.w_out = in[15];
  p.g_ffn = in[16]; p.w_up = in[17]; p.w_down = in[18]; p.g_fin = in[19];
  p.out = (float*)d_out;
  char* ws = (char*)d_ws;
  size_t off = 0;
  auto alloc = [&](size_t bytes) { char* r = ws + off; off += (bytes + 255) & ~(size_t)255; return r; };
  p.WT_UQ = (u16*)alloc((size_t)3072 * 512 * 2);
  p.WT_UK = (u16*)alloc((size_t)2048 * 256 * 2);
  p.WT_UV = (u16*)alloc((size_t)2048 * 256 * 2);
  p.WT_OUT = (u16*)alloc((size_t)2048 * 2048 * 2);
  p.WT_UP = (u16*)alloc((size_t)8192 * 2048 * 2);
  p.WT_DOWN = (u16*)alloc((size_t)2048 * 8192 * 2);
  p.CQ = (u16*)alloc((size_t)MT * 512 * 2);
  p.CKV = (u16*)alloc((size_t)KROWS * 256 * 2);
  p.KR = (u16*)alloc((size_t)KROWS * 64 * 2);
  p.GA = (u16*)alloc((size_t)MT * 2048 * 2);
  p.GB = (u16*)alloc((size_t)MT * 2048 * 2);
  p.CS = (float*)alloc((size_t)MT * 32 * 4);
  p.SN = (float*)alloc((size_t)MT * 32 * 4);
  const size_t ubase = off;
  p.WT_IN = (u16*)alloc((size_t)INP * 2048 * 2);
  p.H = (u16*)alloc((size_t)MT * 2048 * 2);
  p.AQ = (u16*)alloc((size_t)MT * 2048 * 2);
  p.KA = (u16*)alloc((size_t)MP * 2048 * 2);
  p.VAT = (u16*)alloc((size_t)MP * 2048 * 2);
  p.IXQ = (u16*)alloc((size_t)MT * 1024 * 2);
  p.IXK = (u16*)alloc((size_t)KROWS * 64 * 2);
  p.SEL = (unsigned long long*)alloc((size_t)MT * 256 * 8);
  p.IXW = (float*)alloc((size_t)MT * 16 * 4);
  const size_t endA = off;
  off = ubase;
  p.QB = (u16*)alloc((size_t)MT * 3072 * 2);
  p.KB = (u16*)alloc((size_t)KROWS * 2048 * 2);
  p.VBT_P = (u16*)alloc((size_t)2048 * MP * 2);
  p.VBT_S = (u16*)alloc((size_t)16 * 2048 * VSS * 2);
  const size_t endB = off;
  off = ubase;
  p.H2 = (u16*)alloc((size_t)MT * 2048 * 2);
  p.U = (u16*)alloc((size_t)MT * DFF * 2);
  const size_t endC = off;
  size_t need = endA > endB ? endA : endB;
  if (endC > need) need = endC;
  if (need > ws_size) { fprintf(stderr, "kernel_launch: workspace too small: need %zu have %zu\n", need, ws_size); return; }
  void* args[] = {&p};
  hipError_t e = hipLaunchCooperativeKernel((const void*)fwd_megakernel, dim3(grid_blocks), dim3(NTHREADS), args, LDS_BYTES, stream);
  if (e != hipSuccess) fprintf(stderr, "cooperative launch failed: %s (grid %d)\n", hipGetErrorString(e), grid_blocks);
}
```

```cpp
#include <hip/hip_runtime.h>
#include <hip/hip_cooperative_groups.h>
#include <cstdio>
#include <cstdint>
namespace cg = cooperative_groups;

typedef unsigned short u16;
typedef __attribute__((ext_vector_type(8))) short bf16x8;
typedef __attribute__((ext_vector_type(4))) short bf16x4;
typedef __attribute__((ext_vector_type(4))) float f32x4;
typedef __attribute__((ext_vector_type(2))) float f32x2;
typedef __attribute__((ext_vector_type(2))) __bf16 bf16x2_t;
typedef __attribute__((ext_vector_type(4))) unsigned u32x4;
typedef __attribute__((ext_vector_type(2))) unsigned u32x2;

#define DI __device__ __forceinline__

constexpr int MP = 16384;
constexpr int MS = 256;
constexpr int MT = MP + MS;
constexpr int DM = 2048;
constexpr int INC = 12176;
constexpr int INP = 12288;
constexpr int SK = 1040;
constexpr int KROWS = MP + 16 * SK;
constexpr int VSS = 1088;
constexpr int DFF = 8192;
constexpr int ZRW = 832;
#ifndef PH
#define PH 0x7ff
#endif
#ifndef REP
#define REP 0
#endif
#define NREP(k) (((REP >> (k)) & 1) + 1)
constexpr int NTHREADS = 512;
constexpr int VB_LDS = 75776;
constexpr int LDS_BYTES = 2 * VB_LDS;

constexpr size_t O_Y = 0;
constexpr size_t O_AKP = 34078720;
constexpr size_t O_AVP = 67633152;
constexpr size_t O_IDXP = 101187584;
constexpr size_t O_CKVP = 102236160;
constexpr size_t O_KRP = 106430464;
constexpr size_t O_AKS = 107479040;
constexpr size_t O_AVS = 108003328;
constexpr size_t O_IDXS = 108527616;
constexpr size_t O_CKVS = 108544000;
constexpr size_t O_KRS = 108609536;

struct Params {
  const float *x_p, *x_s, *c_ak, *c_av, *c_idx, *c_ckv, *c_kr, *rel, *g_mix, *w_in, *g_q, *w_uq, *g_kv, *w_uk, *w_uv, *w_out, *g_ffn, *w_up, *w_down, *g_fin;
  float* out;
  u16 *WT_UQ, *WT_UK, *WT_UV, *WT_OUT, *WT_UP, *WT_DOWN, *CQ, *CKV, *KR, *GA, *GB;
  float *CS, *SN;
  u16 *WT_IN, *H, *AQ, *KA, *VAT, *IXQ, *IXK;
  float* IXW;
  unsigned long long* SEL;
  u16 *QB, *KB, *VBT_P, *VBT_S;
  u16 *H2, *U;
};

DI int otid() { int t = threadIdx.x; asm volatile("" : "+v"(t)); return t; }
DI unsigned cvtpk(float lo, float hi) {
  f32x2 v = {lo, hi};
  bf16x2_t b = __builtin_convertvector(v, bf16x2_t);
  return __builtin_bit_cast(unsigned, b);
}
DI u16 f2bf(float x) { return (u16)(cvtpk(x, 0.f) & 0xffffu); }
DI float bf2f(u16 b) { return __uint_as_float(((unsigned)b) << 16); }
DI float bflo(unsigned w) { return __uint_as_float(w << 16); }
DI float bfhi(unsigned w) { return __uint_as_float(w & 0xffff0000u); }
DI float dot2bf(unsigned a, unsigned b, float c) {
  return __builtin_amdgcn_fdot2_f32_bf16(__builtin_bit_cast(bf16x2_t, a), __builtin_bit_cast(bf16x2_t, b), c, false);
}
DI float wave_sum(float v) {
#pragma unroll
  for (int o = 32; o > 0; o >>= 1) v += __shfl_xor(v, o);
  return v;
}
DI int qpos_of(int t) { return t < MP ? t : 1024 + ((t - MP) & 15); }
DI int krow_of(int t) { return t < MP ? t : MP + ((t - MP) >> 4) * SK + 1024 + ((t - MP) & 15); }
DI float inv_freq(int i) { return exp2f(-(float)i * 0.41524101186092029f); }

DI void transpose_tile(const float* __restrict__ W, int K, int N, u16* __restrict__ Wt, int tile, float* s  ) {
  const int nkt = K >> 6;
  const int kt = tile % nkt, nt = tile / nkt;
  const int k0 = kt << 6, n0 = nt << 6;
  const int tid = otid() & 255;
  const int c = tid & 63, r0 = tid >> 6;
  __syncthreads();
#pragma unroll
  for (int i = 0; i < 16; ++i) {
    int r = i * 4 + r0;
    float v = (n0 + c < N) ? W[(size_t)(k0 + r) * N + n0 + c] : 0.f;
    s[r * 65 + c] = v;
  }
  __syncthreads();
  const int kp = (tid & 31) * 2, rr0 = tid >> 5;
#pragma unroll
  for (int i = 0; i < 8; ++i) {
    int rr = i * 8 + rr0;
    unsigned pk = cvtpk(s[kp * 65 + rr], s[(kp + 1) * 65 + rr]);
    *(unsigned*)(Wt + (size_t)(n0 + rr) * K + k0 + kp) = pk;
  }
}

DI void rms_row_2048(const float* __restrict__ x, const float* __restrict__ g, u16* __restrict__ out, int lane) {
  f32x4 v[8];
  float ss = 0.f;
#pragma unroll
  for (int i = 0; i < 8; ++i) {
    v[i] = *(const f32x4*)(x + i * 256 + lane * 4);
    ss += v[i][0] * v[i][0] + v[i][1] * v[i][1] + v[i][2] * v[i][2] + v[i][3] * v[i][3];
  }
  ss = wave_sum(ss);
  float r = rsqrtf(ss * (1.f / 2048.f) + 1e-6f);
#pragma unroll
  for (int i = 0; i < 8; ++i) {
    f32x4 gg = *(const f32x4*)(g + i * 256 + lane * 4);
    u32x2 o;
    o[0] = cvtpk(v[i][0] * r * gg[0], v[i][1] * r * gg[1]);
    o[1] = cvtpk(v[i][2] * r * gg[2], v[i][3] * r * gg[3]);
    *(u32x2*)(out + i * 256 + lane * 4) = o;
  }
}

enum { EPI_IN = 0, EPI_QB, EPI_BF16, EPI_VT, EPI_RES, EPI_RELU2, EPI_ACC };
constexpr float QSC = 0.07216878364870322f * 1.4426950408889634f;
constexpr int LSTR = 72;
#ifndef PFA
#define PFA 8
#endif

template <int EPI>
DI void gemm_epilogue(const Params& p, f32x4 (&acc)[8][4], int m0, int n0, int wr, int wc, int fr, int fq, u16* Cb, int ldc) {
  const int cw = n0 + wc * 64;
#pragma clang loop unroll(full)
  for (int m = 0; m < 8; ++m) {
    const int rb = m0 + wr * 128 + m * 16 + fq * 4;
    if (EPI == EPI_QB) {
      const int within = cw % 192;
      if (within == 128) {
#pragma clang loop unroll(full)
        for (int n = 0; n < 2; ++n) {
          const int i = n * 16 + fr;
#pragma clang loop unroll(full)
          for (int j = 0; j < 4; ++j) {
            const int row = rb + j;
            const float cs = p.CS[(size_t)row * 32 + i], sn = p.SN[(size_t)row * 32 + i];
            float x1 = acc[m][n][j] * QSC, x2 = acc[m][n + 2][j] * QSC;
            p.QB[(size_t)row * 3072 + cw + i] = f2bf(x1 * cs - x2 * sn);
            p.QB[(size_t)row * 3072 + cw + i + 32] = f2bf(x1 * sn + x2 * cs);
          }
        }
        continue;
      }
    }
#pragma clang loop unroll(full)
    for (int n = 0; n < 4; ++n) {
      const int colt = cw + n * 16;
      const int col = colt + fr;
      if (EPI == EPI_IN) {
        if (colt >= 4096 && colt < 6144 && rb < MP) {
          u32x2 pk;
          pk[0] = cvtpk(acc[m][n][0], acc[m][n][1]);
          pk[1] = cvtpk(acc[m][n][2], acc[m][n][3]);
          *(u32x2*)(p.VAT + (size_t)(col - 4096) * MP + rb) = pk;
        }
      }
      if (EPI == EPI_VT) {
        u32x2 pk;
        pk[0] = cvtpk(acc[m][n][0], acc[m][n][1]);
        pk[1] = cvtpk(acc[m][n][2], acc[m][n][3]);
        u16* dst;
        if (rb < MP) dst = p.VBT_P + (size_t)col * MP + rb;
        else { int r2 = rb - MP; int b = r2 / SK; int s = r2 - b * SK; dst = p.VBT_S + ((size_t)b * 2048 + col) * VSS + s; }
        *(u32x2*)dst = pk;
        continue;
      }
#pragma clang loop unroll(full)
      for (int j = 0; j < 4; ++j) {
        const int row = rb + j;
        const float v = acc[m][n][j];
        if (EPI == EPI_IN) {
          if (colt < 2048) p.AQ[(size_t)row * 2048 + col] = f2bf(v * (0.08838834764831845f * 1.4426950408889634f));
          else if (colt < 4096) {
            int c = col - 2048;
            if (row < MP) { p.out[O_AKP + (size_t)row * 2048 + c] = v; p.KA[(size_t)row * 2048 + c] = f2bf(v); }
            else p.out[O_AKS + (size_t)(row - MP) * 2048 + c] = v;
          } else if (colt < 6144) {
            int c = col - 4096;
            if (row < MP) p.out[O_AVP + (size_t)row * 2048 + c] = v;
            else p.out[O_AVS + (size_t)(row - MP) * 2048 + c] = v;
          } else if (colt < 7168) p.IXQ[(size_t)row * 1024 + (col - 6144)] = f2bf(v);
          else if (colt < 7232) {
            int c = col - 7168;
            if (row < MP) p.out[O_IDXP + (size_t)row * 64 + c] = v; else p.out[O_IDXS + (size_t)(row - MP) * 64 + c] = v;
            p.IXK[(size_t)krow_of(row) * 64 + c] = f2bf(v);
          } else if (colt < 7248) p.IXW[(size_t)row * 16 + (col - 7232)] = v * 0.25f;
          else if (colt < 8080) p.out[O_Y + (size_t)row * ZRW + (col - 7248)] = v;
          else if (colt < 10128) p.GA[(size_t)row * 2048 + (col - 8080)] = f2bf(1.f / (1.f + __expf(-v)));
          else if (colt < INC) p.GB[(size_t)row * 2048 + (col - 10128)] = f2bf(1.f / (1.f + __expf(-v)));
        } else if (EPI == EPI_QB) {
          Cb[(size_t)row * ldc + col] = f2bf(v * QSC);
        } else if (EPI == EPI_BF16) {
          Cb[(size_t)row * ldc + col] = f2bf(v);
        } else if (EPI == EPI_RES) {
          float xv = row < MP ? p.x_p[(size_t)row * 2048 + col] : p.x_s[(size_t)(row - MP) * 2048 + col];
          p.out[O_Y + (size_t)row * 2048 + col] = xv + v;
        } else if (EPI == EPI_RELU2) {
          float r = fmaxf(v, 0.f);
          p.U[(size_t)row * DFF + col] = f2bf(r * r);
        } else if (EPI == EPI_ACC) {
          p.out[O_Y + (size_t)row * 2048 + col] += v;
        }
      }
    }
  }
}

constexpr int GSTAGE = 512 * LSTR;
template <int EPI>
DI void gemm_tile(const Params& p, const u16* __restrict__ A, int lda, const u16* __restrict__ Bt, int ldb, int K, int m0, int n0,
                  char* smem, u16* Cb, int ldc) {
  u16* sbase = (u16*)smem;
  const int tid = otid(), lane = tid & 63, w = tid >> 6;
  const int wr = w >> 2, wc = w & 3, fr = lane & 15, fq = lane >> 4;
  f32x4 acc[8][4];
#pragma unroll
  for (int m = 0; m < 8; ++m)
#pragma unroll
    for (int n = 0; n < 4; ++n) acc[m][n] = (f32x4){0.f, 0.f, 0.f, 0.f};
  const int lr = tid >> 3, lk = (tid & 7) * 8;
  const u16* Ag = A + (size_t)(m0 + lr) * lda + lk;
  const u16* Bg = Bt + (size_t)(n0 + lr) * ldb + lk;
  const int nk = K >> 6;
  u32x4 ra[4], rb[4];
#define G_LOAD(T) { const int k_ = (T) << 6; _Pragma("unroll") for (int i = 0; i < 4; ++i) { \
    ra[i] = *(const u32x4*)(Ag + (size_t)(i * 64) * lda + k_); rb[i] = *(const u32x4*)(Bg + (size_t)(i * 64) * ldb + k_); } }
#define L_STORE(ST) { u16* dA_ = sbase + (ST) * GSTAGE + lr * LSTR + lk; u16* dB_ = dA_ + 256 * LSTR; _Pragma("unroll") for (int i = 0; i < 4; ++i) { \
    *(u32x4*)(dA_ + i * 64 * LSTR) = ra[i]; *(u32x4*)(dB_ + i * 64 * LSTR) = rb[i]; } }
  G_LOAD(0)
  L_STORE(0)
  G_LOAD(1)
#pragma unroll 1
  for (int kt = 0; kt < nk; ++kt) {
    __syncthreads();
    if (kt + 1 < nk) L_STORE((kt + 1) & 1)
    G_LOAD(min(kt + 2, nk - 1))
    const u16* cA = sbase + (kt & 1) * GSTAGE + (wr * 128 + fr) * LSTR + fq * 8;
    const u16* cB = sbase + (kt & 1) * GSTAGE + 256 * LSTR + (wc * 64 + fr) * LSTR + fq * 8;
#pragma unroll
    for (int ks = 0; ks < 2; ++ks) {
      bf16x8 bfr[4];
#pragma unroll
      for (int n = 0; n < 4; ++n) bfr[n] = *(const bf16x8*)(cB + n * 16 * LSTR + ks * 32);
#pragma unroll
      for (int mh = 0; mh < 2; ++mh) {
        bf16x8 af[4];
#pragma unroll
        for (int m = 0; m < 4; ++m) af[m] = *(const bf16x8*)(cA + (mh * 4 + m) * 16 * LSTR + ks * 32);
#pragma unroll
        for (int m = 0; m < 4; ++m)
#pragma unroll
          for (int n = 0; n < 4; ++n)
            acc[mh * 4 + m][n] = __builtin_amdgcn_mfma_f32_16x16x32_bf16(af[m], bfr[n], acc[mh * 4 + m][n], 0, 0, 0);
      }
    }
  }
#undef G_LOAD
#undef L_STORE
  gemm_epilogue<EPI>(p, acc, m0, n0, wr, wc, fr, fq, Cb, ldc);
}

template <int EPI>
DI void gemm_phase(const Params& p, const u16* A, int lda, const u16* Bt, int ldb, int K, int mtiles, int ntiles, char* smem, u16* Cb, int ldc,
                   int start, int stride) {
  const int total = mtiles * ntiles;
  const int GM = 8;
  for (int id = start; id < total; id += stride) {
    const int per = GM * ntiles;
    const int g = id / per, rem = id - g * per;
    const int fm = g * GM;
    const int gsz = min(GM, mtiles - fm);
    const int mt = fm + rem % gsz, nt = rem / gsz;
    gemm_tile<EPI>(p, A, lda, Bt, ldb, K, mt * 256, nt * 256, smem, Cb, ldc);
  }
}

DI void post_row(const Params& p, int t, int lane) {
  const float* zr = p.out + O_Y + (size_t)t * ZRW;
  {
    f32x4 a = *(const f32x4*)(zr + lane * 4), b = *(const f32x4*)(zr + 256 + lane * 4);
    float ss = a[0] * a[0] + a[1] * a[1] + a[2] * a[2] + a[3] * a[3] + b[0] * b[0] + b[1] * b[1] + b[2] * b[2] + b[3] * b[3];
    ss = wave_sum(ss);
    float r = rsqrtf(ss * (1.f / 512.f) + 1e-6f);
    f32x4 ga = *(const f32x4*)(p.g_q + lane * 4), gb = *(const f32x4*)(p.g_q + 256 + lane * 4);
    u32x2 o;
    o[0] = cvtpk(a[0] * r * ga[0], a[1] * r * ga[1]); o[1] = cvtpk(a[2] * r * ga[2], a[3] * r * ga[3]);
    *(u32x2*)(p.CQ + (size_t)t * 512 + lane * 4) = o;
    o[0] = cvtpk(b[0] * r * gb[0], b[1] * r * gb[1]); o[1] = cvtpk(b[2] * r * gb[2], b[3] * r * gb[3]);
    *(u32x2*)(p.CQ + (size_t)t * 512 + 256 + lane * 4) = o;
  }
  const int kr_row = krow_of(t);
  {
    f32x4 a = *(const f32x4*)(zr + 512 + lane * 4);
    float ss = a[0] * a[0] + a[1] * a[1] + a[2] * a[2] + a[3] * a[3];
    ss = wave_sum(ss);
    float r = rsqrtf(ss * (1.f / 256.f) + 1e-6f);
    f32x4 g = *(const f32x4*)(p.g_kv + lane * 4);
    f32x4 o = {a[0] * r * g[0], a[1] * r * g[1], a[2] * r * g[2], a[3] * r * g[3]};
    float* od = t < MP ? p.out + O_CKVP + (size_t)t * 256 : p.out + O_CKVS + (size_t)(t - MP) * 256;
    *(f32x4*)(od + lane * 4) = o;
    u32x2 ob; ob[0] = cvtpk(o[0], o[1]); ob[1] = cvtpk(o[2], o[3]);
    *(u32x2*)(p.CKV + (size_t)kr_row * 256 + lane * 4) = ob;
  }
  if (lane < 32) {
    float x1 = zr[768 + lane], x2 = zr[768 + 32 + lane];
    float ang = (float)qpos_of(t) * inv_freq(lane);
    float cs = cosf(ang), sn = sinf(ang);
    p.CS[(size_t)t * 32 + lane] = cs; p.SN[(size_t)t * 32 + lane] = sn;
    float o1 = x1 * cs - x2 * sn, o2 = x1 * sn + x2 * cs;
    float* od = t < MP ? p.out + O_KRP + (size_t)t * 64 : p.out + O_KRS + (size_t)(t - MP) * 64;
    od[lane] = o1; od[lane + 32] = o2;
    p.KR[(size_t)kr_row * 64 + lane] = f2bf(o1);
    p.KR[(size_t)kr_row * 64 + lane + 32] = f2bf(o2);
  }
}

template <int CTRL> DI float dpp_add(float v) {
  int sft = __builtin_amdgcn_update_dpp(0, __float_as_int(v), CTRL, 0xf, 0xf, true);
  return v + __int_as_float(sft);
}
DI float row16_sum(float v) { v = dpp_add<0x111>(v); v = dpp_add<0x112>(v); v = dpp_add<0x114>(v); v = dpp_add<0x118>(v); return v; }
DI unsigned fkey(float f) { unsigned u = __float_as_uint(f); return (u & 0x80000000u) ? ~u : (u | 0x80000000u); }

DI void radix_select(unsigned* sc, int* hist, int* misc, int n, unsigned long long* sel, int tid, int lane, int w) {
  __syncthreads();
  unsigned prefix = 0;
  int remaining = 256;
#pragma unroll 1
  for (int pass = 0; pass < 3; ++pass) {
    const int shift = pass == 0 ? 21 : (pass == 1 ? 10 : 0);
    const int bits = pass == 2 ? 10 : 11;
    const unsigned bmask = (1u << bits) - 1u;
    if (pass > 0) {
      *(int4*)&hist[tid * 8] = make_int4(0, 0, 0, 0);
      *(int4*)&hist[tid * 8 + 4] = make_int4(0, 0, 0, 0);
      __syncthreads();
      const int hs = shift + bits;
      const unsigned want = prefix >> hs;
      for (int i = tid * 4; i < n; i += 256 * 4) {
        const u32x4 u4 = *(const u32x4*)(sc + i);
#pragma unroll
        for (int e = 0; e < 4; ++e)
          if ((u4[e] >> hs) == want) atomicAdd(&hist[(u4[e] >> shift) & bmask], 1);
      }
      __syncthreads();
    }
    const int4 h0 = *(const int4*)&hist[tid * 8], h1 = *(const int4*)&hist[tid * 8 + 4];
    const int s8 = h0.x + h0.y + h0.z + h0.w + h1.x + h1.y + h1.z + h1.w;
    int suf = s8;
#pragma unroll
    for (int d = 1; d < 64; d <<= 1) { int v = __shfl_down(suf, d); if (lane + d < 64) suf += v; }
    if (lane == 0) misc[w] = suf;
    __syncthreads();
    int above = 0;
    for (int ww = w + 1; ww < 4; ++ww) above += misc[ww];
    const int excl = above + suf - s8;
    if (excl < remaining && remaining <= excl + s8) {
      int c = excl, bin = 0, nrem = 0;
#define TK_STEP(val, idx) if (c < remaining && remaining <= c + (val)) { bin = tid * 8 + (idx); nrem = remaining - c; } c += (val);
      TK_STEP(h1.w, 7) TK_STEP(h1.z, 6) TK_STEP(h1.y, 5) TK_STEP(h1.x, 4) TK_STEP(h0.w, 3) TK_STEP(h0.z, 2) TK_STEP(h0.y, 1) TK_STEP(h0.x, 0)
#undef TK_STEP
      misc[4] = bin; misc[5] = nrem;
    }
    __syncthreads();
    prefix |= ((unsigned)misc[4]) << shift;
    remaining = misc[5];
    __syncthreads();
  }
  const unsigned T = prefix;
  const int seg = ((n + 255) >> 8) << 6;
  const int beg = w * seg;
  int ceq = 0;
  for (int i = beg + lane; i < beg + seg; i += 64) {
    bool in = i < n; unsigned u = in ? sc[i] : 0u;
    ceq += __popcll(__ballot(in && u == T));
  }
  if (lane == 0) misc[12 + w] = ceq;
  __syncthreads();
  int oe = 0;
  for (int ww = 0; ww < w; ++ww) oe += misc[12 + ww];
  const unsigned long long lt = (1ull << lane) - 1ull;
  for (int i0 = beg; i0 < beg + seg; i0 += 64) {
    const int i = i0 + lane;
    bool in = i < n; unsigned u = in ? sc[i] : 0u;
    bool g = in && u > T, e = in && u == T;
    unsigned long long be = __ballot(e);
    int pe = oe + __popcll(be & lt);
    unsigned long long sm = __ballot(g || (e && pe < remaining));
    if (lane == 0 && i0 < n) sel[i0 >> 6] = sm;
    oe += __popcll(be);
  }
}

constexpr int NQ = 4;
DI void topk_group(const Params& p, int t, char* smem, unsigned* scr1, unsigned* scr2, unsigned* scr3) {
  unsigned* sc = (unsigned*)smem;
  int* hist = (int*)(smem + 65536);
  int* misc = hist + 2048;
  const int tid = otid() & 255, lane = tid & 63, w = tid >> 6, fr = lane & 15, fq = lane >> 4;
  int n; const u16* ixk;
  if (t < MP) { n = 64 * ((t >> 6) + 1); ixk = p.IXK; }
  else { int b = (t - MP) >> 4; n = SK; ixk = p.IXK + (size_t)(MP + b * SK) * 64; }
  unsigned long long* sel = p.SEL + (size_t)t * 256;
  __syncthreads();
  if (n <= 256) {
    if (tid < 4) {
      unsigned long long v = (tid < (n >> 6)) ? ~0ull : 0ull;
#pragma unroll
      for (int qi = 0; qi < NQ; ++qi) sel[qi * 256 + tid] = v;
    }
    return;
  }
  *(int4*)&hist[tid * 8] = make_int4(0, 0, 0, 0);
  *(int4*)&hist[tid * 8 + 4] = make_int4(0, 0, 0, 0);
  __syncthreads();
  {
    const u16* q = p.IXQ + (size_t)t * 1024 + fr * 64 + fq * 8;
    bf16x8 a0[NQ], a1[NQ];
    f32x4 wv[NQ];
#pragma unroll
    for (int qi = 0; qi < NQ; ++qi) {
      a0[qi] = *(const bf16x8*)(q + qi * 1024); a1[qi] = *(const bf16x8*)(q + qi * 1024 + 32);
      wv[qi] = *(const f32x4*)(p.IXW + (size_t)(t + qi) * 16 + fq * 4);
    }
    const int ntile = n >> 4;
    for (int kt0 = w; kt0 < ntile; kt0 += 32) {
      bf16x8 b0[8], b1[8];
#pragma unroll
      for (int g = 0; g < 8; ++g) {
        const int kt = min(kt0 + g * 4, ntile - 1);
        const u16* kp = ixk + (size_t)(kt * 16 + fr) * 64 + fq * 8;
        b0[g] = *(const bf16x8*)kp; b1[g] = *(const bf16x8*)(kp + 32);
      }
      float pt[NQ][8];
#pragma unroll
      for (int g = 0; g < 8; ++g) {
#pragma unroll
        for (int qi = 0; qi < NQ; ++qi) {
          f32x4 c = {0.f, 0.f, 0.f, 0.f};
          c = __builtin_amdgcn_mfma_f32_16x16x32_bf16(a0[qi], b0[g], c, 0, 0, 0);
          c = __builtin_amdgcn_mfma_f32_16x16x32_bf16(a1[qi], b1[g], c, 0, 0, 0);
          pt[qi][g] = fmaxf(c[0], 0.f) * wv[qi][0] + fmaxf(c[1], 0.f) * wv[qi][1] + fmaxf(c[2], 0.f) * wv[qi][2] + fmaxf(c[3], 0.f) * wv[qi][3];
        }
      }
#pragma unroll
      for (int g = 0; g < 8; g += 2) {
        const int kt = kt0 + (g + (lane >> 5)) * 4;
        const bool st = (lane & 16) == 0 && kt < ntile;
#pragma unroll
        for (int qi = 0; qi < NQ; ++qi) {
          auto r32 = __builtin_amdgcn_permlane32_swap(__float_as_uint(pt[qi][g]), __float_as_uint(pt[qi][g + 1]), false, false);
          float s2 = __uint_as_float(r32[0]) + __uint_as_float(r32[1]);
          auto r16 = __builtin_amdgcn_permlane16_swap(__float_as_uint(s2), __float_as_uint(s2), false, false);
          float sv = __uint_as_float(r16[0]) + __uint_as_float(r16[1]);
          if (st) {
            unsigned u = fkey(sv);
            if (qi == 0) { sc[kt * 16 + fr] = u; atomicAdd(&hist[u >> 21], 1); }
            else if (qi == 1) scr1[kt * 16 + fr] = u;
            else if (qi == 2) scr2[kt * 16 + fr] = u;
            else scr3[kt * 16 + fr] = u;
          }
        }
      }
    }
  }
  radix_select(sc, hist, misc, n, sel, tid, lane, w);
#pragma unroll 1
  for (int qi = 1; qi < NQ; ++qi) {
    const unsigned* scr = qi == 1 ? scr1 : (qi == 2 ? scr2 : scr3);
    __syncthreads();
    *(int4*)&hist[tid * 8] = make_int4(0, 0, 0, 0);
    *(int4*)&hist[tid * 8 + 4] = make_int4(0, 0, 0, 0);
    __syncthreads();
    for (int i = tid * 4; i < n; i += 256 * 4) {
      const u32x4 u4 = *(const u32x4*)(scr + i);
      *(u32x4*)(sc + i) = u4;
#pragma unroll
      for (int e = 0; e < 4; ++e) atomicAdd(&hist[u4[e] >> 21], 1);
    }
    radix_select(sc, hist, misc, n, sel + qi * 256, tid, lane, w);
  }
}

constexpr int KSTR = 200;
constexpr int VSTR = 72;

template <int MODE>
DI void attn_item(const Params& p, int item, char* smem, u16* gdst) {
  constexpr int NKS = MODE == 0 ? 6 : 4;
  constexpr int ASTAGE = 64 * KSTR + 128 * VSTR;
  u16* sbase = (u16*)smem;
  float* sBias = (float*)(sbase + 2 * ASTAGE);
  const int tid = otid(), lane = tid & 63, w = tid >> 6, fr = lane & 15, fq = lane >> 4;
  int h, q0, nq, krow0, nkeys, ntiles, myt, b = 0, qpos0;
  const u16* vt; size_t vstride;
  const bool sample = item >= 1024;
  if (!sample) {
    const int i = 63 - (item >> 4);
    h = item & 15; q0 = i * 256; nq = 256; krow0 = 0; nkeys = q0 + 256; ntiles = 4 * i + 4; qpos0 = q0;
    vt = (MODE == 0 ? p.VBT_P : p.VAT) + (size_t)h * 128 * MP; vstride = MP;
    myt = ntiles - 3 + (w >> 1);
  } else {
    const int j = item - 1024; b = j >> 4;
    h = j & 15; q0 = MP + b * 16; nq = 16; krow0 = MP + b * SK; nkeys = SK; ntiles = 17; qpos0 = 1024;
    vt = p.VBT_S + ((size_t)b * 2048 + h * 128) * VSS; vstride = VSS;
    myt = ntiles;
  }
  const int wq0 = w * 32;
  const bool active = wq0 < nq;
  __syncthreads();
  if (MODE == 1) {
    for (int i = tid; i < 257; i += NTHREADS) {
      int rel = i - 128;
      int ret = rel > 0 ? 16 : 0;
      int n = rel < 0 ? -rel : rel;
      float lf = logf((float)max(n, 1) / 8.0f) / 2.772588722239781f * 8.0f;
      int large = min(8 + (int)lf, 15);
      int bk = ret + (n < 8 ? n : large);
      sBias[i] = (p.rel[bk * 16 + h] - p.rel[15 * 16 + h]) * 1.4426950408889634f;
    }
  }
  bf16x8 qf[2][NKS];
  int qrow[2];
#pragma unroll
  for (int qt = 0; qt < 2; ++qt) {
    const int qr = min(wq0 + qt * 16 + fr, nq - 1);
    qrow[qt] = qr;
    const u16* qp = (MODE == 0) ? p.QB + (size_t)(q0 + qr) * 3072 + h * 192 + fq * 8 : p.AQ + (size_t)(q0 + qr) * 2048 + h * 128 + fq * 8;
#pragma unroll
    for (int ks = 0; ks < NKS; ++ks) qf[qt][ks] = *(const bf16x8*)(qp + ks * 32);
  }
  f32x4 o[2][8];
#pragma unroll
  for (int qt = 0; qt < 2; ++qt)
#pragma unroll
    for (int dt = 0; dt < 8; ++dt) o[qt][dt] = (f32x4){0.f, 0.f, 0.f, 0.f};
  float mrow[2] = {-1e30f, -1e30f}, lrow[2] = {0.f, 0.f};
  const float SC = (MODE == 0 ? 0.07216878364870322f : 0.08838834764831845f) * 1.4426950408889634f;

  unsigned long long mqn[2] = {0ull, 0ull};
  if (MODE == 1) {
#pragma unroll
    for (int qt = 0; qt < 2; ++qt) mqn[qt] = p.SEL[(size_t)(q0 + qrow[qt]) * 256];
  }
  constexpr int NKL = MODE == 0 ? 3 : 2;
  const bool direct = (MODE == 1) && sample;
  u32x4 rk[NKL], rv[2];
#define KV_LOAD(JT) { const size_t kr0_ = (size_t)(krow0 + (JT) * 64); const u16* kb_ = (MODE == 0 ? p.KB : p.KA) + (kr0_ + (tid >> 4)) * 2048 + h * 128 + (tid & 15) * 8; \
    _Pragma("unroll") for (int i = 0; i < 2; ++i) rk[i] = *(const u32x4*)(kb_ + (size_t)i * 32 * 2048); \
    if (MODE == 0) rk[NKL - 1] = *(const u32x4*)(p.KR + (kr0_ + (tid >> 3)) * 64 + (tid & 7) * 8); \
    const u16* vp_ = vt + (size_t)(tid >> 3) * vstride + (JT) * 64 + (tid & 7) * 8; \
    _Pragma("unroll") for (int i = 0; i < 2; ++i) rv[i] = *(const u32x4*)(vp_ + (size_t)i * 64 * vstride); }
#define KV_STORE(ST) { u16* sk_ = sbase + (ST) * ASTAGE; u16* dk_ = sk_ + (tid >> 4) * KSTR + (tid & 15) * 8; \
    _Pragma("unroll") for (int i = 0; i < 2; ++i) *(u32x4*)(dk_ + i * 32 * KSTR) = rk[i]; \
    if (MODE == 0) *(u32x4*)(sk_ + (tid >> 3) * KSTR + 128 + (tid & 7) * 8) = rk[NKL - 1]; \
    u16* dv_ = sk_ + 64 * KSTR + (tid >> 3) * VSTR + (tid & 7) * 8; \
    _Pragma("unroll") for (int i = 0; i < 2; ++i) *(u32x4*)(dv_ + i * 64 * VSTR) = rv[i]; }
  if (!direct) {
    KV_LOAD(0)
    KV_STORE(0)
    KV_LOAD(min(1, ntiles - 1))
  }
  for (int jt = 0; jt < ntiles; ++jt) {
    const int key0 = jt * 64;
    u16* sK = sbase + (jt & 1) * ASTAGE;
    u16* sV = sK + 64 * KSTR;
    unsigned long long mq[2] = {mqn[0], mqn[1]};
    if (MODE == 1) {
      const int jn = min(jt + 1, ntiles - 1);
#pragma unroll
      for (int qt = 0; qt < 2; ++qt) mqn[qt] = p.SEL[(size_t)(q0 + qrow[qt]) * 256 + jn];
    }
    __syncthreads();
    if (!direct) {
      if (jt + 1 < ntiles) KV_STORE((jt + 1) & 1)
      KV_LOAD(min(jt + 2, ntiles - 1))
    } else {
#pragma unroll 2
      for (int i = 0; i < 4; ++i) {
        const int c = tid + i * NTHREADS;
        const int key = c >> 5, part = c & 31;
        const int s = key0 + key;
        const int sc_ = min(s, SK - 1);
        const size_t o1 = sc_ < 1024 ? ((size_t)b * 1024 + sc_) * 2048 : ((size_t)b * 16 + (sc_ - 1024)) * 2048;
        const float* kp = (sc_ < 1024 ? p.c_ak : p.out + O_AKS) + o1 + h * 128 + part * 4;
        const float* vp = (sc_ < 1024 ? p.c_av : p.out + O_AVS) + o1 + h * 128 + part * 4;
        f32x4 kv = *(const f32x4*)kp, vv = *(const f32x4*)vp;
        u32x2 kk; kk[0] = cvtpk(kv[0], kv[1]); kk[1] = cvtpk(kv[2], kv[3]);
        *(u32x2*)(sK + key * KSTR + part * 4) = kk;
        const bool ok = s < SK;
#pragma unroll
        for (int e = 0; e < 4; ++e) sV[(part * 4 + e) * VSTR + key] = ok ? f2bf(vv[e]) : (u16)0;
      }
      __syncthreads();
    }
    if (active && jt < myt) {
      f32x4 s[2][4];
#pragma unroll
      for (int qt = 0; qt < 2; ++qt)
#pragma unroll
        for (int kt = 0; kt < 4; ++kt) s[qt][kt] = (f32x4){0.f, 0.f, 0.f, 0.f};
#pragma unroll
      for (int kt = 0; kt < 4; ++kt) {
#pragma unroll
        for (int ks = 0; ks < NKS; ++ks) {
          bf16x8 kf = *(const bf16x8*)(sK + (kt * 16 + fr) * KSTR + ks * 32 + fq * 8);
          s[0][kt] = __builtin_amdgcn_mfma_f32_16x16x32_bf16(kf, qf[0][ks], s[0][kt], 0, 0, 0);
          s[1][kt] = __builtin_amdgcn_mfma_f32_16x16x32_bf16(kf, qf[1][ks], s[1][kt], 0, 0, 0);
        }
      }
      unsigned mlo[2] = {0u, 0u}, mhi[2] = {0u, 0u};
      if (MODE == 0) {
        if (key0 + 64 > nkeys) {
#pragma unroll
          for (int kt = 0; kt < 4; ++kt)
#pragma unroll
            for (int j = 0; j < 4; ++j)
              if (key0 + kt * 16 + fq * 4 + j >= nkeys) { s[0][kt][j] = -1e30f; s[1][kt][j] = -1e30f; }
        }
      } else {
        const bool far = (key0 + 63) - (qpos0 + wq0) <= -128;
        if (!far) {
#pragma unroll
          for (int qt = 0; qt < 2; ++qt) {
            const int rb = key0 + fq * 4 - (qpos0 + qrow[qt]) + 128;
#pragma unroll
            for (int kt = 0; kt < 4; ++kt)
#pragma unroll
              for (int j = 0; j < 4; ++j) {
                int r = min(max(rb + kt * 16 + j, 0), 256);
                s[qt][kt][j] += sBias[r];
              }
          }
        }
#pragma unroll
        for (int qt = 0; qt < 2; ++qt) {
          const unsigned long long mm = mq[qt] >> (fq * 4);
          mlo[qt] = (unsigned)mm; mhi[qt] = (unsigned)(mm >> 32);
        }
      }
      bf16x8 pf[2][2];
#pragma unroll
      for (int qt = 0; qt < 2; ++qt) {
        float mx = -1e30f;
#pragma unroll
        for (int kt = 0; kt < 4; ++kt)
#pragma unroll
          for (int j = 0; j < 4; ++j) mx = fmaxf(mx, s[qt][kt][j]);
        mx = fmaxf(mx, __shfl_xor(mx, 16));
        mx = fmaxf(mx, __shfl_xor(mx, 32));
        const float mn = fmaxf(mrow[qt], mx);
        const float alpha = exp2f(mrow[qt] - mn);
        mrow[qt] = mn;
        float rs = 0.f;
#pragma unroll
        for (int kt = 0; kt < 4; ++kt)
#pragma unroll
          for (int j = 0; j < 4; ++j) {
            float pv = exp2f(s[qt][kt][j] - mn);
            if (MODE == 1) {
              const int keep = __builtin_amdgcn_sbfe((int)(kt < 2 ? mlo[qt] : mhi[qt]), (kt & 1) * 16 + j, 1);
              pv = __int_as_float(__float_as_int(pv) & keep);
            }
            s[qt][kt][j] = pv; rs += pv;
          }
        rs += __shfl_xor(rs, 16);
        rs += __shfl_xor(rs, 32);
        lrow[qt] = lrow[qt] * alpha + rs;
        if (__ballot(alpha != 1.f) != 0ull) {
#pragma unroll
          for (int dt = 0; dt < 8; ++dt) o[qt][dt] *= alpha;
        }
#pragma unroll
        for (int s2 = 0; s2 < 2; ++s2) {
          u32x4 pk;
          pk[0] = cvtpk(s[qt][2 * s2][0], s[qt][2 * s2][1]);
          pk[1] = cvtpk(s[qt][2 * s2][2], s[qt][2 * s2][3]);
          pk[2] = cvtpk(s[qt][2 * s2 + 1][0], s[qt][2 * s2 + 1][1]);
          pk[3] = cvtpk(s[qt][2 * s2 + 1][2], s[qt][2 * s2 + 1][3]);
          pf[qt][s2] = __builtin_bit_cast(bf16x8, pk);
        }
      }
#pragma unroll
      for (int dt = 0; dt < 8; ++dt) {
#pragma unroll
        for (int s2 = 0; s2 < 2; ++s2) {
          const u16* vp = sV + (dt * 16 + fr) * VSTR + fq * 4;
          u32x2 v0 = *(const u32x2*)(vp + (2 * s2) * 16);
          u32x2 v1 = *(const u32x2*)(vp + (2 * s2 + 1) * 16);
          u32x4 vv = {v0[0], v0[1], v1[0], v1[1]};
          bf16x8 vf = __builtin_bit_cast(bf16x8, vv);
          o[0][dt] = __builtin_amdgcn_mfma_f32_16x16x32_bf16(vf, pf[0][s2], o[0][dt], 0, 0, 0);
          o[1][dt] = __builtin_amdgcn_mfma_f32_16x16x32_bf16(vf, pf[1][s2], o[1][dt], 0, 0, 0);
        }
      }
    }
  }
  if (active) {
#pragma unroll
    for (int qt = 0; qt < 2; ++qt) {
      const int qr = wq0 + qt * 16 + fr;
      if (qr < nq) {
        const float inv = 1.f / lrow[qt];
        const size_t row = (size_t)(q0 + qr);
#pragma unroll
        for (int dt = 0; dt < 8; ++dt) {
          const size_t off = row * 2048 + h * 128 + dt * 16 + fq * 4;
          u32x2 ga = *(const u32x2*)(p.GA + off);
          u32x2 r;
          if (MODE == 0) {
            u32x2 gb = *(const u32x2*)(p.GB + off);
            r[0] = cvtpk(bflo(gb[0]) * o[qt][dt][0] * inv + bflo(ga[0]), bfhi(gb[0]) * o[qt][dt][1] * inv + bfhi(ga[0]));
            r[1] = cvtpk(bflo(gb[1]) * o[qt][dt][2] * inv + bflo(ga[1]), bfhi(gb[1]) * o[qt][dt][3] * inv + bfhi(ga[1]));
          } else {
            r[0] = cvtpk(bflo(ga[0]) * o[qt][dt][0] * inv, bfhi(ga[0]) * o[qt][dt][1] * inv);
            r[1] = cvtpk(bflo(ga[1]) * o[qt][dt][2] * inv, bfhi(ga[1]) * o[qt][dt][3] * inv);
          }
          *(u32x2*)(gdst + off) = r;
        }
      }
    }
  }
}

#undef KV_LOAD
#undef KV_STORE
__global__ void __launch_bounds__(NTHREADS) fwd_megakernel(Params p) {
  extern __shared__ __attribute__((aligned(16))) char smem[];
  cg::grid_group grid = cg::this_grid();
#define IDS const int tid = otid(); const int lane = tid & 63, w = tid >> 6; const int bid = blockIdx.x, nb = gridDim.x; \
  const int gw = bid * 8 + w, ngw = nb * 8; (void)tid; (void)lane; (void)gw; (void)ngw; (void)bid; (void)nb;

#if PH & (1 << 0)
  { IDS
  {
    const int vb = tid >> 8;
    float* st = (float*)(smem + vb * VB_LDS);
    const int vbid = bid * 2 + vb, nvb = nb * 2;
    for (int t = vbid; t < 32 * 192; t += nvb) transpose_tile(p.w_in, 2048, INC, p.WT_IN, t, st);
    for (int t = vbid; t < 8 * 48; t += nvb) transpose_tile(p.w_uq, 512, 3072, p.WT_UQ, t, st);
    for (int t = vbid; t < 4 * 32; t += nvb) transpose_tile(p.w_uk, 256, 2048, p.WT_UK, t, st);
    for (int t = vbid; t < 4 * 32; t += nvb) transpose_tile(p.w_uv, 256, 2048, p.WT_UV, t, st);
    for (int t = vbid; t < 32 * 32; t += nvb) transpose_tile(p.w_out, 2048, 2048, p.WT_OUT, t, st);
    for (int t = vbid; t < 32 * 128; t += nvb) transpose_tile(p.w_up, 2048, 8192, p.WT_UP, t, st);
    for (int t = vbid; t < 128 * 32; t += nvb) transpose_tile(p.w_down, 8192, 2048, p.WT_DOWN, t, st);
    for (int r = gw; r < MT; r += ngw) {
      const float* x = r < MP ? p.x_p + (size_t)r * 2048 : p.x_s + (size_t)(r - MP) * 2048;
      rms_row_2048(x, p.g_mix, p.H + (size_t)r * 2048, lane);
    }
    const int gt = bid * NTHREADS + tid, ngt = nb * NTHREADS;
    for (int i = gt; i < 16 * 1024 * 64 / 4; i += ngt) {
      int e = i * 4; int b = e >> 16; int rem = e & 65535; int s = rem >> 6, c = rem & 63;
      size_t dst = (size_t)(MP + b * SK + s) * 64 + c;
      f32x4 a = *(const f32x4*)(p.c_idx + e), k = *(const f32x4*)(p.c_kr + e);
      u32x2 o; o[0] = cvtpk(a[0], a[1]); o[1] = cvtpk(a[2], a[3]);
      *(u32x2*)(p.IXK + dst) = o;
      o[0] = cvtpk(k[0], k[1]); o[1] = cvtpk(k[2], k[3]);
      *(u32x2*)(p.KR + dst) = o;
    }
    for (int i = gt; i < 16 * 1024 * 256 / 4; i += ngt) {
      int e = i * 4; int b = e >> 18; int rem = e & 262143; int s = rem >> 8, c = rem & 255;
      size_t dst = (size_t)(MP + b * SK + s) * 256 + c;
      f32x4 a = *(const f32x4*)(p.c_ckv + e);
      u32x2 o; o[0] = cvtpk(a[0], a[1]); o[1] = cvtpk(a[2], a[3]);
      *(u32x2*)(p.CKV + dst) = o;
    }
  }
  }
#endif
  grid.sync();
#if PH & (1 << 1)
  { IDS
  for (int rep = 0; rep < NREP(1); ++rep) gemm_phase<EPI_IN>(p, p.H, 2048, p.WT_IN, 2048, 2048, MT / 256, INP / 256, smem, nullptr, 0, bid, nb);
  }
#endif
  grid.sync();
#if PH & (1 << 2)
  { IDS
  for (int t = gw; t < MT; t += ngw) post_row(p, t, lane);
  {
    const int vb = tid >> 8, vbid = bid * 2 + vb;
    char* sm = smem + vb * VB_LDS;
    for (int rep = 0; rep < NREP(2); ++rep) for (int t = vbid * NQ; t < MT; t += nb * 2 * NQ)
      topk_group(p, t, sm, (unsigned*)(p.out + O_Y + 14000000) + (size_t)vbid * 16384, (unsigned*)(p.out + O_Y + 14000000) + (size_t)(512 + vbid) * 16384,
                 (unsigned*)p.H + (size_t)vbid * 16384);
  }
  }
#endif
  grid.sync();
#if PH & (1 << 3)
  { IDS
    const int total = 1024 + 256;
    for (int rep = 0; rep < NREP(3); ++rep) {
      u16* gdst = (rep + 1 < NREP(3)) ? (u16*)(p.out + O_Y) : p.GA;
      for (int r = 0;; ++r) {
        int id = (r & 1) ? r * nb + (nb - 1 - bid) : r * nb + bid;
        if (r * nb >= total) break;
        if (id < total) attn_item<1>(p, id, smem, gdst);
      }
    }
  }
#endif
  grid.sync();
#if PH & (1 << 4)
  { IDS
  {
    const int gt = bid * NTHREADS + tid, ngt = nb * NTHREADS;
    for (int i = gt; i < 16 * 2048 * 6; i += ngt) {
      int r = i / 6, c = i - r * 6;
      *(u32x4*)(p.VBT_S + (size_t)r * VSS + SK + c * 8) = (u32x4){0u, 0u, 0u, 0u};
    }
    const int nqb = (MT / 256) * 12, nkb = (KROWS / 256) * 8;
    const int total = nqb + 2 * nkb;
    for (int id = bid; id < total; id += nb) {
      if (id < nqb) gemm_phase<EPI_QB>(p, p.CQ, 512, p.WT_UQ, 512, 512, MT / 256, 12, smem, p.QB, 3072, id, 1 << 30);
      else if (id < nqb + nkb) gemm_phase<EPI_BF16>(p, p.CKV, 256, p.WT_UK, 256, 256, KROWS / 256, 8, smem, p.KB, 2048, id - nqb, 1 << 30);
      else gemm_phase<EPI_VT>(p, p.CKV, 256, p.WT_UV, 256, 256, KROWS / 256, 8, smem, nullptr, 0, id - nqb - nkb, 1 << 30);
    }
  }
  }
#endif
  grid.sync();
#if PH & (1 << 5)
  { IDS
  {
    const int total = 1024 + 256;
    for (int rep = 0; rep < NREP(5); ++rep) {
      u16* gdst = (rep + 1 < NREP(5)) ? (u16*)(p.out + O_Y) : p.GB;
      for (int r = 0;; ++r) {
        int id = (r & 1) ? r * nb + (nb - 1 - bid) : r * nb + bid;
        if (r * nb >= total) break;
        if (id < total) attn_item<0>(p, id, smem, gdst);
      }
    }
  }
  }
#endif
  grid.sync();
#if PH & (1 << 6)
  { IDS
  gemm_phase<EPI_RES>(p, p.GB, 2048, p.WT_OUT, 2048, 2048, MT / 256, 8, smem, nullptr, 0, bid, nb);
  }
#endif
  grid.sync();
#if PH & (1 << 7)
  { IDS
  for (int r = gw; r < MT; r += ngw) rms_row_2048(p.out + O_Y + (size_t)r * 2048, p.g_ffn, p.H2 + (size_t)r * 2048, lane);
  }
#endif
  grid.sync();
#if PH & (1 << 8)
  { IDS
  gemm_phase<EPI_RELU2>(p, p.H2, 2048, p.WT_UP, 2048, 2048, MT / 256, 32, smem, nullptr, 0, bid, nb);
  }
#endif
  grid.sync();
#if PH & (1 << 9)
  { IDS
  gemm_phase<EPI_ACC>(p, p.U, DFF, p.WT_DOWN, DFF, DFF, MT / 256, 8, smem, nullptr, 0, bid, nb);
  }
#endif
  grid.sync();
#if PH & (1 << 10)
  { IDS
  for (int r = gw; r < MT; r += ngw) {
    float* x = p.out + O_Y + (size_t)r * 2048;
    f32x4 v[8];
    float ss = 0.f;
#pragma unroll
    for (int i = 0; i < 8; ++i) {
      v[i] = *(const f32x4*)(x + i * 256 + lane * 4);
      ss += v[i][0] * v[i][0] + v[i][1] * v[i][1] + v[i][2] * v[i][2] + v[i][3] * v[i][3];
    }
    ss = wave_sum(ss);
    float rr = rsqrtf(ss * (1.f / 2048.f) + 1e-6f);
#pragma unroll
    for (int i = 0; i < 8; ++i) {
      f32x4 gg = *(const f32x4*)(p.g_fin + i * 256 + lane * 4);
      f32x4 o = {v[i][0] * rr * gg[0], v[i][1] * rr * gg[1], v[i][2] * rr * gg[2], v[i][3] * rr * gg[3]};
      *(f32x4*)(x + i * 256 + lane * 4) = o;
    }
  }
  }
#endif
}

extern "C" void kernel_launch(void* const* d_in, const int* in_sizes, int n_in, void* d_out, int out_size, void* d_ws, size_t ws_size,
                              hipStream_t stream) {
  static int grid_blocks = 0;
  if (!grid_blocks) {
    int dev = 0, cus = 0, per_cu = 0;
    hipGetDevice(&dev);
    hipDeviceGetAttribute(&cus, hipDeviceAttributeMultiprocessorCount, dev);
    if (hipFuncSetAttribute((const void*)fwd_megakernel, hipFuncAttributeMaxDynamicSharedMemorySize, LDS_BYTES) != hipSuccess)
      fprintf(stderr, "kernel_launch: hipFuncSetAttribute failed\n");
    hipOccupancyMaxActiveBlocksPerMultiprocessor(&per_cu, (const void*)fwd_megakernel, NTHREADS, LDS_BYTES);
    if (per_cu < 1) per_cu = 1;
    if (per_cu > 1) per_cu = 1;
    grid_blocks = cus * per_cu;
  }
  Params p{};
  const float* const* in = (const float* const*)d_in;
  p.x_p = in[0]; p.x_s = in[1]; p.c_ak = in[2]; p.c_av = in[3]; p.c_idx = in[4]; p.c_ckv = in[5]; p.c_kr = in[6]; p.rel = in[7];
  p.g_mix = in[8]; p.w_in = in[9]; p.g_q = in[10]; p.w_uq = in[11]; p.g_kv = in[12]; p.w_uk = in[13]; p.w_uv = in[14]; p.w_out = in[15];
  p.g_ffn = in[16]; p.w_up = in[17]; p.w_down = in[18]; p.g_fin = in[19];
  p.out = (float*)d_out;
  char* ws = (char*)d_ws;
  size_t off = 0;
  auto alloc = [&](size_t bytes) { char* r = ws + off; off += (bytes + 255) & ~(size_t)255; return r; };
  p.WT_UQ = (u16*)alloc((size_t)3072 * 512 * 2);
  p.WT_UK = (u16*)alloc((size_t)2048 * 256 * 2);
  p.WT_UV = (u16*)alloc((size_t)2048 * 256 * 2);
  p.WT_OUT = (u16*)alloc((size_t)2048 * 2048 * 2);
  p.WT_UP = (u16*)alloc((size_t)8192 * 2048 * 2);
  p.WT_DOWN = (u16*)alloc((size_t)2048 * 8192 * 2);
  p.CQ = (u16*)alloc((size_t)MT * 512 * 2);
  p.CKV = (u16*)alloc((size_t)KROWS * 256 * 2);
  p.KR = (u16*)alloc((size_t)KROWS * 64 * 2);
  p.GA = (u16*)alloc((size_t)MT * 2048 * 2);
  p.GB = (u16*)alloc((size_t)MT * 2048 * 2);
  p.CS = (float*)alloc((size_t)MT * 32 * 4);
  p.SN = (float*)alloc((size_t)MT * 32 * 4);
  const size_t ubase = off;
  p.WT_IN = (u16*)alloc((size_t)INP * 2048 * 2);
  p.H = (u16*)alloc((size_t)MT * 2048 * 2);
  p.AQ = (u16*)alloc((size_t)MT * 2048 * 2);
  p.KA = (u16*)alloc((size_t)MP * 2048 * 2);
  p.VAT = (u16*)alloc((size_t)MP * 2048 * 2);
  p.IXQ = (u16*)alloc((size_t)MT * 1024 * 2);
  p.IXK = (u16*)alloc((size_t)KROWS * 64 * 2);
  p.SEL = (unsigned long long*)alloc((size_t)MT * 256 * 8);
  p.IXW = (float*)alloc((size_t)MT * 16 * 4);
  const size_t endA = off;
  off = ubase;
  p.QB = (u16*)alloc((size_t)MT * 3072 * 2);
  p.KB = (u16*)alloc((size_t)KROWS * 2048 * 2);
  p.VBT_P = (u16*)alloc((size_t)2048 * MP * 2);
  p.VBT_S = (u16*)alloc((size_t)16 * 2048 * VSS * 2);
  const size_t endB = off;
  off = ubase;
  p.H2 = (u16*)alloc((size_t)MT * 2048 * 2);
  p.U = (u16*)alloc((size_t)MT * DFF * 2);
  const size_t endC = off;
  size_t need = endA > endB ? endA : endB;
  if (endC > need) need = endC;
  if (need > ws_size) { fprintf(stderr, "kernel_launch: workspace too small: need %zu have %zu\n", need, ws_size); return; }
  void* args[] = {&p};
  hipError_t e = hipLaunchCooperativeKernel((const void*)fwd_megakernel, dim3(grid_blocks), dim3(NTHREADS), args, LDS_BYTES, stream);
  if (e != hipSuccess) fprintf(stderr, "cooperative launch failed: %s (grid %d)\n", hipGetErrorString(e), grid_blocks);
}
```

```cpp
#include <hip/hip_runtime.h>
#include <hip/hip_cooperative_groups.h>
#include <cstdio>
#include <cstdint>
namespace cg = cooperative_groups;

typedef unsigned short u16;
typedef __attribute__((ext_vector_type(8))) short bf16x8;
typedef __attribute__((ext_vector_type(4))) short bf16x4;
typedef __attribute__((ext_vector_type(4))) float f32x4;
typedef __attribute__((ext_vector_type(2))) float f32x2;
typedef __attribute__((ext_vector_type(2))) __bf16 bf16x2_t;
typedef __attribute__((ext_vector_type(4))) unsigned u32x4;
typedef __attribute__((ext_vector_type(2))) unsigned u32x2;

#define DI __device__ __forceinline__

constexpr int MP = 16384;
constexpr int MS = 256;
constexpr int MT = MP + MS;
constexpr int DM = 2048;
constexpr int INC = 12176;
constexpr int INP = 12288;
constexpr int SK = 1040;
constexpr int KROWS = MP + 16 * SK;
constexpr int VSS = 1088;
constexpr int DFF = 8192;
constexpr int ZRW = 832;
#ifndef PH
#define PH 0x7ff
#endif
#ifndef REP
#define REP 0
#endif
#define NREP(k) (((REP >> (k)) & 1) + 1)
constexpr int NTHREADS = 512;
constexpr int VB_LDS = 75776;
constexpr int LDS_BYTES = 2 * VB_LDS;

constexpr size_t O_Y = 0;
constexpr size_t O_AKP = 34078720;
constexpr size_t O_AVP = 67633152;
constexpr size_t O_IDXP = 101187584;
constexpr size_t O_CKVP = 102236160;
constexpr size_t O_KRP = 106430464;
constexpr size_t O_AKS = 107479040;
constexpr size_t O_AVS = 108003328;
constexpr size_t O_IDXS = 108527616;
constexpr size_t O_CKVS = 108544000;
constexpr size_t O_KRS = 108609536;

struct Params {
  const float *x_p, *x_s, *c_ak, *c_av, *c_idx, *c_ckv, *c_kr, *rel, *g_mix, *w_in, *g_q, *w_uq, *g_kv, *w_uk, *w_uv, *w_out, *g_ffn, *w_up, *w_down, *g_fin;
  float* out;
  u16 *WT_UQ, *WT_UK, *WT_UV, *WT_OUT, *WT_UP, *WT_DOWN, *CQ, *CKV, *KR, *GA, *GB;
  float *CS, *SN;
  u16 *WT_IN, *H, *AQ, *KA, *VAT, *IXQ, *IXK;
  float* IXW;
  unsigned long long* SEL;
  u16 *QB, *KB, *VBT_P, *VBT_S;
  u16 *H2, *U;
};

DI int otid() { int t = threadIdx.x; asm volatile("" : "+v"(t)); return t; }
DI unsigned cvtpk(float lo, float hi) {
  f32x2 v = {lo, hi};
  bf16x2_t b = __builtin_convertvector(v, bf16x2_t);
  return __builtin_bit_cast(unsigned, b);
}
DI u16 f2bf(float x) { return (u16)(cvtpk(x, 0.f) & 0xffffu); }
DI float bf2f(u16 b) { return __uint_as_float(((unsigned)b) << 16); }
DI float bflo(unsigned w) { return __uint_as_float(w << 16); }
DI float bfhi(unsigned w) { return __uint_as_float(w & 0xffff0000u); }
DI float dot2bf(unsigned a, unsigned b, float c) {
  return __builtin_amdgcn_fdot2_f32_bf16(__builtin_bit_cast(bf16x2_t, a), __builtin_bit_cast(bf16x2_t, b), c, false);
}
DI float wave_sum(float v) {
#pragma unroll
  for (int o = 32; o > 0; o >>= 1) v += __shfl_xor(v, o);
  return v;
}
DI int qpos_of(int t) { return t < MP ? t : 1024 + ((t - MP) & 15); }
DI int krow_of(int t) { return t < MP ? t : MP + ((t - MP) >> 4) * SK + 1024 + ((t - MP) & 15); }
DI float inv_freq(int i) { return exp2f(-(float)i * 0.41524101186092029f); }

DI void transpose_tile(const float* __restrict__ W, int K, int N, u16* __restrict__ Wt, int tile, float* s  ) {
  const int nkt = K >> 6;
  const int kt = tile % nkt, nt = tile / nkt;
  const int k0 = kt << 6, n0 = nt << 6;
  const int tid = otid() & 255;
  const int c = tid & 63, r0 = tid >> 6;
  __syncthreads();
#pragma unroll
  for (int i = 0; i < 16; ++i) {
    int r = i * 4 + r0;
    float v = (n0 + c < N) ? W[(size_t)(k0 + r) * N + n0 + c] : 0.f;
    s[r * 65 + c] = v;
  }
  __syncthreads();
  const int kp = (tid & 31) * 2, rr0 = tid >> 5;
#pragma unroll
  for (int i = 0; i < 8; ++i) {
    int rr = i * 8 + rr0;
    unsigned pk = cvtpk(s[kp * 65 + rr], s[(kp + 1) * 65 + rr]);
    *(unsigned*)(Wt + (size_t)(n0 + rr) * K + k0 + kp) = pk;
  }
}

DI void rms_row_2048(const float* __restrict__ x, const float* __restrict__ g, u16* __restrict__ out, int lane) {
  f32x4 v[8];
  float ss = 0.f;
#pragma unroll
  for (int i = 0; i < 8; ++i) {
    v[i] = *(const f32x4*)(x + i * 256 + lane * 4);
    ss += v[i][0] * v[i][0] + v[i][1] * v[i][1] + v[i][2] * v[i][2] + v[i][3] * v[i][3];
  }
  ss = wave_sum(ss);
  float r = rsqrtf(ss * (1.f / 2048.f) + 1e-6f);
#pragma unroll
  for (int i = 0; i < 8; ++i) {
    f32x4 gg = *(const f32x4*)(g + i * 256 + lane * 4);
    u32x2 o;
    o[0] = cvtpk(v[i][0] * r * gg[0], v[i][1] * r * gg[1]);
    o[1] = cvtpk(v[i][2] * r * gg[2], v[i][3] * r * gg[3]);
    *(u32x2*)(out + i * 256 + lane * 4) = o;
  }
}

enum { EPI_IN = 0, EPI_QB, EPI_BF16, EPI_VT, EPI_RES, EPI_RELU2, EPI_ACC, EPI_ATOM };
constexpr float QSC = 0.07216878364870322f * 1.4426950408889634f;
constexpr int LSTR = 72;
#ifndef PFA
#define PFA 8
#endif

template <int EPI>
DI void gemm_epilogue(const Params& p, f32x4 (&acc)[8][4], int m0, int n0, int wr, int wc, int fr, int fq, u16* Cb, int ldc) {
  const int cw = n0 + wc * 64;
#pragma clang loop unroll(full)
  for (int m = 0; m < 8; ++m) {
    const int rb = m0 + wr * 128 + m * 16 + fq * 4;
    if (EPI == EPI_QB) {
      const int within = cw % 192;
      if (within == 128) {
#pragma clang loop unroll(full)
        for (int n = 0; n < 2; ++n) {
          const int i = n * 16 + fr;
#pragma clang loop unroll(full)
          for (int j = 0; j < 4; ++j) {
            const int row = rb + j;
            const float cs = p.CS[(size_t)row * 32 + i], sn = p.SN[(size_t)row * 32 + i];
            float x1 = acc[m][n][j] * QSC, x2 = acc[m][n + 2][j] * QSC;
            p.QB[(size_t)row * 3072 + cw + i] = f2bf(x1 * cs - x2 * sn);
            p.QB[(size_t)row * 3072 + cw + i + 32] = f2bf(x1 * sn + x2 * cs);
          }
        }
        continue;
      }
    }
#pragma clang loop unroll(full)
    for (int n = 0; n < 4; ++n) {
      const int colt = cw + n * 16;
      const int col = colt + fr;
      if (EPI == EPI_IN) {
        if (colt >= 4096 && colt < 6144 && rb < MP) {
          u32x2 pk;
          pk[0] = cvtpk(acc[m][n][0], acc[m][n][1]);
          pk[1] = cvtpk(acc[m][n][2], acc[m][n][3]);
          *(u32x2*)(p.VAT + (size_t)(col - 4096) * MP + rb) = pk;
        }
      }
      if (EPI == EPI_VT) {
        u32x2 pk;
        pk[0] = cvtpk(acc[m][n][0], acc[m][n][1]);
        pk[1] = cvtpk(acc[m][n][2], acc[m][n][3]);
        u16* dst;
        if (rb < MP) dst = p.VBT_P + (size_t)col * MP + rb;
        else { int r2 = rb - MP; int b = r2 / SK; int s = r2 - b * SK; dst = p.VBT_S + ((size_t)b * 2048 + col) * VSS + s; }
        *(u32x2*)dst = pk;
        continue;
      }
#pragma clang loop unroll(full)
      for (int j = 0; j < 4; ++j) {
        const int row = rb + j;
        const float v = acc[m][n][j];
        if (EPI == EPI_IN) {
          if (colt < 2048) p.AQ[(size_t)row * 2048 + col] = f2bf(v * (0.08838834764831845f * 1.4426950408889634f));
          else if (colt < 4096) {
            int c = col - 2048;
            if (row < MP) { p.out[O_AKP + (size_t)row * 2048 + c] = v; p.KA[(size_t)row * 2048 + c] = f2bf(v); }
            else p.out[O_AKS + (size_t)(row - MP) * 2048 + c] = v;
          } else if (colt < 6144) {
            int c = col - 4096;
            if (row < MP) p.out[O_AVP + (size_t)row * 2048 + c] = v;
            else p.out[O_AVS + (size_t)(row - MP) * 2048 + c] = v;
          } else if (colt < 7168) p.IXQ[(size_t)row * 1024 + (col - 6144)] = f2bf(v);
          else if (colt < 7232) {
            int c = col - 7168;
            if (row < MP) p.out[O_IDXP + (size_t)row * 64 + c] = v; else p.out[O_IDXS + (size_t)(row - MP) * 64 + c] = v;
            p.IXK[(size_t)krow_of(row) * 64 + c] = f2bf(v);
          } else if (colt < 7248) p.IXW[(size_t)row * 16 + (col - 7232)] = v * 0.25f;
          else if (colt < 8080) p.out[O_Y + (size_t)row * ZRW + (col - 7248)] = v;
          else if (colt < 10128) p.GA[(size_t)row * 2048 + (col - 8080)] = f2bf(1.f / (1.f + __expf(-v)));
          else if (colt < INC) p.GB[(size_t)row * 2048 + (col - 10128)] = f2bf(1.f / (1.f + __expf(-v)));
        } else if (EPI == EPI_QB) {
          Cb[(size_t)row * ldc + col] = f2bf(v * QSC);
        } else if (EPI == EPI_BF16) {
          Cb[(size_t)row * ldc + col] = f2bf(v);
        } else if (EPI == EPI_RES) {
          float xv = row < MP ? p.x_p[(size_t)row * 2048 + col] : p.x_s[(size_t)(row - MP) * 2048 + col];
          p.out[O_Y + (size_t)row * 2048 + col] = xv + v;
        } else if (EPI == EPI_RELU2) {
          float r = fmaxf(v, 0.f);
          p.U[(size_t)row * DFF + col] = f2bf(r * r);
        } else if (EPI == EPI_ACC) {
          p.out[O_Y + (size_t)row * 2048 + col] += v;
        } else if (EPI == EPI_ATOM) {
          atomicAdd(&p.out[O_Y + (size_t)row * 2048 + col], v);
        }
      }
    }
  }
}

constexpr int GSTAGE = 512 * LSTR;
template <int EPI>
DI void gemm_tile(const Params& p, const u16* __restrict__ A, int lda, const u16* __restrict__ Bt, int ldb, int K, int m0, int n0,
                  char* smem, u16* Cb, int ldc) {
  u16* sbase = (u16*)smem;
  const int tid = otid(), lane = tid & 63, w = tid >> 6;
  const int wr = w >> 2, wc = w & 3, fr = lane & 15, fq = lane >> 4;
  f32x4 acc[8][4];
#pragma unroll
  for (int m = 0; m < 8; ++m)
#pragma unroll
    for (int n = 0; n < 4; ++n) acc[m][n] = (f32x4){0.f, 0.f, 0.f, 0.f};
  const int lr = tid >> 3, lk = (tid & 7) * 8;
  const u16* Ag = A + (size_t)(m0 + lr) * lda + lk;
  const u16* Bg = Bt + (size_t)(n0 + lr) * ldb + lk;
  const int nk = K >> 6;
  u32x4 ra[4], rb[4];
#define G_LOAD(T) { const int k_ = (T) << 6; _Pragma("unroll") for (int i = 0; i < 4; ++i) { \
    ra[i] = *(const u32x4*)(Ag + (size_t)(i * 64) * lda + k_); rb[i] = *(const u32x4*)(Bg + (size_t)(i * 64) * ldb + k_); } }
#define L_STORE(ST) { u16* dA_ = sbase + (ST) * GSTAGE + lr * LSTR + lk; u16* dB_ = dA_ + 256 * LSTR; _Pragma("unroll") for (int i = 0; i < 4; ++i) { \
    *(u32x4*)(dA_ + i * 64 * LSTR) = ra[i]; *(u32x4*)(dB_ + i * 64 * LSTR) = rb[i]; } }
  G_LOAD(0)
  L_STORE(0)
  G_LOAD(1)
#pragma unroll 1
  for (int kt = 0; kt < nk; ++kt) {
    __syncthreads();
    if (kt + 1 < nk) L_STORE((kt + 1) & 1)
    G_LOAD(min(kt + 2, nk - 1))
    const u16* cA = sbase + (kt & 1) * GSTAGE + (wr * 128 + fr) * LSTR + fq * 8;
    const u16* cB = sbase + (kt & 1) * GSTAGE + 256 * LSTR + (wc * 64 + fr) * LSTR + fq * 8;
#pragma unroll
    for (int ks = 0; ks < 2; ++ks) {
      bf16x8 bfr[4];
#pragma unroll
      for (int n = 0; n < 4; ++n) bfr[n] = *(const bf16x8*)(cB + n * 16 * LSTR + ks * 32);
#pragma unroll
      for (int mh = 0; mh < 2; ++mh) {
        bf16x8 af[4];
#pragma unroll
        for (int m = 0; m < 4; ++m) af[m] = *(const bf16x8*)(cA + (mh * 4 + m) * 16 * LSTR + ks * 32);
#pragma unroll
        for (int m = 0; m < 4; ++m)
#pragma unroll
          for (int n = 0; n < 4; ++n)
            acc[mh * 4 + m][n] = __builtin_amdgcn_mfma_f32_16x16x32_bf16(af[m], bfr[n], acc[mh * 4 + m][n], 0, 0, 0);
      }
    }
  }
#undef G_LOAD
#undef L_STORE
  gemm_epilogue<EPI>(p, acc, m0, n0, wr, wc, fr, fq, Cb, ldc);
}

template <int EPI>
DI void gemm_phase(const Params& p, const u16* A, int lda, const u16* Bt, int ldb, int K, int mtiles, int ntiles, char* smem, u16* Cb, int ldc,
                   int start, int stride) {
  const int total = mtiles * ntiles;
  const int GM = 8;
  for (int id = start; id < total; id += stride) {
    const int per = GM * ntiles;
    const int g = id / per, rem = id - g * per;
    const int fm = g * GM;
    const int gsz = min(GM, mtiles - fm);
    const int mt = fm + rem % gsz, nt = rem / gsz;
    gemm_tile<EPI>(p, A, lda, Bt, ldb, K, mt * 256, nt * 256, smem, Cb, ldc);
  }
}

DI void post_row(const Params& p, int t, int lane) {
  const float* zr = p.out + O_Y + (size_t)t * ZRW;
  {
    f32x4 a = *(const f32x4*)(zr + lane * 4), b = *(const f32x4*)(zr + 256 + lane * 4);
    float ss = a[0] * a[0] + a[1] * a[1] + a[2] * a[2] + a[3] * a[3] + b[0] * b[0] + b[1] * b[1] + b[2] * b[2] + b[3] * b[3];
    ss = wave_sum(ss);
    float r = rsqrtf(ss * (1.f / 512.f) + 1e-6f);
    f32x4 ga = *(const f32x4*)(p.g_q + lane * 4), gb = *(const f32x4*)(p.g_q + 256 + lane * 4);
    u32x2 o;
    o[0] = cvtpk(a[0] * r * ga[0], a[1] * r * ga[1]); o[1] = cvtpk(a[2] * r * ga[2], a[3] * r * ga[3]);
    *(u32x2*)(p.CQ + (size_t)t * 512 + lane * 4) = o;
    o[0] = cvtpk(b[0] * r * gb[0], b[1] * r * gb[1]); o[1] = cvtpk(b[2] * r * gb[2], b[3] * r * gb[3]);
    *(u32x2*)(p.CQ + (size_t)t * 512 + 256 + lane * 4) = o;
  }
  const int kr_row = krow_of(t);
  {
    f32x4 a = *(const f32x4*)(zr + 512 + lane * 4);
    float ss = a[0] * a[0] + a[1] * a[1] + a[2] * a[2] + a[3] * a[3];
    ss = wave_sum(ss);
    float r = rsqrtf(ss * (1.f / 256.f) + 1e-6f);
    f32x4 g = *(const f32x4*)(p.g_kv + lane * 4);
    f32x4 o = {a[0] * r * g[0], a[1] * r * g[1], a[2] * r * g[2], a[3] * r * g[3]};
    float* od = t < MP ? p.out + O_CKVP + (size_t)t * 256 : p.out + O_CKVS + (size_t)(t - MP) * 256;
    *(f32x4*)(od + lane * 4) = o;
    u32x2 ob; ob[0] = cvtpk(o[0], o[1]); ob[1] = cvtpk(o[2], o[3]);
    *(u32x2*)(p.CKV + (size_t)kr_row * 256 + lane * 4) = ob;
  }
  if (lane < 32) {
    float x1 = zr[768 + lane], x2 = zr[768 + 32 + lane];
    float ang = (float)qpos_of(t) * inv_freq(lane);
    float cs = cosf(ang), sn = sinf(ang);
    p.CS[(size_t)t * 32 + lane] = cs; p.SN[(size_t)t * 32 + lane] = sn;
    float o1 = x1 * cs - x2 * sn, o2 = x1 * sn + x2 * cs;
    float* od = t < MP ? p.out + O_KRP + (size_t)t * 64 : p.out + O_KRS + (size_t)(t - MP) * 64;
    od[lane] = o1; od[lane + 32] = o2;
    p.KR[(size_t)kr_row * 64 + lane] = f2bf(o1);
    p.KR[(size_t)kr_row * 64 + lane + 32] = f2bf(o2);
  }
}

template <int CTRL> DI float dpp_add(float v) {
  int sft = __builtin_amdgcn_update_dpp(0, __float_as_int(v), CTRL, 0xf, 0xf, true);
  return v + __int_as_float(sft);
}
DI float row16_sum(float v) { v = dpp_add<0x111>(v); v = dpp_add<0x112>(v); v = dpp_add<0x114>(v); v = dpp_add<0x118>(v); return v; }
DI unsigned fkey(float f) { unsigned u = __float_as_uint(f); return (u & 0x80000000u) ? ~u : (u | 0x80000000u); }

DI void radix_select(unsigned* sc, int* hist, int* misc, int n, unsigned long long* sel, int tid, int lane, int w) {
  __syncthreads();
  unsigned prefix = 0;
  int remaining = 256;
#pragma unroll 1
  for (int pass = 0; pass < 3; ++pass) {
    const int shift = pass == 0 ? 21 : (pass == 1 ? 10 : 0);
    const int bits = pass == 2 ? 10 : 11;
    const unsigned bmask = (1u << bits) - 1u;
    if (pass > 0) {
      *(int4*)&hist[tid * 8] = make_int4(0, 0, 0, 0);
      *(int4*)&hist[tid * 8 + 4] = make_int4(0, 0, 0, 0);
      __syncthreads();
      const int hs = shift + bits;
      const unsigned want = prefix >> hs;
      for (int i = tid * 4; i < n; i += 256 * 4) {
        const u32x4 u4 = *(const u32x4*)(sc + i);
#pragma unroll
        for (int e = 0; e < 4; ++e)
          if ((u4[e] >> hs) == want) atomicAdd(&hist[(u4[e] >> shift) & bmask], 1);
      }
      __syncthreads();
    }
    const int4 h0 = *(const int4*)&hist[tid * 8], h1 = *(const int4*)&hist[tid * 8 + 4];
    const int s8 = h0.x + h0.y + h0.z + h0.w + h1.x + h1.y + h1.z + h1.w;
    int suf = s8;
#pragma unroll
    for (int d = 1; d < 64; d <<= 1) { int v = __shfl_down(suf, d); if (lane + d < 64) suf += v; }
    if (lane == 0) misc[w] = suf;
    __syncthreads();
    int above = 0;
    for (int ww = w + 1; ww < 4; ++ww) above += misc[ww];
    const int excl = above + suf - s8;
    if (excl < remaining && remaining <= excl + s8) {
      int c = excl, bin = 0, nrem = 0;
#define TK_STEP(val, idx) if (c < remaining && remaining <= c + (val)) { bin = tid * 8 + (idx); nrem = remaining - c; } c += (val);
      TK_STEP(h1.w, 7) TK_STEP(h1.z, 6) TK_STEP(h1.y, 5) TK_STEP(h1.x, 4) TK_STEP(h0.w, 3) TK_STEP(h0.z, 2) TK_STEP(h0.y, 1) TK_STEP(h0.x, 0)
#undef TK_STEP
      misc[4] = bin; misc[5] = nrem;
    }
    __syncthreads();
    prefix |= ((unsigned)misc[4]) << shift;
    remaining = misc[5];
    __syncthreads();
  }
  const unsigned T = prefix;
  const int seg = ((n + 255) >> 8) << 6;
  const int beg = w * seg;
  int ceq = 0;
  for (int i = beg + lane; i < beg + seg; i += 64) {
    bool in = i < n; unsigned u = in ? sc[i] : 0u;
    ceq += __popcll(__ballot(in && u == T));
  }
  if (lane == 0) misc[12 + w] = ceq;
  __syncthreads();
  int oe = 0;
  for (int ww = 0; ww < w; ++ww) oe += misc[12 + ww];
  const unsigned long long lt = (1ull << lane) - 1ull;
  for (int i0 = beg; i0 < beg + seg; i0 += 64) {
    const int i = i0 + lane;
    bool in = i < n; unsigned u = in ? sc[i] : 0u;
    bool g = in && u > T, e = in && u == T;
    unsigned long long be = __ballot(e);
    int pe = oe + __popcll(be & lt);
    unsigned long long sm = __ballot(g || (e && pe < remaining));
    if (lane == 0 && i0 < n) sel[i0 >> 6] = sm;
    oe += __popcll(be);
  }
}

constexpr int NQ = 4;
DI void topk_group(const Params& p, int t, char* smem, unsigned* scr1, unsigned* scr2, unsigned* scr3) {
  unsigned* sc = (unsigned*)smem;
  int* hist = (int*)(smem + 65536);
  int* misc = hist + 2048;
  const int tid = otid() & 255, lane = tid & 63, w = tid >> 6, fr = lane & 15, fq = lane >> 4;
  int n; const u16* ixk;
  if (t < MP) { n = 64 * ((t >> 6) + 1); ixk = p.IXK; }
  else { int b = (t - MP) >> 4; n = SK; ixk = p.IXK + (size_t)(MP + b * SK) * 64; }
  unsigned long long* sel = p.SEL + (size_t)t * 256;
  __syncthreads();
  if (n <= 256) {
    if (tid < 4) {
      unsigned long long v = (tid < (n >> 6)) ? ~0ull : 0ull;
#pragma unroll
      for (int qi = 0; qi < NQ; ++qi) sel[qi * 256 + tid] = v;
    }
    return;
  }
  *(int4*)&hist[tid * 8] = make_int4(0, 0, 0, 0);
  *(int4*)&hist[tid * 8 + 4] = make_int4(0, 0, 0, 0);
  __syncthreads();
  {
    const u16* q = p.IXQ + (size_t)t * 1024 + fr * 64 + fq * 8;
    bf16x8 a0[NQ], a1[NQ];
    f32x4 wv[NQ];
#pragma unroll
    for (int qi = 0; qi < NQ; ++qi) {
      a0[qi] = *(const bf16x8*)(q + qi * 1024); a1[qi] = *(const bf16x8*)(q + qi * 1024 + 32);
      wv[qi] = *(const f32x4*)(p.IXW + (size_t)(t + qi) * 16 + fq * 4);
    }
    const int ntile = n >> 4;
    for (int kt0 = w; kt0 < ntile; kt0 += 32) {
      bf16x8 b0[8], b1[8];
#pragma unroll
      for (int g = 0; g < 8; ++g) {
        const int kt = min(kt0 + g * 4, ntile - 1);
        const u16* kp = ixk + (size_t)(kt * 16 + fr) * 64 + fq * 8;
        b0[g] = *(const bf16x8*)kp; b1[g] = *(const bf16x8*)(kp + 32);
      }
      float pt[NQ][8];
#pragma unroll
      for (int g = 0; g < 8; ++g) {
#pragma unroll
        for (int qi = 0; qi < NQ; ++qi) {
          f32x4 c = {0.f, 0.f, 0.f, 0.f};
          c = __builtin_amdgcn_mfma_f32_16x16x32_bf16(a0[qi], b0[g], c, 0, 0, 0);
          c = __builtin_amdgcn_mfma_f32_16x16x32_bf16(a1[qi], b1[g], c, 0, 0, 0);
          pt[qi][g] = fmaxf(c[0], 0.f) * wv[qi][0] + fmaxf(c[1], 0.f) * wv[qi][1] + fmaxf(c[2], 0.f) * wv[qi][2] + fmaxf(c[3], 0.f) * wv[qi][3];
        }
      }
#pragma unroll
      for (int g = 0; g < 8; g += 2) {
        const int kt = kt0 + (g + (lane >> 5)) * 4;
        const bool st = (lane & 16) == 0 && kt < ntile;
#pragma unroll
        for (int qi = 0; qi < NQ; ++qi) {
          auto r32 = __builtin_amdgcn_permlane32_swap(__float_as_uint(pt[qi][g]), __float_as_uint(pt[qi][g + 1]), false, false);
          float s2 = __uint_as_float(r32[0]) + __uint_as_float(r32[1]);
          auto r16 = __builtin_amdgcn_permlane16_swap(__float_as_uint(s2), __float_as_uint(s2), false, false);
          float sv = __uint_as_float(r16[0]) + __uint_as_float(r16[1]);
          if (st) {
            unsigned u = fkey(sv);
            if (qi == 0) { sc[kt * 16 + fr] = u; atomicAdd(&hist[u >> 21], 1); }
            else if (qi == 1) scr1[kt * 16 + fr] = u;
            else if (qi == 2) scr2[kt * 16 + fr] = u;
            else scr3[kt * 16 + fr] = u;
          }
        }
      }
    }
  }
  radix_select(sc, hist, misc, n, sel, tid, lane, w);
#pragma unroll 1
  for (int qi = 1; qi < NQ; ++qi) {
    const unsigned* scr = qi == 1 ? scr1 : (qi == 2 ? scr2 : scr3);
    __syncthreads();
    *(int4*)&hist[tid * 8] = make_int4(0, 0, 0, 0);
    *(int4*)&hist[tid * 8 + 4] = make_int4(0, 0, 0, 0);
    __syncthreads();
    for (int i = tid * 4; i < n; i += 256 * 4) {
      const u32x4 u4 = *(const u32x4*)(scr + i);
      *(u32x4*)(sc + i) = u4;
#pragma unroll
      for (int e = 0; e < 4; ++e) atomicAdd(&hist[u4[e] >> 21], 1);
    }
    radix_select(sc, hist, misc, n, sel + qi * 256, tid, lane, w);
  }
}

constexpr int KSTR = 200;
constexpr int VSTR = 72;

template <int MODE>
DI void attn_item(const Params& p, int item, char* smem, u16* gdst) {
  constexpr int NKS = MODE == 0 ? 6 : 4;
  constexpr int ASTAGE = 64 * KSTR + 128 * VSTR;
  u16* sbase = (u16*)smem;
  float* sBias = (float*)(sbase + 2 * ASTAGE);
  const int tid = otid(), lane = tid & 63, w = tid >> 6, fr = lane & 15, fq = lane >> 4;
  int h, q0, nq, krow0, nkeys, ntiles, myt, b = 0, qpos0;
  const u16* vt; size_t vstride;
  const bool sample = item >= 1024;
  if (!sample) {
    const int i = 63 - (item >> 4);
    h = item & 15; q0 = i * 256; nq = 256; krow0 = 0; nkeys = q0 + 256; ntiles = 4 * i + 4; qpos0 = q0;
    vt = (MODE == 0 ? p.VBT_P : p.VAT) + (size_t)h * 128 * MP; vstride = MP;
    myt = ntiles - 3 + (w >> 1);
  } else {
    const int j = item - 1024; b = j >> 4;
    h = j & 15; q0 = MP + b * 16; nq = 16; krow0 = MP + b * SK; nkeys = SK; ntiles = 17; qpos0 = 1024;
    vt = p.VBT_S + ((size_t)b * 2048 + h * 128) * VSS; vstride = VSS;
    myt = ntiles;
  }
  const int wq0 = w * 32;
  const bool active = wq0 < nq;
  __syncthreads();
  if (MODE == 1) {
    for (int i = tid; i < 257; i += NTHREADS) {
      int rel = i - 128;
      int ret = rel > 0 ? 16 : 0;
      int n = rel < 0 ? -rel : rel;
      float lf = logf((float)max(n, 1) / 8.0f) / 2.772588722239781f * 8.0f;
      int large = min(8 + (int)lf, 15);
      int bk = ret + (n < 8 ? n : large);
      sBias[i] = (p.rel[bk * 16 + h] - p.rel[15 * 16 + h]) * 1.4426950408889634f;
    }
  }
  bf16x8 qf[2][NKS];
  int qrow[2];
#pragma unroll
  for (int qt = 0; qt < 2; ++qt) {
    const int qr = min(wq0 + qt * 16 + fr, nq - 1);
    qrow[qt] = qr;
    const u16* qp = (MODE == 0) ? p.QB + (size_t)(q0 + qr) * 3072 + h * 192 + fq * 8 : p.AQ + (size_t)(q0 + qr) * 2048 + h * 128 + fq * 8;
#pragma unroll
    for (int ks = 0; ks < NKS; ++ks) qf[qt][ks] = *(const bf16x8*)(qp + ks * 32);
  }
  f32x4 o[2][8];
#pragma unroll
  for (int qt = 0; qt < 2; ++qt)
#pragma unroll
    for (int dt = 0; dt < 8; ++dt) o[qt][dt] = (f32x4){0.f, 0.f, 0.f, 0.f};
  float mrow[2] = {-1e30f, -1e30f}, lrow[2] = {0.f, 0.f};
  const float SC = (MODE == 0 ? 0.07216878364870322f : 0.08838834764831845f) * 1.4426950408889634f;

  unsigned long long mqn[2] = {0ull, 0ull};
  if (MODE == 1) {
#pragma unroll
    for (int qt = 0; qt < 2; ++qt) mqn[qt] = p.SEL[(size_t)(q0 + qrow[qt]) * 256];
  }
  constexpr int NKL = MODE == 0 ? 3 : 2;
  const bool direct = (MODE == 1) && sample;
  u32x4 rk[NKL], rv[2];
#define KV_LOAD(JT) { const size_t kr0_ = (size_t)(krow0 + (JT) * 64); const u16* kb_ = (MODE == 0 ? p.KB : p.KA) + (kr0_ + (tid >> 4)) * 2048 + h * 128 + (tid & 15) * 8; \
    _Pragma("unroll") for (int i = 0; i < 2; ++i) rk[i] = *(const u32x4*)(kb_ + (size_t)i * 32 * 2048); \
    if (MODE == 0) rk[NKL - 1] = *(const u32x4*)(p.KR + (kr0_ + (tid >> 3)) * 64 + (tid & 7) * 8); \
    const u16* vp_ = vt + (size_t)(tid >> 3) * vstride + (JT) * 64 + (tid & 7) * 8; \
    _Pragma("unroll") for (int i = 0; i < 2; ++i) rv[i] = *(const u32x4*)(vp_ + (size_t)i * 64 * vstride); }
#define KV_STORE(ST) { u16* sk_ = sbase + (ST) * ASTAGE; u16* dk_ = sk_ + (tid >> 4) * KSTR + (tid & 15) * 8; \
    _Pragma("unroll") for (int i = 0; i < 2; ++i) *(u32x4*)(dk_ + i * 32 * KSTR) = rk[i]; \
    if (MODE == 0) *(u32x4*)(sk_ + (tid >> 3) * KSTR + 128 + (tid & 7) * 8) = rk[NKL - 1]; \
    u16* dv_ = sk_ + 64 * KSTR + (tid >> 3) * VSTR + (tid & 7) * 8; \
    _Pragma("unroll") for (int i = 0; i < 2; ++i) *(u32x4*)(dv_ + i * 64 * VSTR) = rv[i]; }
  if (!direct) {
    KV_LOAD(0)
    KV_STORE(0)
    KV_LOAD(min(1, ntiles - 1))
  }
  for (int jt = 0; jt < ntiles; ++jt) {
    const int key0 = jt * 64;
    u16* sK = sbase + (jt & 1) * ASTAGE;
    u16* sV = sK + 64 * KSTR;
    unsigned long long mq[2] = {mqn[0], mqn[1]};
    if (MODE == 1) {
      const int jn = min(jt + 1, ntiles - 1);
#pragma unroll
      for (int qt = 0; qt < 2; ++qt) mqn[qt] = p.SEL[(size_t)(q0 + qrow[qt]) * 256 + jn];
    }
    __syncthreads();
    if (!direct) {
      if (jt + 1 < ntiles) KV_STORE((jt + 1) & 1)
      KV_LOAD(min(jt + 2, ntiles - 1))
    } else {
#pragma unroll 2
      for (int i = 0; i < 4; ++i) {
        const int c = tid + i * NTHREADS;
        const int key = c >> 5, part = c & 31;
        const int s = key0 + key;
        const int sc_ = min(s, SK - 1);
        const size_t o1 = sc_ < 1024 ? ((size_t)b * 1024 + sc_) * 2048 : ((size_t)b * 16 + (sc_ - 1024)) * 2048;
        const float* kp = (sc_ < 1024 ? p.c_ak : p.out + O_AKS) + o1 + h * 128 + part * 4;
        const float* vp = (sc_ < 1024 ? p.c_av : p.out + O_AVS) + o1 + h * 128 + part * 4;
        f32x4 kv = *(const f32x4*)kp, vv = *(const f32x4*)vp;
        u32x2 kk; kk[0] = cvtpk(kv[0], kv[1]); kk[1] = cvtpk(kv[2], kv[3]);
        *(u32x2*)(sK + key * KSTR + part * 4) = kk;
        const bool ok = s < SK;
#pragma unroll
        for (int e = 0; e < 4; ++e) sV[(part * 4 + e) * VSTR + key] = ok ? f2bf(vv[e]) : (u16)0;
      }
      __syncthreads();
    }
    if (active && jt < myt) {
      f32x4 s[2][4];
#pragma unroll
      for (int qt = 0; qt < 2; ++qt)
#pragma unroll
        for (int kt = 0; kt < 4; ++kt) s[qt][kt] = (f32x4){0.f, 0.f, 0.f, 0.f};
#pragma unroll
      for (int kt = 0; kt < 4; ++kt) {
#pragma unroll
        for (int ks = 0; ks < NKS; ++ks) {
          bf16x8 kf = *(const bf16x8*)(sK + (kt * 16 + fr) * KSTR + ks * 32 + fq * 8);
          s[0][kt] = __builtin_amdgcn_mfma_f32_16x16x32_bf16(kf, qf[0][ks], s[0][kt], 0, 0, 0);
          s[1][kt] = __builtin_amdgcn_mfma_f32_16x16x32_bf16(kf, qf[1][ks], s[1][kt], 0, 0, 0);
        }
      }
      unsigned mlo[2] = {0u, 0u}, mhi[2] = {0u, 0u};
      if (MODE == 0) {
        if (key0 + 64 > nkeys) {
#pragma unroll
          for (int kt = 0; kt < 4; ++kt)
#pragma unroll
            for (int j = 0; j < 4; ++j)
              if (key0 + kt * 16 + fq * 4 + j >= nkeys) { s[0][kt][j] = -1e30f; s[1][kt][j] = -1e30f; }
        }
      } else {
        const bool far = (key0 + 63) - (qpos0 + wq0) <= -128;
        if (!far) {
#pragma unroll
          for (int qt = 0; qt < 2; ++qt) {
            const int rb = key0 + fq * 4 - (qpos0 + qrow[qt]) + 128;
#pragma unroll
            for (int kt = 0; kt < 4; ++kt)
#pragma unroll
              for (int j = 0; j < 4; ++j) {
                int r = min(max(rb + kt * 16 + j, 0), 256);
                s[qt][kt][j] += sBias[r];
              }
          }
        }
#pragma unroll
        for (int qt = 0; qt < 2; ++qt) {
          const unsigned long long mm = mq[qt] >> (fq * 4);
          mlo[qt] = (unsigned)mm; mhi[qt] = (unsigned)(mm >> 32);
        }
      }
      bf16x8 pf[2][2];
#pragma unroll
      for (int qt = 0; qt < 2; ++qt) {
        float mx = -1e30f;
#pragma unroll
        for (int kt = 0; kt < 4; ++kt)
#pragma unroll
          for (int j = 0; j < 4; ++j) mx = fmaxf(mx, s[qt][kt][j]);
        mx = fmaxf(mx, __shfl_xor(mx, 16));
        mx = fmaxf(mx, __shfl_xor(mx, 32));
        const float mn = fmaxf(mrow[qt], mx);
        const float alpha = exp2f(mrow[qt] - mn);
        mrow[qt] = mn;
        float rs = 0.f;
#pragma unroll
        for (int kt = 0; kt < 4; ++kt)
#pragma unroll
          for (int j = 0; j < 4; ++j) {
            float pv = exp2f(s[qt][kt][j] - mn);
            if (MODE == 1) {
              const int keep = __builtin_amdgcn_sbfe((int)(kt < 2 ? mlo[qt] : mhi[qt]), (kt & 1) * 16 + j, 1);
              pv = __int_as_float(__float_as_int(pv) & keep);
            }
            s[qt][kt][j] = pv; rs += pv;
          }
        rs += __shfl_xor(rs, 16);
        rs += __shfl_xor(rs, 32);
        lrow[qt] = lrow[qt] * alpha + rs;
        if (__ballot(alpha != 1.f) != 0ull) {
#pragma unroll
          for (int dt = 0; dt < 8; ++dt) o[qt][dt] *= alpha;
        }
#pragma unroll
        for (int s2 = 0; s2 < 2; ++s2) {
          u32x4 pk;
          pk[0] = cvtpk(s[qt][2 * s2][0], s[qt][2 * s2][1]);
          pk[1] = cvtpk(s[qt][2 * s2][2], s[qt][2 * s2][3]);
          pk[2] = cvtpk(s[qt][2 * s2 + 1][0], s[qt][2 * s2 + 1][1]);
          pk[3] = cvtpk(s[qt][2 * s2 + 1][2], s[qt][2 * s2 + 1][3]);
          pf[qt][s2] = __builtin_bit_cast(bf16x8, pk);
        }
      }
#pragma unroll
      for (int dt = 0; dt < 8; ++dt) {
#pragma unroll
        for (int s2 = 0; s2 < 2; ++s2) {
          const u16* vp = sV + (dt * 16 + fr) * VSTR + fq * 4;
          u32x2 v0 = *(const u32x2*)(vp + (2 * s2) * 16);
          u32x2 v1 = *(const u32x2*)(vp + (2 * s2 + 1) * 16);
          u32x4 vv = {v0[0], v0[1], v1[0], v1[1]};
          bf16x8 vf = __builtin_bit_cast(bf16x8, vv);
          o[0][dt] = __builtin_amdgcn_mfma_f32_16x16x32_bf16(vf, pf[0][s2], o[0][dt], 0, 0, 0);
          o[1][dt] = __builtin_amdgcn_mfma_f32_16x16x32_bf16(vf, pf[1][s2], o[1][dt], 0, 0, 0);
        }
      }
    }
  }
  if (active) {
#pragma unroll
    for (int qt = 0; qt < 2; ++qt) {
      const int qr = wq0 + qt * 16 + fr;
      if (qr < nq) {
        const float inv = 1.f / lrow[qt];
        const size_t row = (size_t)(q0 + qr);
#pragma unroll
        for (int dt = 0; dt < 8; ++dt) {
          const size_t off = row * 2048 + h * 128 + dt * 16 + fq * 4;
          u32x2 ga = *(const u32x2*)(p.GA + off);
          u32x2 r;
          if (MODE == 0) {
            u32x2 gb = *(const u32x2*)(p.GB + off);
            r[0] = cvtpk(bflo(gb[0]) * o[qt][dt][0] * inv + bflo(ga[0]), bfhi(gb[0]) * o[qt][dt][1] * inv + bfhi(ga[0]));
            r[1] = cvtpk(bflo(gb[1]) * o[qt][dt][2] * inv + bflo(ga[1]), bfhi(gb[1]) * o[qt][dt][3] * inv + bfhi(ga[1]));
          } else {
            r[0] = cvtpk(bflo(ga[0]) * o[qt][dt][0] * inv, bfhi(ga[0]) * o[qt][dt][1] * inv);
            r[1] = cvtpk(bflo(ga[1]) * o[qt][dt][2] * inv, bfhi(ga[1]) * o[qt][dt][3] * inv);
          }
          *(u32x2*)(gdst + off) = r;
        }
      }
    }
  }
}

#undef KV_LOAD
#undef KV_STORE
__global__ void __launch_bounds__(NTHREADS) fwd_megakernel(Params p) {
  extern __shared__ __attribute__((aligned(16))) char smem[];
  cg::grid_group grid = cg::this_grid();
#define IDS const int tid = otid(); const int lane = tid & 63, w = tid >> 6; const int bid = blockIdx.x, nb = gridDim.x; \
  const int gw = bid * 8 + w, ngw = nb * 8; (void)tid; (void)lane; (void)gw; (void)ngw; (void)bid; (void)nb;

#if PH & (1 << 0)
  { IDS
  {
    const int vb = tid >> 8;
    float* st = (float*)(smem + vb * VB_LDS);
    const int vbid = bid * 2 + vb, nvb = nb * 2;
    for (int t = vbid; t < 32 * 192; t += nvb) transpose_tile(p.w_in, 2048, INC, p.WT_IN, t, st);
    for (int t = vbid; t < 8 * 48; t += nvb) transpose_tile(p.w_uq, 512, 3072, p.WT_UQ, t, st);
    for (int t = vbid; t < 4 * 32; t += nvb) transpose_tile(p.w_uk, 256, 2048, p.WT_UK, t, st);
    for (int t = vbid; t < 4 * 32; t += nvb) transpose_tile(p.w_uv, 256, 2048, p.WT_UV, t, st);
    for (int t = vbid; t < 32 * 32; t += nvb) transpose_tile(p.w_out, 2048, 2048, p.WT_OUT, t, st);
    for (int t = vbid; t < 32 * 128; t += nvb) transpose_tile(p.w_up, 2048, 8192, p.WT_UP, t, st);
    for (int t = vbid; t < 128 * 32; t += nvb) transpose_tile(p.w_down, 8192, 2048, p.WT_DOWN, t, st);
    for (int r = gw; r < MT; r += ngw) {
      const float* x = r < MP ? p.x_p + (size_t)r * 2048 : p.x_s + (size_t)(r - MP) * 2048;
      rms_row_2048(x, p.g_mix, p.H + (size_t)r * 2048, lane);
    }
    const int gt = bid * NTHREADS + tid, ngt = nb * NTHREADS;
    for (int i = gt; i < 16 * 1024 * 64 / 4; i += ngt) {
      int e = i * 4; int b = e >> 16; int rem = e & 65535; int s = rem >> 6, c = rem & 63;
      size_t dst = (size_t)(MP + b * SK + s) * 64 + c;
      f32x4 a = *(const f32x4*)(p.c_idx + e), k = *(const f32x4*)(p.c_kr + e);
      u32x2 o; o[0] = cvtpk(a[0], a[1]); o[1] = cvtpk(a[2], a[3]);
      *(u32x2*)(p.IXK + dst) = o;
      o[0] = cvtpk(k[0], k[1]); o[1] = cvtpk(k[2], k[3]);
      *(u32x2*)(p.KR + dst) = o;
    }
    for (int i = gt; i < 16 * 1024 * 256 / 4; i += ngt) {
      int e = i * 4; int b = e >> 18; int rem = e & 262143; int s = rem >> 8, c = rem & 255;
      size_t dst = (size_t)(MP + b * SK + s) * 256 + c;
      f32x4 a = *(const f32x4*)(p.c_ckv + e);
      u32x2 o; o[0] = cvtpk(a[0], a[1]); o[1] = cvtpk(a[2], a[3]);
      *(u32x2*)(p.CKV + dst) = o;
    }
  }
  }
#endif
  grid.sync();
#if PH & (1 << 1)
  { IDS
  for (int rep = 0; rep < NREP(1); ++rep) gemm_phase<EPI_IN>(p, p.H, 2048, p.WT_IN, 2048, 2048, MT / 256, INP / 256, smem, nullptr, 0, bid, nb);
  }
#endif
  grid.sync();
#if PH & (1 << 2)
  { IDS
  for (int t = gw; t < MT; t += ngw) post_row(p, t, lane);
  {
    const int vb = tid >> 8, vbid = bid * 2 + vb;
    char* sm = smem + vb * VB_LDS;
    for (int rep = 0; rep < NREP(2); ++rep) for (int t = vbid * NQ; t < MT; t += nb * 2 * NQ)
      topk_group(p, t, sm, (unsigned*)(p.out + O_Y + 14000000) + (size_t)vbid * 16384, (unsigned*)(p.out + O_Y + 14000000) + (size_t)(512 + vbid) * 16384,
                 (unsigned*)p.H + (size_t)vbid * 16384);
  }
  }
#endif
  grid.sync();
#if PH & (1 << 3)
  { IDS
    const int total = 1024 + 256;
    for (int rep = 0; rep < NREP(3); ++rep) {
      u16* gdst = (rep + 1 < NREP(3)) ? (u16*)(p.out + O_Y) : p.GA;
      for (int r = 0;; ++r) {
        int id = (r & 1) ? r * nb + (nb - 1 - bid) : r * nb + bid;
        if (r * nb >= total) break;
        if (id < total) attn_item<1>(p, id, smem, gdst);
      }
    }
  }
#endif
  grid.sync();
#if PH & (1 << 4)
  { IDS
  {
    const int gt = bid * NTHREADS + tid, ngt = nb * NTHREADS;
    for (int i = gt; i < MS * 2048 / 4; i += ngt)
      *(f32x4*)(p.out + O_Y + (size_t)MP * 2048 + (size_t)i * 4) = *(const f32x4*)(p.x_s + (size_t)i * 4);
    for (int i = gt; i < 16 * 2048 * 6; i += ngt) {
      int r = i / 6, c = i - r * 6;
      *(u32x4*)(p.VBT_S + (size_t)r * VSS + SK + c * 8) = (u32x4){0u, 0u, 0u, 0u};
    }
    const int nqb = (MT / 256) * 12, nkb = (KROWS / 256) * 8;
    const int total = nqb + 2 * nkb;
    for (int id = bid; id < total; id += nb) {
      if (id < nqb) gemm_phase<EPI_QB>(p, p.CQ, 512, p.WT_UQ, 512, 512, MT / 256, 12, smem, p.QB, 3072, id, 1 << 30);
      else if (id < nqb + nkb) gemm_phase<EPI_BF16>(p, p.CKV, 256, p.WT_UK, 256, 256, KROWS / 256, 8, smem, p.KB, 2048, id - nqb, 1 << 30);
      else gemm_phase<EPI_VT>(p, p.CKV, 256, p.WT_UV, 256, 256, KROWS / 256, 8, smem, nullptr, 0, id - nqb - nkb, 1 << 30);
    }
  }
  }
#endif
  grid.sync();
#if PH & (1 << 5)
  { IDS
  {
    const int total = 1024 + 256;
    for (int rep = 0; rep < NREP(5); ++rep) {
      u16* gdst = (rep + 1 < NREP(5)) ? (u16*)(p.out + O_Y) : p.GB;
      for (int r = 0;; ++r) {
        int id = (r & 1) ? r * nb + (nb - 1 - bid) : r * nb + bid;
        if (r * nb >= total) break;
        if (id < total) attn_item<0>(p, id, smem, gdst);
      }
    }
  }
  }
#endif
  grid.sync();
#if PH & (1 << 6)
  { IDS
  gemm_phase<EPI_RES>(p, p.GB, 2048, p.WT_OUT, 2048, 2048, MT / 256 - 1, 8, smem, nullptr, 0, bid, nb);
  for (int id = bid; id < 128; id += nb) {
    const int nt = id & 7, kc = id >> 3;
    gemm_tile<EPI_ATOM>(p, p.GB + kc * 128, 2048, p.WT_OUT + kc * 128, 2048, 128, (MT / 256 - 1) * 256, nt * 256, smem, nullptr, 0);
  }
  }
#endif
  grid.sync();
#if PH & (1 << 7)
  { IDS
  for (int r = gw; r < MT; r += ngw) rms_row_2048(p.out + O_Y + (size_t)r * 2048, p.g_ffn, p.H2 + (size_t)r * 2048, lane);
  }
#endif
  grid.sync();
#if PH & (1 << 8)
  { IDS
  gemm_phase<EPI_RELU2>(p, p.H2, 2048, p.WT_UP, 2048, 2048, MT / 256, 32, smem, nullptr, 0, bid, nb);
  }
#endif
  grid.sync();
#if PH & (1 << 9)
  { IDS
  gemm_phase<EPI_ACC>(p, p.U, DFF, p.WT_DOWN, DFF, DFF, MT / 256 - 1, 8, smem, nullptr, 0, bid, nb);
  for (int id = bid; id < 256; id += nb) {
    const int nt = id & 7, kc = id >> 3;
    gemm_tile<EPI_ATOM>(p, p.U + kc * 256, DFF, p.WT_DOWN + kc * 256, DFF, 256, (MT / 256 - 1) * 256, nt * 256, smem, nullptr, 0);
  }
  }
#endif
  grid.sync();
#if PH & (1 << 10)
  { IDS
  for (int r = gw; r < MT; r += ngw) {
    float* x = p.out + O_Y + (size_t)r * 2048;
    f32x4 v[8];
    float ss = 0.f;
#pragma unroll
    for (int i = 0; i < 8; ++i) {
      v[i] = *(const f32x4*)(x + i * 256 + lane * 4);
      ss += v[i][0] * v[i][0] + v[i][1] * v[i][1] + v[i][2] * v[i][2] + v[i][3] * v[i][3];
    }
    ss = wave_sum(ss);
    float rr = rsqrtf(ss * (1.f / 2048.f) + 1e-6f);
#pragma unroll
    for (int i = 0; i < 8; ++i) {
      f32x4 gg = *(const f32x4*)(p.g_fin + i * 256 + lane * 4);
      f32x4 o = {v[i][0] * rr * gg[0], v[i][1] * rr * gg[1], v[i][2] * rr * gg[2], v[i][3] * rr * gg[3]};
      *(f32x4*)(x + i * 256 + lane * 4) = o;
    }
  }
  }
#endif
}

extern "C" void kernel_launch(void* const* d_in, const int* in_sizes, int n_in, void* d_out, int out_size, void* d_ws, size_t ws_size,
                              hipStream_t stream) {
  static int grid_blocks = 0;
  if (!grid_blocks) {
    int dev = 0, cus = 0, per_cu = 0;
    hipGetDevice(&dev);
    hipDeviceGetAttribute(&cus, hipDeviceAttributeMultiprocessorCount, dev);
    if (hipFuncSetAttribute((const void*)fwd_megakernel, hipFuncAttributeMaxDynamicSharedMemorySize, LDS_BYTES) != hipSuccess)
      fprintf(stderr, "kernel_launch: hipFuncSetAttribute failed\n");
    hipOccupancyMaxActiveBlocksPerMultiprocessor(&per_cu, (const void*)fwd_megakernel, NTHREADS, LDS_BYTES);
    if (per_cu < 1) per_cu = 1;
    if (per_cu > 1) per_cu = 1;
    grid_blocks = cus * per_cu;
  }
  Params p{};
  const float* const* in = (const float* const*)d_in;
  p.x_p = in[0]; p.x_s = in[1]; p.c_ak = in[2]; p.c_av = in[3]; p.c_idx = in[4]; p.c_ckv = in[5]; p.c_kr = in[6]; p.rel = in[7];
  p.g_mix = in[8]; p.w_in = in[9]; p.g_q = in[10]; p.w_uq = in[11]; p.g_kv = in[12]; p.w_uk = in[13]; p.w_uv = in[14]; p.w_out = in[15];
  p.g_ffn = in[16]; p.w_up = in[17]; p.w_down = in[18]; p.g_fin = in[19];
  p.out = (float*)d_out;
  char* ws = (char*)d_ws;
  size_t off = 0;
  auto alloc = [&](size_t bytes) { char* r = ws + off; off += (bytes + 255) & ~(size_t)255; return r; };
  p.WT_UQ = (u16*)alloc((size_t)3072 * 512 * 2);
  p.WT_UK = (u16*)alloc((size_t)2048 * 256 * 2);
  p.WT_UV = (u16*)alloc((size_t)2048 * 256 * 2);
  p.WT_OUT = (u16*)alloc((size_t)2048 * 2048 * 2);
  p.WT_UP = (u16*)alloc((size_t)8192 * 2048 * 2);
  p.WT_DOWN = (u16*)alloc((size_t)2048 * 8192 * 2);
  p.CQ = (u16*)alloc((size_t)MT * 512 * 2);
  p.CKV = (u16*)alloc((size_t)KROWS * 256 * 2);
  p.KR = (u16*)alloc((size_t)KROWS * 64 * 2);
  p.GA = (u16*)alloc((size_t)MT * 2048 * 2);
  p.GB = (u16*)alloc((size_t)MT * 2048 * 2);
  p.CS = (float*)alloc((size_t)MT * 32 * 4);
  p.SN = (float*)alloc((size_t)MT * 32 * 4);
  const size_t ubase = off;
  p.WT_IN = (u16*)alloc((size_t)INP * 2048 * 2);
  p.H = (u16*)alloc((size_t)MT * 2048 * 2);
  p.AQ = (u16*)alloc((size_t)MT * 2048 * 2);
  p.KA = (u16*)alloc((size_t)MP * 2048 * 2);
  p.VAT = (u16*)alloc((size_t)MP * 2048 * 2);
  p.IXQ = (u16*)alloc((size_t)MT * 1024 * 2);
  p.IXK = (u16*)alloc((size_t)KROWS * 64 * 2);
  p.SEL = (unsigned long long*)alloc((size_t)MT * 256 * 8);
  p.IXW = (float*)alloc((size_t)MT * 16 * 4);
  const size_t endA = off;
  off = ubase;
  p.QB = (u16*)alloc((size_t)MT * 3072 * 2);
  p.KB = (u16*)alloc((size_t)KROWS * 2048 * 2);
  p.VBT_P = (u16*)alloc((size_t)2048 * MP * 2);
  p.VBT_S = (u16*)alloc((size_t)16 * 2048 * VSS * 2);
  const size_t endB = off;
  off = ubase;
  p.H2 = (u16*)alloc((size_t)MT * 2048 * 2);
  p.U = (u16*)alloc((size_t)MT * DFF * 2);
  const size_t endC = off;
  size_t need = endA > endB ? endA : endB;
  if (endC > need) need = endC;
  if (need > ws_size) { fprintf(stderr, "kernel_launch: workspace too small: need %zu have %zu\n", need, ws_size); return; }
  void* args[] = {&p};
  hipError_t e = hipLaunchCooperativeKernel((const void*)fwd_megakernel, dim3(grid_blocks), dim3(NTHREADS), args, LDS_BYTES, stream);
  if (e != hipSuccess) fprintf(stderr, "cooperative launch failed: %s (grid %d)\n", hipGetErrorString(e), grid_blocks);
}
```

```cpp
#include <hip/hip_runtime.h>
#include <hip/hip_cooperative_groups.h>
#include <cstdio>
#include <cstdint>
namespace cg = cooperative_groups;

typedef unsigned short u16;
typedef __attribute__((ext_vector_type(8))) short bf16x8;
typedef __attribute__((ext_vector_type(4))) short bf16x4;
typedef __attribute__((ext_vector_type(4))) float f32x4;
typedef __attribute__((ext_vector_type(2))) float f32x2;
typedef __attribute__((ext_vector_type(2))) __bf16 bf16x2_t;
typedef __attribute__((ext_vector_type(4))) unsigned u32x4;
typedef __attribute__((ext_vector_type(2))) unsigned u32x2;

#define DI __device__ __forceinline__

constexpr int MP = 16384;
constexpr int MS = 256;
constexpr int MT = MP + MS;
constexpr int DM = 2048;
constexpr int INC = 12176;
constexpr int INP = 12288;
constexpr int SK = 1040;
constexpr int KROWS = MP + 16 * SK;
constexpr int VSS = 1088;
constexpr int DFF = 8192;
constexpr int ZRW = 832;
#ifndef PH
#define PH 0x7ff
#endif
#ifndef REP
#define REP 0
#endif
#define NREP(k) (((REP >> (k)) & 1) + 1)
constexpr int NTHREADS = 512;
constexpr int VB_LDS = 75776;
constexpr int LDS_BYTES = 2 * VB_LDS;

constexpr size_t O_Y = 0;
constexpr size_t O_AKP = 34078720;
constexpr size_t O_AVP = 67633152;
constexpr size_t O_IDXP = 101187584;
constexpr size_t O_CKVP = 102236160;
constexpr size_t O_KRP = 106430464;
constexpr size_t O_AKS = 107479040;
constexpr size_t O_AVS = 108003328;
constexpr size_t O_IDXS = 108527616;
constexpr size_t O_CKVS = 108544000;
constexpr size_t O_KRS = 108609536;

struct Params {
  const float *x_p, *x_s, *c_ak, *c_av, *c_idx, *c_ckv, *c_kr, *rel, *g_mix, *w_in, *g_q, *w_uq, *g_kv, *w_uk, *w_uv, *w_out, *g_ffn, *w_up, *w_down, *g_fin;
  float* out;
  u16 *WT_UQ, *WT_UK, *WT_UV, *WT_OUT, *WT_UP, *WT_DOWN, *CQ, *CKV, *KR, *GA, *GB;
  float *CS, *SN;
  u16 *WT_IN, *H, *AQ, *KA, *VAT, *IXQ, *IXK;
  float* IXW;
  unsigned long long* SEL;
  u16 *QB, *KB, *VBT_P, *VBT_S;
  u16 *H2, *U;
};

DI int otid() { int t = threadIdx.x; asm volatile("" : "+v"(t)); return t; }
DI unsigned cvtpk(float lo, float hi) {
  f32x2 v = {lo, hi};
  bf16x2_t b = __builtin_convertvector(v, bf16x2_t);
  return __builtin_bit_cast(unsigned, b);
}
DI u16 f2bf(float x) { return (u16)(cvtpk(x, 0.f) & 0xffffu); }
DI float bf2f(u16 b) { return __uint_as_float(((unsigned)b) << 16); }
DI float bflo(unsigned w) { return __uint_as_float(w << 16); }
DI float bfhi(unsigned w) { return __uint_as_float(w & 0xffff0000u); }
DI float dot2bf(unsigned a, unsigned b, float c) {
  return __builtin_amdgcn_fdot2_f32_bf16(__builtin_bit_cast(bf16x2_t, a), __builtin_bit_cast(bf16x2_t, b), c, false);
}
DI float wave_sum(float v) {
#pragma unroll
  for (int o = 32; o > 0; o >>= 1) v += __shfl_xor(v, o);
  return v;
}
DI int qpos_of(int t) { return t < MP ? t : 1024 + ((t - MP) & 15); }
DI int krow_of(int t) { return t < MP ? t : MP + ((t - MP) >> 4) * SK + 1024 + ((t - MP) & 15); }
DI float inv_freq(int i) { return exp2f(-(float)i * 0.41524101186092029f); }

DI void transpose_tile(const float* __restrict__ W, int K, int N, u16* __restrict__ Wt, int tile, float* s  ) {
  const int nkt = K >> 6;
  const int kt = tile % nkt, nt = tile / nkt;
  const int k0 = kt << 6, n0 = nt << 6;
  const int tid = otid() & 255;
  const int c = tid & 63, r0 = tid >> 6;
  __syncthreads();
#pragma unroll
  for (int i = 0; i < 16; ++i) {
    int r = i * 4 + r0;
    float v = (n0 + c < N) ? W[(size_t)(k0 + r) * N + n0 + c] : 0.f;
    s[r * 65 + c] = v;
  }
  __syncthreads();
  const int kp = (tid & 31) * 2, rr0 = tid >> 5;
#pragma unroll
  for (int i = 0; i < 8; ++i) {
    int rr = i * 8 + rr0;
    unsigned pk = cvtpk(s[kp * 65 + rr], s[(kp + 1) * 65 + rr]);
    *(unsigned*)(Wt + (size_t)(n0 + rr) * K + k0 + kp) = pk;
  }
}

DI void rms_row_2048(const float* __restrict__ x, const float* __restrict__ g, u16* __restrict__ out, int lane) {
  f32x4 v[8];
  float ss = 0.f;
#pragma unroll
  for (int i = 0; i < 8; ++i) {
    v[i] = *(const f32x4*)(x + i * 256 + lane * 4);
    ss += v[i][0] * v[i][0] + v[i][1] * v[i][1] + v[i][2] * v[i][2] + v[i][3] * v[i][3];
  }
  ss = wave_sum(ss);
  float r = rsqrtf(ss * (1.f / 2048.f) + 1e-6f);
#pragma unroll
  for (int i = 0; i < 8; ++i) {
    f32x4 gg = *(const f32x4*)(g + i * 256 + lane * 4);
    u32x2 o;
    o[0] = cvtpk(v[i][0] * r * gg[0], v[i][1] * r * gg[1]);
    o[1] = cvtpk(v[i][2] * r * gg[2], v[i][3] * r * gg[3]);
    *(u32x2*)(out + i * 256 + lane * 4) = o;
  }
}

enum { EPI_IN = 0, EPI_QB, EPI_BF16, EPI_VT, EPI_RES, EPI_RELU2, EPI_ACC, EPI_ATOM };
constexpr float QSC = 0.07216878364870322f * 1.4426950408889634f;
constexpr int LSTR = 72;
#ifndef PFA
#define PFA 8
#endif

template <int EPI>
DI void gemm_epilogue(const Params& p, f32x4 (&acc)[8][4], int m0, int n0, int wr, int wc, int fr, int fq, u16* Cb, int ldc) {
  const int cw = n0 + wc * 64;
#pragma clang loop unroll(full)
  for (int m = 0; m < 8; ++m) {
    const int rb = m0 + wr * 128 + m * 16 + fq * 4;
    if (EPI == EPI_QB) {
      const int within = cw % 192;
      if (within == 128) {
#pragma clang loop unroll(full)
        for (int n = 0; n < 2; ++n) {
          const int i = n * 16 + fr;
#pragma clang loop unroll(full)
          for (int j = 0; j < 4; ++j) {
            const int row = rb + j;
            const float cs = p.CS[(size_t)row * 32 + i], sn = p.SN[(size_t)row * 32 + i];
            float x1 = acc[m][n][j] * QSC, x2 = acc[m][n + 2][j] * QSC;
            p.QB[(size_t)row * 3072 + cw + i] = f2bf(x1 * cs - x2 * sn);
            p.QB[(size_t)row * 3072 + cw + i + 32] = f2bf(x1 * sn + x2 * cs);
          }
        }
        continue;
      }
    }
#pragma clang loop unroll(full)
    for (int n = 0; n < 4; ++n) {
      const int colt = cw + n * 16;
      const int col = colt + fr;
      if (EPI == EPI_IN) {
        if (colt >= 4096 && colt < 6144 && rb < MP) {
          u32x2 pk;
          pk[0] = cvtpk(acc[m][n][0], acc[m][n][1]);
          pk[1] = cvtpk(acc[m][n][2], acc[m][n][3]);
          *(u32x2*)(p.VAT + (size_t)(col - 4096) * MP + rb) = pk;
        }
      }
      if (EPI == EPI_VT) {
        u32x2 pk;
        pk[0] = cvtpk(acc[m][n][0], acc[m][n][1]);
        pk[1] = cvtpk(acc[m][n][2], acc[m][n][3]);
        u16* dst;
        if (rb < MP) dst = p.VBT_P + (size_t)col * MP + rb;
        else { int r2 = rb - MP; int b = r2 / SK; int s = r2 - b * SK; dst = p.VBT_S + ((size_t)b * 2048 + col) * VSS + s; }
        *(u32x2*)dst = pk;
        continue;
      }
#pragma clang loop unroll(full)
      for (int j = 0; j < 4; ++j) {
        const int row = rb + j;
        const float v = acc[m][n][j];
        if (EPI == EPI_IN) {
          if (colt < 2048) p.AQ[(size_t)row * 2048 + col] = f2bf(v * (0.08838834764831845f * 1.4426950408889634f));
          else if (colt < 4096) {
            int c = col - 2048;
            if (row < MP) { p.out[O_AKP + (size_t)row * 2048 + c] = v; p.KA[(size_t)row * 2048 + c] = f2bf(v); }
            else p.out[O_AKS + (size_t)(row - MP) * 2048 + c] = v;
          } else if (colt < 6144) {
            int c = col - 4096;
            if (row < MP) p.out[O_AVP + (size_t)row * 2048 + c] = v;
            else p.out[O_AVS + (size_t)(row - MP) * 2048 + c] = v;
          } else if (colt < 7168) p.IXQ[(size_t)row * 1024 + (col - 6144)] = f2bf(v);
          else if (colt < 7232) {
            int c = col - 7168;
            if (row < MP) p.out[O_IDXP + (size_t)row * 64 + c] = v; else p.out[O_IDXS + (size_t)(row - MP) * 64 + c] = v;
            p.IXK[(size_t)krow_of(row) * 64 + c] = f2bf(v);
          } else if (colt < 7248) p.IXW[(size_t)row * 16 + (col - 7232)] = v * 0.25f;
          else if (colt < 8080) p.out[O_Y + (size_t)row * ZRW + (col - 7248)] = v;
          else if (colt < 10128) p.GA[(size_t)row * 2048 + (col - 8080)] = f2bf(1.f / (1.f + __expf(-v)));
          else if (colt < INC) p.GB[(size_t)row * 2048 + (col - 10128)] = f2bf(1.f / (1.f + __expf(-v)));
        } else if (EPI == EPI_QB) {
          Cb[(size_t)row * ldc + col] = f2bf(v * QSC);
        } else if (EPI == EPI_BF16) {
          Cb[(size_t)row * ldc + col] = f2bf(v);
        } else if (EPI == EPI_RES) {
          float xv = row < MP ? p.x_p[(size_t)row * 2048 + col] : p.x_s[(size_t)(row - MP) * 2048 + col];
          p.out[O_Y + (size_t)row * 2048 + col] = xv + v;
        } else if (EPI == EPI_RELU2) {
          float r = fmaxf(v, 0.f);
          p.U[(size_t)row * DFF + col] = f2bf(r * r);
        } else if (EPI == EPI_ACC) {
          p.out[O_Y + (size_t)row * 2048 + col] += v;
        } else if (EPI == EPI_ATOM) {
          atomicAdd(&p.out[O_Y + (size_t)row * 2048 + col], v);
        }
      }
    }
  }
}

constexpr int GSTAGE = 512 * LSTR;
template <int EPI>
DI void gemm_tile(const Params& p, const u16* __restrict__ A, int lda, const u16* __restrict__ Bt, int ldb, int K, int m0, int n0,
                  char* smem, u16* Cb, int ldc) {
  u16* sbase = (u16*)smem;
  const int tid = otid(), lane = tid & 63, w = tid >> 6;
  const int wr = w >> 2, wc = w & 3, fr = lane & 15, fq = lane >> 4;
  f32x4 acc[8][4];
#pragma unroll
  for (int m = 0; m < 8; ++m)
#pragma unroll
    for (int n = 0; n < 4; ++n) acc[m][n] = (f32x4){0.f, 0.f, 0.f, 0.f};
  const int lr = tid >> 3, lk = (tid & 7) * 8;
  const u16* Ag = A + (size_t)(m0 + lr) * lda + lk;
  const u16* Bg = Bt + (size_t)(n0 + lr) * ldb + lk;
  const int nk = K >> 6;
  u32x4 ra[4], rb[4];
#define G_LOAD(T) { const int k_ = (T) << 6; _Pragma("unroll") for (int i = 0; i < 4; ++i) { \
    ra[i] = *(const u32x4*)(Ag + (size_t)(i * 64) * lda + k_); rb[i] = *(const u32x4*)(Bg + (size_t)(i * 64) * ldb + k_); } }
#define L_STORE(ST) { u16* dA_ = sbase + (ST) * GSTAGE + lr * LSTR + lk; u16* dB_ = dA_ + 256 * LSTR; _Pragma("unroll") for (int i = 0; i < 4; ++i) { \
    *(u32x4*)(dA_ + i * 64 * LSTR) = ra[i]; *(u32x4*)(dB_ + i * 64 * LSTR) = rb[i]; } }
  G_LOAD(0)
  L_STORE(0)
  G_LOAD(1)
#pragma unroll 1
  for (int kt = 0; kt < nk; ++kt) {
    __syncthreads();
    if (kt + 1 < nk) L_STORE((kt + 1) & 1)
    G_LOAD(min(kt + 2, nk - 1))
    const u16* cA = sbase + (kt & 1) * GSTAGE + (wr * 128 + fr) * LSTR + fq * 8;
    const u16* cB = sbase + (kt & 1) * GSTAGE + 256 * LSTR + (wc * 64 + fr) * LSTR + fq * 8;
#pragma unroll
    for (int ks = 0; ks < 2; ++ks) {
      bf16x8 bfr[4];
#pragma unroll
      for (int n = 0; n < 4; ++n) bfr[n] = *(const bf16x8*)(cB + n * 16 * LSTR + ks * 32);
#pragma unroll
      for (int mh = 0; mh < 2; ++mh) {
        bf16x8 af[4];
#pragma unroll
        for (int m = 0; m < 4; ++m) af[m] = *(const bf16x8*)(cA + (mh * 4 + m) * 16 * LSTR + ks * 32);
        __builtin_amdgcn_s_setprio(1);
#pragma unroll
        for (int m = 0; m < 4; ++m)
#pragma unroll
          for (int n = 0; n < 4; ++n)
            acc[mh * 4 + m][n] = __builtin_amdgcn_mfma_f32_16x16x32_bf16(af[m], bfr[n], acc[mh * 4 + m][n], 0, 0, 0);
        __builtin_amdgcn_s_setprio(0);
      }
    }
  }
#undef G_LOAD
#undef L_STORE
  gemm_epilogue<EPI>(p, acc, m0, n0, wr, wc, fr, fq, Cb, ldc);
}

template <int EPI>
DI void gemm_phase(const Params& p, const u16* A, int lda, const u16* Bt, int ldb, int K, int mtiles, int ntiles, char* smem, u16* Cb, int ldc,
                   int start, int stride) {
  const int total = mtiles * ntiles;
  const int GM = 8;
  for (int id = start; id < total; id += stride) {
    const int per = GM * ntiles;
    const int g = id / per, rem = id - g * per;
    const int fm = g * GM;
    const int gsz = min(GM, mtiles - fm);
    const int mt = fm + rem % gsz, nt = rem / gsz;
    gemm_tile<EPI>(p, A, lda, Bt, ldb, K, mt * 256, nt * 256, smem, Cb, ldc);
  }
}

DI void post_row(const Params& p, int t, int lane) {
  const float* zr = p.out + O_Y + (size_t)t * ZRW;
  {
    f32x4 a = *(const f32x4*)(zr + lane * 4), b = *(const f32x4*)(zr + 256 + lane * 4);
    float ss = a[0] * a[0] + a[1] * a[1] + a[2] * a[2] + a[3] * a[3] + b[0] * b[0] + b[1] * b[1] + b[2] * b[2] + b[3] * b[3];
    ss = wave_sum(ss);
    float r = rsqrtf(ss * (1.f / 512.f) + 1e-6f);
    f32x4 ga = *(const f32x4*)(p.g_q + lane * 4), gb = *(const f32x4*)(p.g_q + 256 + lane * 4);
    u32x2 o;
    o[0] = cvtpk(a[0] * r * ga[0], a[1] * r * ga[1]); o[1] = cvtpk(a[2] * r * ga[2], a[3] * r * ga[3]);
    *(u32x2*)(p.CQ + (size_t)t * 512 + lane * 4) = o;
    o[0] = cvtpk(b[0] * r * gb[0], b[1] * r * gb[1]); o[1] = cvtpk(b[2] * r * gb[2], b[3] * r * gb[3]);
    *(u32x2*)(p.CQ + (size_t)t * 512 + 256 + lane * 4) = o;
  }
  const int kr_row = krow_of(t);
  {
    f32x4 a = *(const f32x4*)(zr + 512 + lane * 4);
    float ss = a[0] * a[0] + a[1] * a[1] + a[2] * a[2] + a[3] * a[3];
    ss = wave_sum(ss);
    float r = rsqrtf(ss * (1.f / 256.f) + 1e-6f);
    f32x4 g = *(const f32x4*)(p.g_kv + lane * 4);
    f32x4 o = {a[0] * r * g[0], a[1] * r * g[1], a[2] * r * g[2], a[3] * r * g[3]};
    float* od = t < MP ? p.out + O_CKVP + (size_t)t * 256 : p.out + O_CKVS + (size_t)(t - MP) * 256;
    *(f32x4*)(od + lane * 4) = o;
    u32x2 ob; ob[0] = cvtpk(o[0], o[1]); ob[1] = cvtpk(o[2], o[3]);
    *(u32x2*)(p.CKV + (size_t)kr_row * 256 + lane * 4) = ob;
  }
  if (lane < 32) {
    float x1 = zr[768 + lane], x2 = zr[768 + 32 + lane];
    float ang = (float)qpos_of(t) * inv_freq(lane);
    float cs = cosf(ang), sn = sinf(ang);
    p.CS[(size_t)t * 32 + lane] = cs; p.SN[(size_t)t * 32 + lane] = sn;
    float o1 = x1 * cs - x2 * sn, o2 = x1 * sn + x2 * cs;
    float* od = t < MP ? p.out + O_KRP + (size_t)t * 64 : p.out + O_KRS + (size_t)(t - MP) * 64;
    od[lane] = o1; od[lane + 32] = o2;
    p.KR[(size_t)kr_row * 64 + lane] = f2bf(o1);
    p.KR[(size_t)kr_row * 64 + lane + 32] = f2bf(o2);
  }
}

template <int CTRL> DI float dpp_add(float v) {
  int sft = __builtin_amdgcn_update_dpp(0, __float_as_int(v), CTRL, 0xf, 0xf, true);
  return v + __int_as_float(sft);
}
DI float row16_sum(float v) { v = dpp_add<0x111>(v); v = dpp_add<0x112>(v); v = dpp_add<0x114>(v); v = dpp_add<0x118>(v); return v; }
DI unsigned fkey(float f) { unsigned u = __float_as_uint(f); return (u & 0x80000000u) ? ~u : (u | 0x80000000u); }

DI void radix_select(unsigned* sc, int* hist, int* misc, int n, unsigned long long* sel, int tid, int lane, int w) {
  __syncthreads();
  unsigned prefix = 0;
  int remaining = 256;
#pragma unroll 1
  for (int pass = 0; pass < 3; ++pass) {
    const int shift = pass == 0 ? 21 : (pass == 1 ? 10 : 0);
    const int bits = pass == 2 ? 10 : 11;
    const unsigned bmask = (1u << bits) - 1u;
    if (pass > 0) {
      *(int4*)&hist[tid * 8] = make_int4(0, 0, 0, 0);
      *(int4*)&hist[tid * 8 + 4] = make_int4(0, 0, 0, 0);
      __syncthreads();
      const int hs = shift + bits;
      const unsigned want = prefix >> hs;
      for (int i = tid * 4; i < n; i += 256 * 4) {
        const u32x4 u4 = *(const u32x4*)(sc + i);
#pragma unroll
        for (int e = 0; e < 4; ++e)
          if ((u4[e] >> hs) == want) atomicAdd(&hist[(u4[e] >> shift) & bmask], 1);
      }
      __syncthreads();
    }
    const int4 h0 = *(const int4*)&hist[tid * 8], h1 = *(const int4*)&hist[tid * 8 + 4];
    const int s8 = h0.x + h0.y + h0.z + h0.w + h1.x + h1.y + h1.z + h1.w;
    int suf = s8;
#pragma unroll
    for (int d = 1; d < 64; d <<= 1) { int v = __shfl_down(suf, d); if (lane + d < 64) suf += v; }
    if (lane == 0) misc[w] = suf;
    __syncthreads();
    int above = 0;
    for (int ww = w + 1; ww < 4; ++ww) above += misc[ww];
    const int excl = above + suf - s8;
    if (excl < remaining && remaining <= excl + s8) {
      int c = excl, bin = 0, nrem = 0;
#define TK_STEP(val, idx) if (c < remaining && remaining <= c + (val)) { bin = tid * 8 + (idx); nrem = remaining - c; } c += (val);
      TK_STEP(h1.w, 7) TK_STEP(h1.z, 6) TK_STEP(h1.y, 5) TK_STEP(h1.x, 4) TK_STEP(h0.w, 3) TK_STEP(h0.z, 2) TK_STEP(h0.y, 1) TK_STEP(h0.x, 0)
#undef TK_STEP
      misc[4] = bin; misc[5] = nrem;
    }
    __syncthreads();
    prefix |= ((unsigned)misc[4]) << shift;
    remaining = misc[5];
    __syncthreads();
  }
  const unsigned T = prefix;
  const int seg = ((n + 255) >> 8) << 6;
  const int beg = w * seg;
  int ceq = 0;
  for (int i = beg + lane; i < beg + seg; i += 64) {
    bool in = i < n; unsigned u = in ? sc[i] : 0u;
    ceq += __popcll(__ballot(in && u == T));
  }
  if (lane == 0) misc[12 + w] = ceq;
  __syncthreads();
  int oe = 0;
  for (int ww = 0; ww < w; ++ww) oe += misc[12 + ww];
  const unsigned long long lt = (1ull << lane) - 1ull;
  for (int i0 = beg; i0 < beg + seg; i0 += 64) {
    const int i = i0 + lane;
    bool in = i < n; unsigned u = in ? sc[i] : 0u;
    bool g = in && u > T, e = in && u == T;
    unsigned long long be = __ballot(e);
    int pe = oe + __popcll(be & lt);
    unsigned long long sm = __ballot(g || (e && pe < remaining));
    if (lane == 0 && i0 < n) sel[i0 >> 6] = sm;
    oe += __popcll(be);
  }
}

constexpr int NQ = 4;
DI void topk_group(const Params& p, int t, char* smem, unsigned* scr1, unsigned* scr2, unsigned* scr3) {
  unsigned* sc = (unsigned*)smem;
  int* hist = (int*)(smem + 65536);
  int* misc = hist + 2048;
  const int tid = otid() & 255, lane = tid & 63, w = tid >> 6, fr = lane & 15, fq = lane >> 4;
  int n; const u16* ixk;
  if (t < MP) { n = 64 * ((t >> 6) + 1); ixk = p.IXK; }
  else { int b = (t - MP) >> 4; n = SK; ixk = p.IXK + (size_t)(MP + b * SK) * 64; }
  unsigned long long* sel = p.SEL + (size_t)t * 256;
  __syncthreads();
  if (n <= 256) {
    if (tid < 4) {
      unsigned long long v = (tid < (n >> 6)) ? ~0ull : 0ull;
#pragma unroll
      for (int qi = 0; qi < NQ; ++qi) sel[qi * 256 + tid] = v;
    }
    return;
  }
  *(int4*)&hist[tid * 8] = make_int4(0, 0, 0, 0);
  *(int4*)&hist[tid * 8 + 4] = make_int4(0, 0, 0, 0);
  __syncthreads();
  {
    const u16* q = p.IXQ + (size_t)t * 1024 + fr * 64 + fq * 8;
    bf16x8 a0[NQ], a1[NQ];
    f32x4 wv[NQ];
#pragma unroll
    for (int qi = 0; qi < NQ; ++qi) {
      a0[qi] = *(const bf16x8*)(q + qi * 1024); a1[qi] = *(const bf16x8*)(q + qi * 1024 + 32);
      wv[qi] = *(const f32x4*)(p.IXW + (size_t)(t + qi) * 16 + fq * 4);
    }
    const int ntile = n >> 4;
    for (int kt0 = w; kt0 < ntile; kt0 += 32) {
      bf16x8 b0[8], b1[8];
#pragma unroll
      for (int g = 0; g < 8; ++g) {
        const int kt = min(kt0 + g * 4, ntile - 1);
        const u16* kp = ixk + (size_t)(kt * 16 + fr) * 64 + fq * 8;
        b0[g] = *(const bf16x8*)kp; b1[g] = *(const bf16x8*)(kp + 32);
      }
      float pt[NQ][8];
#pragma unroll
      for (int g = 0; g < 8; ++g) {
#pragma unroll
        for (int qi = 0; qi < NQ; ++qi) {
          f32x4 c = {0.f, 0.f, 0.f, 0.f};
          c = __builtin_amdgcn_mfma_f32_16x16x32_bf16(a0[qi], b0[g], c, 0, 0, 0);
          c = __builtin_amdgcn_mfma_f32_16x16x32_bf16(a1[qi], b1[g], c, 0, 0, 0);
          pt[qi][g] = fmaxf(c[0], 0.f) * wv[qi][0] + fmaxf(c[1], 0.f) * wv[qi][1] + fmaxf(c[2], 0.f) * wv[qi][2] + fmaxf(c[3], 0.f) * wv[qi][3];
        }
      }
#pragma unroll
      for (int g = 0; g < 8; g += 2) {
        const int kt = kt0 + (g + (lane >> 5)) * 4;
        const bool st = (lane & 16) == 0 && kt < ntile;
#pragma unroll
        for (int qi = 0; qi < NQ; ++qi) {
          auto r32 = __builtin_amdgcn_permlane32_swap(__float_as_uint(pt[qi][g]), __float_as_uint(pt[qi][g + 1]), false, false);
          float s2 = __uint_as_float(r32[0]) + __uint_as_float(r32[1]);
          auto r16 = __builtin_amdgcn_permlane16_swap(__float_as_uint(s2), __float_as_uint(s2), false, false);
          float sv = __uint_as_float(r16[0]) + __uint_as_float(r16[1]);
          if (st) {
            unsigned u = fkey(sv);
            if (qi == 0) { sc[kt * 16 + fr] = u; atomicAdd(&hist[u >> 21], 1); }
            else if (qi == 1) scr1[kt * 16 + fr] = u;
            else if (qi == 2) scr2[kt * 16 + fr] = u;
            else scr3[kt * 16 + fr] = u;
          }
        }
      }
    }
  }
  radix_select(sc, hist, misc, n, sel, tid, lane, w);
#pragma unroll 1
  for (int qi = 1; qi < NQ; ++qi) {
    const unsigned* scr = qi == 1 ? scr1 : (qi == 2 ? scr2 : scr3);
    __syncthreads();
    *(int4*)&hist[tid * 8] = make_int4(0, 0, 0, 0);
    *(int4*)&hist[tid * 8 + 4] = make_int4(0, 0, 0, 0);
    __syncthreads();
    for (int i = tid * 4; i < n; i += 256 * 4) {
      const u32x4 u4 = *(const u32x4*)(scr + i);
      *(u32x4*)(sc + i) = u4;
#pragma unroll
      for (int e = 0; e < 4; ++e) atomicAdd(&hist[u4[e] >> 21], 1);
    }
    radix_select(sc, hist, misc, n, sel + qi * 256, tid, lane, w);
  }
}

constexpr int KSTR = 200;
constexpr int VSTR = 72;

template <int MODE>
DI void attn_item(const Params& p, int item, char* smem, u16* gdst) {
  constexpr int NKS = MODE == 0 ? 6 : 4;
  constexpr int ASTAGE = 64 * KSTR + 128 * VSTR;
  u16* sbase = (u16*)smem;
  float* sBias = (float*)(sbase + 2 * ASTAGE);
  const int tid = otid(), lane = tid & 63, w = tid >> 6, fr = lane & 15, fq = lane >> 4;
  int h, q0, nq, krow0, nkeys, ntiles, myt, b = 0, qpos0;
  const u16* vt; size_t vstride;
  const bool sample = item >= 1024;
  if (!sample) {
    const int i = 63 - (item >> 4);
    h = item & 15; q0 = i * 256; nq = 256; krow0 = 0; nkeys = q0 + 256; ntiles = 4 * i + 4; qpos0 = q0;
    vt = (MODE == 0 ? p.VBT_P : p.VAT) + (size_t)h * 128 * MP; vstride = MP;
    myt = ntiles - 3 + (w >> 1);
  } else {
    const int j = item - 1024; b = j >> 4;
    h = j & 15; q0 = MP + b * 16; nq = 16; krow0 = MP + b * SK; nkeys = SK; ntiles = 17; qpos0 = 1024;
    vt = p.VBT_S + ((size_t)b * 2048 + h * 128) * VSS; vstride = VSS;
    myt = ntiles;
  }
  const int wq0 = w * 32;
  const bool active = wq0 < nq;
  __syncthreads();
  if (MODE == 1) {
    for (int i = tid; i < 257; i += NTHREADS) {
      int rel = i - 128;
      int ret = rel > 0 ? 16 : 0;
      int n = rel < 0 ? -rel : rel;
      float lf = logf((float)max(n, 1) / 8.0f) / 2.772588722239781f * 8.0f;
      int large = min(8 + (int)lf, 15);
      int bk = ret + (n < 8 ? n : large);
      sBias[i] = (p.rel[bk * 16 + h] - p.rel[15 * 16 + h]) * 1.4426950408889634f;
    }
  }
  bf16x8 qf[2][NKS];
  int qrow[2];
#pragma unroll
  for (int qt = 0; qt < 2; ++qt) {
    const int qr = min(wq0 + qt * 16 + fr, nq - 1);
    qrow[qt] = qr;
    const u16* qp = (MODE == 0) ? p.QB + (size_t)(q0 + qr) * 3072 + h * 192 + fq * 8 : p.AQ + (size_t)(q0 + qr) * 2048 + h * 128 + fq * 8;
#pragma unroll
    for (int ks = 0; ks < NKS; ++ks) qf[qt][ks] = *(const bf16x8*)(qp + ks * 32);
  }
  f32x4 o[2][8];
#pragma unroll
  for (int qt = 0; qt < 2; ++qt)
#pragma unroll
    for (int dt = 0; dt < 8; ++dt) o[qt][dt] = (f32x4){0.f, 0.f, 0.f, 0.f};
  float mrow[2] = {-1e30f, -1e30f}, lrow[2] = {0.f, 0.f};
  const float SC = (MODE == 0 ? 0.07216878364870322f : 0.08838834764831845f) * 1.4426950408889634f;

  unsigned long long mqn[2] = {0ull, 0ull};
  if (MODE == 1) {
#pragma unroll
    for (int qt = 0; qt < 2; ++qt) mqn[qt] = p.SEL[(size_t)(q0 + qrow[qt]) * 256];
  }
  constexpr int NKL = MODE == 0 ? 3 : 2;
  const bool direct = (MODE == 1) && sample;
  u32x4 rk[NKL], rv[2];
#define KV_LOAD(JT) { const size_t kr0_ = (size_t)(krow0 + (JT) * 64); const u16* kb_ = (MODE == 0 ? p.KB : p.KA) + (kr0_ + (tid >> 4)) * 2048 + h * 128 + (tid & 15) * 8; \
    _Pragma("unroll") for (int i = 0; i < 2; ++i) rk[i] = *(const u32x4*)(kb_ + (size_t)i * 32 * 2048); \
    if (MODE == 0) rk[NKL - 1] = *(const u32x4*)(p.KR + (kr0_ + (tid >> 3)) * 64 + (tid & 7) * 8); \
    const u16* vp_ = vt + (size_t)(tid >> 3) * vstride + (JT) * 64 + (tid & 7) * 8; \
    _Pragma("unroll") for (int i = 0; i < 2; ++i) rv[i] = *(const u32x4*)(vp_ + (size_t)i * 64 * vstride); }
#define KV_STORE(ST) { u16* sk_ = sbase + (ST) * ASTAGE; u16* dk_ = sk_ + (tid >> 4) * KSTR + (tid & 15) * 8; \
    _Pragma("unroll") for (int i = 0; i < 2; ++i) *(u32x4*)(dk_ + i * 32 * KSTR) = rk[i]; \
    if (MODE == 0) *(u32x4*)(sk_ + (tid >> 3) * KSTR + 128 + (tid & 7) * 8) = rk[NKL - 1]; \
    u16* dv_ = sk_ + 64 * KSTR + (tid >> 3) * VSTR + (tid & 7) * 8; \
    _Pragma("unroll") for (int i = 0; i < 2; ++i) *(u32x4*)(dv_ + i * 64 * VSTR) = rv[i]; }
  if (!direct) {
    KV_LOAD(0)
    KV_STORE(0)
    KV_LOAD(min(1, ntiles - 1))
  }
  for (int jt = 0; jt < ntiles; ++jt) {
    const int key0 = jt * 64;
    u16* sK = sbase + (jt & 1) * ASTAGE;
    u16* sV = sK + 64 * KSTR;
    unsigned long long mq[2] = {mqn[0], mqn[1]};
    if (MODE == 1) {
      const int jn = min(jt + 1, ntiles - 1);
#pragma unroll
      for (int qt = 0; qt < 2; ++qt) mqn[qt] = p.SEL[(size_t)(q0 + qrow[qt]) * 256 + jn];
    }
    __syncthreads();
    if (!direct) {
      if (jt + 1 < ntiles) KV_STORE((jt + 1) & 1)
      KV_LOAD(min(jt + 2, ntiles - 1))
    } else {
#pragma unroll 2
      for (int i = 0; i < 4; ++i) {
        const int c = tid + i * NTHREADS;
        const int key = c >> 5, part = c & 31;
        const int s = key0 + key;
        const int sc_ = min(s, SK - 1);
        const size_t o1 = sc_ < 1024 ? ((size_t)b * 1024 + sc_) * 2048 : ((size_t)b * 16 + (sc_ - 1024)) * 2048;
        const float* kp = (sc_ < 1024 ? p.c_ak : p.out + O_AKS) + o1 + h * 128 + part * 4;
        const float* vp = (sc_ < 1024 ? p.c_av : p.out + O_AVS) + o1 + h * 128 + part * 4;
        f32x4 kv = *(const f32x4*)kp, vv = *(const f32x4*)vp;
        u32x2 kk; kk[0] = cvtpk(kv[0], kv[1]); kk[1] = cvtpk(kv[2], kv[3]);
        *(u32x2*)(sK + key * KSTR + part * 4) = kk;
        const bool ok = s < SK;
#pragma unroll
        for (int e = 0; e < 4; ++e) sV[(part * 4 + e) * VSTR + key] = ok ? f2bf(vv[e]) : (u16)0;
      }
      __syncthreads();
    }
    if (active && jt < myt) {
      f32x4 s[2][4];
#pragma unroll
      for (int qt = 0; qt < 2; ++qt)
#pragma unroll
        for (int kt = 0; kt < 4; ++kt) s[qt][kt] = (f32x4){0.f, 0.f, 0.f, 0.f};
      __builtin_amdgcn_s_setprio(1);
#pragma unroll
      for (int kt = 0; kt < 4; ++kt) {
#pragma unroll
        for (int ks = 0; ks < NKS; ++ks) {
          bf16x8 kf = *(const bf16x8*)(sK + (kt * 16 + fr) * KSTR + ks * 32 + fq * 8);
          s[0][kt] = __builtin_amdgcn_mfma_f32_16x16x32_bf16(kf, qf[0][ks], s[0][kt], 0, 0, 0);
          s[1][kt] = __builtin_amdgcn_mfma_f32_16x16x32_bf16(kf, qf[1][ks], s[1][kt], 0, 0, 0);
        }
      }
      __builtin_amdgcn_s_setprio(0);
      unsigned mlo[2] = {0u, 0u}, mhi[2] = {0u, 0u};
      if (MODE == 0) {
        if (key0 + 64 > nkeys) {
#pragma unroll
          for (int kt = 0; kt < 4; ++kt)
#pragma unroll
            for (int j = 0; j < 4; ++j)
              if (key0 + kt * 16 + fq * 4 + j >= nkeys) { s[0][kt][j] = -1e30f; s[1][kt][j] = -1e30f; }
        }
      } else {
        const bool far = (key0 + 63) - (qpos0 + wq0) <= -128;
        if (!far) {
#pragma unroll
          for (int qt = 0; qt < 2; ++qt) {
            const int rb = key0 + fq * 4 - (qpos0 + qrow[qt]) + 128;
#pragma unroll
            for (int kt = 0; kt < 4; ++kt)
#pragma unroll
              for (int j = 0; j < 4; ++j) {
                int r = min(max(rb + kt * 16 + j, 0), 256);
                s[qt][kt][j] += sBias[r];
              }
          }
        }
#pragma unroll
        for (int qt = 0; qt < 2; ++qt) {
          const unsigned long long mm = mq[qt] >> (fq * 4);
          mlo[qt] = (unsigned)mm; mhi[qt] = (unsigned)(mm >> 32);
        }
      }
      bf16x8 pf[2][2];
#pragma unroll
      for (int qt = 0; qt < 2; ++qt) {
        float mx = -1e30f;
#pragma unroll
        for (int kt = 0; kt < 4; ++kt)
#pragma unroll
          for (int j = 0; j < 4; ++j) mx = fmaxf(mx, s[qt][kt][j]);
        mx = fmaxf(mx, __shfl_xor(mx, 16));
        mx = fmaxf(mx, __shfl_xor(mx, 32));
        const float mn = fmaxf(mrow[qt], mx);
        const float alpha = exp2f(mrow[qt] - mn);
        mrow[qt] = mn;
        float rs = 0.f;
#pragma unroll
        for (int kt = 0; kt < 4; ++kt)
#pragma unroll
          for (int j = 0; j < 4; ++j) {
            float pv = exp2f(s[qt][kt][j] - mn);
            if (MODE == 1) {
              const int keep = __builtin_amdgcn_sbfe((int)(kt < 2 ? mlo[qt] : mhi[qt]), (kt & 1) * 16 + j, 1);
              pv = __int_as_float(__float_as_int(pv) & keep);
            }
            s[qt][kt][j] = pv; rs += pv;
          }
        rs += __shfl_xor(rs, 16);
        rs += __shfl_xor(rs, 32);
        lrow[qt] = lrow[qt] * alpha + rs;
        if (__ballot(alpha != 1.f) != 0ull) {
#pragma unroll
          for (int dt = 0; dt < 8; ++dt) o[qt][dt] *= alpha;
        }
#pragma unroll
        for (int s2 = 0; s2 < 2; ++s2) {
          u32x4 pk;
          pk[0] = cvtpk(s[qt][2 * s2][0], s[qt][2 * s2][1]);
          pk[1] = cvtpk(s[qt][2 * s2][2], s[qt][2 * s2][3]);
          pk[2] = cvtpk(s[qt][2 * s2 + 1][0], s[qt][2 * s2 + 1][1]);
          pk[3] = cvtpk(s[qt][2 * s2 + 1][2], s[qt][2 * s2 + 1][3]);
          pf[qt][s2] = __builtin_bit_cast(bf16x8, pk);
        }
      }
      __builtin_amdgcn_s_setprio(1);
#pragma unroll
      for (int dt = 0; dt < 8; ++dt) {
#pragma unroll
        for (int s2 = 0; s2 < 2; ++s2) {
          const u16* vp = sV + (dt * 16 + fr) * VSTR + fq * 4;
          u32x2 v0 = *(const u32x2*)(vp + (2 * s2) * 16);
          u32x2 v1 = *(const u32x2*)(vp + (2 * s2 + 1) * 16);
          u32x4 vv = {v0[0], v0[1], v1[0], v1[1]};
          bf16x8 vf = __builtin_bit_cast(bf16x8, vv);
          o[0][dt] = __builtin_amdgcn_mfma_f32_16x16x32_bf16(vf, pf[0][s2], o[0][dt], 0, 0, 0);
          o[1][dt] = __builtin_amdgcn_mfma_f32_16x16x32_bf16(vf, pf[1][s2], o[1][dt], 0, 0, 0);
        }
      }
      __builtin_amdgcn_s_setprio(0);
    }
  }
  if (active) {
#pragma unroll
    for (int qt = 0; qt < 2; ++qt) {
      const int qr = wq0 + qt * 16 + fr;
      if (qr < nq) {
        const float inv = 1.f / lrow[qt];
        const size_t row = (size_t)(q0 + qr);
#pragma unroll
        for (int dt = 0; dt < 8; ++dt) {
          const size_t off = row * 2048 + h * 128 + dt * 16 + fq * 4;
          u32x2 ga = *(const u32x2*)(p.GA + off);
          u32x2 r;
          if (MODE == 0) {
            u32x2 gb = *(const u32x2*)(p.GB + off);
            r[0] = cvtpk(bflo(gb[0]) * o[qt][dt][0] * inv + bflo(ga[0]), bfhi(gb[0]) * o[qt][dt][1] * inv + bfhi(ga[0]));
            r[1] = cvtpk(bflo(gb[1]) * o[qt][dt][2] * inv + bflo(ga[1]), bfhi(gb[1]) * o[qt][dt][3] * inv + bfhi(ga[1]));
          } else {
            r[0] = cvtpk(bflo(ga[0]) * o[qt][dt][0] * inv, bfhi(ga[0]) * o[qt][dt][1] * inv);
            r[1] = cvtpk(bflo(ga[1]) * o[qt][dt][2] * inv, bfhi(ga[1]) * o[qt][dt][3] * inv);
          }
          *(u32x2*)(gdst + off) = r;
        }
      }
    }
  }
}

#undef KV_LOAD
#undef KV_STORE
__global__ void __launch_bounds__(NTHREADS) fwd_megakernel(Params p) {
  extern __shared__ __attribute__((aligned(16))) char smem[];
  cg::grid_group grid = cg::this_grid();
#define IDS const int tid = otid(); const int lane = tid & 63, w = tid >> 6; const int bid = blockIdx.x, nb = gridDim.x; \
  const int gw = bid * 8 + w, ngw = nb * 8; (void)tid; (void)lane; (void)gw; (void)ngw; (void)bid; (void)nb;

#if PH & (1 << 0)
  { IDS
  {
    const int vb = tid >> 8;
    float* st = (float*)(smem + vb * VB_LDS);
    const int vbid = bid * 2 + vb, nvb = nb * 2;
    for (int t = vbid; t < 32 * 192; t += nvb) transpose_tile(p.w_in, 2048, INC, p.WT_IN, t, st);
    for (int t = vbid; t < 8 * 48; t += nvb) transpose_tile(p.w_uq, 512, 3072, p.WT_UQ, t, st);
    for (int t = vbid; t < 4 * 32; t += nvb) transpose_tile(p.w_uk, 256, 2048, p.WT_UK, t, st);
    for (int t = vbid; t < 4 * 32; t += nvb) transpose_tile(p.w_uv, 256, 2048, p.WT_UV, t, st);
    for (int t = vbid; t < 32 * 32; t += nvb) transpose_tile(p.w_out, 2048, 2048, p.WT_OUT, t, st);
    for (int t = vbid; t < 32 * 128; t += nvb) transpose_tile(p.w_up, 2048, 8192, p.WT_UP, t, st);
    for (int t = vbid; t < 128 * 32; t += nvb) transpose_tile(p.w_down, 8192, 2048, p.WT_DOWN, t, st);
    for (int r = gw; r < MT; r += ngw) {
      const float* x = r < MP ? p.x_p + (size_t)r * 2048 : p.x_s + (size_t)(r - MP) * 2048;
      rms_row_2048(x, p.g_mix, p.H + (size_t)r * 2048, lane);
    }
    const int gt = bid * NTHREADS + tid, ngt = nb * NTHREADS;
    for (int i = gt; i < 16 * 1024 * 64 / 4; i += ngt) {
      int e = i * 4; int b = e >> 16; int rem = e & 65535; int s = rem >> 6, c = rem & 63;
      size_t dst = (size_t)(MP + b * SK + s) * 64 + c;
      f32x4 a = *(const f32x4*)(p.c_idx + e), k = *(const f32x4*)(p.c_kr + e);
      u32x2 o; o[0] = cvtpk(a[0], a[1]); o[1] = cvtpk(a[2], a[3]);
      *(u32x2*)(p.IXK + dst) = o;
      o[0] = cvtpk(k[0], k[1]); o[1] = cvtpk(k[2], k[3]);
      *(u32x2*)(p.KR + dst) = o;
    }
    for (int i = gt; i < 16 * 1024 * 256 / 4; i += ngt) {
      int e = i * 4; int b = e >> 18; int rem = e & 262143; int s = rem >> 8, c = rem & 255;
      size_t dst = (size_t)(MP + b * SK + s) * 256 + c;
      f32x4 a = *(const f32x4*)(p.c_ckv + e);
      u32x2 o; o[0] = cvtpk(a[0], a[1]); o[1] = cvtpk(a[2], a[3]);
      *(u32x2*)(p.CKV + dst) = o;
    }
  }
  }
#endif
  grid.sync();
#if PH & (1 << 1)
  { IDS
  for (int rep = 0; rep < NREP(1); ++rep) gemm_phase<EPI_IN>(p, p.H, 2048, p.WT_IN, 2048, 2048, MT / 256, INP / 256, smem, nullptr, 0, bid, nb);
  }
#endif
  grid.sync();
#if PH & (1 << 2)
  { IDS
  for (int t = gw; t < MT; t += ngw) post_row(p, t, lane);
  {
    const int vb = tid >> 8, vbid = bid * 2 + vb;
    char* sm = smem + vb * VB_LDS;
    for (int rep = 0; rep < NREP(2); ++rep) for (int t = vbid * NQ; t < MT; t += nb * 2 * NQ)
      topk_group(p, t, sm, (unsigned*)(p.out + O_Y + 14000000) + (size_t)vbid * 16384, (unsigned*)(p.out + O_Y + 14000000) + (size_t)(512 + vbid) * 16384,
                 (unsigned*)p.H + (size_t)vbid * 16384);
  }
  }
#endif
  grid.sync();
#if PH & (1 << 3)
  { IDS
    const int total = 1024 + 256;
    for (int rep = 0; rep < NREP(3); ++rep) {
      u16* gdst = (rep + 1 < NREP(3)) ? (u16*)(p.out + O_Y) : p.GA;
      for (int r = 0;; ++r) {
        int id = (r & 1) ? r * nb + (nb - 1 - bid) : r * nb + bid;
        if (r * nb >= total) break;
        if (id < total) attn_item<1>(p, id, smem, gdst);
      }
    }
  }
#endif
  grid.sync();
#if PH & (1 << 4)
  { IDS
  {
    const int gt = bid * NTHREADS + tid, ngt = nb * NTHREADS;
    for (int i = gt; i < MS * 2048 / 4; i += ngt)
      *(f32x4*)(p.out + O_Y + (size_t)MP * 2048 + (size_t)i * 4) = *(const f32x4*)(p.x_s + (size_t)i * 4);
    for (int i = gt; i < 16 * 2048 * 6; i += ngt) {
      int r = i / 6, c = i - r * 6;
      *(u32x4*)(p.VBT_S + (size_t)r * VSS + SK + c * 8) = (u32x4){0u, 0u, 0u, 0u};
    }
    const int nqb = (MT / 256) * 12, nkb = (KROWS / 256) * 8;
    const int total = nqb + 2 * nkb;
    for (int id = bid; id < total; id += nb) {
      if (id < nqb) gemm_phase<EPI_QB>(p, p.CQ, 512, p.WT_UQ, 512, 512, MT / 256, 12, smem, p.QB, 3072, id, 1 << 30);
      else if (id < nqb + nkb) gemm_phase<EPI_BF16>(p, p.CKV, 256, p.WT_UK, 256, 256, KROWS / 256, 8, smem, p.KB, 2048, id - nqb, 1 << 30);
      else gemm_phase<EPI_VT>(p, p.CKV, 256, p.WT_UV, 256, 256, KROWS / 256, 8, smem, nullptr, 0, id - nqb - nkb, 1 << 30);
    }
  }
  }
#endif
  grid.sync();
#if PH & (1 << 5)
  { IDS
  {
    const int total = 1024 + 256;
    for (int rep = 0; rep < NREP(5); ++rep) {
      u16* gdst = (rep + 1 < NREP(5)) ? (u16*)(p.out + O_Y) : p.GB;
      for (int r = 0;; ++r) {
        int id = (r & 1) ? r * nb + (nb - 1 - bid) : r * nb + bid;
        if (r * nb >= total) break;
        if (id < total) attn_item<0>(p, id, smem, gdst);
      }
    }
  }
  }
#endif
  grid.sync();
#if PH & (1 << 6)
  { IDS
  gemm_phase<EPI_RES>(p, p.GB, 2048, p.WT_OUT, 2048, 2048, MT / 256 - 1, 8, smem, nullptr, 0, bid, nb);
  for (int id = bid; id < 128; id += nb) {
    const int nt = id & 7, kc = id >> 3;
    gemm_tile<EPI_ATOM>(p, p.GB + kc * 128, 2048, p.WT_OUT + kc * 128, 2048, 128, (MT / 256 - 1) * 256, nt * 256, smem, nullptr, 0);
  }
  }
#endif
  grid.sync();
#if PH & (1 << 7)
  { IDS
  for (int r = gw; r < MT; r += ngw) rms_row_2048(p.out + O_Y + (size_t)r * 2048, p.g_ffn, p.H2 + (size_t)r * 2048, lane);
  }
#endif
  grid.sync();
#if PH & (1 << 8)
  { IDS
  gemm_phase<EPI_RELU2>(p, p.H2, 2048, p.WT_UP, 2048, 2048, MT / 256, 32, smem, nullptr, 0, bid, nb);
  }
#endif
  grid.sync();
#if PH & (1 << 9)
  { IDS
  gemm_phase<EPI_ACC>(p, p.U, DFF, p.WT_DOWN, DFF, DFF, MT / 256 - 1, 8, smem, nullptr, 0, bid, nb);
  for (int id = bid; id < 256; id += nb) {
    const int nt = id & 7, kc = id >> 3;
    gemm_tile<EPI_ATOM>(p, p.U + kc * 256, DFF, p.WT_DOWN + kc * 256, DFF, 256, (MT / 256 - 1) * 256, nt * 256, smem, nullptr, 0);
  }
  }
#endif
  grid.sync();
#if PH & (1 << 10)
  { IDS
  for (int r = gw; r < MT; r += ngw) {
    float* x = p.out + O_Y + (size_t)r * 2048;
    f32x4 v[8];
    float ss = 0.f;
#pragma unroll
    for (int i = 0; i < 8; ++i) {
      v[i] = *(const f32x4*)(x + i * 256 + lane * 4);
      ss += v[i][0] * v[i][0] + v[i][1] * v[i][1] + v[i][2] * v[i][2] + v[i][3] * v[i][3];
    }
    ss = wave_sum(ss);
    float rr = rsqrtf(ss * (1.f / 2048.f) + 1e-6f);
#pragma unroll
    for (int i = 0; i < 8; ++i) {
      f32x4 gg = *(const f32x4*)(p.g_fin + i * 256 + lane * 4);
      f32x4 o = {v[i][0] * rr * gg[0], v[i][1] * rr * gg[1], v[i][2] * rr * gg[2], v[i][3] * rr * gg[3]};
      *(f32x4*)(x + i * 256 + lane * 4) = o;
    }
  }
  }
#endif
}

extern "C" void kernel_launch(void* const* d_in, const int* in_sizes, int n_in, void* d_out, int out_size, void* d_ws, size_t ws_size,
                              hipStream_t stream) {
  static int grid_blocks = 0;
  if (!grid_blocks) {
    int dev = 0, cus = 0, per_cu = 0;
    hipGetDevice(&dev);
    hipDeviceGetAttribute(&cus, hipDeviceAttributeMultiprocessorCount, dev);
    if (hipFuncSetAttribute((const void*)fwd_megakernel, hipFuncAttributeMaxDynamicSharedMemorySize, LDS_BYTES) != hipSuccess)
      fprintf(stderr, "kernel_launch: hipFuncSetAttribute failed\n");
    hipOccupancyMaxActiveBlocksPerMultiprocessor(&per_cu, (const void*)fwd_megakernel, NTHREADS, LDS_BYTES);
    if (per_cu < 1) per_cu = 1;
    if (per_cu > 1) per_cu = 1;
    grid_blocks = cus * per_cu;
  }
  Params p{};
  const float* const* in = (const float* const*)d_in;
  p.x_p = in[0]; p.x_s = in[1]; p.c_ak = in[2]; p.c_av = in[3]; p.c_idx = in[4]; p.c_ckv = in[5]; p.c_kr = in[6]; p.rel = in[7];
  p.g_mix = in[8]; p.w_in = in[9]; p.g_q = in[10]; p.w_uq = in[11]; p.g_kv = in[12]; p.w_uk = in[13]; p.w_uv = in[14]; p.w_out = in[15];
  p.g_ffn = in[16]; p.w_up = in[17]; p.w_down = in[18]; p.g_fin = in[19];
  p.out = (float*)d_out;
  char* ws = (char*)d_ws;
  size_t off = 0;
  auto alloc = [&](size_t bytes) { char* r = ws + off; off += (bytes + 255) & ~(size_t)255; return r; };
  p.WT_UQ = (u16*)alloc((size_t)3072 * 512 * 2);
  p.WT_UK = (u16*)alloc((size_t)2048 * 256 * 2);
  p.WT_UV = (u16*)alloc((size_t)2048 * 256 * 2);
  p.WT_OUT = (u16*)alloc((size_t)2048 * 2048 * 2);
  p.WT_UP = (u16*)alloc((size_t)8192 * 2048 * 2);
  p.WT_DOWN = (u16*)alloc((size_t)2048 * 8192 * 2);
  p.CQ = (u16*)alloc((size_t)MT * 512 * 2);
  p.CKV = (u16*)alloc((size_t)KROWS * 256 * 2);
  p.KR = (u16*)alloc((size_t)KROWS * 64 * 2);
  p.GA = (u16*)alloc((size_t)MT * 2048 * 2);
  p.GB = (u16*)alloc((size_t)MT * 2048 * 2);
  p.CS = (float*)alloc((size_t)MT * 32 * 4);
  p.SN = (float*)alloc((size_t)MT * 32 * 4);
  const size_t ubase = off;
  p.WT_IN = (u16*)alloc((size_t)INP * 2048 * 2);
  p.H = (u16*)alloc((size_t)MT * 2048 * 2);
  p.AQ = (u16*)alloc((size_t)MT * 2048 * 2);
  p.KA = (u16*)alloc((size_t)MP * 2048 * 2);
  p.VAT = (u16*)alloc((size_t)MP * 2048 * 2);
  p.IXQ = (u16*)alloc((size_t)MT * 1024 * 2);
  p.IXK = (u16*)alloc((size_t)KROWS * 64 * 2);
  p.SEL = (unsigned long long*)alloc((size_t)MT * 256 * 8);
  p.IXW = (float*)alloc((size_t)MT * 16 * 4);
  const size_t endA = off;
  off = ubase;
  p.QB = (u16*)alloc((size_t)MT * 3072 * 2);
  p.KB = (u16*)alloc((size_t)KROWS * 2048 * 2);
  p.VBT_P = (u16*)alloc((size_t)2048 * MP * 2);
  p.VBT_S = (u16*)alloc((size_t)16 * 2048 * VSS * 2);
  const size_t endB = off;
  off = ubase;
  p.H2 = (u16*)alloc((size_t)MT * 2048 * 2);
  p.U = (u16*)alloc((size_t)MT * DFF * 2);
  const size_t endC = off;
  size_t need = endA > endB ? endA : endB;
  if (endC > need) need = endC;
  if (need > ws_size) { fprintf(stderr, "kernel_launch: workspace too small: need %zu have %zu\n", need, ws_size); return; }
  void* args[] = {&p};
  hipError_t e = hipLaunchCooperativeKernel((const void*)fwd_megakernel, dim3(grid_blocks), dim3(NTHREADS), args, LDS_BYTES, stream);
  if (e != hipSuccess) fprintf(stderr, "cooperative launch failed: %s (grid %d)\n", hipGetErrorString(e), grid_blocks);
}
```

```cpp
#include <hip/hip_runtime.h>
#include <hip/hip_cooperative_groups.h>
#include <cstdio>
#include <cstdint>
namespace cg = cooperative_groups;

typedef unsigned short u16;
typedef __attribute__((ext_vector_type(8))) short bf16x8;
typedef __attribute__((ext_vector_type(4))) short bf16x4;
typedef __attribute__((ext_vector_type(4))) float f32x4;
typedef __attribute__((ext_vector_type(2))) float f32x2;
typedef __attribute__((ext_vector_type(2))) __bf16 bf16x2_t;
typedef __attribute__((ext_vector_type(4))) unsigned u32x4;
typedef __attribute__((ext_vector_type(2))) unsigned u32x2;

#define DI __device__ __forceinline__

constexpr int MP = 16384;
constexpr int MS = 256;
constexpr int MT = MP + MS;
constexpr int DM = 2048;
constexpr int INC = 12176;
constexpr int INP = 12288;
constexpr int SK = 1040;
constexpr int KROWS = MP + 16 * SK;
constexpr int VSS = 1088;
constexpr int DFF = 8192;
constexpr int ZRW = 832;
#ifndef PH
#define PH 0x7ff
#endif
#ifndef REP
#define REP 0
#endif
#define NREP(k) (((REP >> (k)) & 1) + 1)
constexpr int NTHREADS = 512;
constexpr int VB_LDS = 75776;
constexpr int LDS_BYTES = 2 * VB_LDS;

constexpr size_t O_Y = 0;
constexpr size_t O_AKP = 34078720;
constexpr size_t O_AVP = 67633152;
constexpr size_t O_IDXP = 101187584;
constexpr size_t O_CKVP = 102236160;
constexpr size_t O_KRP = 106430464;
constexpr size_t O_AKS = 107479040;
constexpr size_t O_AVS = 108003328;
constexpr size_t O_IDXS = 108527616;
constexpr size_t O_CKVS = 108544000;
constexpr size_t O_KRS = 108609536;

struct Params {
  const float *x_p, *x_s, *c_ak, *c_av, *c_idx, *c_ckv, *c_kr, *rel, *g_mix, *w_in, *g_q, *w_uq, *g_kv, *w_uk, *w_uv, *w_out, *g_ffn, *w_up, *w_down, *g_fin;
  float* out;
  u16 *WT_UQ, *WT_UK, *WT_UV, *WT_OUT, *WT_UP, *WT_DOWN, *CQ, *CKV, *KR, *GA, *GB;
  float *CS, *SN;
  u16 *WT_IN, *H, *AQ, *KA, *VAT, *IXQ, *IXK;
  float* IXW;
  unsigned long long* SEL;
  u16 *QB, *KB, *VBT_P, *VBT_S;
  u16 *H2, *U;
};

DI int otid() { int t = threadIdx.x; asm volatile("" : "+v"(t)); return t; }
DI unsigned cvtpk(float lo, float hi) {
  f32x2 v = {lo, hi};
  bf16x2_t b = __builtin_convertvector(v, bf16x2_t);
  return __builtin_bit_cast(unsigned, b);
}
DI u16 f2bf(float x) { return (u16)(cvtpk(x, 0.f) & 0xffffu); }
DI float bf2f(u16 b) { return __uint_as_float(((unsigned)b) << 16); }
DI float bflo(unsigned w) { return __uint_as_float(w << 16); }
DI float bfhi(unsigned w) { return __uint_as_float(w & 0xffff0000u); }
DI float dot2bf(unsigned a, unsigned b, float c) {
  return __builtin_amdgcn_fdot2_f32_bf16(__builtin_bit_cast(bf16x2_t, a), __builtin_bit_cast(bf16x2_t, b), c, false);
}
DI float wave_sum(float v) {
#pragma unroll
  for (int o = 32; o > 0; o >>= 1) v += __shfl_xor(v, o);
  return v;
}
DI int qpos_of(int t) { return t < MP ? t : 1024 + ((t - MP) & 15); }
DI int krow_of(int t) { return t < MP ? t : MP + ((t - MP) >> 4) * SK + 1024 + ((t - MP) & 15); }
DI float inv_freq(int i) { return exp2f(-(float)i * 0.41524101186092029f); }

DI void transpose_tile(const float* __restrict__ W, int K, int N, u16* __restrict__ Wt, int tile, float* s  ) {
  const int nkt = K >> 6;
  const int kt = tile % nkt, nt = tile / nkt;
  const int k0 = kt << 6, n0 = nt << 6;
  const int tid = otid() & 255;
  const int c = tid & 63, r0 = tid >> 6;
  __syncthreads();
#pragma unroll
  for (int i = 0; i < 16; ++i) {
    int r = i * 4 + r0;
    float v = (n0 + c < N) ? W[(size_t)(k0 + r) * N + n0 + c] : 0.f;
    s[r * 65 + c] = v;
  }
  __syncthreads();
  const int kp = (tid & 31) * 2, rr0 = tid >> 5;
#pragma unroll
  for (int i = 0; i < 8; ++i) {
    int rr = i * 8 + rr0;
    unsigned pk = cvtpk(s[kp * 65 + rr], s[(kp + 1) * 65 + rr]);
    *(unsigned*)(Wt + (size_t)(n0 + rr) * K + k0 + kp) = pk;
  }
}

DI void rms_row_2048(const float* __restrict__ x, const float* __restrict__ g, u16* __restrict__ out, int lane) {
  f32x4 v[8];
  float ss = 0.f;
#pragma unroll
  for (int i = 0; i < 8; ++i) {
    v[i] = *(const f32x4*)(x + i * 256 + lane * 4);
    ss += v[i][0] * v[i][0] + v[i][1] * v[i][1] + v[i][2] * v[i][2] + v[i][3] * v[i][3];
  }
  ss = wave_sum(ss);
  float r = rsqrtf(ss * (1.f / 2048.f) + 1e-6f);
#pragma unroll
  for (int i = 0; i < 8; ++i) {
    f32x4 gg = *(const f32x4*)(g + i * 256 + lane * 4);
    u32x2 o;
    o[0] = cvtpk(v[i][0] * r * gg[0], v[i][1] * r * gg[1]);
    o[1] = cvtpk(v[i][2] * r * gg[2], v[i][3] * r * gg[3]);
    *(u32x2*)(out + i * 256 + lane * 4) = o;
  }
}

enum { EPI_IN = 0, EPI_QB, EPI_BF16, EPI_VT, EPI_RES, EPI_RELU2, EPI_ACC, EPI_ATOM };
constexpr float QSC = 0.07216878364870322f * 1.4426950408889634f;
constexpr int LSTR = 64;
#ifndef PFA
#define PFA 8
#endif

template <int EPI> struct EpiSwap { static constexpr bool v = (EPI != EPI_VT); };

DI u32x2 pack4(f32x4 v) { u32x2 r; r[0] = cvtpk(v[0], v[1]); r[1] = cvtpk(v[2], v[3]); return r; }
DI float sigm(float v) { return 1.f / (1.f + __expf(-v)); }

template <int EPI>
DI void gemm_epilogue(const Params& p, f32x4 (&acc)[8][4], int m0, int n0, int wr, int wc, int fr, int fq, u16* Cb, int ldc) {
  const int cw = n0 + wc * 64;
  if (EPI == EPI_VT) {
#pragma clang loop unroll(full)
    for (int m = 0; m < 8; ++m) {
      const int rb = m0 + wr * 128 + m * 16 + fq * 4;
#pragma clang loop unroll(full)
      for (int n = 0; n < 4; ++n) {
        const int col = cw + n * 16 + fr;
        u16* dst;
        if (rb < MP) dst = p.VBT_P + (size_t)col * MP + rb;
        else { int r2 = rb - MP; int b = r2 / SK; int s = r2 - b * SK; dst = p.VBT_S + ((size_t)b * 2048 + col) * VSS + s; }
        *(u32x2*)dst = pack4(acc[m][n]);
      }
    }
    return;
  }
  const int rbase = m0 + wr * 128 + fr;
  const int c4 = fq * 4;
  if (EPI == EPI_QB) {
    if (cw % 192 == 128) {
#pragma clang loop unroll(full)
      for (int m = 0; m < 8; ++m) {
        const int row = rbase + m * 16;
#pragma clang loop unroll(full)
        for (int n = 0; n < 2; ++n) {
          const int i0 = n * 16 + c4;
          const f32x4 cs = *(const f32x4*)(p.CS + (size_t)row * 32 + i0), sn = *(const f32x4*)(p.SN + (size_t)row * 32 + i0);
          const f32x4 x1 = acc[m][n] * QSC, x2 = acc[m][n + 2] * QSC;
          *(u32x2*)(p.QB + (size_t)row * 3072 + cw + i0) = pack4(x1 * cs - x2 * sn);
          *(u32x2*)(p.QB + (size_t)row * 3072 + cw + i0 + 32) = pack4(x1 * sn + x2 * cs);
        }
      }
      return;
    }
  }
#pragma clang loop unroll(full)
  for (int n = 0; n < 4; ++n) {
    const int colt = cw + n * 16;
    const int col = colt + c4;
    if (EPI == EPI_IN) {
      const bool smp = m0 >= MP;
      if (colt < 2048) {
#pragma clang loop unroll(full)
        for (int m = 0; m < 8; ++m) *(u32x2*)(p.AQ + (size_t)(rbase + m * 16) * 2048 + col) = pack4(acc[m][n] * (0.08838834764831845f * 1.4426950408889634f));
      } else if (colt < 4096) {
        const int c = col - 2048;
#pragma clang loop unroll(full)
        for (int m = 0; m < 8; ++m) {
          const int row = rbase + m * 16;
          if (!smp) { *(f32x4*)(p.out + O_AKP + (size_t)row * 2048 + c) = acc[m][n]; *(u32x2*)(p.KA + (size_t)row * 2048 + c) = pack4(acc[m][n]); }
          else *(f32x4*)(p.out + O_AKS + (size_t)(row - MP) * 2048 + c) = acc[m][n];
        }
      } else if (colt < 6144) {
        const int c = col - 4096;
#pragma clang loop unroll(full)
        for (int m = 0; m < 8; ++m) {
          const int row = rbase + m * 16;
          if (!smp) {
            *(f32x4*)(p.out + O_AVP + (size_t)row * 2048 + c) = acc[m][n];
#pragma clang loop unroll(full)
            for (int j = 0; j < 4; ++j) p.VAT[(size_t)(c + j) * MP + row] = f2bf(acc[m][n][j]);
          } else *(f32x4*)(p.out + O_AVS + (size_t)(row - MP) * 2048 + c) = acc[m][n];
        }
      } else if (colt < 7168) {
#pragma clang loop unroll(full)
        for (int m = 0; m < 8; ++m) *(u32x2*)(p.IXQ + (size_t)(rbase + m * 16) * 1024 + (col - 6144)) = pack4(acc[m][n]);
      } else if (colt < 7232) {
        const int c = col - 7168;
#pragma clang loop unroll(full)
        for (int m = 0; m < 8; ++m) {
          const int row = rbase + m * 16;
          if (!smp) *(f32x4*)(p.out + O_IDXP + (size_t)row * 64 + c) = acc[m][n];
          else *(f32x4*)(p.out + O_IDXS + (size_t)(row - MP) * 64 + c) = acc[m][n];
          *(u32x2*)(p.IXK + (size_t)krow_of(row) * 64 + c) = pack4(acc[m][n]);
        }
      } else if (colt < 7248) {
#pragma clang loop unroll(full)
        for (int m = 0; m < 8; ++m) *(f32x4*)(p.IXW + (size_t)(rbase + m * 16) * 16 + (col - 7232)) = acc[m][n] * 0.25f;
      } else if (colt < 8080) {
#pragma clang loop unroll(full)
        for (int m = 0; m < 8; ++m) *(f32x4*)(p.out + O_Y + (size_t)(rbase + m * 16) * ZRW + (col - 7248)) = acc[m][n];
      } else if (colt < INC) {
        u16* G = colt < 10128 ? p.GA : p.GB;
        const int c = colt < 10128 ? col - 8080 : col - 10128;
#pragma clang loop unroll(full)
        for (int m = 0; m < 8; ++m) {
          f32x4 v = acc[m][n];
          f32x4 g = {sigm(v[0]), sigm(v[1]), sigm(v[2]), sigm(v[3])};
          *(u32x2*)(G + (size_t)(rbase + m * 16) * 2048 + c) = pack4(g);
        }
      }
    } else {
#pragma clang loop unroll(full)
      for (int m = 0; m < 8; ++m) {
        const int row = rbase + m * 16;
        const f32x4 v = acc[m][n];
        if (EPI == EPI_QB) {
          *(u32x2*)(Cb + (size_t)row * ldc + col) = pack4(v * QSC);
        } else if (EPI == EPI_BF16) {
          *(u32x2*)(Cb + (size_t)row * ldc + col) = pack4(v);
        } else if (EPI == EPI_RES) {
          const f32x4 xv = row < MP ? *(const f32x4*)(p.x_p + (size_t)row * 2048 + col) : *(const f32x4*)(p.x_s + (size_t)(row - MP) * 2048 + col);
          *(f32x4*)(p.out + O_Y + (size_t)row * 2048 + col) = xv + v;
          if ((m & 3) == 3) __builtin_amdgcn_sched_barrier(0);
        } else if (EPI == EPI_RELU2) {
          f32x4 r = {fmaxf(v[0], 0.f), fmaxf(v[1], 0.f), fmaxf(v[2], 0.f), fmaxf(v[3], 0.f)};
          *(u32x2*)(p.U + (size_t)row * DFF + col) = pack4(r * r);
        } else if (EPI == EPI_ACC) {
          float* d = p.out + O_Y + (size_t)row * 2048 + col;
          *(f32x4*)d = *(const f32x4*)d + v;
          if ((m & 3) == 3) __builtin_amdgcn_sched_barrier(0);
        } else if (EPI == EPI_ATOM) {
#pragma clang loop unroll(full)
          for (int j = 0; j < 4; ++j) atomicAdd(p.out + O_Y + (size_t)row * 2048 + col + j, v[j]);
        }
      }
    }
  }
}

constexpr int GSTAGE = 512 * LSTR;
template <int EPI>
DI void gemm_tile(const Params& p, const u16* __restrict__ A, int lda, const u16* __restrict__ Bt, int ldb, int K, int m0, int n0,
                  char* smem, u16* Cb, int ldc) {
  u16* sbase = (u16*)smem;
  const int tid = otid(), lane = tid & 63, w = tid >> 6;
  const int wr = w >> 2, wc = w & 3, fr = lane & 15, fq = lane >> 4;
  f32x4 acc[8][4];
#pragma unroll
  for (int m = 0; m < 8; ++m)
#pragma unroll
    for (int n = 0; n < 4; ++n) acc[m][n] = (f32x4){0.f, 0.f, 0.f, 0.f};
  const int lr = tid >> 3, lk = (tid & 7) * 8;
  const int lkw = ((tid & 7) ^ ((lr >> 1) & 7)) * 8;
  const int fsw = (fr >> 1) & 7, fo0 = (fq ^ fsw) * 8, fo1 = ((4 + fq) ^ fsw) * 8;
  const u16* Ag = A + (size_t)(m0 + lr) * lda + lk;
  const u16* Bg = Bt + (size_t)(n0 + lr) * ldb + lk;
  const int nk = K >> 6;
  u32x4 ra[4], rb[4];
#define G_LOAD(T) { const int k_ = (T) << 6; _Pragma("unroll") for (int i = 0; i < 4; ++i) { \
    ra[i] = *(const u32x4*)(Ag + (size_t)(i * 64) * lda + k_); rb[i] = *(const u32x4*)(Bg + (size_t)(i * 64) * ldb + k_); } }
#define L_STORE(ST) { u16* dA_ = sbase + (ST) * GSTAGE + lr * LSTR + lkw; u16* dB_ = dA_ + 256 * LSTR; _Pragma("unroll") for (int i = 0; i < 4; ++i) { \
    *(u32x4*)(dA_ + i * 64 * LSTR) = ra[i]; *(u32x4*)(dB_ + i * 64 * LSTR) = rb[i]; } }
  G_LOAD(0)
  L_STORE(0)
  G_LOAD(1)
#pragma unroll 1
  for (int kt = 0; kt < nk; ++kt) {
    __syncthreads();
    if (kt + 1 < nk) L_STORE((kt + 1) & 1)
    G_LOAD(min(kt + 2, nk - 1))
    const u16* cA = sbase + (kt & 1) * GSTAGE + (wr * 128 + fr) * LSTR;
    const u16* cB = sbase + (kt & 1) * GSTAGE + 256 * LSTR + (wc * 64 + fr) * LSTR;
#pragma unroll
    for (int ks = 0; ks < 2; ++ks) {
      bf16x8 bfr[4];
#pragma unroll
      for (int n = 0; n < 4; ++n) bfr[n] = *(const bf16x8*)(cB + n * 16 * LSTR + (ks ? fo1 : fo0));
#pragma unroll
      for (int mh = 0; mh < 2; ++mh) {
        bf16x8 af[4];
#pragma unroll
        for (int m = 0; m < 4; ++m) af[m] = *(const bf16x8*)(cA + (mh * 4 + m) * 16 * LSTR + (ks ? fo1 : fo0));
        __builtin_amdgcn_s_setprio(1);
#pragma unroll
        for (int m = 0; m < 4; ++m)
#pragma unroll
          for (int n = 0; n < 4; ++n)
            acc[mh * 4 + m][n] = EpiSwap<EPI>::v ? __builtin_amdgcn_mfma_f32_16x16x32_bf16(bfr[n], af[m], acc[mh * 4 + m][n], 0, 0, 0)
                                                 : __builtin_amdgcn_mfma_f32_16x16x32_bf16(af[m], bfr[n], acc[mh * 4 + m][n], 0, 0, 0);
        __builtin_amdgcn_s_setprio(0);
      }
    }
  }
#undef G_LOAD
#undef L_STORE
  gemm_epilogue<EPI>(p, acc, m0, n0, wr, wc, fr, fq, Cb, ldc);
}

template <int EPI>
DI void gemm_phase(const Params& p, const u16* A, int lda, const u16* Bt, int ldb, int K, int mtiles, int ntiles, char* smem, u16* Cb, int ldc,
                   int start, int stride) {
  if (stride == 256) {
    const int gm = (mtiles + 3) >> 2, gn = (ntiles + 7) >> 3, nsg = gm * gn;
    const int xcd = start & 7, li = start >> 3;
    for (int sg = xcd; sg < nsg; sg += 8) {
      const int gni = sg / gm, gmi = sg - gni * gm;
      const int mt = gmi * 4 + (li & 3), nt = gni * 8 + (li >> 2);
      if (mt < mtiles && nt < ntiles) gemm_tile<EPI>(p, A, lda, Bt, ldb, K, mt * 256, nt * 256, smem, Cb, ldc);
    }
    return;
  }
  const int total = mtiles * ntiles;
  const int GM = 8;
  for (int id = start; id < total; id += stride) {
    const int per = GM * ntiles;
    const int g = id / per, rem = id - g * per;
    const int fm = g * GM;
    const int gsz = min(GM, mtiles - fm);
    const int mt = fm + rem % gsz, nt = rem / gsz;
    gemm_tile<EPI>(p, A, lda, Bt, ldb, K, mt * 256, nt * 256, smem, Cb, ldc);
  }
}

DI void post_row(const Params& p, int t, int lane) {
  const float* zr = p.out + O_Y + (size_t)t * ZRW;
  {
    f32x4 a = *(const f32x4*)(zr + lane * 4), b = *(const f32x4*)(zr + 256 + lane * 4);
    float ss = a[0] * a[0] + a[1] * a[1] + a[2] * a[2] + a[3] * a[3] + b[0] * b[0] + b[1] * b[1] + b[2] * b[2] + b[3] * b[3];
    ss = wave_sum(ss);
    float r = rsqrtf(ss * (1.f / 512.f) + 1e-6f);
    f32x4 ga = *(const f32x4*)(p.g_q + lane * 4), gb = *(const f32x4*)(p.g_q + 256 + lane * 4);
    u32x2 o;
    o[0] = cvtpk(a[0] * r * ga[0], a[1] * r * ga[1]); o[1] = cvtpk(a[2] * r * ga[2], a[3] * r * ga[3]);
    *(u32x2*)(p.CQ + (size_t)t * 512 + lane * 4) = o;
    o[0] = cvtpk(b[0] * r * gb[0], b[1] * r * gb[1]); o[1] = cvtpk(b[2] * r * gb[2], b[3] * r * gb[3]);
    *(u32x2*)(p.CQ + (size_t)t * 512 + 256 + lane * 4) = o;
  }
  const int kr_row = krow_of(t);
  {
    f32x4 a = *(const f32x4*)(zr + 512 + lane * 4);
    float ss = a[0] * a[0] + a[1] * a[1] + a[2] * a[2] + a[3] * a[3];
    ss = wave_sum(ss);
    float r = rsqrtf(ss * (1.f / 256.f) + 1e-6f);
    f32x4 g = *(const f32x4*)(p.g_kv + lane * 4);
    f32x4 o = {a[0] * r * g[0], a[1] * r * g[1], a[2] * r * g[2], a[3] * r * g[3]};
    float* od = t < MP ? p.out + O_CKVP + (size_t)t * 256 : p.out + O_CKVS + (size_t)(t - MP) * 256;
    *(f32x4*)(od + lane * 4) = o;
    u32x2 ob; ob[0] = cvtpk(o[0], o[1]); ob[1] = cvtpk(o[2], o[3]);
    *(u32x2*)(p.CKV + (size_t)kr_row * 256 + lane * 4) = ob;
  }
  if (lane < 32) {
    float x1 = zr[768 + lane], x2 = zr[768 + 32 + lane];
    float ang = (float)qpos_of(t) * inv_freq(lane);
    float cs = cosf(ang), sn = sinf(ang);
    p.CS[(size_t)t * 32 + lane] = cs; p.SN[(size_t)t * 32 + lane] = sn;
    float o1 = x1 * cs - x2 * sn, o2 = x1 * sn + x2 * cs;
    float* od = t < MP ? p.out + O_KRP + (size_t)t * 64 : p.out + O_KRS + (size_t)(t - MP) * 64;
    od[lane] = o1; od[lane + 32] = o2;
    p.KR[(size_t)kr_row * 64 + lane] = f2bf(o1);
    p.KR[(size_t)kr_row * 64 + lane + 32] = f2bf(o2);
  }
}

template <int CTRL> DI float dpp_add(float v) {
  int sft = __builtin_amdgcn_update_dpp(0, __float_as_int(v), CTRL, 0xf, 0xf, true);
  return v + __int_as_float(sft);
}
DI float row16_sum(float v) { v = dpp_add<0x111>(v); v = dpp_add<0x112>(v); v = dpp_add<0x114>(v); v = dpp_add<0x118>(v); return v; }
DI unsigned fkey(float f) { unsigned u = __float_as_uint(f); return (u & 0x80000000u) ? ~u : (u | 0x80000000u); }

DI void radix_select(unsigned* sc, int* hist, int* misc, int n, unsigned long long* sel, int tid, int lane, int w) {
  __syncthreads();
  unsigned prefix = 0;
  int remaining = 256;
#pragma unroll 1
  for (int pass = 0; pass < 3; ++pass) {
    const int shift = pass == 0 ? 21 : (pass == 1 ? 10 : 0);
    const int bits = pass == 2 ? 10 : 11;
    const unsigned bmask = (1u << bits) - 1u;
    if (pass > 0) {
      *(int4*)&hist[tid * 8] = make_int4(0, 0, 0, 0);
      *(int4*)&hist[tid * 8 + 4] = make_int4(0, 0, 0, 0);
      __syncthreads();
      const int hs = shift + bits;
      const unsigned want = prefix >> hs;
      for (int i = tid * 4; i < n; i += 256 * 4) {
        const u32x4 u4 = *(const u32x4*)(sc + i);
#pragma unroll
        for (int e = 0; e < 4; ++e)
          if ((u4[e] >> hs) == want) atomicAdd(&hist[(u4[e] >> shift) & bmask], 1);
      }
      __syncthreads();
    }
    const int4 h0 = *(const int4*)&hist[tid * 8], h1 = *(const int4*)&hist[tid * 8 + 4];
    const int s8 = h0.x + h0.y + h0.z + h0.w + h1.x + h1.y + h1.z + h1.w;
    int suf = s8;
#pragma unroll
    for (int d = 1; d < 64; d <<= 1) { int v = __shfl_down(suf, d); if (lane + d < 64) suf += v; }
    if (lane == 0) misc[w] = suf;
    __syncthreads();
    int above = 0;
    for (int ww = w + 1; ww < 4; ++ww) above += misc[ww];
    const int excl = above + suf - s8;
    if (excl < remaining && remaining <= excl + s8) {
      int c = excl, bin = 0, nrem = 0;
#define TK_STEP(val, idx) if (c < remaining && remaining <= c + (val)) { bin = tid * 8 + (idx); nrem = remaining - c; } c += (val);
      TK_STEP(h1.w, 7) TK_STEP(h1.z, 6) TK_STEP(h1.y, 5) TK_STEP(h1.x, 4) TK_STEP(h0.w, 3) TK_STEP(h0.z, 2) TK_STEP(h0.y, 1) TK_STEP(h0.x, 0)
#undef TK_STEP
      misc[4] = bin; misc[5] = nrem;
    }
    __syncthreads();
    prefix |= ((unsigned)misc[4]) << shift;
    remaining = misc[5];
    __syncthreads();
  }
  const unsigned T = prefix;
  const int seg = ((n + 255) >> 8) << 6;
  const int beg = w * seg;
  int ceq = 0;
  for (int i = beg + lane; i < beg + seg; i += 64) {
    bool in = i < n; unsigned u = in ? sc[i] : 0u;
    ceq += __popcll(__ballot(in && u == T));
  }
  if (lane == 0) misc[12 + w] = ceq;
  __syncthreads();
  int oe = 0;
  for (int ww = 0; ww < w; ++ww) oe += misc[12 + ww];
  const unsigned long long lt = (1ull << lane) - 1ull;
  for (int i0 = beg; i0 < beg + seg; i0 += 64) {
    const int i = i0 + lane;
    bool in = i < n; unsigned u = in ? sc[i] : 0u;
    bool g = in && u > T, e = in && u == T;
    unsigned long long be = __ballot(e);
    int pe = oe + __popcll(be & lt);
    unsigned long long sm = __ballot(g || (e && pe < remaining));
    if (lane == 0 && i0 < n) sel[i0 >> 6] = sm;
    oe += __popcll(be);
  }
}

constexpr int NQ = 4;
DI void topk_group(const Params& p, int t, char* smem, unsigned* scr1, unsigned* scr2, unsigned* scr3) {
  unsigned* sc = (unsigned*)smem;
  int* hist = (int*)(smem + 65536);
  int* misc = hist + 2048;
  const int tid = otid() & 255, lane = tid & 63, w = tid >> 6, fr = lane & 15, fq = lane >> 4;
  int n; const u16* ixk;
  if (t < MP) { n = 64 * ((t >> 6) + 1); ixk = p.IXK; }
  else { int b = (t - MP) >> 4; n = SK; ixk = p.IXK + (size_t)(MP + b * SK) * 64; }
  unsigned long long* sel = p.SEL + (size_t)t * 256;
  __syncthreads();
  if (n <= 256) {
    if (tid < 4) {
      unsigned long long v = (tid < (n >> 6)) ? ~0ull : 0ull;
#pragma unroll
      for (int qi = 0; qi < NQ; ++qi) sel[qi * 256 + tid] = v;
    }
    return;
  }
  *(int4*)&hist[tid * 8] = make_int4(0, 0, 0, 0);
  *(int4*)&hist[tid * 8 + 4] = make_int4(0, 0, 0, 0);
  __syncthreads();
  {
    const u16* q = p.IXQ + (size_t)t * 1024 + fr * 64 + fq * 8;
    bf16x8 a0[NQ], a1[NQ];
    f32x4 wv[NQ];
#pragma unroll
    for (int qi = 0; qi < NQ; ++qi) {
      a0[qi] = *(const bf16x8*)(q + qi * 1024); a1[qi] = *(const bf16x8*)(q + qi * 1024 + 32);
      wv[qi] = *(const f32x4*)(p.IXW + (size_t)(t + qi) * 16 + fq * 4);
    }
    const int ntile = n >> 4;
    for (int kt0 = w; kt0 < ntile; kt0 += 32) {
      bf16x8 b0[8], b1[8];
#pragma unroll
      for (int g = 0; g < 8; ++g) {
        const int kt = min(kt0 + g * 4, ntile - 1);
        const u16* kp = ixk + (size_t)(kt * 16 + fr) * 64 + fq * 8;
        b0[g] = *(const bf16x8*)kp; b1[g] = *(const bf16x8*)(kp + 32);
      }
      float pt[NQ][8];
#pragma unroll
      for (int g = 0; g < 8; ++g) {
#pragma unroll
        for (int qi = 0; qi < NQ; ++qi) {
          f32x4 c = {0.f, 0.f, 0.f, 0.f};
          c = __builtin_amdgcn_mfma_f32_16x16x32_bf16(a0[qi], b0[g], c, 0, 0, 0);
          c = __builtin_amdgcn_mfma_f32_16x16x32_bf16(a1[qi], b1[g], c, 0, 0, 0);
          pt[qi][g] = fmaxf(c[0], 0.f) * wv[qi][0] + fmaxf(c[1], 0.f) * wv[qi][1] + fmaxf(c[2], 0.f) * wv[qi][2] + fmaxf(c[3], 0.f) * wv[qi][3];
        }
      }
#pragma unroll
      for (int g = 0; g < 8; g += 2) {
        const int kt = kt0 + (g + (lane >> 5)) * 4;
        const bool st = (lane & 16) == 0 && kt < ntile;
#pragma unroll
        for (int qi = 0; qi < NQ; ++qi) {
          auto r32 = __builtin_amdgcn_permlane32_swap(__float_as_uint(pt[qi][g]), __float_as_uint(pt[qi][g + 1]), false, false);
          float s2 = __uint_as_float(r32[0]) + __uint_as_float(r32[1]);
          auto r16 = __builtin_amdgcn_permlane16_swap(__float_as_uint(s2), __float_as_uint(s2), false, false);
          float sv = __uint_as_float(r16[0]) + __uint_as_float(r16[1]);
          if (st) {
            unsigned u = fkey(sv);
            if (qi == 0) { sc[kt * 16 + fr] = u; atomicAdd(&hist[u >> 21], 1); }
            else if (qi == 1) scr1[kt * 16 + fr] = u;
            else if (qi == 2) scr2[kt * 16 + fr] = u;
            else scr3[kt * 16 + fr] = u;
          }
        }
      }
    }
  }
  radix_select(sc, hist, misc, n, sel, tid, lane, w);
#pragma unroll 1
  for (int qi = 1; qi < NQ; ++qi) {
    const unsigned* scr = qi == 1 ? scr1 : (qi == 2 ? scr2 : scr3);
    __syncthreads();
    *(int4*)&hist[tid * 8] = make_int4(0, 0, 0, 0);
    *(int4*)&hist[tid * 8 + 4] = make_int4(0, 0, 0, 0);
    __syncthreads();
    for (int i = tid * 4; i < n; i += 256 * 4) {
      const u32x4 u4 = *(const u32x4*)(scr + i);
      *(u32x4*)(sc + i) = u4;
#pragma unroll
      for (int e = 0; e < 4; ++e) atomicAdd(&hist[u4[e] >> 21], 1);
    }
    radix_select(sc, hist, misc, n, sel + qi * 256, tid, lane, w);
  }
}

constexpr int KSTR = 192;
constexpr int VSTR = 72;

template <int MODE>
DI void attn_item(const Params& p, int item, char* smem, u16* gdst) {
  constexpr int NKS = MODE == 0 ? 6 : 4;
  constexpr int ASTAGE = 64 * KSTR + 128 * VSTR;
  u16* sbase = (u16*)smem;
  float* sBias = (float*)(sbase + 2 * ASTAGE);
  const int tid = otid(), lane = tid & 63, w = tid >> 6, fr = lane & 15, fq = lane >> 4;
  const int ksw = (fr >> 1) & 7, ko0 = (fq ^ ksw) * 8, ko1 = ((4 + fq) ^ ksw) * 8;
  int h, q0, nq, krow0, nkeys, ntiles, myt, b = 0, qpos0;
  const u16* vt; size_t vstride;
  const bool sample = item >= 1024;
  if (!sample) {
    const int i = 63 - (item >> 4);
    h = item & 15; q0 = i * 256; nq = 256; krow0 = 0; nkeys = q0 + 256; ntiles = 4 * i + 4; qpos0 = q0;
    vt = (MODE == 0 ? p.VBT_P : p.VAT) + (size_t)h * 128 * MP; vstride = MP;
    myt = ntiles - 3 + (w >> 1);
  } else {
    const int j = item - 1024; b = j >> 4;
    h = j & 15; q0 = MP + b * 16; nq = 16; krow0 = MP + b * SK; nkeys = SK; ntiles = 17; qpos0 = 1024;
    vt = p.VBT_S + ((size_t)b * 2048 + h * 128) * VSS; vstride = VSS;
    myt = ntiles;
  }
  const int wq0 = w * 32;
  const bool active = wq0 < nq;
  __syncthreads();
  if (MODE == 1) {
    for (int i = tid; i < 257; i += NTHREADS) {
      int rel = i - 128;
      int ret = rel > 0 ? 16 : 0;
      int n = rel < 0 ? -rel : rel;
      float lf = logf((float)max(n, 1) / 8.0f) / 2.772588722239781f * 8.0f;
      int large = min(8 + (int)lf, 15);
      int bk = ret + (n < 8 ? n : large);
      sBias[i] = (p.rel[bk * 16 + h] - p.rel[15 * 16 + h]) * 1.4426950408889634f;
    }
  }
  bf16x8 qf[2][NKS];
  int qrow[2];
#pragma unroll
  for (int qt = 0; qt < 2; ++qt) {
    const int qr = min(wq0 + qt * 16 + fr, nq - 1);
    qrow[qt] = qr;
    const u16* qp = (MODE == 0) ? p.QB + (size_t)(q0 + qr) * 3072 + h * 192 + fq * 8 : p.AQ + (size_t)(q0 + qr) * 2048 + h * 128 + fq * 8;
#pragma unroll
    for (int ks = 0; ks < NKS; ++ks) qf[qt][ks] = *(const bf16x8*)(qp + ks * 32);
  }
  f32x4 o[2][8];
#pragma unroll
  for (int qt = 0; qt < 2; ++qt)
#pragma unroll
    for (int dt = 0; dt < 8; ++dt) o[qt][dt] = (f32x4){0.f, 0.f, 0.f, 0.f};
  float mrow[2] = {-1e30f, -1e30f}, lrow[2] = {0.f, 0.f};
  const float SC = (MODE == 0 ? 0.07216878364870322f : 0.08838834764831845f) * 1.4426950408889634f;

  unsigned long long mqn[2] = {0ull, 0ull};
  if (MODE == 1) {
#pragma unroll
    for (int qt = 0; qt < 2; ++qt) mqn[qt] = p.SEL[(size_t)(q0 + qrow[qt]) * 256];
  }
  constexpr int NKL = MODE == 0 ? 3 : 2;
  const bool direct = (MODE == 1) && sample;
  u32x4 rk[NKL], rv[2];
#define KV_LOAD(JT) { const size_t kr0_ = (size_t)(krow0 + (JT) * 64); const u16* kb_ = (MODE == 0 ? p.KB : p.KA) + (kr0_ + (tid >> 4)) * 2048 + h * 128 + (tid & 15) * 8; \
    _Pragma("unroll") for (int i = 0; i < 2; ++i) rk[i] = *(const u32x4*)(kb_ + (size_t)i * 32 * 2048); \
    if (MODE == 0) rk[NKL - 1] = *(const u32x4*)(p.KR + (kr0_ + (tid >> 3)) * 64 + (tid & 7) * 8); \
    const u16* vp_ = vt + (size_t)(tid >> 3) * vstride + (JT) * 64 + (tid & 7) * 8; \
    _Pragma("unroll") for (int i = 0; i < 2; ++i) rv[i] = *(const u32x4*)(vp_ + (size_t)i * 64 * vstride); }
#define KV_STORE(ST) { u16* sk_ = sbase + (ST) * ASTAGE; u16* dk_ = sk_ + (tid >> 4) * KSTR + ((tid & 15) ^ ((tid >> 5) & 7)) * 8; \
    _Pragma("unroll") for (int i = 0; i < 2; ++i) *(u32x4*)(dk_ + i * 32 * KSTR) = rk[i]; \
    if (MODE == 0) *(u32x4*)(sk_ + (tid >> 3) * KSTR + 128 + ((tid & 7) ^ ((tid >> 4) & 7)) * 8) = rk[NKL - 1]; \
    u16* dv_ = sk_ + 64 * KSTR + (tid >> 3) * VSTR + (tid & 7) * 8; \
    _Pragma("unroll") for (int i = 0; i < 2; ++i) *(u32x4*)(dv_ + i * 64 * VSTR) = rv[i]; }
  if (!direct) {
    KV_LOAD(0)
    KV_STORE(0)
    KV_LOAD(min(1, ntiles - 1))
  }
  for (int jt = 0; jt < ntiles; ++jt) {
    const int key0 = jt * 64;
    u16* sK = sbase + (jt & 1) * ASTAGE;
    u16* sV = sK + 64 * KSTR;
    unsigned long long mq[2] = {mqn[0], mqn[1]};
    if (MODE == 1) {
      const int jn = min(jt + 1, ntiles - 1);
#pragma unroll
      for (int qt = 0; qt < 2; ++qt) mqn[qt] = p.SEL[(size_t)(q0 + qrow[qt]) * 256 + jn];
    }
    __syncthreads();
    if (!direct) {
      if (jt + 1 < ntiles) KV_STORE((jt + 1) & 1)
      KV_LOAD(min(jt + 2, ntiles - 1))
    } else {
#pragma unroll 2
      for (int i = 0; i < 4; ++i) {
        const int c = tid + i * NTHREADS;
        const int key = c >> 5, part = c & 31;
        const int s = key0 + key;
        const int sc_ = min(s, SK - 1);
        const size_t o1 = sc_ < 1024 ? ((size_t)b * 1024 + sc_) * 2048 : ((size_t)b * 16 + (sc_ - 1024)) * 2048;
        const float* kp = (sc_ < 1024 ? p.c_ak : p.out + O_AKS) + o1 + h * 128 + part * 4;
        const float* vp = (sc_ < 1024 ? p.c_av : p.out + O_AVS) + o1 + h * 128 + part * 4;
        f32x4 kv = *(const f32x4*)kp, vv = *(const f32x4*)vp;
        u32x2 kk; kk[0] = cvtpk(kv[0], kv[1]); kk[1] = cvtpk(kv[2], kv[3]);
        *(u32x2*)(sK + key * KSTR + (((part >> 1) ^ ((key >> 1) & 7)) * 8) + (part & 1) * 4) = kk;
        const bool ok = s < SK;
#pragma unroll
        for (int e = 0; e < 4; ++e) sV[(part * 4 + e) * VSTR + key] = ok ? f2bf(vv[e]) : (u16)0;
      }
      __syncthreads();
    }
    if (active && jt < myt) {
      f32x4 s[2][4];
#pragma unroll
      for (int qt = 0; qt < 2; ++qt)
#pragma unroll
        for (int kt = 0; kt < 4; ++kt) s[qt][kt] = (f32x4){0.f, 0.f, 0.f, 0.f};
      __builtin_amdgcn_s_setprio(1);
#pragma unroll
      for (int kt = 0; kt < 4; ++kt) {
#pragma unroll
        for (int ks = 0; ks < NKS; ++ks) {
          bf16x8 kf = *(const bf16x8*)(sK + (kt * 16 + fr) * KSTR + (ks >> 1) * 64 + ((ks & 1) ? ko1 : ko0));
          s[0][kt] = __builtin_amdgcn_mfma_f32_16x16x32_bf16(kf, qf[0][ks], s[0][kt], 0, 0, 0);
          s[1][kt] = __builtin_amdgcn_mfma_f32_16x16x32_bf16(kf, qf[1][ks], s[1][kt], 0, 0, 0);
        }
      }
      __builtin_amdgcn_s_setprio(0);
      unsigned mlo[2] = {0u, 0u}, mhi[2] = {0u, 0u};
      if (MODE == 0) {
        if (key0 + 64 > nkeys) {
#pragma unroll
          for (int kt = 0; kt < 4; ++kt)
#pragma unroll
            for (int j = 0; j < 4; ++j)
              if (key0 + kt * 16 + fq * 4 + j >= nkeys) { s[0][kt][j] = -1e30f; s[1][kt][j] = -1e30f; }
        }
      } else {
        const bool far = (key0 + 63) - (qpos0 + wq0) <= -128;
        if (!far) {
#pragma unroll
          for (int qt = 0; qt < 2; ++qt) {
            const int rb = key0 + fq * 4 - (qpos0 + qrow[qt]) + 128;
#pragma unroll
            for (int kt = 0; kt < 4; ++kt)
#pragma unroll
              for (int j = 0; j < 4; ++j) {
                int r = min(max(rb + kt * 16 + j, 0), 256);
                s[qt][kt][j] += sBias[r];
              }
          }
        }
#pragma unroll
        for (int qt = 0; qt < 2; ++qt) {
          const unsigned long long mm = mq[qt] >> (fq * 4);
          mlo[qt] = (unsigned)mm; mhi[qt] = (unsigned)(mm >> 32);
        }
      }
      bf16x8 pf[2][2];
#pragma unroll
      for (int qt = 0; qt < 2; ++qt) {
        float mx = -1e30f;
#pragma unroll
        for (int kt = 0; kt < 4; ++kt)
#pragma unroll
          for (int j = 0; j < 4; ++j) mx = fmaxf(mx, s[qt][kt][j]);
        mx = fmaxf(mx, __shfl_xor(mx, 16));
        mx = fmaxf(mx, __shfl_xor(mx, 32));
        const float mn = fmaxf(mrow[qt], mx);
        const float alpha = __builtin_amdgcn_exp2f(mrow[qt] - mn);
        mrow[qt] = mn;
        float rs = 0.f;
#pragma unroll
        for (int kt = 0; kt < 4; ++kt)
#pragma unroll
          for (int j = 0; j < 4; ++j) {
            float pv = __builtin_amdgcn_exp2f(s[qt][kt][j] - mn);
            if (MODE == 1) {
              const int keep = __builtin_amdgcn_sbfe((int)(kt < 2 ? mlo[qt] : mhi[qt]), (kt & 1) * 16 + j, 1);
              pv = __int_as_float(__float_as_int(pv) & keep);
            }
            s[qt][kt][j] = pv; rs += pv;
          }
        rs += __shfl_xor(rs, 16);
        rs += __shfl_xor(rs, 32);
        lrow[qt] = lrow[qt] * alpha + rs;
        if (__ballot(alpha != 1.f) != 0ull) {
#pragma unroll
          for (int dt = 0; dt < 8; ++dt) o[qt][dt] *= alpha;
        }
#pragma unroll
        for (int s2 = 0; s2 < 2; ++s2) {
          u32x4 pk;
          pk[0] = cvtpk(s[qt][2 * s2][0], s[qt][2 * s2][1]);
          pk[1] = cvtpk(s[qt][2 * s2][2], s[qt][2 * s2][3]);
          pk[2] = cvtpk(s[qt][2 * s2 + 1][0], s[qt][2 * s2 + 1][1]);
          pk[3] = cvtpk(s[qt][2 * s2 + 1][2], s[qt][2 * s2 + 1][3]);
          pf[qt][s2] = __builtin_bit_cast(bf16x8, pk);
        }
      }
      __builtin_amdgcn_s_setprio(1);
#pragma unroll
      for (int dt = 0; dt < 8; ++dt) {
#pragma unroll
        for (int s2 = 0; s2 < 2; ++s2) {
          const u16* vp = sV + (dt * 16 + fr) * VSTR + fq * 4;
          u32x2 v0 = *(const u32x2*)(vp + (2 * s2) * 16);
          u32x2 v1 = *(const u32x2*)(vp + (2 * s2 + 1) * 16);
          u32x4 vv = {v0[0], v0[1], v1[0], v1[1]};
          bf16x8 vf = __builtin_bit_cast(bf16x8, vv);
          o[0][dt] = __builtin_amdgcn_mfma_f32_16x16x32_bf16(vf, pf[0][s2], o[0][dt], 0, 0, 0);
          o[1][dt] = __builtin_amdgcn_mfma_f32_16x16x32_bf16(vf, pf[1][s2], o[1][dt], 0, 0, 0);
        }
      }
      __builtin_amdgcn_s_setprio(0);
    }
  }
  if (active) {
#pragma unroll
    for (int qt = 0; qt < 2; ++qt) {
      const int qr = wq0 + qt * 16 + fr;
      if (qr < nq) {
        const float inv = 1.f / lrow[qt];
        const size_t row = (size_t)(q0 + qr);
#pragma unroll
        for (int dt = 0; dt < 8; ++dt) {
          const size_t off = row * 2048 + h * 128 + dt * 16 + fq * 4;
          u32x2 ga = *(const u32x2*)(p.GA + off);
          u32x2 r;
          if (MODE == 0) {
            u32x2 gb = *(const u32x2*)(p.GB + off);
            r[0] = cvtpk(bflo(gb[0]) * o[qt][dt][0] * inv + bflo(ga[0]), bfhi(gb[0]) * o[qt][dt][1] * inv + bfhi(ga[0]));
            r[1] = cvtpk(bflo(gb[1]) * o[qt][dt][2] * inv + bflo(ga[1]), bfhi(gb[1]) * o[qt][dt][3] * inv + bfhi(ga[1]));
          } else {
            r[0] = cvtpk(bflo(ga[0]) * o[qt][dt][0] * inv, bfhi(ga[0]) * o[qt][dt][1] * inv);
            r[1] = cvtpk(bflo(ga[1]) * o[qt][dt][2] * inv, bfhi(ga[1]) * o[qt][dt][3] * inv);
          }
          *(u32x2*)(gdst + off) = r;
        }
      }
    }
  }
}

#undef KV_LOAD
#undef KV_STORE
__global__ void __launch_bounds__(NTHREADS) fwd_megakernel(Params p) {
  extern __shared__ __attribute__((aligned(16))) char smem[];
  cg::grid_group grid = cg::this_grid();
#define IDS const int tid = otid(); const int lane = tid & 63, w = tid >> 6; const int bid = blockIdx.x, nb = gridDim.x; \
  const int gw = bid * 8 + w, ngw = nb * 8; (void)tid; (void)lane; (void)gw; (void)ngw; (void)bid; (void)nb;

#if PH & (1 << 0)
  { IDS
  {
    const int vb = tid >> 8;
    float* st = (float*)(smem + vb * VB_LDS);
    const int vbid = bid * 2 + vb, nvb = nb * 2;
    for (int t = vbid; t < 32 * 192; t += nvb) transpose_tile(p.w_in, 2048, INC, p.WT_IN, t, st);
    for (int t = vbid; t < 8 * 48; t += nvb) transpose_tile(p.w_uq, 512, 3072, p.WT_UQ, t, st);
    for (int t = vbid; t < 4 * 32; t += nvb) transpose_tile(p.w_uk, 256, 2048, p.WT_UK, t, st);
    for (int t = vbid; t < 4 * 32; t += nvb) transpose_tile(p.w_uv, 256, 2048, p.WT_UV, t, st);
    for (int t = vbid; t < 32 * 32; t += nvb) transpose_tile(p.w_out, 2048, 2048, p.WT_OUT, t, st);
    for (int t = vbid; t < 32 * 128; t += nvb) transpose_tile(p.w_up, 2048, 8192, p.WT_UP, t, st);
    for (int t = vbid; t < 128 * 32; t += nvb) transpose_tile(p.w_down, 8192, 2048, p.WT_DOWN, t, st);
    for (int r = gw; r < MT; r += ngw) {
      const float* x = r < MP ? p.x_p + (size_t)r * 2048 : p.x_s + (size_t)(r - MP) * 2048;
      rms_row_2048(x, p.g_mix, p.H + (size_t)r * 2048, lane);
    }
    const int gt = bid * NTHREADS + tid, ngt = nb * NTHREADS;
    for (int i = gt; i < 16 * 1024 * 64 / 4; i += ngt) {
      int e = i * 4; int b = e >> 16; int rem = e & 65535; int s = rem >> 6, c = rem & 63;
      size_t dst = (size_t)(MP + b * SK + s) * 64 + c;
      f32x4 a = *(const f32x4*)(p.c_idx + e), k = *(const f32x4*)(p.c_kr + e);
      u32x2 o; o[0] = cvtpk(a[0], a[1]); o[1] = cvtpk(a[2], a[3]);
      *(u32x2*)(p.IXK + dst) = o;
      o[0] = cvtpk(k[0], k[1]); o[1] = cvtpk(k[2], k[3]);
      *(u32x2*)(p.KR + dst) = o;
    }
    for (int i = gt; i < 16 * 1024 * 256 / 4; i += ngt) {
      int e = i * 4; int b = e >> 18; int rem = e & 262143; int s = rem >> 8, c = rem & 255;
      size_t dst = (size_t)(MP + b * SK + s) * 256 + c;
      f32x4 a = *(const f32x4*)(p.c_ckv + e);
      u32x2 o; o[0] = cvtpk(a[0], a[1]); o[1] = cvtpk(a[2], a[3]);
      *(u32x2*)(p.CKV + dst) = o;
    }
  }
  }
#endif
  grid.sync();
#if PH & (1 << 1)
  { IDS
  for (int rep = 0; rep < NREP(1); ++rep) gemm_phase<EPI_IN>(p, p.H, 2048, p.WT_IN, 2048, 2048, MT / 256, INP / 256, smem, nullptr, 0, bid, nb);
  }
#endif
  grid.sync();
#if PH & (1 << 2)
  { IDS
  for (int t = gw; t < MT; t += ngw) post_row(p, t, lane);
  {
    const int vb = tid >> 8, vbid = bid * 2 + vb;
    char* sm = smem + vb * VB_LDS;
    for (int rep = 0; rep < NREP(2); ++rep) for (int t = vbid * NQ; t < MT; t += nb * 2 * NQ)
      topk_group(p, t, sm, (unsigned*)(p.out + O_Y + 14000000) + (size_t)vbid * 16384, (unsigned*)(p.out + O_Y + 14000000) + (size_t)(512 + vbid) * 16384,
                 (unsigned*)p.H + (size_t)vbid * 16384);
  }
  }
#endif
  grid.sync();
#if PH & (1 << 3)
  { IDS
    const int total = 1024 + 256;
    for (int rep = 0; rep < NREP(3); ++rep) {
      u16* gdst = (rep + 1 < NREP(3)) ? (u16*)(p.out + O_Y) : p.GA;
      for (int r = 0;; ++r) {
        int id = (r & 1) ? r * nb + (nb - 1 - bid) : r * nb + bid;
        if (r * nb >= total) break;
        if (id < total) attn_item<1>(p, id, smem, gdst);
      }
    }
  }
#endif
  grid.sync();
#if PH & (1 << 4)
  { IDS
  {
    const int gt = bid * NTHREADS + tid, ngt = nb * NTHREADS;
    for (int i = gt; i < MS * 2048 / 4; i += ngt)
      *(f32x4*)(p.out + O_Y + (size_t)MP * 2048 + (size_t)i * 4) = *(const f32x4*)(p.x_s + (size_t)i * 4);
    for (int i = gt; i < 16 * 2048 * 6; i += ngt) {
      int r = i / 6, c = i - r * 6;
      *(u32x4*)(p.VBT_S + (size_t)r * VSS + SK + c * 8) = (u32x4){0u, 0u, 0u, 0u};
    }
    const int nqb = (MT / 256) * 12, nkb = (KROWS / 256) * 8;
    const int total = nqb + 2 * nkb;
    for (int id = bid; id < total; id += nb) {
      if (id < nqb) gemm_phase<EPI_QB>(p, p.CQ, 512, p.WT_UQ, 512, 512, MT / 256, 12, smem, p.QB, 3072, id, 1 << 30);
      else if (id < nqb + nkb) gemm_phase<EPI_BF16>(p, p.CKV, 256, p.WT_UK, 256, 256, KROWS / 256, 8, smem, p.KB, 2048, id - nqb, 1 << 30);
      else gemm_phase<EPI_VT>(p, p.CKV, 256, p.WT_UV, 256, 256, KROWS / 256, 8, smem, nullptr, 0, id - nqb - nkb, 1 << 30);
    }
  }
  }
#endif
  grid.sync();
#if PH & (1 << 5)
  { IDS
  {
    const int total = 1024 + 256;
    for (int rep = 0; rep < NREP(5); ++rep) {
      u16* gdst = (rep + 1 < NREP(5)) ? (u16*)(p.out + O_Y) : p.GB;
      for (int r = 0;; ++r) {
        int id = (r & 1) ? r * nb + (nb - 1 - bid) : r * nb + bid;
        if (r * nb >= total) break;
        if (id < total) attn_item<0>(p, id, smem, gdst);
      }
    }
  }
  }
#endif
  grid.sync();
#if PH & (1 << 6)
  { IDS
  gemm_phase<EPI_RES>(p, p.GB, 2048, p.WT_OUT, 2048, 2048, MT / 256 - 1, 8, smem, nullptr, 0, bid, nb);
  for (int id = bid; id < 128; id += nb) {
    const int nt = id & 7, kc = id >> 3;
    gemm_tile<EPI_ATOM>(p, p.GB + kc * 128, 2048, p.WT_OUT + kc * 128, 2048, 128, (MT / 256 - 1) * 256, nt * 256, smem, nullptr, 0);
  }
  }
#endif
  grid.sync();
#if PH & (1 << 7)
  { IDS
  for (int r = gw; r < MT; r += ngw) rms_row_2048(p.out + O_Y + (size_t)r * 2048, p.g_ffn, p.H2 + (size_t)r * 2048, lane);
  }
#endif
  grid.sync();
#if PH & (1 << 8)
  { IDS
  for (int rep = 0; rep < NREP(8); ++rep) gemm_phase<EPI_RELU2>(p, p.H2, 2048, p.WT_UP, 2048, 2048, MT / 256, 32, smem, nullptr, 0, bid, nb);
  }
#endif
  grid.sync();
#if PH & (1 << 9)
  { IDS
  gemm_phase<EPI_ACC>(p, p.U, DFF, p.WT_DOWN, DFF, DFF, MT / 256 - 1, 8, smem, nullptr, 0, bid, nb);
  for (int id = bid; id < 256; id += nb) {
    const int nt = id & 7, kc = id >> 3;
    gemm_tile<EPI_ATOM>(p, p.U + kc * 256, DFF, p.WT_DOWN + kc * 256, DFF, 256, (MT / 256 - 1) * 256, nt * 256, smem, nullptr, 0);
  }
  }
#endif
  grid.sync();
#if PH & (1 << 10)
  { IDS
  for (int r = gw; r < MT; r += ngw) {
    float* x = p.out + O_Y + (size_t)r * 2048;
    f32x4 v[8];
    float ss = 0.f;
#pragma unroll
    for (int i = 0; i < 8; ++i) {
      v[i] = *(const f32x4*)(x + i * 256 + lane * 4);
      ss += v[i][0] * v[i][0] + v[i][1] * v[i][1] + v[i][2] * v[i][2] + v[i][3] * v[i][3];
    }
    ss = wave_sum(ss);
    float rr = rsqrtf(ss * (1.f / 2048.f) + 1e-6f);
#pragma unroll
    for (int i = 0; i < 8; ++i) {
      f32x4 gg = *(const f32x4*)(p.g_fin + i * 256 + lane * 4);
      f32x4 o = {v[i][0] * rr * gg[0], v[i][1] * rr * gg[1], v[i][2] * rr * gg[2], v[i][3] * rr * gg[3]};
      *(f32x4*)(x + i * 256 + lane * 4) = o;
    }
  }
  }
#endif
}

extern "C" void kernel_launch(void* const* d_in, const int* in_sizes, int n_in, void* d_out, int out_size, void* d_ws, size_t ws_size,
                              hipStream_t stream) {
  static int grid_blocks = 0;
  if (!grid_blocks) {
    int dev = 0, cus = 0, per_cu = 0;
    hipGetDevice(&dev);
    hipDeviceGetAttribute(&cus, hipDeviceAttributeMultiprocessorCount, dev);
    if (hipFuncSetAttribute((const void*)fwd_megakernel, hipFuncAttributeMaxDynamicSharedMemorySize, LDS_BYTES) != hipSuccess)
      fprintf(stderr, "kernel_launch: hipFuncSetAttribute failed\n");
    hipOccupancyMaxActiveBlocksPerMultiprocessor(&per_cu, (const void*)fwd_megakernel, NTHREADS, LDS_BYTES);
    if (per_cu < 1) per_cu = 1;
    if (per_cu > 1) per_cu = 1;
    grid_blocks = cus * per_cu;
  }
  Params p{};
  const float* const* in = (const float* const*)d_in;
  p.x_p = in[0]; p.x_s = in[1]; p.c_ak = in[2]; p.c_av = in[3]; p.c_idx = in[4]; p.c_ckv = in[5]; p.c_kr = in[6]; p.rel = in[7];
  p.g_mix = in[8]; p.w_in = in[9]; p.g_q = in[10]; p.w_uq = in[11]; p.g_kv = in[12]; p.w_uk = in[13]; p.w_uv = in[14]; p.w_out = in[15];
  p.g_ffn = in[16]; p.w_up = in[17]; p.w_down = in[18]; p.g_fin = in[19];
  p.out = (float*)d_out;
  char* ws = (char*)d_ws;
  size_t off = 0;
  auto alloc = [&](size_t bytes) { char* r = ws + off; off += (bytes + 255) & ~(size_t)255; return r; };
  p.WT_UQ = (u16*)alloc((size_t)3072 * 512 * 2);
  p.WT_UK = (u16*)alloc((size_t)2048 * 256 * 2);
  p.WT_UV = (u16*)alloc((size_t)2048 * 256 * 2);
  p.WT_OUT = (u16*)alloc((size_t)2048 * 2048 * 2);
  p.WT_UP = (u16*)alloc((size_t)8192 * 2048 * 2);
  p.WT_DOWN = (u16*)alloc((size_t)2048 * 8192 * 2);
  p.CQ = (u16*)alloc((size_t)MT * 512 * 2);
  p.CKV = (u16*)alloc((size_t)KROWS * 256 * 2);
  p.KR = (u16*)alloc((size_t)KROWS * 64 * 2);
  p.GA = (u16*)alloc((size_t)MT * 2048 * 2);
  p.GB = (u16*)alloc((size_t)MT * 2048 * 2);
  p.CS = (float*)alloc((size_t)MT * 32 * 4);
  p.SN = (float*)alloc((size_t)MT * 32 * 4);
  const size_t ubase = off;
  p.WT_IN = (u16*)alloc((size_t)INP * 2048 * 2);
  p.H = (u16*)alloc((size_t)MT * 2048 * 2);
  p.AQ = (u16*)alloc((size_t)MT * 2048 * 2);
  p.KA = (u16*)alloc((size_t)MP * 2048 * 2);
  p.VAT = (u16*)alloc((size_t)MP * 2048 * 2);
  p.IXQ = (u16*)alloc((size_t)MT * 1024 * 2);
  p.IXK = (u16*)alloc((size_t)KROWS * 64 * 2);
  p.SEL = (unsigned long long*)alloc((size_t)MT * 256 * 8);
  p.IXW = (float*)alloc((size_t)MT * 16 * 4);
  const size_t endA = off;
  off = ubase;
  p.QB = (u16*)alloc((size_t)MT * 3072 * 2);
  p.KB = (u16*)alloc((size_t)KROWS * 2048 * 2);
  p.VBT_P = (u16*)alloc((size_t)2048 * MP * 2);
  p.VBT_S = (u16*)alloc((size_t)16 * 2048 * VSS * 2);
  const size_t endB = off;
  off = ubase;
  p.H2 = (u16*)alloc((size_t)MT * 2048 * 2);
  p.U = (u16*)alloc((size_t)MT * DFF * 2);
  const size_t endC = off;
  size_t need = endA > endB ? endA : endB;
  if (endC > need) need = endC;
  if (need > ws_size) { fprintf(stderr, "kernel_launch: workspace too small: need %zu have %zu\n", need, ws_size); return; }
  void* args[] = {&p};
  hipError_t e = hipLaunchCooperativeKernel((const void*)fwd_megakernel, dim3(grid_blocks), dim3(NTHREADS), args, LDS_BYTES, stream);
  if (e != hipSuccess) fprintf(stderr, "cooperative launch failed: %s (grid %d)\n", hipGetErrorString(e), grid_blocks);
}
```

```cpp
#include <hip/hip_runtime.h>
#include <hip/hip_cooperative_groups.h>
#include <cstdio>
#include <cstdint>
namespace cg = cooperative_groups;

typedef unsigned short u16;
typedef __attribute__((ext_vector_type(8))) short bf16x8;
typedef __attribute__((ext_vector_type(4))) short bf16x4;
typedef __attribute__((ext_vector_type(4))) float f32x4;
typedef __attribute__((ext_vector_type(2))) float f32x2;
typedef __attribute__((ext_vector_type(2))) __bf16 bf16x2_t;
typedef __attribute__((ext_vector_type(4))) unsigned u32x4;
typedef __attribute__((ext_vector_type(2))) unsigned u32x2;

#define DI __device__ __forceinline__

constexpr int MP = 16384;
constexpr int MS = 256;
constexpr int MT = MP + MS;
constexpr int DM = 2048;
constexpr int INC = 12176;
constexpr int INP = 12288;
constexpr int SK = 1040;
constexpr int KROWS = MP + 16 * SK;
constexpr int VSS = 1088;
constexpr int DFF = 8192;
constexpr int ZRW = 832;
#ifndef PH
#define PH 0x7ff
#endif
#ifndef REP
#define REP 0
#endif
#define NREP(k) (((REP >> (k)) & 1) + 1)
constexpr int NTHREADS = 512;
constexpr int VB_LDS = 75776;
constexpr int LDS_BYTES = 2 * VB_LDS;

constexpr size_t O_Y = 0;
constexpr size_t O_AKP = 34078720;
constexpr size_t O_AVP = 67633152;
constexpr size_t O_IDXP = 101187584;
constexpr size_t O_CKVP = 102236160;
constexpr size_t O_KRP = 106430464;
constexpr size_t O_AKS = 107479040;
constexpr size_t O_AVS = 108003328;
constexpr size_t O_IDXS = 108527616;
constexpr size_t O_CKVS = 108544000;
constexpr size_t O_KRS = 108609536;

struct Params {
  const float *x_p, *x_s, *c_ak, *c_av, *c_idx, *c_ckv, *c_kr, *rel, *g_mix, *w_in, *g_q, *w_uq, *g_kv, *w_uk, *w_uv, *w_out, *g_ffn, *w_up, *w_down, *g_fin;
  float* out;
  u16 *WT_UQ, *WT_UK, *WT_UV, *WT_OUT, *WT_UP, *WT_DOWN, *CQ, *CKV, *KR, *GA, *GB;
  float *CS, *SN;
  u16 *WT_IN, *H, *AQ, *KA, *VAT, *IXQ, *IXK;
  float* IXW;
  unsigned long long* SEL;
  u16 *QB, *KB, *VBT_P, *VBT_S;
  u16 *H2, *U;
};

DI int otid() { int t = threadIdx.x; asm volatile("" : "+v"(t)); return t; }
DI unsigned cvtpk(float lo, float hi) {
  f32x2 v = {lo, hi};
  bf16x2_t b = __builtin_convertvector(v, bf16x2_t);
  return __builtin_bit_cast(unsigned, b);
}
DI u16 f2bf(float x) { return (u16)(cvtpk(x, 0.f) & 0xffffu); }
DI float bf2f(u16 b) { return __uint_as_float(((unsigned)b) << 16); }
DI float bflo(unsigned w) { return __uint_as_float(w << 16); }
DI float bfhi(unsigned w) { return __uint_as_float(w & 0xffff0000u); }
DI float dot2bf(unsigned a, unsigned b, float c) {
  return __builtin_amdgcn_fdot2_f32_bf16(__builtin_bit_cast(bf16x2_t, a), __builtin_bit_cast(bf16x2_t, b), c, false);
}
DI float wave_sum(float v) {
#pragma unroll
  for (int o = 32; o > 0; o >>= 1) v += __shfl_xor(v, o);
  return v;
}
DI int qpos_of(int t) { return t < MP ? t : 1024 + ((t - MP) & 15); }
DI int krow_of(int t) { return t < MP ? t : MP + ((t - MP) >> 4) * SK + 1024 + ((t - MP) & 15); }
DI float inv_freq(int i) { return exp2f(-(float)i * 0.41524101186092029f); }

DI void transpose_tile(const float* __restrict__ W, int K, int N, u16* __restrict__ Wt, int tile, float* s  ) {
  const int nkt = K >> 6;
  const int kt = tile % nkt, nt = tile / nkt;
  const int k0 = kt << 6, n0 = nt << 6;
  const int tid = otid() & 255;
  const int c = tid & 63, r0 = tid >> 6;
  __syncthreads();
#pragma unroll
  for (int i = 0; i < 16; ++i) {
    int r = i * 4 + r0;
    float v = (n0 + c < N) ? W[(size_t)(k0 + r) * N + n0 + c] : 0.f;
    s[r * 65 + c] = v;
  }
  __syncthreads();
  const int kp = (tid & 31) * 2, rr0 = tid >> 5;
#pragma unroll
  for (int i = 0; i < 8; ++i) {
    int rr = i * 8 + rr0;
    unsigned pk = cvtpk(s[kp * 65 + rr], s[(kp + 1) * 65 + rr]);
    *(unsigned*)(Wt + (size_t)(n0 + rr) * K + k0 + kp) = pk;
  }
}

DI void rms_row_2048(const float* __restrict__ x, const float* __restrict__ g, u16* __restrict__ out, int lane) {
  f32x4 v[8];
  float ss = 0.f;
#pragma unroll
  for (int i = 0; i < 8; ++i) {
    v[i] = *(const f32x4*)(x + i * 256 + lane * 4);
    ss += v[i][0] * v[i][0] + v[i][1] * v[i][1] + v[i][2] * v[i][2] + v[i][3] * v[i][3];
  }
  ss = wave_sum(ss);
  float r = rsqrtf(ss * (1.f / 2048.f) + 1e-6f);
#pragma unroll
  for (int i = 0; i < 8; ++i) {
    f32x4 gg = *(const f32x4*)(g + i * 256 + lane * 4);
    u32x2 o;
    o[0] = cvtpk(v[i][0] * r * gg[0], v[i][1] * r * gg[1]);
    o[1] = cvtpk(v[i][2] * r * gg[2], v[i][3] * r * gg[3]);
    *(u32x2*)(out + i * 256 + lane * 4) = o;
  }
}

enum { EPI_IN = 0, EPI_QB, EPI_BF16, EPI_VT, EPI_RES, EPI_RELU2, EPI_ACC, EPI_ATOM };
constexpr float QSC = 0.07216878364870322f * 1.4426950408889634f;
constexpr int LSTR = 64;
#ifndef PFA
#define PFA 8
#endif

template <int EPI> struct EpiSwap { static constexpr bool v = (EPI != EPI_VT); };

DI u32x2 pack4(f32x4 v) { u32x2 r; r[0] = cvtpk(v[0], v[1]); r[1] = cvtpk(v[2], v[3]); return r; }
DI float sigm(float v) { return 1.f / (1.f + __expf(-v)); }

template <int EPI>
DI void gemm_epilogue(const Params& p, f32x4 (&acc)[8][4], int m0, int n0, int wr, int wc, int fr, int fq, u16* Cb, int ldc) {
  const int cw = n0 + wc * 64;
  if (EPI == EPI_VT) {
#pragma clang loop unroll(full)
    for (int m = 0; m < 8; ++m) {
      const int rb = m0 + wr * 128 + m * 16 + fq * 4;
#pragma clang loop unroll(full)
      for (int n = 0; n < 4; ++n) {
        const int col = cw + n * 16 + fr;
        u16* dst;
        if (rb < MP) dst = p.VBT_P + (size_t)col * MP + rb;
        else { int r2 = rb - MP; int b = r2 / SK; int s = r2 - b * SK; dst = p.VBT_S + ((size_t)b * 2048 + col) * VSS + s; }
        *(u32x2*)dst = pack4(acc[m][n]);
      }
    }
    return;
  }
  const int rbase = m0 + wr * 128 + fr;
  const int c4 = fq * 4;
  if (EPI == EPI_QB) {
    if (cw % 192 == 128) {
#pragma clang loop unroll(full)
      for (int m = 0; m < 8; ++m) {
        const int row = rbase + m * 16;
#pragma clang loop unroll(full)
        for (int n = 0; n < 2; ++n) {
          const int i0 = n * 16 + c4;
          const f32x4 cs = *(const f32x4*)(p.CS + (size_t)row * 32 + i0), sn = *(const f32x4*)(p.SN + (size_t)row * 32 + i0);
          const f32x4 x1 = acc[m][n] * QSC, x2 = acc[m][n + 2] * QSC;
          *(u32x2*)(p.QB + (size_t)row * 3072 + cw + i0) = pack4(x1 * cs - x2 * sn);
          *(u32x2*)(p.QB + (size_t)row * 3072 + cw + i0 + 32) = pack4(x1 * sn + x2 * cs);
        }
      }
      return;
    }
  }
#pragma clang loop unroll(full)
  for (int n = 0; n < 4; ++n) {
    const int colt = cw + n * 16;
    const int col = colt + c4;
    if (EPI == EPI_IN) {
      const bool smp = m0 >= MP;
      if (colt < 2048) {
#pragma clang loop unroll(full)
        for (int m = 0; m < 8; ++m) *(u32x2*)(p.AQ + (size_t)(rbase + m * 16) * 2048 + col) = pack4(acc[m][n] * (0.08838834764831845f * 1.4426950408889634f));
      } else if (colt < 4096) {
        const int c = col - 2048;
#pragma clang loop unroll(full)
        for (int m = 0; m < 8; ++m) {
          const int row = rbase + m * 16;
          if (!smp) { *(f32x4*)(p.out + O_AKP + (size_t)row * 2048 + c) = acc[m][n]; *(u32x2*)(p.KA + (size_t)row * 2048 + c) = pack4(acc[m][n]); }
          else *(f32x4*)(p.out + O_AKS + (size_t)(row - MP) * 2048 + c) = acc[m][n];
        }
      } else if (colt < 6144) {
        const int c = col - 4096;
#pragma clang loop unroll(full)
        for (int m = 0; m < 8; ++m) {
          const int row = rbase + m * 16;
          if (!smp) {
            *(f32x4*)(p.out + O_AVP + (size_t)row * 2048 + c) = acc[m][n];
#pragma clang loop unroll(full)
            for (int j = 0; j < 4; ++j) p.VAT[(size_t)(c + j) * MP + row] = f2bf(acc[m][n][j]);
          } else *(f32x4*)(p.out + O_AVS + (size_t)(row - MP) * 2048 + c) = acc[m][n];
        }
      } else if (colt < 7168) {
#pragma clang loop unroll(full)
        for (int m = 0; m < 8; ++m) *(u32x2*)(p.IXQ + (size_t)(rbase + m * 16) * 1024 + (col - 6144)) = pack4(acc[m][n]);
      } else if (colt < 7232) {
        const int c = col - 7168;
#pragma clang loop unroll(full)
        for (int m = 0; m < 8; ++m) {
          const int row = rbase + m * 16;
          if (!smp) *(f32x4*)(p.out + O_IDXP + (size_t)row * 64 + c) = acc[m][n];
          else *(f32x4*)(p.out + O_IDXS + (size_t)(row - MP) * 64 + c) = acc[m][n];
          *(u32x2*)(p.IXK + (size_t)krow_of(row) * 64 + c) = pack4(acc[m][n]);
        }
      } else if (colt < 7248) {
#pragma clang loop unroll(full)
        for (int m = 0; m < 8; ++m) *(f32x4*)(p.IXW + (size_t)(rbase + m * 16) * 16 + (col - 7232)) = acc[m][n] * 0.25f;
      } else if (colt < 8080) {
#pragma clang loop unroll(full)
        for (int m = 0; m < 8; ++m) *(f32x4*)(p.out + O_Y + (size_t)(rbase + m * 16) * ZRW + (col - 7248)) = acc[m][n];
      } else if (colt < INC) {
        u16* G = colt < 10128 ? p.GA : p.GB;
        const int c = colt < 10128 ? col - 8080 : col - 10128;
#pragma clang loop unroll(full)
        for (int m = 0; m < 8; ++m) {
          f32x4 v = acc[m][n];
          f32x4 g = {sigm(v[0]), sigm(v[1]), sigm(v[2]), sigm(v[3])};
          *(u32x2*)(G + (size_t)(rbase + m * 16) * 2048 + c) = pack4(g);
        }
      }
    } else {
#pragma clang loop unroll(full)
      for (int m = 0; m < 8; ++m) {
        const int row = rbase + m * 16;
        const f32x4 v = acc[m][n];
        if (EPI == EPI_QB) {
          *(u32x2*)(Cb + (size_t)row * ldc + col) = pack4(v * QSC);
        } else if (EPI == EPI_BF16) {
          *(u32x2*)(Cb + (size_t)row * ldc + col) = pack4(v);
        } else if (EPI == EPI_RES) {
          const f32x4 xv = row < MP ? *(const f32x4*)(p.x_p + (size_t)row * 2048 + col) : *(const f32x4*)(p.x_s + (size_t)(row - MP) * 2048 + col);
          *(f32x4*)(p.out + O_Y + (size_t)row * 2048 + col) = xv + v;
          if ((m & 3) == 3) __builtin_amdgcn_sched_barrier(0);
        } else if (EPI == EPI_RELU2) {
          f32x4 r = {fmaxf(v[0], 0.f), fmaxf(v[1], 0.f), fmaxf(v[2], 0.f), fmaxf(v[3], 0.f)};
          *(u32x2*)(p.U + (size_t)row * DFF + col) = pack4(r * r);
        } else if (EPI == EPI_ACC) {
          float* d = p.out + O_Y + (size_t)row * 2048 + col;
          *(f32x4*)d = *(const f32x4*)d + v;
          if ((m & 3) == 3) __builtin_amdgcn_sched_barrier(0);
        } else if (EPI == EPI_ATOM) {
#pragma clang loop unroll(full)
          for (int j = 0; j < 4; ++j) atomicAdd(p.out + O_Y + (size_t)row * 2048 + col + j, v[j]);
        }
      }
    }
  }
}

constexpr int GSTAGE = 512 * LSTR;
template <int EPI>
DI void gemm_tile(const Params& p, const u16* __restrict__ A, int lda, const u16* __restrict__ Bt, int ldb, int K, int m0, int n0,
                  char* smem, u16* Cb, int ldc) {
  u16* sbase = (u16*)smem;
  const int tid = otid(), lane = tid & 63, w = tid >> 6;
  const int wr = w >> 2, wc = w & 3, fr = lane & 15, fq = lane >> 4;
  f32x4 acc[8][4];
#pragma unroll
  for (int m = 0; m < 8; ++m)
#pragma unroll
    for (int n = 0; n < 4; ++n) acc[m][n] = (f32x4){0.f, 0.f, 0.f, 0.f};
  const int lr = tid >> 3, lk = (tid & 7) * 8;
  const int lkw = ((tid & 7) ^ ((lr >> 1) & 7)) * 8;
  const int fsw = (fr >> 1) & 7, fo0 = (fq ^ fsw) * 8, fo1 = ((4 + fq) ^ fsw) * 8;
  const u16* Ag = A + (size_t)(m0 + lr) * lda + lk;
  const u16* Bg = Bt + (size_t)(n0 + lr) * ldb + lk;
  const int nk = K >> 6;
  u32x4 ra[4], rb[4];
#define G_LOAD(T) { const int k_ = (T) << 6; _Pragma("unroll") for (int i = 0; i < 4; ++i) { \
    ra[i] = *(const u32x4*)(Ag + (size_t)(i * 64) * lda + k_); rb[i] = *(const u32x4*)(Bg + (size_t)(i * 64) * ldb + k_); } }
#define L_STORE(ST) { u16* dA_ = sbase + (ST) * GSTAGE + lr * LSTR + lkw; u16* dB_ = dA_ + 256 * LSTR; _Pragma("unroll") for (int i = 0; i < 4; ++i) { \
    *(u32x4*)(dA_ + i * 64 * LSTR) = ra[i]; *(u32x4*)(dB_ + i * 64 * LSTR) = rb[i]; } }
  G_LOAD(0)
  L_STORE(0)
  G_LOAD(1)
#pragma unroll 1
  for (int kt = 0; kt < nk; ++kt) {
    __syncthreads();
    if (kt + 1 < nk) L_STORE((kt + 1) & 1)
    G_LOAD(min(kt + 2, nk - 1))
    const u16* cA = sbase + (kt & 1) * GSTAGE + (wr * 128 + fr) * LSTR;
    const u16* cB = sbase + (kt & 1) * GSTAGE + 256 * LSTR + (wc * 64 + fr) * LSTR;
#pragma unroll
    for (int ks = 0; ks < 2; ++ks) {
      bf16x8 bfr[4];
#pragma unroll
      for (int n = 0; n < 4; ++n) bfr[n] = *(const bf16x8*)(cB + n * 16 * LSTR + (ks ? fo1 : fo0));
#pragma unroll
      for (int mh = 0; mh < 2; ++mh) {
        bf16x8 af[4];
#pragma unroll
        for (int m = 0; m < 4; ++m) af[m] = *(const bf16x8*)(cA + (mh * 4 + m) * 16 * LSTR + (ks ? fo1 : fo0));
        __builtin_amdgcn_s_setprio(1);
#pragma unroll
        for (int m = 0; m < 4; ++m)
#pragma unroll
          for (int n = 0; n < 4; ++n)
            acc[mh * 4 + m][n] = EpiSwap<EPI>::v ? __builtin_amdgcn_mfma_f32_16x16x32_bf16(bfr[n], af[m], acc[mh * 4 + m][n], 0, 0, 0)
                                                 : __builtin_amdgcn_mfma_f32_16x16x32_bf16(af[m], bfr[n], acc[mh * 4 + m][n], 0, 0, 0);
        __builtin_amdgcn_s_setprio(0);
      }
    }
  }
#undef G_LOAD
#undef L_STORE
  gemm_epilogue<EPI>(p, acc, m0, n0, wr, wc, fr, fq, Cb, ldc);
}

template <int EPI>
DI void gemm_phase(const Params& p, const u16* A, int lda, const u16* Bt, int ldb, int K, int mtiles, int ntiles, char* smem, u16* Cb, int ldc,
                   int start, int stride) {
  if (stride == 256) {
    const int gm = (mtiles + 3) >> 2, gn = (ntiles + 7) >> 3, nsg = gm * gn;
    const int xcd = start & 7, li = start >> 3;
    for (int sg = xcd; sg < nsg; sg += 8) {
      const int gni = sg / gm, gmi = sg - gni * gm;
      const int mt = gmi * 4 + (li & 3), nt = gni * 8 + (li >> 2);
      if (mt < mtiles && nt < ntiles) gemm_tile<EPI>(p, A, lda, Bt, ldb, K, mt * 256, nt * 256, smem, Cb, ldc);
    }
    return;
  }
  const int total = mtiles * ntiles;
  const int GM = 8;
  for (int id = start; id < total; id += stride) {
    const int per = GM * ntiles;
    const int g = id / per, rem = id - g * per;
    const int fm = g * GM;
    const int gsz = min(GM, mtiles - fm);
    const int mt = fm + rem % gsz, nt = rem / gsz;
    gemm_tile<EPI>(p, A, lda, Bt, ldb, K, mt * 256, nt * 256, smem, Cb, ldc);
  }
}

DI void post_row(const Params& p, int t, int lane) {
  const float* zr = p.out + O_Y + (size_t)t * ZRW;
  {
    f32x4 a = *(const f32x4*)(zr + lane * 4), b = *(const f32x4*)(zr + 256 + lane * 4);
    float ss = a[0] * a[0] + a[1] * a[1] + a[2] * a[2] + a[3] * a[3] + b[0] * b[0] + b[1] * b[1] + b[2] * b[2] + b[3] * b[3];
    ss = wave_sum(ss);
    float r = rsqrtf(ss * (1.f / 512.f) + 1e-6f);
    f32x4 ga = *(const f32x4*)(p.g_q + lane * 4), gb = *(const f32x4*)(p.g_q + 256 + lane * 4);
    u32x2 o;
    o[0] = cvtpk(a[0] * r * ga[0], a[1] * r * ga[1]); o[1] = cvtpk(a[2] * r * ga[2], a[3] * r * ga[3]);
    *(u32x2*)(p.CQ + (size_t)t * 512 + lane * 4) = o;
    o[0] = cvtpk(b[0] * r * gb[0], b[1] * r * gb[1]); o[1] = cvtpk(b[2] * r * gb[2], b[3] * r * gb[3]);
    *(u32x2*)(p.CQ + (size_t)t * 512 + 256 + lane * 4) = o;
  }
  const int kr_row = krow_of(t);
  {
    f32x4 a = *(const f32x4*)(zr + 512 + lane * 4);
    float ss = a[0] * a[0] + a[1] * a[1] + a[2] * a[2] + a[3] * a[3];
    ss = wave_sum(ss);
    float r = rsqrtf(ss * (1.f / 256.f) + 1e-6f);
    f32x4 g = *(const f32x4*)(p.g_kv + lane * 4);
    f32x4 o = {a[0] * r * g[0], a[1] * r * g[1], a[2] * r * g[2], a[3] * r * g[3]};
    float* od = t < MP ? p.out + O_CKVP + (size_t)t * 256 : p.out + O_CKVS + (size_t)(t - MP) * 256;
    *(f32x4*)(od + lane * 4) = o;
    u32x2 ob; ob[0] = cvtpk(o[0], o[1]); ob[1] = cvtpk(o[2], o[3]);
    *(u32x2*)(p.CKV + (size_t)kr_row * 256 + lane * 4) = ob;
  }
  if (lane < 32) {
    float x1 = zr[768 + lane], x2 = zr[768 + 32 + lane];
    float ang = (float)qpos_of(t) * inv_freq(lane);
    float cs = cosf(ang), sn = sinf(ang);
    p.CS[(size_t)t * 32 + lane] = cs; p.SN[(size_t)t * 32 + lane] = sn;
    float o1 = x1 * cs - x2 * sn, o2 = x1 * sn + x2 * cs;
    float* od = t < MP ? p.out + O_KRP + (size_t)t * 64 : p.out + O_KRS + (size_t)(t - MP) * 64;
    od[lane] = o1; od[lane + 32] = o2;
    p.KR[(size_t)kr_row * 64 + lane] = f2bf(o1);
    p.KR[(size_t)kr_row * 64 + lane + 32] = f2bf(o2);
  }
}

template <int CTRL> DI float dpp_add(float v) {
  int sft = __builtin_amdgcn_update_dpp(0, __float_as_int(v), CTRL, 0xf, 0xf, true);
  return v + __int_as_float(sft);
}
DI float row16_sum(float v) { v = dpp_add<0x111>(v); v = dpp_add<0x112>(v); v = dpp_add<0x114>(v); v = dpp_add<0x118>(v); return v; }
DI unsigned fkey(float f) { unsigned u = __float_as_uint(f); return (u & 0x80000000u) ? ~u : (u | 0x80000000u); }

DI void radix_select(unsigned* sc, int* hist, int* misc, int n, unsigned long long* sel, int tid, int lane, int w) {
  __syncthreads();
  unsigned prefix = 0;
  int remaining = 256;
#pragma unroll 1
  for (int pass = 0; pass < 3; ++pass) {
    const int shift = pass == 0 ? 21 : (pass == 1 ? 10 : 0);
    const int bits = pass == 2 ? 10 : 11;
    const unsigned bmask = (1u << bits) - 1u;
    if (pass > 0) {
      *(int4*)&hist[tid * 8] = make_int4(0, 0, 0, 0);
      *(int4*)&hist[tid * 8 + 4] = make_int4(0, 0, 0, 0);
      __syncthreads();
      const int hs = shift + bits;
      const unsigned want = prefix >> hs;
      for (int i = tid * 4; i < n; i += 256 * 4) {
        const u32x4 u4 = *(const u32x4*)(sc + i);
#pragma unroll
        for (int e = 0; e < 4; ++e)
          if ((u4[e] >> hs) == want) atomicAdd(&hist[(u4[e] >> shift) & bmask], 1);
      }
      __syncthreads();
    }
    const int4 h0 = *(const int4*)&hist[tid * 8], h1 = *(const int4*)&hist[tid * 8 + 4];
    const int s8 = h0.x + h0.y + h0.z + h0.w + h1.x + h1.y + h1.z + h1.w;
    int suf = s8;
#pragma unroll
    for (int d = 1; d < 64; d <<= 1) { int v = __shfl_down(suf, d); if (lane + d < 64) suf += v; }
    if (lane == 0) misc[w] = suf;
    __syncthreads();
    int above = 0;
    for (int ww = w + 1; ww < 4; ++ww) above += misc[ww];
    const int excl = above + suf - s8;
    if (excl < remaining && remaining <= excl + s8) {
      int c = excl, bin = 0, nrem = 0;
#define TK_STEP(val, idx) if (c < remaining && remaining <= c + (val)) { bin = tid * 8 + (idx); nrem = remaining - c; } c += (val);
      TK_STEP(h1.w, 7) TK_STEP(h1.z, 6) TK_STEP(h1.y, 5) TK_STEP(h1.x, 4) TK_STEP(h0.w, 3) TK_STEP(h0.z, 2) TK_STEP(h0.y, 1) TK_STEP(h0.x, 0)
#undef TK_STEP
      misc[4] = bin; misc[5] = nrem;
    }
    __syncthreads();
    prefix |= ((unsigned)misc[4]) << shift;
    remaining = misc[5];
    __syncthreads();
  }
  const unsigned T = prefix;
  const int seg = ((n + 255) >> 8) << 6;
  const int beg = w * seg;
  int ceq = 0;
  for (int i = beg + lane; i < beg + seg; i += 64) {
    bool in = i < n; unsigned u = in ? sc[i] : 0u;
    ceq += __popcll(__ballot(in && u == T));
  }
  if (lane == 0) misc[12 + w] = ceq;
  __syncthreads();
  int oe = 0;
  for (int ww = 0; ww < w; ++ww) oe += misc[12 + ww];
  const unsigned long long lt = (1ull << lane) - 1ull;
  for (int i0 = beg; i0 < beg + seg; i0 += 64) {
    const int i = i0 + lane;
    bool in = i < n; unsigned u = in ? sc[i] : 0u;
    bool g = in && u > T, e = in && u == T;
    unsigned long long be = __ballot(e);
    int pe = oe + __popcll(be & lt);
    unsigned long long sm = __ballot(g || (e && pe < remaining));
    if (lane == 0 && i0 < n) sel[i0 >> 6] = sm;
    oe += __popcll(be);
  }
}

constexpr int NQ = 4;
DI void topk_group(const Params& p, int t, char* smem, unsigned* scr1, unsigned* scr2, unsigned* scr3) {
  unsigned* sc = (unsigned*)smem;
  int* hist = (int*)(smem + 65536);
  int* misc = hist + 2048;
  const int tid = otid() & 255, lane = tid & 63, w = tid >> 6, fr = lane & 15, fq = lane >> 4;
  int n; const u16* ixk;
  if (t < MP) { n = 64 * ((t >> 6) + 1); ixk = p.IXK; }
  else { int b = (t - MP) >> 4; n = SK; ixk = p.IXK + (size_t)(MP + b * SK) * 64; }
  unsigned long long* sel = p.SEL + (size_t)t * 256;
  __syncthreads();
  if (n <= 256) {
    if (tid < 4) {
      unsigned long long v = (tid < (n >> 6)) ? ~0ull : 0ull;
#pragma unroll
      for (int qi = 0; qi < NQ; ++qi) sel[qi * 256 + tid] = v;
    }
    return;
  }
  *(int4*)&hist[tid * 8] = make_int4(0, 0, 0, 0);
  *(int4*)&hist[tid * 8 + 4] = make_int4(0, 0, 0, 0);
  __syncthreads();
  {
    const u16* q = p.IXQ + (size_t)t * 1024 + fr * 64 + fq * 8;
    bf16x8 a0[NQ], a1[NQ];
    f32x4 wv[NQ];
#pragma unroll
    for (int qi = 0; qi < NQ; ++qi) {
      a0[qi] = *(const bf16x8*)(q + qi * 1024); a1[qi] = *(const bf16x8*)(q + qi * 1024 + 32);
      wv[qi] = *(const f32x4*)(p.IXW + (size_t)(t + qi) * 16 + fq * 4);
    }
    const int ntile = n >> 4;
    for (int kt0 = w; kt0 < ntile; kt0 += 32) {
      bf16x8 b0[8], b1[8];
#pragma unroll
      for (int g = 0; g < 8; ++g) {
        const int kt = min(kt0 + g * 4, ntile - 1);
        const u16* kp = ixk + (size_t)(kt * 16 + fr) * 64 + fq * 8;
        b0[g] = *(const bf16x8*)kp; b1[g] = *(const bf16x8*)(kp + 32);
      }
      float pt[NQ][8];
#pragma unroll
      for (int g = 0; g < 8; ++g) {
#pragma unroll
        for (int qi = 0; qi < NQ; ++qi) {
          f32x4 c = {0.f, 0.f, 0.f, 0.f};
          c = __builtin_amdgcn_mfma_f32_16x16x32_bf16(a0[qi], b0[g], c, 0, 0, 0);
          c = __builtin_amdgcn_mfma_f32_16x16x32_bf16(a1[qi], b1[g], c, 0, 0, 0);
          pt[qi][g] = fmaxf(c[0], 0.f) * wv[qi][0] + fmaxf(c[1], 0.f) * wv[qi][1] + fmaxf(c[2], 0.f) * wv[qi][2] + fmaxf(c[3], 0.f) * wv[qi][3];
        }
      }
#pragma unroll
      for (int g = 0; g < 8; g += 2) {
        const int kt = kt0 + (g + (lane >> 5)) * 4;
        const bool st = (lane & 16) == 0 && kt < ntile;
#pragma unroll
        for (int qi = 0; qi < NQ; ++qi) {
          auto r32 = __builtin_amdgcn_permlane32_swap(__float_as_uint(pt[qi][g]), __float_as_uint(pt[qi][g + 1]), false, false);
          float s2 = __uint_as_float(r32[0]) + __uint_as_float(r32[1]);
          auto r16 = __builtin_amdgcn_permlane16_swap(__float_as_uint(s2), __float_as_uint(s2), false, false);
          float sv = __uint_as_float(r16[0]) + __uint_as_float(r16[1]);
          if (st) {
            unsigned u = fkey(sv);
            if (qi == 0) { sc[kt * 16 + fr] = u; atomicAdd(&hist[u >> 21], 1); }
            else if (qi == 1) scr1[kt * 16 + fr] = u;
            else if (qi == 2) scr2[kt * 16 + fr] = u;
            else scr3[kt * 16 + fr] = u;
          }
        }
      }
    }
  }
  radix_select(sc, hist, misc, n, sel, tid, lane, w);
#pragma unroll 1
  for (int qi = 1; qi < NQ; ++qi) {
    const unsigned* scr = qi == 1 ? scr1 : (qi == 2 ? scr2 : scr3);
    __syncthreads();
    *(int4*)&hist[tid * 8] = make_int4(0, 0, 0, 0);
    *(int4*)&hist[tid * 8 + 4] = make_int4(0, 0, 0, 0);
    __syncthreads();
    for (int i = tid * 4; i < n; i += 256 * 4) {
      const u32x4 u4 = *(const u32x4*)(scr + i);
      *(u32x4*)(sc + i) = u4;
#pragma unroll
      for (int e = 0; e < 4; ++e) atomicAdd(&hist[u4[e] >> 21], 1);
    }
    radix_select(sc, hist, misc, n, sel + qi * 256, tid, lane, w);
  }
}

constexpr int KSTR = 192;
constexpr int VSTR = 72;
DI float xq_max(float x) {
  auto a = __builtin_amdgcn_permlane16_swap(__float_as_uint(x), __float_as_uint(x), false, false);
  x = fmaxf(__uint_as_float(a[0]), __uint_as_float(a[1]));
  auto b = __builtin_amdgcn_permlane32_swap(__float_as_uint(x), __float_as_uint(x), false, false);
  return fmaxf(__uint_as_float(b[0]), __uint_as_float(b[1]));
}
DI float xq_sum(float x) {
  auto a = __builtin_amdgcn_permlane16_swap(__float_as_uint(x), __float_as_uint(x), false, false);
  x = __uint_as_float(a[0]) + __uint_as_float(a[1]);
  auto b = __builtin_amdgcn_permlane32_swap(__float_as_uint(x), __float_as_uint(x), false, false);
  return __uint_as_float(b[0]) + __uint_as_float(b[1]);
}

template <int MODE>
DI void attn_item(const Params& p, int item, char* smem, u16* gdst) {
  constexpr int NKS = MODE == 0 ? 6 : 4;
  constexpr int ASTAGE = 64 * KSTR + 128 * VSTR;
  u16* sbase = (u16*)smem;
  float* sBias = (float*)(sbase + 2 * ASTAGE);
  const int tid = otid(), lane = tid & 63, w = tid >> 6, fr = lane & 15, fq = lane >> 4;
  const int ksw = (fr >> 1) & 7, ko0 = (fq ^ ksw) * 8, ko1 = ((4 + fq) ^ ksw) * 8;
  int h, q0, nq, krow0, nkeys, ntiles, myt, b = 0, qpos0;
  const u16* vt; size_t vstride;
  const bool sample = item >= 1024;
  if (!sample) {
    const int i = 63 - (item >> 4);
    h = item & 15; q0 = i * 256; nq = 256; krow0 = 0; nkeys = q0 + 256; ntiles = 4 * i + 4; qpos0 = q0;
    vt = (MODE == 0 ? p.VBT_P : p.VAT) + (size_t)h * 128 * MP; vstride = MP;
    myt = ntiles - 3 + (w >> 1);
  } else {
    const int j = item - 1024; b = j >> 4;
    h = j & 15; q0 = MP + b * 16; nq = 16; krow0 = MP + b * SK; nkeys = SK; ntiles = 17; qpos0 = 1024;
    vt = p.VBT_S + ((size_t)b * 2048 + h * 128) * VSS; vstride = VSS;
    myt = ntiles;
  }
  const int wq0 = w * 32;
  const bool active = wq0 < nq;
  __syncthreads();
  if (MODE == 1) {
    for (int i = tid; i < 257; i += NTHREADS) {
      int rel = i - 128;
      int ret = rel > 0 ? 16 : 0;
      int n = rel < 0 ? -rel : rel;
      float lf = logf((float)max(n, 1) / 8.0f) / 2.772588722239781f * 8.0f;
      int large = min(8 + (int)lf, 15);
      int bk = ret + (n < 8 ? n : large);
      sBias[i] = (p.rel[bk * 16 + h] - p.rel[15 * 16 + h]) * 1.4426950408889634f;
    }
  }
  bf16x8 qf[2][NKS];
  int qrow[2];
#pragma unroll
  for (int qt = 0; qt < 2; ++qt) {
    const int qr = min(wq0 + qt * 16 + fr, nq - 1);
    qrow[qt] = qr;
    const u16* qp = (MODE == 0) ? p.QB + (size_t)(q0 + qr) * 3072 + h * 192 + fq * 8 : p.AQ + (size_t)(q0 + qr) * 2048 + h * 128 + fq * 8;
#pragma unroll
    for (int ks = 0; ks < NKS; ++ks) qf[qt][ks] = *(const bf16x8*)(qp + ks * 32);
  }
  f32x4 o[2][8];
#pragma unroll
  for (int qt = 0; qt < 2; ++qt)
#pragma unroll
    for (int dt = 0; dt < 8; ++dt) o[qt][dt] = (f32x4){0.f, 0.f, 0.f, 0.f};
  float mrow[2] = {-1e30f, -1e30f}, lrow[2] = {0.f, 0.f};
  const float SC = (MODE == 0 ? 0.07216878364870322f : 0.08838834764831845f) * 1.4426950408889634f;

  unsigned long long mqn[2] = {0ull, 0ull};
  if (MODE == 1) {
#pragma unroll
    for (int qt = 0; qt < 2; ++qt) mqn[qt] = p.SEL[(size_t)(q0 + qrow[qt]) * 256];
  }
  constexpr int NKL = MODE == 0 ? 3 : 2;
  const bool direct = (MODE == 1) && sample;
  u32x4 rk[NKL], rv[2];
#define KV_LOAD(JT) { const size_t kr0_ = (size_t)(krow0 + (JT) * 64); const u16* kb_ = (MODE == 0 ? p.KB : p.KA) + (kr0_ + (tid >> 4)) * 2048 + h * 128 + (tid & 15) * 8; \
    _Pragma("unroll") for (int i = 0; i < 2; ++i) rk[i] = *(const u32x4*)(kb_ + (size_t)i * 32 * 2048); \
    if (MODE == 0) rk[NKL - 1] = *(const u32x4*)(p.KR + (kr0_ + (tid >> 3)) * 64 + (tid & 7) * 8); \
    const u16* vp_ = vt + (size_t)(tid >> 3) * vstride + (JT) * 64 + (tid & 7) * 8; \
    _Pragma("unroll") for (int i = 0; i < 2; ++i) rv[i] = *(const u32x4*)(vp_ + (size_t)i * 64 * vstride); }
#define KV_STORE(ST) { u16* sk_ = sbase + (ST) * ASTAGE; u16* dk_ = sk_ + (tid >> 4) * KSTR + ((tid & 15) ^ ((tid >> 5) & 7)) * 8; \
    _Pragma("unroll") for (int i = 0; i < 2; ++i) *(u32x4*)(dk_ + i * 32 * KSTR) = rk[i]; \
    if (MODE == 0) *(u32x4*)(sk_ + (tid >> 3) * KSTR + 128 + ((tid & 7) ^ ((tid >> 4) & 7)) * 8) = rk[NKL - 1]; \
    u16* dv_ = sk_ + 64 * KSTR + (tid >> 3) * VSTR + (tid & 7) * 8; \
    _Pragma("unroll") for (int i = 0; i < 2; ++i) *(u32x4*)(dv_ + i * 64 * VSTR) = rv[i]; }
  if (!direct) {
    KV_LOAD(0)
    KV_STORE(0)
    KV_LOAD(min(1, ntiles - 1))
  }
  for (int jt = 0; jt < ntiles; ++jt) {
    const int key0 = jt * 64;
    u16* sK = sbase + (jt & 1) * ASTAGE;
    u16* sV = sK + 64 * KSTR;
    unsigned long long mq[2] = {mqn[0], mqn[1]};
    if (MODE == 1) {
      const int jn = min(jt + 1, ntiles - 1);
#pragma unroll
      for (int qt = 0; qt < 2; ++qt) mqn[qt] = p.SEL[(size_t)(q0 + qrow[qt]) * 256 + jn];
    }
    __syncthreads();
    if (!direct) {
      if (jt + 1 < ntiles) KV_STORE((jt + 1) & 1)
      KV_LOAD(min(jt + 2, ntiles - 1))
    } else {
#pragma unroll 2
      for (int i = 0; i < 4; ++i) {
        const int c = tid + i * NTHREADS;
        const int key = c >> 5, part = c & 31;
        const int s = key0 + key;
        const int sc_ = min(s, SK - 1);
        const size_t o1 = sc_ < 1024 ? ((size_t)b * 1024 + sc_) * 2048 : ((size_t)b * 16 + (sc_ - 1024)) * 2048;
        const float* kp = (sc_ < 1024 ? p.c_ak : p.out + O_AKS) + o1 + h * 128 + part * 4;
        const float* vp = (sc_ < 1024 ? p.c_av : p.out + O_AVS) + o1 + h * 128 + part * 4;
        f32x4 kv = *(const f32x4*)kp, vv = *(const f32x4*)vp;
        u32x2 kk; kk[0] = cvtpk(kv[0], kv[1]); kk[1] = cvtpk(kv[2], kv[3]);
        *(u32x2*)(sK + key * KSTR + (((part >> 1) ^ ((key >> 1) & 7)) * 8) + (part & 1) * 4) = kk;
        const bool ok = s < SK;
#pragma unroll
        for (int e = 0; e < 4; ++e) sV[(part * 4 + e) * VSTR + key] = ok ? f2bf(vv[e]) : (u16)0;
      }
      __syncthreads();
    }
    if (active && jt < myt) {
      f32x4 s[2][4];
#pragma unroll
      for (int qt = 0; qt < 2; ++qt) {
        const float nb_ = (jt == 0) ? 0.f : -mrow[qt];
#pragma unroll
        for (int kt = 0; kt < 4; ++kt) s[qt][kt] = (f32x4){nb_, nb_, nb_, nb_};
      }
      __builtin_amdgcn_s_setprio(1);
#pragma unroll
      for (int kt = 0; kt < 4; ++kt) {
#pragma unroll
        for (int ks = 0; ks < NKS; ++ks) {
          bf16x8 kf = *(const bf16x8*)(sK + (kt * 16 + fr) * KSTR + (ks >> 1) * 64 + ((ks & 1) ? ko1 : ko0));
          s[0][kt] = __builtin_amdgcn_mfma_f32_16x16x32_bf16(kf, qf[0][ks], s[0][kt], 0, 0, 0);
          s[1][kt] = __builtin_amdgcn_mfma_f32_16x16x32_bf16(kf, qf[1][ks], s[1][kt], 0, 0, 0);
        }
      }
      __builtin_amdgcn_s_setprio(0);
      unsigned mlo[2] = {0u, 0u}, mhi[2] = {0u, 0u};
      if (MODE == 0) {
        if (key0 + 64 > nkeys) {
#pragma unroll
          for (int kt = 0; kt < 4; ++kt)
#pragma unroll
            for (int j = 0; j < 4; ++j)
              if (key0 + kt * 16 + fq * 4 + j >= nkeys) { s[0][kt][j] = -1e30f; s[1][kt][j] = -1e30f; }
        }
      } else {
        const bool far = (key0 + 63) - (qpos0 + wq0) <= -128;
        if (!far) {
#pragma unroll
          for (int qt = 0; qt < 2; ++qt) {
            const int rb = key0 + fq * 4 - (qpos0 + qrow[qt]) + 128;
#pragma unroll
            for (int kt = 0; kt < 4; ++kt)
#pragma unroll
              for (int j = 0; j < 4; ++j) {
                int r = min(max(rb + kt * 16 + j, 0), 256);
                s[qt][kt][j] += sBias[r];
              }
          }
        }
#pragma unroll
        for (int qt = 0; qt < 2; ++qt) {
          const unsigned long long mm = mq[qt] >> (fq * 4);
          mlo[qt] = (unsigned)mm; mhi[qt] = (unsigned)(mm >> 32);
        }
      }
      bf16x8 pf[2][2];
#pragma unroll
      for (int qt = 0; qt < 2; ++qt) {
        float mx = -1e30f;
#pragma unroll
        for (int kt = 0; kt < 4; ++kt)
#pragma unroll
          for (int j = 0; j < 4; ++j) mx = fmaxf(mx, s[qt][kt][j]);
        mx = xq_max(mx);
        const float delta = (jt == 0) ? mx : fmaxf(mx, 0.f);
        mrow[qt] = (jt == 0) ? delta : mrow[qt] + delta;
        const bool grow = __ballot(delta != 0.f) != 0ull;
        float alpha = 1.f;
        if (grow) {
          alpha = __builtin_amdgcn_exp2f(-delta);
#pragma unroll
          for (int kt = 0; kt < 4; ++kt) s[qt][kt] -= delta;
        }
        float rs = 0.f;
#pragma unroll
        for (int kt = 0; kt < 4; ++kt)
#pragma unroll
          for (int j = 0; j < 4; ++j) {
            float pv = __builtin_amdgcn_exp2f(s[qt][kt][j]);
            if (MODE == 1) {
              const int keep = __builtin_amdgcn_sbfe((int)(kt < 2 ? mlo[qt] : mhi[qt]), (kt & 1) * 16 + j, 1);
              pv = __int_as_float(__float_as_int(pv) & keep);
            }
            s[qt][kt][j] = pv; rs += pv;
          }
        rs = xq_sum(rs);
        lrow[qt] = lrow[qt] * alpha + rs;
        if (grow) {
#pragma unroll
          for (int dt = 0; dt < 8; ++dt) o[qt][dt] *= alpha;
        }
#pragma unroll
        for (int s2 = 0; s2 < 2; ++s2) {
          u32x4 pk;
          pk[0] = cvtpk(s[qt][2 * s2][0], s[qt][2 * s2][1]);
          pk[1] = cvtpk(s[qt][2 * s2][2], s[qt][2 * s2][3]);
          pk[2] = cvtpk(s[qt][2 * s2 + 1][0], s[qt][2 * s2 + 1][1]);
          pk[3] = cvtpk(s[qt][2 * s2 + 1][2], s[qt][2 * s2 + 1][3]);
          pf[qt][s2] = __builtin_bit_cast(bf16x8, pk);
        }
      }
      __builtin_amdgcn_s_setprio(1);
#pragma unroll
      for (int dt = 0; dt < 8; ++dt) {
#pragma unroll
        for (int s2 = 0; s2 < 2; ++s2) {
          const u16* vp = sV + (dt * 16 + fr) * VSTR + fq * 4;
          u32x2 v0 = *(const u32x2*)(vp + (2 * s2) * 16);
          u32x2 v1 = *(const u32x2*)(vp + (2 * s2 + 1) * 16);
          u32x4 vv = {v0[0], v0[1], v1[0], v1[1]};
          bf16x8 vf = __builtin_bit_cast(bf16x8, vv);
          o[0][dt] = __builtin_amdgcn_mfma_f32_16x16x32_bf16(vf, pf[0][s2], o[0][dt], 0, 0, 0);
          o[1][dt] = __builtin_amdgcn_mfma_f32_16x16x32_bf16(vf, pf[1][s2], o[1][dt], 0, 0, 0);
        }
      }
      __builtin_amdgcn_s_setprio(0);
    }
  }
  if (active) {
#pragma unroll
    for (int qt = 0; qt < 2; ++qt) {
      const int qr = wq0 + qt * 16 + fr;
      if (qr < nq) {
        const float inv = 1.f / lrow[qt];
        const size_t row = (size_t)(q0 + qr);
#pragma unroll
        for (int dt = 0; dt < 8; ++dt) {
          const size_t off = row * 2048 + h * 128 + dt * 16 + fq * 4;
          u32x2 ga = *(const u32x2*)(p.GA + off);
          u32x2 r;
          if (MODE == 0) {
            u32x2 gb = *(const u32x2*)(p.GB + off);
            r[0] = cvtpk(bflo(gb[0]) * o[qt][dt][0] * inv + bflo(ga[0]), bfhi(gb[0]) * o[qt][dt][1] * inv + bfhi(ga[0]));
            r[1] = cvtpk(bflo(gb[1]) * o[qt][dt][2] * inv + bflo(ga[1]), bfhi(gb[1]) * o[qt][dt][3] * inv + bfhi(ga[1]));
          } else {
            r[0] = cvtpk(bflo(ga[0]) * o[qt][dt][0] * inv, bfhi(ga[0]) * o[qt][dt][1] * inv);
            r[1] = cvtpk(bflo(ga[1]) * o[qt][dt][2] * inv, bfhi(ga[1]) * o[qt][dt][3] * inv);
          }
          *(u32x2*)(gdst + off) = r;
        }
      }
    }
  }
}

#undef KV_LOAD
#undef KV_STORE
__global__ void __launch_bounds__(NTHREADS) fwd_megakernel(Params p) {
  extern __shared__ __attribute__((aligned(16))) char smem[];
  cg::grid_group grid = cg::this_grid();
#define IDS const int tid = otid(); const int lane = tid & 63, w = tid >> 6; const int bid = blockIdx.x, nb = gridDim.x; \
  const int gw = bid * 8 + w, ngw = nb * 8; (void)tid; (void)lane; (void)gw; (void)ngw; (void)bid; (void)nb;

#if PH & (1 << 0)
  { IDS
  {
    const int vb = tid >> 8;
    float* st = (float*)(smem + vb * VB_LDS);
    const int vbid = bid * 2 + vb, nvb = nb * 2;
    for (int t = vbid; t < 32 * 192; t += nvb) transpose_tile(p.w_in, 2048, INC, p.WT_IN, t, st);
    for (int t = vbid; t < 8 * 48; t += nvb) transpose_tile(p.w_uq, 512, 3072, p.WT_UQ, t, st);
    for (int t = vbid; t < 4 * 32; t += nvb) transpose_tile(p.w_uk, 256, 2048, p.WT_UK, t, st);
    for (int t = vbid; t < 4 * 32; t += nvb) transpose_tile(p.w_uv, 256, 2048, p.WT_UV, t, st);
    for (int t = vbid; t < 32 * 32; t += nvb) transpose_tile(p.w_out, 2048, 2048, p.WT_OUT, t, st);
    for (int t = vbid; t < 32 * 128; t += nvb) transpose_tile(p.w_up, 2048, 8192, p.WT_UP, t, st);
    for (int t = vbid; t < 128 * 32; t += nvb) transpose_tile(p.w_down, 8192, 2048, p.WT_DOWN, t, st);
    for (int r = gw; r < MT; r += ngw) {
      const float* x = r < MP ? p.x_p + (size_t)r * 2048 : p.x_s + (size_t)(r - MP) * 2048;
      rms_row_2048(x, p.g_mix, p.H + (size_t)r * 2048, lane);
    }
    const int gt = bid * NTHREADS + tid, ngt = nb * NTHREADS;
    for (int i = gt; i < 16 * 1024 * 64 / 4; i += ngt) {
      int e = i * 4; int b = e >> 16; int rem = e & 65535; int s = rem >> 6, c = rem & 63;
      size_t dst = (size_t)(MP + b * SK + s) * 64 + c;
      f32x4 a = *(const f32x4*)(p.c_idx + e), k = *(const f32x4*)(p.c_kr + e);
      u32x2 o; o[0] = cvtpk(a[0], a[1]); o[1] = cvtpk(a[2], a[3]);
      *(u32x2*)(p.IXK + dst) = o;
      o[0] = cvtpk(k[0], k[1]); o[1] = cvtpk(k[2], k[3]);
      *(u32x2*)(p.KR + dst) = o;
    }
    for (int i = gt; i < 16 * 1024 * 256 / 4; i += ngt) {
      int e = i * 4; int b = e >> 18; int rem = e & 262143; int s = rem >> 8, c = rem & 255;
      size_t dst = (size_t)(MP + b * SK + s) * 256 + c;
      f32x4 a = *(const f32x4*)(p.c_ckv + e);
      u32x2 o; o[0] = cvtpk(a[0], a[1]); o[1] = cvtpk(a[2], a[3]);
      *(u32x2*)(p.CKV + dst) = o;
    }
  }
  }
#endif
  grid.sync();
#if PH & (1 << 1)
  { IDS
  for (int rep = 0; rep < NREP(1); ++rep) gemm_phase<EPI_IN>(p, p.H, 2048, p.WT_IN, 2048, 2048, MT / 256, INP / 256, smem, nullptr, 0, bid, nb);
  }
#endif
  grid.sync();
#if PH & (1 << 2)
  { IDS
  for (int t = gw; t < MT; t += ngw) post_row(p, t, lane);
  {
    const int vb = tid >> 8, vbid = bid * 2 + vb;
    char* sm = smem + vb * VB_LDS;
    for (int rep = 0; rep < NREP(2); ++rep) for (int t = vbid * NQ; t < MT; t += nb * 2 * NQ)
      topk_group(p, t, sm, (unsigned*)(p.out + O_Y + 14000000) + (size_t)vbid * 16384, (unsigned*)(p.out + O_Y + 14000000) + (size_t)(512 + vbid) * 16384,
                 (unsigned*)p.H + (size_t)vbid * 16384);
  }
  }
#endif
  grid.sync();
#if PH & (1 << 3)
  { IDS
    const int total = 1024 + 256;
    for (int rep = 0; rep < NREP(3); ++rep) {
      u16* gdst = (rep + 1 < NREP(3)) ? (u16*)(p.out + O_Y) : p.GA;
      for (int r = 0;; ++r) {
        int id = (r & 1) ? r * nb + (nb - 1 - bid) : r * nb + bid;
        if (r * nb >= total) break;
        if (id < total) attn_item<1>(p, id, smem, gdst);
      }
    }
  }
#endif
  grid.sync();
#if PH & (1 << 4)
  { IDS
  {
    const int gt = bid * NTHREADS + tid, ngt = nb * NTHREADS;
    for (int i = gt; i < MS * 2048 / 4; i += ngt)
      *(f32x4*)(p.out + O_Y + (size_t)MP * 2048 + (size_t)i * 4) = *(const f32x4*)(p.x_s + (size_t)i * 4);
    for (int i = gt; i < 16 * 2048 * 6; i += ngt) {
      int r = i / 6, c = i - r * 6;
      *(u32x4*)(p.VBT_S + (size_t)r * VSS + SK + c * 8) = (u32x4){0u, 0u, 0u, 0u};
    }
    const int nqb = (MT / 256) * 12, nkb = (KROWS / 256) * 8;
    const int total = nqb + 2 * nkb;
    for (int id = bid; id < total; id += nb) {
      if (id < nqb) gemm_phase<EPI_QB>(p, p.CQ, 512, p.WT_UQ, 512, 512, MT / 256, 12, smem, p.QB, 3072, id, 1 << 30);
      else if (id < nqb + nkb) gemm_phase<EPI_BF16>(p, p.CKV, 256, p.WT_UK, 256, 256, KROWS / 256, 8, smem, p.KB, 2048, id - nqb, 1 << 30);
      else gemm_phase<EPI_VT>(p, p.CKV, 256, p.WT_UV, 256, 256, KROWS / 256, 8, smem, nullptr, 0, id - nqb - nkb, 1 << 30);
    }
  }
  }
#endif
  grid.sync();
#if PH & (1 << 5)
  { IDS
  {
    const int total = 1024 + 256;
    for (int rep = 0; rep < NREP(5); ++rep) {
      u16* gdst = (rep + 1 < NREP(5)) ? (u16*)(p.out + O_Y) : p.GB;
      for (int r = 0;; ++r) {
        int id = (r & 1) ? r * nb + (nb - 1 - bid) : r * nb + bid;
        if (r * nb >= total) break;
        if (id < total) attn_item<0>(p, id, smem, gdst);
      }
    }
  }
  }
#endif
  grid.sync();
#if PH & (1 << 6)
  { IDS
  gemm_phase<EPI_RES>(p, p.GB, 2048, p.WT_OUT, 2048, 2048, MT / 256 - 1, 8, smem, nullptr, 0, bid, nb);
  for (int id = bid; id < 128; id += nb) {
    const int nt = id & 7, kc = id >> 3;
    gemm_tile<EPI_ATOM>(p, p.GB + kc * 128, 2048, p.WT_OUT + kc * 128, 2048, 128, (MT / 256 - 1) * 256, nt * 256, smem, nullptr, 0);
  }
  }
#endif
  grid.sync();
#if PH & (1 << 7)
  { IDS
  for (int r = gw; r < MT; r += ngw) rms_row_2048(p.out + O_Y + (size_t)r * 2048, p.g_ffn, p.H2 + (size_t)r * 2048, lane);
  }
#endif
  grid.sync();
#if PH & (1 << 8)
  { IDS
  for (int rep = 0; rep < NREP(8); ++rep) gemm_phase<EPI_RELU2>(p, p.H2, 2048, p.WT_UP, 2048, 2048, MT / 256, 32, smem, nullptr, 0, bid, nb);
  }
#endif
  grid.sync();
#if PH & (1 << 9)
  { IDS
  gemm_phase<EPI_ACC>(p, p.U, DFF, p.WT_DOWN, DFF, DFF, MT / 256 - 1, 8, smem, nullptr, 0, bid, nb);
  for (int id = bid; id < 256; id += nb) {
    const int nt = id & 7, kc = id >> 3;
    gemm_tile<EPI_ATOM>(p, p.U + kc * 256, DFF, p.WT_DOWN + kc * 256, DFF, 256, (MT / 256 - 1) * 256, nt * 256, smem, nullptr, 0);
  }
  }
#endif
  grid.sync();
#if PH & (1 << 10)
  { IDS
  for (int r = gw; r < MT; r += ngw) {
    float* x = p.out + O_Y + (size_t)r * 2048;
    f32x4 v[8];
    float ss = 0.f;
#pragma unroll
    for (int i = 0; i < 8; ++i) {
      v[i] = *(const f32x4*)(x + i * 256 + lane * 4);
      ss += v[i][0] * v[i][0] + v[i][1] * v[i][1] + v[i][2] * v[i][2] + v[i][3] * v[i][3];
    }
    ss = wave_sum(ss);
    float rr = rsqrtf(ss * (1.f / 2048.f) + 1e-6f);
#pragma unroll
    for (int i = 0; i < 8; ++i) {
      f32x4 gg = *(const f32x4*)(p.g_fin + i * 256 + lane * 4);
      f32x4 o = {v[i][0] * rr * gg[0], v[i][1] * rr * gg[1], v[i][2] * rr * gg[2], v[i][3] * rr * gg[3]};
      *(f32x4*)(x + i * 256 + lane * 4) = o;
    }
  }
  }
#endif
}

extern "C" void kernel_launch(void* const* d_in, const int* in_sizes, int n_in, void* d_out, int out_size, void* d_ws, size_t ws_size,
                              hipStream_t stream) {
  static int grid_blocks = 0;
  if (!grid_blocks) {
    int dev = 0, cus = 0, per_cu = 0;
    hipGetDevice(&dev);
    hipDeviceGetAttribute(&cus, hipDeviceAttributeMultiprocessorCount, dev);
    if (hipFuncSetAttribute((const void*)fwd_megakernel, hipFuncAttributeMaxDynamicSharedMemorySize, LDS_BYTES) != hipSuccess)
      fprintf(stderr, "kernel_launch: hipFuncSetAttribute failed\n");
    hipOccupancyMaxActiveBlocksPerMultiprocessor(&per_cu, (const void*)fwd_megakernel, NTHREADS, LDS_BYTES);
    if (per_cu < 1) per_cu = 1;
    if (per_cu > 1) per_cu = 1;
    grid_blocks = cus * per_cu;
  }
  Params p{};
  const float* const* in = (const float* const*)d_in;
  p.x_p = in[0]; p.x_s = in[1]; p.c_ak = in[2]; p.c_av = in[3]; p.c_idx = in[4]; p.c_ckv = in[5]; p.c_kr = in[6]; p.rel = in[7];
  p.g_mix = in[8]; p.w_in = in[9]; p.g_q = in[10]; p.w_uq = in[11]; p.g_kv = in[12]; p.w_uk = in[13]; p.w_uv = in[14]; p.w_out = in[15];
  p.g_ffn = in[16]; p.w_up = in[17]; p.w_down = in[18]; p.g_fin = in[19];
  p.out = (float*)d_out;
  char* ws = (char*)d_ws;
  size_t off = 0;
  auto alloc = [&](size_t bytes) { char* r = ws + off; off += (bytes + 255) & ~(size_t)255; return r; };
  p.WT_UQ = (u16*)alloc((size_t)3072 * 512 * 2);
  p.WT_UK = (u16*)alloc((size_t)2048 * 256 * 2);
  p.WT_UV = (u16*)alloc((size_t)2048 * 256 * 2);
  p.WT_OUT = (u16*)alloc((size_t)2048 * 2048 * 2);
  p.WT_UP = (u16*)alloc((size_t)8192 * 2048 * 2);
  p.WT_DOWN = (u16*)alloc((size_t)2048 * 8192 * 2);
  p.CQ = (u16*)alloc((size_t)MT * 512 * 2);
  p.CKV = (u16*)alloc((size_t)KROWS * 256 * 2);
  p.KR = (u16*)alloc((size_t)KROWS * 64 * 2);
  p.GA = (u16*)alloc((size_t)MT * 2048 * 2);
  p.GB = (u16*)alloc((size_t)MT * 2048 * 2);
  p.CS = (float*)alloc((size_t)MT * 32 * 4);
  p.SN = (float*)alloc((size_t)MT * 32 * 4);
  const size_t ubase = off;
  p.WT_IN = (u16*)alloc((size_t)INP * 2048 * 2);
  p.H = (u16*)alloc((size_t)MT * 2048 * 2);
  p.AQ = (u16*)alloc((size_t)MT * 2048 * 2);
  p.KA = (u16*)alloc((size_t)MP * 2048 * 2);
  p.VAT = (u16*)alloc((size_t)MP * 2048 * 2);
  p.IXQ = (u16*)alloc((size_t)MT * 1024 * 2);
  p.IXK = (u16*)alloc((size_t)KROWS * 64 * 2);
  p.SEL = (unsigned long long*)alloc((size_t)MT * 256 * 8);
  p.IXW = (float*)alloc((size_t)MT * 16 * 4);
  const size_t endA = off;
  off = ubase;
  p.QB = (u16*)alloc((size_t)MT * 3072 * 2);
  p.KB = (u16*)alloc((size_t)KROWS * 2048 * 2);
  p.VBT_P = (u16*)alloc((size_t)2048 * MP * 2);
  p.VBT_S = (u16*)alloc((size_t)16 * 2048 * VSS * 2);
  const size_t endB = off;
  off = ubase;
  p.H2 = (u16*)alloc((size_t)MT * 2048 * 2);
  p.U = (u16*)alloc((size_t)MT * DFF * 2);
  const size_t endC = off;
  size_t need = endA > endB ? endA : endB;
  if (endC > need) need = endC;
  if (need > ws_size) { fprintf(stderr, "kernel_launch: workspace too small: need %zu have %zu\n", need, ws_size); return; }
  void* args[] = {&p};
  hipError_t e = hipLaunchCooperativeKernel((const void*)fwd_megakernel, dim3(grid_blocks), dim3(NTHREADS), args, LDS_BYTES, stream);
  if (e != hipSuccess) fprintf(stderr, "cooperative launch failed: %s (grid %d)\n", hipGetErrorString(e), grid_blocks);
}
```

```cpp
#include <hip/hip_runtime.h>
#include <hip/hip_cooperative_groups.h>
#include <cstdio>
#include <cstdint>
namespace cg = cooperative_groups;

typedef unsigned short u16;
typedef __attribute__((ext_vector_type(8))) short bf16x8;
typedef __attribute__((ext_vector_type(4))) short bf16x4;
typedef __attribute__((ext_vector_type(4))) float f32x4;
typedef __attribute__((ext_vector_type(2))) float f32x2;
typedef __attribute__((ext_vector_type(2))) __bf16 bf16x2_t;
typedef __attribute__((ext_vector_type(4))) unsigned u32x4;
typedef __attribute__((ext_vector_type(2))) unsigned u32x2;

#define DI __device__ __forceinline__

constexpr int MP = 16384;
constexpr int MS = 256;
constexpr int MT = MP + MS;
constexpr int DM = 2048;
constexpr int INC = 12176;
constexpr int INP = 12288;
constexpr int SK = 1040;
constexpr int KROWS = MP + 16 * SK;
constexpr int VSS = 1088;
constexpr int DFF = 8192;
constexpr int ZRW = 832;
#ifndef PH
#define PH 0x7ff
#endif
#ifndef REP
#define REP 0
#endif
#define NREP(k) (((REP >> (k)) & 1) + 1)
constexpr int NTHREADS = 512;
constexpr int VB_LDS = 75776;
constexpr int LDS_BYTES = 2 * VB_LDS;

constexpr size_t O_Y = 0;
constexpr size_t O_AKP = 34078720;
constexpr size_t O_AVP = 67633152;
constexpr size_t O_IDXP = 101187584;
constexpr size_t O_CKVP = 102236160;
constexpr size_t O_KRP = 106430464;
constexpr size_t O_AKS = 107479040;
constexpr size_t O_AVS = 108003328;
constexpr size_t O_IDXS = 108527616;
constexpr size_t O_CKVS = 108544000;
constexpr size_t O_KRS = 108609536;

struct Params {
  const float *x_p, *x_s, *c_ak, *c_av, *c_idx, *c_ckv, *c_kr, *rel, *g_mix, *w_in, *g_q, *w_uq, *g_kv, *w_uk, *w_uv, *w_out, *g_ffn, *w_up, *w_down, *g_fin;
  float* out;
  u16 *WT_UQ, *WT_UK, *WT_UV, *WT_OUT, *WT_UP, *WT_DOWN, *CQ, *CKV, *KR, *GA, *GB;
  float *CS, *SN;
  u16 *WT_IN, *H, *AQ, *KA, *VAT, *IXQ, *IXK;
  float* IXW;
  unsigned long long* SEL;
  u16 *QB, *KB, *VBT_P, *VBT_S;
  u16 *H2, *U;
};

DI int otid() { int t = threadIdx.x; asm volatile("" : "+v"(t)); return t; }
DI unsigned cvtpk(float lo, float hi) {
  f32x2 v = {lo, hi};
  bf16x2_t b = __builtin_convertvector(v, bf16x2_t);
  return __builtin_bit_cast(unsigned, b);
}
DI u16 f2bf(float x) { return (u16)(cvtpk(x, 0.f) & 0xffffu); }
DI float bf2f(u16 b) { return __uint_as_float(((unsigned)b) << 16); }
DI float bflo(unsigned w) { return __uint_as_float(w << 16); }
DI float bfhi(unsigned w) { return __uint_as_float(w & 0xffff0000u); }
DI float dot2bf(unsigned a, unsigned b, float c) {
  return __builtin_amdgcn_fdot2_f32_bf16(__builtin_bit_cast(bf16x2_t, a), __builtin_bit_cast(bf16x2_t, b), c, false);
}
DI float wave_sum(float v) {
#pragma unroll
  for (int o = 32; o > 0; o >>= 1) v += __shfl_xor(v, o);
  return v;
}
DI int qpos_of(int t) { return t < MP ? t : 1024 + ((t - MP) & 15); }
DI int krow_of(int t) { return t < MP ? t : MP + ((t - MP) >> 4) * SK + 1024 + ((t - MP) & 15); }
DI float inv_freq(int i) { return exp2f(-(float)i * 0.41524101186092029f); }

DI void transpose_tile(const float* __restrict__ W, int K, int N, u16* __restrict__ Wt, int tile, float* s  ) {
  const int nkt = K >> 6;
  const int kt = tile % nkt, nt = tile / nkt;
  const int k0 = kt << 6, n0 = nt << 6;
  const int tid = otid() & 255;
  const int c = tid & 63, r0 = tid >> 6;
  __syncthreads();
#pragma unroll
  for (int i = 0; i < 16; ++i) {
    int r = i * 4 + r0;
    float v = (n0 + c < N) ? W[(size_t)(k0 + r) * N + n0 + c] : 0.f;
    s[r * 65 + c] = v;
  }
  __syncthreads();
  const int kp = (tid & 31) * 2, rr0 = tid >> 5;
#pragma unroll
  for (int i = 0; i < 8; ++i) {
    int rr = i * 8 + rr0;
    unsigned pk = cvtpk(s[kp * 65 + rr], s[(kp + 1) * 65 + rr]);
    *(unsigned*)(Wt + (size_t)(n0 + rr) * K + k0 + kp) = pk;
  }
}

DI void rms_row_2048(const float* __restrict__ x, const float* __restrict__ g, u16* __restrict__ out, int lane) {
  f32x4 v[8];
  float ss = 0.f;
#pragma unroll
  for (int i = 0; i < 8; ++i) {
    v[i] = *(const f32x4*)(x + i * 256 + lane * 4);
    ss += v[i][0] * v[i][0] + v[i][1] * v[i][1] + v[i][2] * v[i][2] + v[i][3] * v[i][3];
  }
  ss = wave_sum(ss);
  float r = rsqrtf(ss * (1.f / 2048.f) + 1e-6f);
#pragma unroll
  for (int i = 0; i < 8; ++i) {
    f32x4 gg = *(const f32x4*)(g + i * 256 + lane * 4);
    u32x2 o;
    o[0] = cvtpk(v[i][0] * r * gg[0], v[i][1] * r * gg[1]);
    o[1] = cvtpk(v[i][2] * r * gg[2], v[i][3] * r * gg[3]);
    *(u32x2*)(out + i * 256 + lane * 4) = o;
  }
}

enum { EPI_IN = 0, EPI_QB, EPI_BF16, EPI_VT, EPI_RES, EPI_RELU2, EPI_ACC, EPI_ATOM };
constexpr float QSC = 0.07216878364870322f * 1.4426950408889634f;
constexpr int LSTR = 64;
#ifndef PFA
#define PFA 8
#endif

template <int EPI> struct EpiSwap { static constexpr bool v = (EPI != EPI_VT); };

DI u32x2 pack4(f32x4 v) { u32x2 r; r[0] = cvtpk(v[0], v[1]); r[1] = cvtpk(v[2], v[3]); return r; }
DI float sigm(float v) { return __builtin_amdgcn_rcpf(1.f + __builtin_amdgcn_exp2f(v * -1.4426950408889634f)); }

template <int EPI>
DI void gemm_epilogue(const Params& p, f32x4 (&acc)[8][4], int m0, int n0, int wr, int wc, int fr, int fq, u16* Cb, int ldc) {
  const int cw = n0 + wc * 64;
  if (EPI == EPI_VT) {
#pragma clang loop unroll(full)
    for (int m = 0; m < 8; ++m) {
      const int rb = m0 + wr * 128 + m * 16 + fq * 4;
#pragma clang loop unroll(full)
      for (int n = 0; n < 4; ++n) {
        const int col = cw + n * 16 + fr;
        u16* dst;
        if (rb < MP) dst = p.VBT_P + (size_t)col * MP + rb;
        else { int r2 = rb - MP; int b = r2 / SK; int s = r2 - b * SK; dst = p.VBT_S + ((size_t)b * 2048 + col) * VSS + s; }
        *(u32x2*)dst = pack4(acc[m][n]);
      }
    }
    return;
  }
  const int rbase = m0 + wr * 128 + fr;
  const int c4 = fq * 4;
  if (EPI == EPI_QB) {
    if (cw % 192 == 128) {
#pragma clang loop unroll(full)
      for (int m = 0; m < 8; ++m) {
        const int row = rbase + m * 16;
#pragma clang loop unroll(full)
        for (int n = 0; n < 2; ++n) {
          const int i0 = n * 16 + c4;
          const f32x4 cs = *(const f32x4*)(p.CS + (size_t)row * 32 + i0), sn = *(const f32x4*)(p.SN + (size_t)row * 32 + i0);
          const f32x4 x1 = acc[m][n] * QSC, x2 = acc[m][n + 2] * QSC;
          *(u32x2*)(p.QB + (size_t)row * 3072 + cw + i0) = pack4(x1 * cs - x2 * sn);
          *(u32x2*)(p.QB + (size_t)row * 3072 + cw + i0 + 32) = pack4(x1 * sn + x2 * cs);
        }
      }
      return;
    }
  }
#pragma clang loop unroll(full)
  for (int n = 0; n < 4; ++n) {
    const int colt = cw + n * 16;
    const int col = colt + c4;
    if (EPI == EPI_IN) {
      const bool smp = m0 >= MP;
      if (colt < 2048) {
#pragma clang loop unroll(full)
        for (int m = 0; m < 8; ++m) *(u32x2*)(p.AQ + (size_t)(rbase + m * 16) * 2048 + col) = pack4(acc[m][n] * (0.08838834764831845f * 1.4426950408889634f));
      } else if (colt < 4096) {
        const int c = col - 2048;
#pragma clang loop unroll(full)
        for (int m = 0; m < 8; ++m) {
          const int row = rbase + m * 16;
          if (!smp) { *(f32x4*)(p.out + O_AKP + (size_t)row * 2048 + c) = acc[m][n]; *(u32x2*)(p.KA + (size_t)row * 2048 + c) = pack4(acc[m][n]); }
          else *(f32x4*)(p.out + O_AKS + (size_t)(row - MP) * 2048 + c) = acc[m][n];
        }
      } else if (colt < 6144) {
        const int c = col - 4096;
#pragma clang loop unroll(full)
        for (int m = 0; m < 8; ++m) {
          const int row = rbase + m * 16;
          if (!smp) {
            *(f32x4*)(p.out + O_AVP + (size_t)row * 2048 + c) = acc[m][n];
#pragma clang loop unroll(full)
            for (int j = 0; j < 4; ++j) p.VAT[(size_t)(c + j) * MP + row] = f2bf(acc[m][n][j]);
          } else *(f32x4*)(p.out + O_AVS + (size_t)(row - MP) * 2048 + c) = acc[m][n];
        }
      } else if (colt < 7168) {
#pragma clang loop unroll(full)
        for (int m = 0; m < 8; ++m) *(u32x2*)(p.IXQ + (size_t)(rbase + m * 16) * 1024 + (col - 6144)) = pack4(acc[m][n]);
      } else if (colt < 7232) {
        const int c = col - 7168;
#pragma clang loop unroll(full)
        for (int m = 0; m < 8; ++m) {
          const int row = rbase + m * 16;
          if (!smp) *(f32x4*)(p.out + O_IDXP + (size_t)row * 64 + c) = acc[m][n];
          else *(f32x4*)(p.out + O_IDXS + (size_t)(row - MP) * 64 + c) = acc[m][n];
          *(u32x2*)(p.IXK + (size_t)krow_of(row) * 64 + c) = pack4(acc[m][n]);
        }
      } else if (colt < 7248) {
#pragma clang loop unroll(full)
        for (int m = 0; m < 8; ++m) *(f32x4*)(p.IXW + (size_t)(rbase + m * 16) * 16 + (col - 7232)) = acc[m][n] * 0.25f;
      } else if (colt < 8080) {
#pragma clang loop unroll(full)
        for (int m = 0; m < 8; ++m) *(f32x4*)(p.out + O_Y + (size_t)(rbase + m * 16) * ZRW + (col - 7248)) = acc[m][n];
      } else if (colt < INC) {
        u16* G = colt < 10128 ? p.GA : p.GB;
        const int c = colt < 10128 ? col - 8080 : col - 10128;
#pragma clang loop unroll(full)
        for (int m = 0; m < 8; ++m) {
          f32x4 v = acc[m][n];
          f32x4 g = {sigm(v[0]), sigm(v[1]), sigm(v[2]), sigm(v[3])};
          *(u32x2*)(G + (size_t)(rbase + m * 16) * 2048 + c) = pack4(g);
        }
      }
    } else {
#pragma clang loop unroll(full)
      for (int m = 0; m < 8; ++m) {
        const int row = rbase + m * 16;
        const f32x4 v = acc[m][n];
        if (EPI == EPI_QB) {
          *(u32x2*)(Cb + (size_t)row * ldc + col) = pack4(v * QSC);
        } else if (EPI == EPI_BF16) {
          *(u32x2*)(Cb + (size_t)row * ldc + col) = pack4(v);
        } else if (EPI == EPI_RES) {
          const f32x4 xv = row < MP ? *(const f32x4*)(p.x_p + (size_t)row * 2048 + col) : *(const f32x4*)(p.x_s + (size_t)(row - MP) * 2048 + col);
          *(f32x4*)(p.out + O_Y + (size_t)row * 2048 + col) = xv + v;
          if ((m & 3) == 3) __builtin_amdgcn_sched_barrier(0);
        } else if (EPI == EPI_RELU2) {
          f32x4 r = {fmaxf(v[0], 0.f), fmaxf(v[1], 0.f), fmaxf(v[2], 0.f), fmaxf(v[3], 0.f)};
          *(u32x2*)(p.U + (size_t)row * DFF + col) = pack4(r * r);
        } else if (EPI == EPI_ACC) {
          float* d = p.out + O_Y + (size_t)row * 2048 + col;
          *(f32x4*)d = *(const f32x4*)d + v;
          if ((m & 3) == 3) __builtin_amdgcn_sched_barrier(0);
        } else if (EPI == EPI_ATOM) {
#pragma clang loop unroll(full)
          for (int j = 0; j < 4; ++j) atomicAdd(p.out + O_Y + (size_t)row * 2048 + col + j, v[j]);
        }
      }
    }
  }
}

constexpr int GSTAGE = 512 * LSTR;
template <int EPI>
DI void gemm_tile(const Params& p, const u16* __restrict__ A, int lda, const u16* __restrict__ Bt, int ldb, int K, int m0, int n0,
                  char* smem, u16* Cb, int ldc) {
  u16* sbase = (u16*)smem;
  const int tid = otid(), lane = tid & 63, w = tid >> 6;
  const int wr = w >> 2, wc = w & 3, fr = lane & 15, fq = lane >> 4;
  f32x4 acc[8][4];
#pragma unroll
  for (int m = 0; m < 8; ++m)
#pragma unroll
    for (int n = 0; n < 4; ++n) acc[m][n] = (f32x4){0.f, 0.f, 0.f, 0.f};
  const int lr = tid >> 3, lk = (tid & 7) * 8;
  const int lkw = ((tid & 7) ^ ((lr >> 1) & 7)) * 8;
  const int fsw = (fr >> 1) & 7, fo0 = (fq ^ fsw) * 8, fo1 = ((4 + fq) ^ fsw) * 8;
  const u16* Ag = A + (size_t)(m0 + lr) * lda + lk;
  const u16* Bg = Bt + (size_t)(n0 + lr) * ldb + lk;
  const int nk = K >> 6;
  u32x4 ra[4], rb[4];
#define G_LOAD(T) { const int k_ = (T) << 6; _Pragma("unroll") for (int i = 0; i < 4; ++i) { \
    ra[i] = *(const u32x4*)(Ag + (size_t)(i * 64) * lda + k_); rb[i] = *(const u32x4*)(Bg + (size_t)(i * 64) * ldb + k_); } }
#define L_STORE(ST) { u16* dA_ = sbase + (ST) * GSTAGE + lr * LSTR + lkw; u16* dB_ = dA_ + 256 * LSTR; _Pragma("unroll") for (int i = 0; i < 4; ++i) { \
    *(u32x4*)(dA_ + i * 64 * LSTR) = ra[i]; *(u32x4*)(dB_ + i * 64 * LSTR) = rb[i]; } }
  G_LOAD(0)
  L_STORE(0)
  G_LOAD(1)
#pragma unroll 1
  for (int kt = 0; kt < nk; ++kt) {
    __syncthreads();
    if (kt + 1 < nk) L_STORE((kt + 1) & 1)
    G_LOAD(min(kt + 2, nk - 1))
    const u16* cA = sbase + (kt & 1) * GSTAGE + (wr * 128 + fr) * LSTR;
    const u16* cB = sbase + (kt & 1) * GSTAGE + 256 * LSTR + (wc * 64 + fr) * LSTR;
#pragma unroll
    for (int ks = 0; ks < 2; ++ks) {
      bf16x8 bfr[4];
#pragma unroll
      for (int n = 0; n < 4; ++n) bfr[n] = *(const bf16x8*)(cB + n * 16 * LSTR + (ks ? fo1 : fo0));
#pragma unroll
      for (int mh = 0; mh < 2; ++mh) {
        bf16x8 af[4];
#pragma unroll
        for (int m = 0; m < 4; ++m) af[m] = *(const bf16x8*)(cA + (mh * 4 + m) * 16 * LSTR + (ks ? fo1 : fo0));
        __builtin_amdgcn_s_setprio(1);
#pragma unroll
        for (int m = 0; m < 4; ++m)
#pragma unroll
          for (int n = 0; n < 4; ++n)
            acc[mh * 4 + m][n] = EpiSwap<EPI>::v ? __builtin_amdgcn_mfma_f32_16x16x32_bf16(bfr[n], af[m], acc[mh * 4 + m][n], 0, 0, 0)
                                                 : __builtin_amdgcn_mfma_f32_16x16x32_bf16(af[m], bfr[n], acc[mh * 4 + m][n], 0, 0, 0);
        __builtin_amdgcn_s_setprio(0);
      }
    }
  }
#undef G_LOAD
#undef L_STORE
  gemm_epilogue<EPI>(p, acc, m0, n0, wr, wc, fr, fq, Cb, ldc);
}

template <int EPI>
DI void gemm_phase(const Params& p, const u16* A, int lda, const u16* Bt, int ldb, int K, int mtiles, int ntiles, char* smem, u16* Cb, int ldc,
                   int start, int stride) {
  if (stride == 256) {
    const int gm = (mtiles + 3) >> 2, gn = (ntiles + 7) >> 3, nsg = gm * gn;
    const int xcd = start & 7, li = start >> 3;
    for (int sg = xcd; sg < nsg; sg += 8) {
      const int gni = sg / gm, gmi = sg - gni * gm;
      const int mt = gmi * 4 + (li & 3), nt = gni * 8 + (li >> 2);
      if (mt < mtiles && nt < ntiles) gemm_tile<EPI>(p, A, lda, Bt, ldb, K, mt * 256, nt * 256, smem, Cb, ldc);
    }
    return;
  }
  const int total = mtiles * ntiles;
  const int GM = 8;
  for (int id = start; id < total; id += stride) {
    const int per = GM * ntiles;
    const int g = id / per, rem = id - g * per;
    const int fm = g * GM;
    const int gsz = min(GM, mtiles - fm);
    const int mt = fm + rem % gsz, nt = rem / gsz;
    gemm_tile<EPI>(p, A, lda, Bt, ldb, K, mt * 256, nt * 256, smem, Cb, ldc);
  }
}

DI void post_row(const Params& p, int t, int lane) {
  const float* zr = p.out + O_Y + (size_t)t * ZRW;
  {
    f32x4 a = *(const f32x4*)(zr + lane * 4), b = *(const f32x4*)(zr + 256 + lane * 4);
    float ss = a[0] * a[0] + a[1] * a[1] + a[2] * a[2] + a[3] * a[3] + b[0] * b[0] + b[1] * b[1] + b[2] * b[2] + b[3] * b[3];
    ss = wave_sum(ss);
    float r = rsqrtf(ss * (1.f / 512.f) + 1e-6f);
    f32x4 ga = *(const f32x4*)(p.g_q + lane * 4), gb = *(const f32x4*)(p.g_q + 256 + lane * 4);
    u32x2 o;
    o[0] = cvtpk(a[0] * r * ga[0], a[1] * r * ga[1]); o[1] = cvtpk(a[2] * r * ga[2], a[3] * r * ga[3]);
    *(u32x2*)(p.CQ + (size_t)t * 512 + lane * 4) = o;
    o[0] = cvtpk(b[0] * r * gb[0], b[1] * r * gb[1]); o[1] = cvtpk(b[2] * r * gb[2], b[3] * r * gb[3]);
    *(u32x2*)(p.CQ + (size_t)t * 512 + 256 + lane * 4) = o;
  }
  const int kr_row = krow_of(t);
  {
    f32x4 a = *(const f32x4*)(zr + 512 + lane * 4);
    float ss = a[0] * a[0] + a[1] * a[1] + a[2] * a[2] + a[3] * a[3];
    ss = wave_sum(ss);
    float r = rsqrtf(ss * (1.f / 256.f) + 1e-6f);
    f32x4 g = *(const f32x4*)(p.g_kv + lane * 4);
    f32x4 o = {a[0] * r * g[0], a[1] * r * g[1], a[2] * r * g[2], a[3] * r * g[3]};
    float* od = t < MP ? p.out + O_CKVP + (size_t)t * 256 : p.out + O_CKVS + (size_t)(t - MP) * 256;
    *(f32x4*)(od + lane * 4) = o;
    u32x2 ob; ob[0] = cvtpk(o[0], o[1]); ob[1] = cvtpk(o[2], o[3]);
    *(u32x2*)(p.CKV + (size_t)kr_row * 256 + lane * 4) = ob;
  }
  if (lane < 32) {
    float x1 = zr[768 + lane], x2 = zr[768 + 32 + lane];
    float ang = (float)qpos_of(t) * inv_freq(lane);
    float cs = cosf(ang), sn = sinf(ang);
    p.CS[(size_t)t * 32 + lane] = cs; p.SN[(size_t)t * 32 + lane] = sn;
    float o1 = x1 * cs - x2 * sn, o2 = x1 * sn + x2 * cs;
    float* od = t < MP ? p.out + O_KRP + (size_t)t * 64 : p.out + O_KRS + (size_t)(t - MP) * 64;
    od[lane] = o1; od[lane + 32] = o2;
    p.KR[(size_t)kr_row * 64 + lane] = f2bf(o1);
    p.KR[(size_t)kr_row * 64 + lane + 32] = f2bf(o2);
  }
}

template <int CTRL> DI float dpp_add(float v) {
  int sft = __builtin_amdgcn_update_dpp(0, __float_as_int(v), CTRL, 0xf, 0xf, true);
  return v + __int_as_float(sft);
}
DI float row16_sum(float v) { v = dpp_add<0x111>(v); v = dpp_add<0x112>(v); v = dpp_add<0x114>(v); v = dpp_add<0x118>(v); return v; }
DI unsigned fkey(float f) { unsigned u = __float_as_uint(f); return (u & 0x80000000u) ? ~u : (u | 0x80000000u); }

DI void radix_select(unsigned* sc, int* hist, int* misc, int n, unsigned long long* sel, int tid, int lane, int w) {
  __syncthreads();
  unsigned prefix = 0;
  int remaining = 256;
#pragma unroll 1
  for (int pass = 0; pass < 3; ++pass) {
    const int shift = pass == 0 ? 21 : (pass == 1 ? 10 : 0);
    const int bits = pass == 2 ? 10 : 11;
    const unsigned bmask = (1u << bits) - 1u;
    if (pass > 0) {
      *(int4*)&hist[tid * 8] = make_int4(0, 0, 0, 0);
      *(int4*)&hist[tid * 8 + 4] = make_int4(0, 0, 0, 0);
      __syncthreads();
      const int hs = shift + bits;
      const unsigned want = prefix >> hs;
      for (int i = tid * 4; i < n; i += 256 * 4) {
        const u32x4 u4 = *(const u32x4*)(sc + i);
#pragma unroll
        for (int e = 0; e < 4; ++e)
          if ((u4[e] >> hs) == want) atomicAdd(&hist[(u4[e] >> shift) & bmask], 1);
      }
      __syncthreads();
    }
    const int4 h0 = *(const int4*)&hist[tid * 8], h1 = *(const int4*)&hist[tid * 8 + 4];
    const int s8 = h0.x + h0.y + h0.z + h0.w + h1.x + h1.y + h1.z + h1.w;
    int suf = s8;
#pragma unroll
    for (int d = 1; d < 64; d <<= 1) { int v = __shfl_down(suf, d); if (lane + d < 64) suf += v; }
    if (lane == 0) misc[w] = suf;
    __syncthreads();
    int above = 0;
    for (int ww = w + 1; ww < 4; ++ww) above += misc[ww];
    const int excl = above + suf - s8;
    if (excl < remaining && remaining <= excl + s8) {
      int c = excl, bin = 0, nrem = 0;
#define TK_STEP(val, idx) if (c < remaining && remaining <= c + (val)) { bin = tid * 8 + (idx); nrem = remaining - c; } c += (val);
      TK_STEP(h1.w, 7) TK_STEP(h1.z, 6) TK_STEP(h1.y, 5) TK_STEP(h1.x, 4) TK_STEP(h0.w, 3) TK_STEP(h0.z, 2) TK_STEP(h0.y, 1) TK_STEP(h0.x, 0)
#undef TK_STEP
      misc[4] = bin; misc[5] = nrem;
    }
    __syncthreads();
    prefix |= ((unsigned)misc[4]) << shift;
    remaining = misc[5];
    __syncthreads();
  }
  const unsigned T = prefix;
  const int seg = ((n + 255) >> 8) << 6;
  const int beg = w * seg;
  int ceq = 0;
  for (int i = beg + lane; i < beg + seg; i += 64) {
    bool in = i < n; unsigned u = in ? sc[i] : 0u;
    ceq += __popcll(__ballot(in && u == T));
  }
  if (lane == 0) misc[12 + w] = ceq;
  __syncthreads();
  int oe = 0;
  for (int ww = 0; ww < w; ++ww) oe += misc[12 + ww];
  const unsigned long long lt = (1ull << lane) - 1ull;
  for (int i0 = beg; i0 < beg + seg; i0 += 64) {
    const int i = i0 + lane;
    bool in = i < n; unsigned u = in ? sc[i] : 0u;
    bool g = in && u > T, e = in && u == T;
    unsigned long long be = __ballot(e);
    int pe = oe + __popcll(be & lt);
    unsigned long long sm = __ballot(g || (e && pe < remaining));
    if (lane == 0 && i0 < n) sel[i0 >> 6] = sm;
    oe += __popcll(be);
  }
}

constexpr int NQ = 4;
DI void topk_group(const Params& p, int t, char* smem, unsigned* scr1, unsigned* scr2, unsigned* scr3) {
  unsigned* sc = (unsigned*)smem;
  int* hist = (int*)(smem + 65536);
  int* misc = hist + 2048;
  const int tid = otid() & 255, lane = tid & 63, w = tid >> 6, fr = lane & 15, fq = lane >> 4;
  int n; const u16* ixk;
  if (t < MP) { n = 64 * ((t >> 6) + 1); ixk = p.IXK; }
  else { int b = (t - MP) >> 4; n = SK; ixk = p.IXK + (size_t)(MP + b * SK) * 64; }
  unsigned long long* sel = p.SEL + (size_t)t * 256;
  __syncthreads();
  if (n <= 256) {
    if (tid < 4) {
      unsigned long long v = (tid < (n >> 6)) ? ~0ull : 0ull;
#pragma unroll
      for (int qi = 0; qi < NQ; ++qi) sel[qi * 256 + tid] = v;
    }
    return;
  }
  *(int4*)&hist[tid * 8] = make_int4(0, 0, 0, 0);
  *(int4*)&hist[tid * 8 + 4] = make_int4(0, 0, 0, 0);
  __syncthreads();
  {
    const u16* q = p.IXQ + (size_t)t * 1024 + fr * 64 + fq * 8;
    bf16x8 a0[NQ], a1[NQ];
    f32x4 wv[NQ];
#pragma unroll
    for (int qi = 0; qi < NQ; ++qi) {
      a0[qi] = *(const bf16x8*)(q + qi * 1024); a1[qi] = *(const bf16x8*)(q + qi * 1024 + 32);
      wv[qi] = *(const f32x4*)(p.IXW + (size_t)(t + qi) * 16 + fq * 4);
    }
    const int ntile = n >> 4;
    for (int kt0 = w; kt0 < ntile; kt0 += 32) {
      bf16x8 b0[8], b1[8];
#pragma unroll
      for (int g = 0; g < 8; ++g) {
        const int kt = min(kt0 + g * 4, ntile - 1);
        const u16* kp = ixk + (size_t)(kt * 16 + fr) * 64 + fq * 8;
        b0[g] = *(const bf16x8*)kp; b1[g] = *(const bf16x8*)(kp + 32);
      }
      float pt[NQ][8];
#pragma unroll
      for (int g = 0; g < 8; ++g) {
#pragma unroll
        for (int qi = 0; qi < NQ; ++qi) {
          f32x4 c = {0.f, 0.f, 0.f, 0.f};
          c = __builtin_amdgcn_mfma_f32_16x16x32_bf16(a0[qi], b0[g], c, 0, 0, 0);
          c = __builtin_amdgcn_mfma_f32_16x16x32_bf16(a1[qi], b1[g], c, 0, 0, 0);
          pt[qi][g] = fmaxf(c[0], 0.f) * wv[qi][0] + fmaxf(c[1], 0.f) * wv[qi][1] + fmaxf(c[2], 0.f) * wv[qi][2] + fmaxf(c[3], 0.f) * wv[qi][3];
        }
      }
#pragma unroll
      for (int g = 0; g < 8; g += 2) {
        const int kt = kt0 + (g + (lane >> 5)) * 4;
        const bool st = (lane & 16) == 0 && kt < ntile;
#pragma unroll
        for (int qi = 0; qi < NQ; ++qi) {
          auto r32 = __builtin_amdgcn_permlane32_swap(__float_as_uint(pt[qi][g]), __float_as_uint(pt[qi][g + 1]), false, false);
          float s2 = __uint_as_float(r32[0]) + __uint_as_float(r32[1]);
          auto r16 = __builtin_amdgcn_permlane16_swap(__float_as_uint(s2), __float_as_uint(s2), false, false);
          float sv = __uint_as_float(r16[0]) + __uint_as_float(r16[1]);
          if (st) {
            unsigned u = fkey(sv);
            if (qi == 0) { sc[kt * 16 + fr] = u; atomicAdd(&hist[u >> 21], 1); }
            else if (qi == 1) scr1[kt * 16 + fr] = u;
            else if (qi == 2) scr2[kt * 16 + fr] = u;
            else scr3[kt * 16 + fr] = u;
          }
        }
      }
    }
  }
  radix_select(sc, hist, misc, n, sel, tid, lane, w);
#pragma unroll 1
  for (int qi = 1; qi < NQ; ++qi) {
    const unsigned* scr = qi == 1 ? scr1 : (qi == 2 ? scr2 : scr3);
    __syncthreads();
    *(int4*)&hist[tid * 8] = make_int4(0, 0, 0, 0);
    *(int4*)&hist[tid * 8 + 4] = make_int4(0, 0, 0, 0);
    __syncthreads();
    for (int i = tid * 4; i < n; i += 256 * 4) {
      const u32x4 u4 = *(const u32x4*)(scr + i);
      *(u32x4*)(sc + i) = u4;
#pragma unroll
      for (int e = 0; e < 4; ++e) atomicAdd(&hist[u4[e] >> 21], 1);
    }
    radix_select(sc, hist, misc, n, sel + qi * 256, tid, lane, w);
  }
}

constexpr int KSTR = 192;
constexpr int VSTR = 72;
DI float xq_max(float x) {
  auto a = __builtin_amdgcn_permlane16_swap(__float_as_uint(x), __float_as_uint(x), false, false);
  x = fmaxf(__uint_as_float(a[0]), __uint_as_float(a[1]));
  auto b = __builtin_amdgcn_permlane32_swap(__float_as_uint(x), __float_as_uint(x), false, false);
  return fmaxf(__uint_as_float(b[0]), __uint_as_float(b[1]));
}
DI float xq_sum(float x) {
  auto a = __builtin_amdgcn_permlane16_swap(__float_as_uint(x), __float_as_uint(x), false, false);
  x = __uint_as_float(a[0]) + __uint_as_float(a[1]);
  auto b = __builtin_amdgcn_permlane32_swap(__float_as_uint(x), __float_as_uint(x), false, false);
  return __uint_as_float(b[0]) + __uint_as_float(b[1]);
}

template <int MODE>
DI void attn_item(const Params& p, int item, char* smem, u16* gdst) {
  constexpr int NKS = MODE == 0 ? 6 : 4;
  constexpr int ASTAGE = 64 * KSTR + 128 * VSTR;
  u16* sbase = (u16*)smem;
  float* sBias = (float*)(sbase + 2 * ASTAGE);
  const int tid = otid(), lane = tid & 63, w = tid >> 6, fr = lane & 15, fq = lane >> 4;
  const int ksw = (fr >> 1) & 7, ko0 = (fq ^ ksw) * 8, ko1 = ((4 + fq) ^ ksw) * 8;
  int h, q0, nq, krow0, nkeys, ntiles, myt, b = 0, qpos0;
  const u16* vt; size_t vstride;
  const bool sample = item >= 1024;
  if (!sample) {
    const int i = 63 - (item >> 4);
    h = item & 15; q0 = i * 256; nq = 256; krow0 = 0; nkeys = q0 + 256; ntiles = 4 * i + 4; qpos0 = q0;
    vt = (MODE == 0 ? p.VBT_P : p.VAT) + (size_t)h * 128 * MP; vstride = MP;
    myt = ntiles - 3 + (w >> 1);
  } else {
    const int j = item - 1024; b = j >> 4;
    h = j & 15; q0 = MP + b * 16; nq = 16; krow0 = MP + b * SK; nkeys = SK; ntiles = 17; qpos0 = 1024;
    vt = p.VBT_S + ((size_t)b * 2048 + h * 128) * VSS; vstride = VSS;
    myt = ntiles;
  }
  const int wq0 = w * 32;
  const bool active = wq0 < nq;
  __syncthreads();
  if (MODE == 1) {
    for (int i = tid; i < 257; i += NTHREADS) {
      int rel = i - 128;
      int ret = rel > 0 ? 16 : 0;
      int n = rel < 0 ? -rel : rel;
      float lf = logf((float)max(n, 1) / 8.0f) / 2.772588722239781f * 8.0f;
      int large = min(8 + (int)lf, 15);
      int bk = ret + (n < 8 ? n : large);
      sBias[i] = (p.rel[bk * 16 + h] - p.rel[15 * 16 + h]) * 1.4426950408889634f;
    }
  }
  bf16x8 qf[2][NKS];
  int qrow[2];
#pragma unroll
  for (int qt = 0; qt < 2; ++qt) {
    const int qr = min(wq0 + qt * 16 + fr, nq - 1);
    qrow[qt] = qr;
    const u16* qp = (MODE == 0) ? p.QB + (size_t)(q0 + qr) * 3072 + h * 192 + fq * 8 : p.AQ + (size_t)(q0 + qr) * 2048 + h * 128 + fq * 8;
#pragma unroll
    for (int ks = 0; ks < NKS; ++ks) qf[qt][ks] = *(const bf16x8*)(qp + ks * 32);
  }
  f32x4 o[2][8];
#pragma unroll
  for (int qt = 0; qt < 2; ++qt)
#pragma unroll
    for (int dt = 0; dt < 8; ++dt) o[qt][dt] = (f32x4){0.f, 0.f, 0.f, 0.f};
  float mrow[2] = {-1e30f, -1e30f}, lrow[2] = {0.f, 0.f};
  const float SC = (MODE == 0 ? 0.07216878364870322f : 0.08838834764831845f) * 1.4426950408889634f;

  unsigned long long mqn[2] = {0ull, 0ull};
  if (MODE == 1) {
#pragma unroll
    for (int qt = 0; qt < 2; ++qt) mqn[qt] = p.SEL[(size_t)(q0 + qrow[qt]) * 256];
  }
  constexpr int NKL = MODE == 0 ? 3 : 2;
  const bool direct = (MODE == 1) && sample;
  u32x4 rk[NKL], rv[2];
#define KV_LOAD(JT) { const size_t kr0_ = (size_t)(krow0 + (JT) * 64); const u16* kb_ = (MODE == 0 ? p.KB : p.KA) + (kr0_ + (tid >> 4)) * 2048 + h * 128 + (tid & 15) * 8; \
    _Pragma("unroll") for (int i = 0; i < 2; ++i) rk[i] = *(const u32x4*)(kb_ + (size_t)i * 32 * 2048); \
    if (MODE == 0) rk[NKL - 1] = *(const u32x4*)(p.KR + (kr0_ + (tid >> 3)) * 64 + (tid & 7) * 8); \
    const u16* vp_ = vt + (size_t)(tid >> 3) * vstride + (JT) * 64 + (tid & 7) * 8; \
    _Pragma("unroll") for (int i = 0; i < 2; ++i) rv[i] = *(const u32x4*)(vp_ + (size_t)i * 64 * vstride); }
#define KV_STORE(ST) { u16* sk_ = sbase + (ST) * ASTAGE; u16* dk_ = sk_ + (tid >> 4) * KSTR + ((tid & 15) ^ ((tid >> 5) & 7)) * 8; \
    _Pragma("unroll") for (int i = 0; i < 2; ++i) *(u32x4*)(dk_ + i * 32 * KSTR) = rk[i]; \
    if (MODE == 0) *(u32x4*)(sk_ + (tid >> 3) * KSTR + 128 + ((tid & 7) ^ ((tid >> 4) & 7)) * 8) = rk[NKL - 1]; \
    u16* dv_ = sk_ + 64 * KSTR + (tid >> 3) * VSTR + (tid & 7) * 8; \
    _Pragma("unroll") for (int i = 0; i < 2; ++i) *(u32x4*)(dv_ + i * 64 * VSTR) = rv[i]; }
  if (!direct) {
    KV_LOAD(0)
    KV_STORE(0)
    KV_LOAD(min(1, ntiles - 1))
  }
  for (int jt = 0; jt < ntiles; ++jt) {
    const int key0 = jt * 64;
    u16* sK = sbase + (jt & 1) * ASTAGE;
    u16* sV = sK + 64 * KSTR;
    unsigned long long mq[2] = {mqn[0], mqn[1]};
    if (MODE == 1) {
      const int jn = min(jt + 1, ntiles - 1);
#pragma unroll
      for (int qt = 0; qt < 2; ++qt) mqn[qt] = p.SEL[(size_t)(q0 + qrow[qt]) * 256 + jn];
    }
    __syncthreads();
    if (!direct) {
      if (jt + 1 < ntiles) KV_STORE((jt + 1) & 1)
      KV_LOAD(min(jt + 2, ntiles - 1))
    } else {
#pragma unroll 2
      for (int i = 0; i < 4; ++i) {
        const int c = tid + i * NTHREADS;
        const int key = c >> 5, part = c & 31;
        const int s = key0 + key;
        const int sc_ = min(s, SK - 1);
        const size_t o1 = sc_ < 1024 ? ((size_t)b * 1024 + sc_) * 2048 : ((size_t)b * 16 + (sc_ - 1024)) * 2048;
        const float* kp = (sc_ < 1024 ? p.c_ak : p.out + O_AKS) + o1 + h * 128 + part * 4;
        const float* vp = (sc_ < 1024 ? p.c_av : p.out + O_AVS) + o1 + h * 128 + part * 4;
        f32x4 kv = *(const f32x4*)kp, vv = *(const f32x4*)vp;
        u32x2 kk; kk[0] = cvtpk(kv[0], kv[1]); kk[1] = cvtpk(kv[2], kv[3]);
        *(u32x2*)(sK + key * KSTR + (((part >> 1) ^ ((key >> 1) & 7)) * 8) + (part & 1) * 4) = kk;
        const bool ok = s < SK;
#pragma unroll
        for (int e = 0; e < 4; ++e) sV[(part * 4 + e) * VSTR + key] = ok ? f2bf(vv[e]) : (u16)0;
      }
      __syncthreads();
    }
    if (active && jt < myt) {
      f32x4 s[2][4];
#pragma unroll
      for (int qt = 0; qt < 2; ++qt) {
        const float nb_ = (jt == 0) ? 0.f : -mrow[qt];
#pragma unroll
        for (int kt = 0; kt < 4; ++kt) s[qt][kt] = (f32x4){nb_, nb_, nb_, nb_};
      }
      __builtin_amdgcn_s_setprio(1);
#pragma unroll
      for (int kt = 0; kt < 4; ++kt) {
#pragma unroll
        for (int ks = 0; ks < NKS; ++ks) {
          bf16x8 kf = *(const bf16x8*)(sK + (kt * 16 + fr) * KSTR + (ks >> 1) * 64 + ((ks & 1) ? ko1 : ko0));
          s[0][kt] = __builtin_amdgcn_mfma_f32_16x16x32_bf16(kf, qf[0][ks], s[0][kt], 0, 0, 0);
          s[1][kt] = __builtin_amdgcn_mfma_f32_16x16x32_bf16(kf, qf[1][ks], s[1][kt], 0, 0, 0);
        }
      }
      __builtin_amdgcn_s_setprio(0);
      unsigned mlo[2] = {0u, 0u}, mhi[2] = {0u, 0u};
      if (MODE == 0) {
        if (key0 + 64 > nkeys) {
#pragma unroll
          for (int kt = 0; kt < 4; ++kt)
#pragma unroll
            for (int j = 0; j < 4; ++j)
              if (key0 + kt * 16 + fq * 4 + j >= nkeys) { s[0][kt][j] = -1e30f; s[1][kt][j] = -1e30f; }
        }
      } else {
        const bool far = (key0 + 63) - (qpos0 + wq0) <= -128;
        if (!far) {
#pragma unroll
          for (int qt = 0; qt < 2; ++qt) {
            const int rb = key0 + fq * 4 - (qpos0 + qrow[qt]) + 128;
#pragma unroll
            for (int kt = 0; kt < 4; ++kt)
#pragma unroll
              for (int j = 0; j < 4; ++j) {
                int r = min(max(rb + kt * 16 + j, 0), 256);
                s[qt][kt][j] += sBias[r];
              }
          }
        }
#pragma unroll
        for (int qt = 0; qt < 2; ++qt) {
          const unsigned long long mm = mq[qt] >> (fq * 4);
          mlo[qt] = (unsigned)mm; mhi[qt] = (unsigned)(mm >> 32);
        }
      }
      bf16x8 pf[2][2];
#pragma unroll
      for (int qt = 0; qt < 2; ++qt) {
        float mx = -1e30f;
#pragma unroll
        for (int kt = 0; kt < 4; ++kt)
#pragma unroll
          for (int j = 0; j < 4; ++j) mx = fmaxf(mx, s[qt][kt][j]);
        mx = xq_max(mx);
        const float delta = (jt == 0) ? mx : fmaxf(mx, 0.f);
        mrow[qt] = (jt == 0) ? delta : mrow[qt] + delta;
        const bool grow = __ballot(delta != 0.f) != 0ull;
        float alpha = 1.f;
        if (grow) {
          alpha = __builtin_amdgcn_exp2f(-delta);
#pragma unroll
          for (int kt = 0; kt < 4; ++kt) s[qt][kt] -= delta;
        }
        float rs = 0.f;
#pragma unroll
        for (int kt = 0; kt < 4; ++kt)
#pragma unroll
          for (int j = 0; j < 4; ++j) {
            float pv = __builtin_amdgcn_exp2f(s[qt][kt][j]);
            if (MODE == 1) {
              const int keep = __builtin_amdgcn_sbfe((int)(kt < 2 ? mlo[qt] : mhi[qt]), (kt & 1) * 16 + j, 1);
              pv = __int_as_float(__float_as_int(pv) & keep);
            }
            s[qt][kt][j] = pv; rs += pv;
          }
        rs = xq_sum(rs);
        lrow[qt] = lrow[qt] * alpha + rs;
        if (grow) {
#pragma unroll
          for (int dt = 0; dt < 8; ++dt) o[qt][dt] *= alpha;
        }
#pragma unroll
        for (int s2 = 0; s2 < 2; ++s2) {
          u32x4 pk;
          pk[0] = cvtpk(s[qt][2 * s2][0], s[qt][2 * s2][1]);
          pk[1] = cvtpk(s[qt][2 * s2][2], s[qt][2 * s2][3]);
          pk[2] = cvtpk(s[qt][2 * s2 + 1][0], s[qt][2 * s2 + 1][1]);
          pk[3] = cvtpk(s[qt][2 * s2 + 1][2], s[qt][2 * s2 + 1][3]);
          pf[qt][s2] = __builtin_bit_cast(bf16x8, pk);
        }
      }
      __builtin_amdgcn_s_setprio(1);
#pragma unroll
      for (int dt = 0; dt < 8; ++dt) {
#pragma unroll
        for (int s2 = 0; s2 < 2; ++s2) {
          const u16* vp = sV + (dt * 16 + fr) * VSTR + fq * 4;
          u32x2 v0 = *(const u32x2*)(vp + (2 * s2) * 16);
          u32x2 v1 = *(const u32x2*)(vp + (2 * s2 + 1) * 16);
          u32x4 vv = {v0[0], v0[1], v1[0], v1[1]};
          bf16x8 vf = __builtin_bit_cast(bf16x8, vv);
          o[0][dt] = __builtin_amdgcn_mfma_f32_16x16x32_bf16(vf, pf[0][s2], o[0][dt], 0, 0, 0);
          o[1][dt] = __builtin_amdgcn_mfma_f32_16x16x32_bf16(vf, pf[1][s2], o[1][dt], 0, 0, 0);
        }
      }
      __builtin_amdgcn_s_setprio(0);
    }
  }
  if (active) {
#pragma unroll
    for (int qt = 0; qt < 2; ++qt) {
      const int qr = wq0 + qt * 16 + fr;
      if (qr < nq) {
        const float inv = 1.f / lrow[qt];
        const size_t row = (size_t)(q0 + qr);
#pragma unroll
        for (int dt = 0; dt < 8; ++dt) {
          const size_t off = row * 2048 + h * 128 + dt * 16 + fq * 4;
          u32x2 ga = *(const u32x2*)(p.GA + off);
          u32x2 r;
          if (MODE == 0) {
            u32x2 gb = *(const u32x2*)(p.GB + off);
            r[0] = cvtpk(bflo(gb[0]) * o[qt][dt][0] * inv + bflo(ga[0]), bfhi(gb[0]) * o[qt][dt][1] * inv + bfhi(ga[0]));
            r[1] = cvtpk(bflo(gb[1]) * o[qt][dt][2] * inv + bflo(ga[1]), bfhi(gb[1]) * o[qt][dt][3] * inv + bfhi(ga[1]));
          } else {
            r[0] = cvtpk(bflo(ga[0]) * o[qt][dt][0] * inv, bfhi(ga[0]) * o[qt][dt][1] * inv);
            r[1] = cvtpk(bflo(ga[1]) * o[qt][dt][2] * inv, bfhi(ga[1]) * o[qt][dt][3] * inv);
          }
          *(u32x2*)(gdst + off) = r;
        }
      }
    }
  }
}

#undef KV_LOAD
#undef KV_STORE
__global__ void __launch_bounds__(NTHREADS) fwd_megakernel(Params p) {
  extern __shared__ __attribute__((aligned(16))) char smem[];
  cg::grid_group grid = cg::this_grid();
#define IDS const int tid = otid(); const int lane = tid & 63, w = tid >> 6; const int bid = blockIdx.x, nb = gridDim.x; \
  const int gw = bid * 8 + w, ngw = nb * 8; (void)tid; (void)lane; (void)gw; (void)ngw; (void)bid; (void)nb;

#if PH & (1 << 0)
  { IDS
  {
    const int vb = tid >> 8;
    float* st = (float*)(smem + vb * VB_LDS);
    const int vbid = bid * 2 + vb, nvb = nb * 2;
    for (int t = vbid; t < 32 * 192; t += nvb) transpose_tile(p.w_in, 2048, INC, p.WT_IN, t, st);
    for (int t = vbid; t < 8 * 48; t += nvb) transpose_tile(p.w_uq, 512, 3072, p.WT_UQ, t, st);
    for (int t = vbid; t < 4 * 32; t += nvb) transpose_tile(p.w_uk, 256, 2048, p.WT_UK, t, st);
    for (int t = vbid; t < 4 * 32; t += nvb) transpose_tile(p.w_uv, 256, 2048, p.WT_UV, t, st);
    for (int t = vbid; t < 32 * 32; t += nvb) transpose_tile(p.w_out, 2048, 2048, p.WT_OUT, t, st);
    for (int t = vbid; t < 32 * 128; t += nvb) transpose_tile(p.w_up, 2048, 8192, p.WT_UP, t, st);
    for (int t = vbid; t < 128 * 32; t += nvb) transpose_tile(p.w_down, 8192, 2048, p.WT_DOWN, t, st);
    for (int r = gw; r < MT; r += ngw) {
      const float* x = r < MP ? p.x_p + (size_t)r * 2048 : p.x_s + (size_t)(r - MP) * 2048;
      rms_row_2048(x, p.g_mix, p.H + (size_t)r * 2048, lane);
    }
    const int gt = bid * NTHREADS + tid, ngt = nb * NTHREADS;
    for (int i = gt; i < 16 * 1024 * 64 / 4; i += ngt) {
      int e = i * 4; int b = e >> 16; int rem = e & 65535; int s = rem >> 6, c = rem & 63;
      size_t dst = (size_t)(MP + b * SK + s) * 64 + c;
      f32x4 a = *(const f32x4*)(p.c_idx + e), k = *(const f32x4*)(p.c_kr + e);
      u32x2 o; o[0] = cvtpk(a[0], a[1]); o[1] = cvtpk(a[2], a[3]);
      *(u32x2*)(p.IXK + dst) = o;
      o[0] = cvtpk(k[0], k[1]); o[1] = cvtpk(k[2], k[3]);
      *(u32x2*)(p.KR + dst) = o;
    }
    for (int i = gt; i < 16 * 1024 * 256 / 4; i += ngt) {
      int e = i * 4; int b = e >> 18; int rem = e & 262143; int s = rem >> 8, c = rem & 255;
      size_t dst = (size_t)(MP + b * SK + s) * 256 + c;
      f32x4 a = *(const f32x4*)(p.c_ckv + e);
      u32x2 o; o[0] = cvtpk(a[0], a[1]); o[1] = cvtpk(a[2], a[3]);
      *(u32x2*)(p.CKV + dst) = o;
    }
  }
  }
#endif
  grid.sync();
#if PH & (1 << 1)
  { IDS
  for (int rep = 0; rep < NREP(1); ++rep) gemm_phase<EPI_IN>(p, p.H, 2048, p.WT_IN, 2048, 2048, MT / 256, INP / 256, smem, nullptr, 0, bid, nb);
  }
#endif
  grid.sync();
#if PH & (1 << 2)
  { IDS
  for (int t = gw; t < MT; t += ngw) post_row(p, t, lane);
  {
    const int vb = tid >> 8, vbid = bid * 2 + vb;
    char* sm = smem + vb * VB_LDS;
    for (int rep = 0; rep < NREP(2); ++rep) for (int t = vbid * NQ; t < MT; t += nb * 2 * NQ)
      topk_group(p, t, sm, (unsigned*)(p.out + O_Y + 14000000) + (size_t)vbid * 16384, (unsigned*)(p.out + O_Y + 14000000) + (size_t)(512 + vbid) * 16384,
                 (unsigned*)p.H + (size_t)vbid * 16384);
  }
  }
#endif
  grid.sync();
#if PH & (1 << 3)
  { IDS
    const int total = 1024 + 256;
    for (int rep = 0; rep < NREP(3); ++rep) {
      u16* gdst = (rep + 1 < NREP(3)) ? (u16*)(p.out + O_Y) : p.GA;
      for (int r = 0;; ++r) {
        int id = (r & 1) ? r * nb + (nb - 1 - bid) : r * nb + bid;
        if (r * nb >= total) break;
        if (id < total) attn_item<1>(p, id, smem, gdst);
      }
    }
  }
#endif
  grid.sync();
#if PH & (1 << 4)
  { IDS
  {
    const int gt = bid * NTHREADS + tid, ngt = nb * NTHREADS;
    for (int i = gt; i < MS * 2048 / 4; i += ngt)
      *(f32x4*)(p.out + O_Y + (size_t)MP * 2048 + (size_t)i * 4) = *(const f32x4*)(p.x_s + (size_t)i * 4);
    for (int i = gt; i < 16 * 2048 * 6; i += ngt) {
      int r = i / 6, c = i - r * 6;
      *(u32x4*)(p.VBT_S + (size_t)r * VSS + SK + c * 8) = (u32x4){0u, 0u, 0u, 0u};
    }
    const int nqb = (MT / 256) * 12, nkb = (KROWS / 256) * 8;
    const int total = nqb + 2 * nkb;
    for (int id = bid; id < total; id += nb) {
      if (id < nqb) gemm_phase<EPI_QB>(p, p.CQ, 512, p.WT_UQ, 512, 512, MT / 256, 12, smem, p.QB, 3072, id, 1 << 30);
      else if (id < nqb + nkb) gemm_phase<EPI_BF16>(p, p.CKV, 256, p.WT_UK, 256, 256, KROWS / 256, 8, smem, p.KB, 2048, id - nqb, 1 << 30);
      else gemm_phase<EPI_VT>(p, p.CKV, 256, p.WT_UV, 256, 256, KROWS / 256, 8, smem, nullptr, 0, id - nqb - nkb, 1 << 30);
    }
  }
  }
#endif
  grid.sync();
#if PH & (1 << 5)
  { IDS
  {
    const int total = 1024 + 256;
    for (int rep = 0; rep < NREP(5); ++rep) {
      u16* gdst = (rep + 1 < NREP(5)) ? (u16*)(p.out + O_Y) : p.GB;
      for (int r = 0;; ++r) {
        int id = (r & 1) ? r * nb + (nb - 1 - bid) : r * nb + bid;
        if (r * nb >= total) break;
        if (id < total) attn_item<0>(p, id, smem, gdst);
      }
    }
  }
  }
#endif
  grid.sync();
#if PH & (1 << 6)
  { IDS
  gemm_phase<EPI_RES>(p, p.GB, 2048, p.WT_OUT, 2048, 2048, MT / 256 - 1, 8, smem, nullptr, 0, bid, nb);
  for (int id = bid; id < 128; id += nb) {
    const int nt = id & 7, kc = id >> 3;
    gemm_tile<EPI_ATOM>(p, p.GB + kc * 128, 2048, p.WT_OUT + kc * 128, 2048, 128, (MT / 256 - 1) * 256, nt * 256, smem, nullptr, 0);
  }
  }
#endif
  grid.sync();
#if PH & (1 << 7)
  { IDS
  for (int r = gw; r < MT; r += ngw) rms_row_2048(p.out + O_Y + (size_t)r * 2048, p.g_ffn, p.H2 + (size_t)r * 2048, lane);
  }
#endif
  grid.sync();
#if PH & (1 << 8)
  { IDS
  for (int rep = 0; rep < NREP(8); ++rep) gemm_phase<EPI_RELU2>(p, p.H2, 2048, p.WT_UP, 2048, 2048, MT / 256, 32, smem, nullptr, 0, bid, nb);
  }
#endif
  grid.sync();
#if PH & (1 << 9)
  { IDS
  gemm_phase<EPI_ACC>(p, p.U, DFF, p.WT_DOWN, DFF, DFF, MT / 256 - 1, 8, smem, nullptr, 0, bid, nb);
  for (int id = bid; id < 256; id += nb) {
    const int nt = id & 7, kc = id >> 3;
    gemm_tile<EPI_ATOM>(p, p.U + kc * 256, DFF, p.WT_DOWN + kc * 256, DFF, 256, (MT / 256 - 1) * 256, nt * 256, smem, nullptr, 0);
  }
  }
#endif
  grid.sync();
#if PH & (1 << 10)
  { IDS
  for (int r = gw; r < MT; r += ngw) {
    float* x = p.out + O_Y + (size_t)r * 2048;
    f32x4 v[8];
    float ss = 0.f;
#pragma unroll
    for (int i = 0; i < 8; ++i) {
      v[i] = *(const f32x4*)(x + i * 256 + lane * 4);
      ss += v[i][0] * v[i][0] + v[i][1] * v[i][1] + v[i][2] * v[i][2] + v[i][3] * v[i][3];
    }
    ss = wave_sum(ss);
    float rr = rsqrtf(ss * (1.f / 2048.f) + 1e-6f);
#pragma unroll
    for (int i = 0; i < 8; ++i) {
      f32x4 gg = *(const f32x4*)(p.g_fin + i * 256 + lane * 4);
      f32x4 o = {v[i][0] * rr * gg[0], v[i][1] * rr * gg[1], v[i][2] * rr * gg[2], v[i][3] * rr * gg[3]};
      *(f32x4*)(x + i * 256 + lane * 4) = o;
    }
  }
  }
#endif
}

extern "C" void kernel_launch(void* const* d_in, const int* in_sizes, int n_in, void* d_out, int out_size, void* d_ws, size_t ws_size,
                              hipStream_t stream) {
  static int grid_blocks = 0;
  if (!grid_blocks) {
    int dev = 0, cus = 0, per_cu = 0;
    hipGetDevice(&dev);
    hipDeviceGetAttribute(&cus, hipDeviceAttributeMultiprocessorCount, dev);
    if (hipFuncSetAttribute((const void*)fwd_megakernel, hipFuncAttributeMaxDynamicSharedMemorySize, LDS_BYTES) != hipSuccess)
      fprintf(stderr, "kernel_launch: hipFuncSetAttribute failed\n");
    hipOccupancyMaxActiveBlocksPerMultiprocessor(&per_cu, (const void*)fwd_megakernel, NTHREADS, LDS_BYTES);
    if (per_cu < 1) per_cu = 1;
    if (per_cu > 1) per_cu = 1;
    grid_blocks = cus * per_cu;
  }
  Params p{};
  const float* const* in = (const float* const*)d_in;
  p.x_p = in[0]; p.x_s = in[1]; p.c_ak = in[2]; p.c_av = in[3]; p.c_idx = in[4]; p.c_ckv = in[5]; p.c_kr = in[6]; p.rel = in[7];
  p.g_mix = in[8]; p.w_in = in[9]; p.g_q = in[10]; p.w_uq = in[11]; p.g_kv = in[12]; p.w_uk = in[13]; p.w_uv = in[14]; p.w_out = in[15];
  p.g_ffn = in[16]; p.w_up = in[17]; p.w_down = in[18]; p.g_fin = in[19];
  p.out = (float*)d_out;
  char* ws = (char*)d_ws;
  size_t off = 0;
  auto alloc = [&](size_t bytes) { char* r = ws + off; off += (bytes + 255) & ~(size_t)255; return r; };
  p.WT_UQ = (u16*)alloc((size_t)3072 * 512 * 2);
  p.WT_UK = (u16*)alloc((size_t)2048 * 256 * 2);
  p.WT_UV = (u16*)alloc((size_t)2048 * 256 * 2);
  p.WT_OUT = (u16*)alloc((size_t)2048 * 2048 * 2);
  p.WT_UP = (u16*)alloc((size_t)8192 * 2048 * 2);
  p.WT_DOWN = (u16*)alloc((size_t)2048 * 8192 * 2);
  p.CQ = (u16*)alloc((size_t)MT * 512 * 2);
  p.CKV = (u16*)alloc((size_t)KROWS * 256 * 2);
  p.KR = (u16*)alloc((size_t)KROWS * 64 * 2);
  p.GA = (u16*)alloc((size_t)MT * 2048 * 2);
  p.GB = (u16*)alloc((size_t)MT * 2048 * 2);
  p.CS = (float*)alloc((size_t)MT * 32 * 4);
  p.SN = (float*)alloc((size_t)MT * 32 * 4);
  const size_t ubase = off;
  p.WT_IN = (u16*)alloc((size_t)INP * 2048 * 2);
  p.H = (u16*)alloc((size_t)MT * 2048 * 2);
  p.AQ = (u16*)alloc((size_t)MT * 2048 * 2);
  p.KA = (u16*)alloc((size_t)MP * 2048 * 2);
  p.VAT = (u16*)alloc((size_t)MP * 2048 * 2);
  p.IXQ = (u16*)alloc((size_t)MT * 1024 * 2);
  p.IXK = (u16*)alloc((size_t)KROWS * 64 * 2);
  p.SEL = (unsigned long long*)alloc((size_t)MT * 256 * 8);
  p.IXW = (float*)alloc((size_t)MT * 16 * 4);
  const size_t endA = off;
  off = ubase;
  p.QB = (u16*)alloc((size_t)MT * 3072 * 2);
  p.KB = (u16*)alloc((size_t)KROWS * 2048 * 2);
  p.VBT_P = (u16*)alloc((size_t)2048 * MP * 2);
  p.VBT_S = (u16*)alloc((size_t)16 * 2048 * VSS * 2);
  const size_t endB = off;
  off = ubase;
  p.H2 = (u16*)alloc((size_t)MT * 2048 * 2);
  p.U = (u16*)alloc((size_t)MT * DFF * 2);
  const size_t endC = off;
  size_t need = endA > endB ? endA : endB;
  if (endC > need) need = endC;
  if (need > ws_size) { fprintf(stderr, "kernel_launch: workspace too small: need %zu have %zu\n", need, ws_size); return; }
  void* args[] = {&p};
  hipError_t e = hipLaunchCooperativeKernel((const void*)fwd_megakernel, dim3(grid_blocks), dim3(NTHREADS), args, LDS_BYTES, stream);
  if (e != hipSuccess) fprintf(stderr, "cooperative launch failed: %s (grid %d)\n", hipGetErrorString(e), grid_blocks);
}
```

```cpp
#include <hip/hip_runtime.h>
#include <hip/hip_cooperative_groups.h>
#include <cstdio>
#include <cstdint>
namespace cg = cooperative_groups;

typedef unsigned short u16;
typedef __attribute__((ext_vector_type(8))) short bf16x8;
typedef __attribute__((ext_vector_type(4))) short bf16x4;
typedef __attribute__((ext_vector_type(4))) float f32x4;
typedef __attribute__((ext_vector_type(2))) float f32x2;
typedef __attribute__((ext_vector_type(2))) __bf16 bf16x2_t;
typedef __attribute__((ext_vector_type(4))) unsigned u32x4;
typedef __attribute__((ext_vector_type(2))) unsigned u32x2;

#define DI __device__ __forceinline__

constexpr int MP = 16384;
constexpr int MS = 256;
constexpr int MT = MP + MS;
constexpr int DM = 2048;
constexpr int INC = 12176;
constexpr int INP = 12288;
constexpr int SK = 1040;
constexpr int KROWS = MP + 16 * SK;
constexpr int VSS = 1088;
constexpr int DFF = 8192;
constexpr int ZRW = 832;
#ifndef PH
#define PH 0x7ff
#endif
#ifndef REP
#define REP 0
#endif
#define NREP(k) (((REP >> (k)) & 1) + 1)
constexpr int NTHREADS = 512;
constexpr int VB_LDS = 75776;
constexpr int LDS_BYTES = 2 * VB_LDS;

constexpr size_t O_Y = 0;
constexpr size_t O_AKP = 34078720;
constexpr size_t O_AVP = 67633152;
constexpr size_t O_IDXP = 101187584;
constexpr size_t O_CKVP = 102236160;
constexpr size_t O_KRP = 106430464;
constexpr size_t O_AKS = 107479040;
constexpr size_t O_AVS = 108003328;
constexpr size_t O_IDXS = 108527616;
constexpr size_t O_CKVS = 108544000;
constexpr size_t O_KRS = 108609536;

struct Params {
  const float *x_p, *x_s, *c_ak, *c_av, *c_idx, *c_ckv, *c_kr, *rel, *g_mix, *w_in, *g_q, *w_uq, *g_kv, *w_uk, *w_uv, *w_out, *g_ffn, *w_up, *w_down, *g_fin;
  float* out;
  u16 *WT_UQ, *WT_UK, *WT_UV, *WT_OUT, *WT_UP, *WT_DOWN, *CQ, *CKV, *KR, *GA, *GB;
  float *CS, *SN;
  u16 *WT_IN, *H, *AQ, *KA, *VAT, *IXQ, *IXK;
  float* IXW;
  unsigned long long* SEL;
  u16 *QB, *KB, *VBT_P, *VBT_S;
  u16 *H2, *U;
};

DI int otid() { int t = threadIdx.x; asm volatile("" : "+v"(t)); return t; }
DI unsigned cvtpk(float lo, float hi) {
  f32x2 v = {lo, hi};
  bf16x2_t b = __builtin_convertvector(v, bf16x2_t);
  return __builtin_bit_cast(unsigned, b);
}
DI u16 f2bf(float x) { return (u16)(cvtpk(x, 0.f) & 0xffffu); }
DI float bf2f(u16 b) { return __uint_as_float(((unsigned)b) << 16); }
DI float bflo(unsigned w) { return __uint_as_float(w << 16); }
DI float bfhi(unsigned w) { return __uint_as_float(w & 0xffff0000u); }
DI float dot2bf(unsigned a, unsigned b, float c) {
  return __builtin_amdgcn_fdot2_f32_bf16(__builtin_bit_cast(bf16x2_t, a), __builtin_bit_cast(bf16x2_t, b), c, false);
}
DI float wave_sum(float v) {
#pragma unroll
  for (int o = 32; o > 0; o >>= 1) v += __shfl_xor(v, o);
  return v;
}
DI int qpos_of(int t) { return t < MP ? t : 1024 + ((t - MP) & 15); }
DI int krow_of(int t) { return t < MP ? t : MP + ((t - MP) >> 4) * SK + 1024 + ((t - MP) & 15); }
DI float inv_freq(int i) { return exp2f(-(float)i * 0.41524101186092029f); }

DI void transpose_tile(const float* __restrict__ W, int K, int N, u16* __restrict__ Wt, int tile, float* s  ) {
  const int nkt = K >> 6;
  const int kt = tile % nkt, nt = tile / nkt;
  const int k0 = kt << 6, n0 = nt << 6;
  const int tid = otid() & 255;
  const int c = tid & 63, r0 = tid >> 6;
  __syncthreads();
#pragma unroll
  for (int i = 0; i < 16; ++i) {
    int r = i * 4 + r0;
    float v = (n0 + c < N) ? W[(size_t)(k0 + r) * N + n0 + c] : 0.f;
    s[r * 65 + c] = v;
  }
  __syncthreads();
  const int kp = (tid & 31) * 2, rr0 = tid >> 5;
#pragma unroll
  for (int i = 0; i < 8; ++i) {
    int rr = i * 8 + rr0;
    unsigned pk = cvtpk(s[kp * 65 + rr], s[(kp + 1) * 65 + rr]);
    *(unsigned*)(Wt + (size_t)(n0 + rr) * K + k0 + kp) = pk;
  }
}

DI void rms_row_2048(const float* __restrict__ x, const float* __restrict__ g, u16* __restrict__ out, int lane) {
  f32x4 v[8];
  float ss = 0.f;
#pragma unroll
  for (int i = 0; i < 8; ++i) {
    v[i] = *(const f32x4*)(x + i * 256 + lane * 4);
    ss += v[i][0] * v[i][0] + v[i][1] * v[i][1] + v[i][2] * v[i][2] + v[i][3] * v[i][3];
  }
  ss = wave_sum(ss);
  float r = rsqrtf(ss * (1.f / 2048.f) + 1e-6f);
#pragma unroll
  for (int i = 0; i < 8; ++i) {
    f32x4 gg = *(const f32x4*)(g + i * 256 + lane * 4);
    u32x2 o;
    o[0] = cvtpk(v[i][0] * r * gg[0], v[i][1] * r * gg[1]);
    o[1] = cvtpk(v[i][2] * r * gg[2], v[i][3] * r * gg[3]);
    *(u32x2*)(out + i * 256 + lane * 4) = o;
  }
}

enum { EPI_IN = 0, EPI_QB, EPI_BF16, EPI_VT, EPI_RES, EPI_RELU2, EPI_ACC, EPI_ATOM };
constexpr float QSC = 0.07216878364870322f * 1.4426950408889634f;
constexpr int LSTR = 64;
#ifndef PFA
#define PFA 8
#endif

template <int EPI> struct EpiSwap { static constexpr bool v = (EPI != EPI_VT); };

DI u32x2 pack4(f32x4 v) { u32x2 r; r[0] = cvtpk(v[0], v[1]); r[1] = cvtpk(v[2], v[3]); return r; }
DI float relu_i(float x) { return __int_as_float(max(__float_as_int(x), 0)); }
DI float sigm(float v) { return __builtin_amdgcn_rcpf(1.f + __builtin_amdgcn_exp2f(v * -1.4426950408889634f)); }

template <int EPI>
DI void gemm_epilogue(const Params& p, f32x4 (&acc)[8][4], int m0, int n0, int wr, int wc, int fr, int fq, u16* Cb, int ldc) {
  const int cw = n0 + wc * 64;
  if (EPI == EPI_VT) {
#pragma clang loop unroll(full)
    for (int m = 0; m < 8; ++m) {
      const int rb = m0 + wr * 128 + m * 16 + fq * 4;
#pragma clang loop unroll(full)
      for (int n = 0; n < 4; ++n) {
        const int col = cw + n * 16 + fr;
        u16* dst;
        if (rb < MP) dst = p.VBT_P + (size_t)col * MP + rb;
        else { int r2 = rb - MP; int b = r2 / SK; int s = r2 - b * SK; dst = p.VBT_S + ((size_t)b * 2048 + col) * VSS + s; }
        *(u32x2*)dst = pack4(acc[m][n]);
      }
    }
    return;
  }
  const int rbase = m0 + wr * 128 + fr;
  const int c4 = fq * 4;
  if (EPI == EPI_QB) {
    if (cw % 192 == 128) {
#pragma clang loop unroll(full)
      for (int m = 0; m < 8; ++m) {
        const int row = rbase + m * 16;
#pragma clang loop unroll(full)
        for (int n = 0; n < 2; ++n) {
          const int i0 = n * 16 + c4;
          const f32x4 cs = *(const f32x4*)(p.CS + (size_t)row * 32 + i0), sn = *(const f32x4*)(p.SN + (size_t)row * 32 + i0);
          const f32x4 x1 = acc[m][n] * QSC, x2 = acc[m][n + 2] * QSC;
          *(u32x2*)(p.QB + (size_t)row * 3072 + cw + i0) = pack4(x1 * cs - x2 * sn);
          *(u32x2*)(p.QB + (size_t)row * 3072 + cw + i0 + 32) = pack4(x1 * sn + x2 * cs);
        }
      }
      return;
    }
  }
#pragma clang loop unroll(full)
  for (int n = 0; n < 4; ++n) {
    const int colt = cw + n * 16;
    const int col = colt + c4;
    if (EPI == EPI_IN) {
      const bool smp = m0 >= MP;
      if (colt < 2048) {
#pragma clang loop unroll(full)
        for (int m = 0; m < 8; ++m) *(u32x2*)(p.AQ + (size_t)(rbase + m * 16) * 2048 + col) = pack4(acc[m][n] * (0.08838834764831845f * 1.4426950408889634f));
      } else if (colt < 4096) {
        const int c = col - 2048;
#pragma clang loop unroll(full)
        for (int m = 0; m < 8; ++m) {
          const int row = rbase + m * 16;
          if (!smp) { *(f32x4*)(p.out + O_AKP + (size_t)row * 2048 + c) = acc[m][n]; *(u32x2*)(p.KA + (size_t)row * 2048 + c) = pack4(acc[m][n]); }
          else *(f32x4*)(p.out + O_AKS + (size_t)(row - MP) * 2048 + c) = acc[m][n];
        }
      } else if (colt < 6144) {
        const int c = col - 4096;
#pragma clang loop unroll(full)
        for (int m = 0; m < 8; ++m) {
          const int row = rbase + m * 16;
          if (!smp) {
            *(f32x4*)(p.out + O_AVP + (size_t)row * 2048 + c) = acc[m][n];
#pragma clang loop unroll(full)
            for (int j = 0; j < 4; ++j) p.VAT[(size_t)(c + j) * MP + row] = f2bf(acc[m][n][j]);
          } else *(f32x4*)(p.out + O_AVS + (size_t)(row - MP) * 2048 + c) = acc[m][n];
        }
      } else if (colt < 7168) {
#pragma clang loop unroll(full)
        for (int m = 0; m < 8; ++m) *(u32x2*)(p.IXQ + (size_t)(rbase + m * 16) * 1024 + (col - 6144)) = pack4(acc[m][n]);
      } else if (colt < 7232) {
        const int c = col - 7168;
#pragma clang loop unroll(full)
        for (int m = 0; m < 8; ++m) {
          const int row = rbase + m * 16;
          if (!smp) *(f32x4*)(p.out + O_IDXP + (size_t)row * 64 + c) = acc[m][n];
          else *(f32x4*)(p.out + O_IDXS + (size_t)(row - MP) * 64 + c) = acc[m][n];
          *(u32x2*)(p.IXK + (size_t)krow_of(row) * 64 + c) = pack4(acc[m][n]);
        }
      } else if (colt < 7248) {
#pragma clang loop unroll(full)
        for (int m = 0; m < 8; ++m) *(f32x4*)(p.IXW + (size_t)(rbase + m * 16) * 16 + (col - 7232)) = acc[m][n] * 0.25f;
      } else if (colt < 8080) {
#pragma clang loop unroll(full)
        for (int m = 0; m < 8; ++m) *(f32x4*)(p.out + O_Y + (size_t)(rbase + m * 16) * ZRW + (col - 7248)) = acc[m][n];
      } else if (colt < INC) {
        u16* G = colt < 10128 ? p.GA : p.GB;
        const int c = colt < 10128 ? col - 8080 : col - 10128;
#pragma clang loop unroll(full)
        for (int m = 0; m < 8; ++m) {
          f32x4 v = acc[m][n];
          f32x4 g = {sigm(v[0]), sigm(v[1]), sigm(v[2]), sigm(v[3])};
          *(u32x2*)(G + (size_t)(rbase + m * 16) * 2048 + c) = pack4(g);
        }
      }
    } else {
#pragma clang loop unroll(full)
      for (int m = 0; m < 8; ++m) {
        const int row = rbase + m * 16;
        const f32x4 v = acc[m][n];
        if (EPI == EPI_QB) {
          *(u32x2*)(Cb + (size_t)row * ldc + col) = pack4(v * QSC);
        } else if (EPI == EPI_BF16) {
          *(u32x2*)(Cb + (size_t)row * ldc + col) = pack4(v);
        } else if (EPI == EPI_RES) {
          const f32x4 xv = row < MP ? *(const f32x4*)(p.x_p + (size_t)row * 2048 + col) : *(const f32x4*)(p.x_s + (size_t)(row - MP) * 2048 + col);
          *(f32x4*)(p.out + O_Y + (size_t)row * 2048 + col) = xv + v;
          if ((m & 3) == 3) __builtin_amdgcn_sched_barrier(0);
        } else if (EPI == EPI_RELU2) {
          f32x4 r = {relu_i(v[0]), relu_i(v[1]), relu_i(v[2]), relu_i(v[3])};
          *(u32x2*)(p.U + (size_t)row * DFF + col) = pack4(r * r);
        } else if (EPI == EPI_ACC) {
          float* d = p.out + O_Y + (size_t)row * 2048 + col;
          *(f32x4*)d = *(const f32x4*)d + v;
          if ((m & 3) == 3) __builtin_amdgcn_sched_barrier(0);
        } else if (EPI == EPI_ATOM) {
#pragma clang loop unroll(full)
          for (int j = 0; j < 4; ++j) atomicAdd(p.out + O_Y + (size_t)row * 2048 + col + j, v[j]);
        }
      }
    }
  }
}

constexpr int GSTAGE = 512 * LSTR;
template <int EPI>
DI void gemm_tile(const Params& p, const u16* __restrict__ A, int lda, const u16* __restrict__ Bt, int ldb, int K, int m0, int n0,
                  char* smem, u16* Cb, int ldc) {
  u16* sbase = (u16*)smem;
  const int tid = otid(), lane = tid & 63, w = tid >> 6;
  const int wr = w >> 2, wc = w & 3, fr = lane & 15, fq = lane >> 4;
  f32x4 acc[8][4];
#pragma unroll
  for (int m = 0; m < 8; ++m)
#pragma unroll
    for (int n = 0; n < 4; ++n) acc[m][n] = (f32x4){0.f, 0.f, 0.f, 0.f};
  const int lr = tid >> 3, lk = (tid & 7) * 8;
  const int lkw = ((tid & 7) ^ ((lr >> 1) & 7)) * 8;
  const int fsw = (fr >> 1) & 7, fo0 = (fq ^ fsw) * 8, fo1 = ((4 + fq) ^ fsw) * 8;
  const u16* Ag = A + (size_t)(m0 + lr) * lda + lk;
  const u16* Bg = Bt + (size_t)(n0 + lr) * ldb + lk;
  const int nk = K >> 6;
  u32x4 ra[4], rb[4];
#define G_LOAD(T) { const int k_ = (T) << 6; _Pragma("unroll") for (int i = 0; i < 4; ++i) { \
    ra[i] = *(const u32x4*)(Ag + (size_t)(i * 64) * lda + k_); rb[i] = *(const u32x4*)(Bg + (size_t)(i * 64) * ldb + k_); } }
#define L_STORE(ST) { u16* dA_ = sbase + (ST) * GSTAGE + lr * LSTR + lkw; u16* dB_ = dA_ + 256 * LSTR; _Pragma("unroll") for (int i = 0; i < 4; ++i) { \
    *(u32x4*)(dA_ + i * 64 * LSTR) = ra[i]; *(u32x4*)(dB_ + i * 64 * LSTR) = rb[i]; } }
  G_LOAD(0)
  L_STORE(0)
  G_LOAD(1)
#pragma unroll 1
  for (int kt = 0; kt < nk; ++kt) {
    __syncthreads();
    if (kt + 1 < nk) L_STORE((kt + 1) & 1)
    G_LOAD(min(kt + 2, nk - 1))
    const u16* cA = sbase + (kt & 1) * GSTAGE + (wr * 128 + fr) * LSTR;
    const u16* cB = sbase + (kt & 1) * GSTAGE + 256 * LSTR + (wc * 64 + fr) * LSTR;
#pragma unroll
    for (int ks = 0; ks < 2; ++ks) {
      bf16x8 bfr[4];
#pragma unroll
      for (int n = 0; n < 4; ++n) bfr[n] = *(const bf16x8*)(cB + n * 16 * LSTR + (ks ? fo1 : fo0));
#pragma unroll
      for (int mh = 0; mh < 2; ++mh) {
        bf16x8 af[4];
#pragma unroll
        for (int m = 0; m < 4; ++m) af[m] = *(const bf16x8*)(cA + (mh * 4 + m) * 16 * LSTR + (ks ? fo1 : fo0));
        __builtin_amdgcn_s_setprio(1);
#pragma unroll
        for (int m = 0; m < 4; ++m)
#pragma unroll
          for (int n = 0; n < 4; ++n)
            acc[mh * 4 + m][n] = EpiSwap<EPI>::v ? __builtin_amdgcn_mfma_f32_16x16x32_bf16(bfr[n], af[m], acc[mh * 4 + m][n], 0, 0, 0)
                                                 : __builtin_amdgcn_mfma_f32_16x16x32_bf16(af[m], bfr[n], acc[mh * 4 + m][n], 0, 0, 0);
        __builtin_amdgcn_s_setprio(0);
      }
    }
  }
#undef G_LOAD
#undef L_STORE
  gemm_epilogue<EPI>(p, acc, m0, n0, wr, wc, fr, fq, Cb, ldc);
}

template <int EPI>
DI void gemm_phase(const Params& p, const u16* A, int lda, const u16* Bt, int ldb, int K, int mtiles, int ntiles, char* smem, u16* Cb, int ldc,
                   int start, int stride) {
  if (stride == 256) {
    const int gm = (mtiles + 3) >> 2, gn = (ntiles + 7) >> 3, nsg = gm * gn;
    const int xcd = start & 7, li = start >> 3;
    for (int sg = xcd; sg < nsg; sg += 8) {
      const int gni = sg / gm, gmi = sg - gni * gm;
      const int mt = gmi * 4 + (li & 3), nt = gni * 8 + (li >> 2);
      if (mt < mtiles && nt < ntiles) gemm_tile<EPI>(p, A, lda, Bt, ldb, K, mt * 256, nt * 256, smem, Cb, ldc);
    }
    return;
  }
  const int total = mtiles * ntiles;
  const int GM = 8;
  for (int id = start; id < total; id += stride) {
    const int per = GM * ntiles;
    const int g = id / per, rem = id - g * per;
    const int fm = g * GM;
    const int gsz = min(GM, mtiles - fm);
    const int mt = fm + rem % gsz, nt = rem / gsz;
    gemm_tile<EPI>(p, A, lda, Bt, ldb, K, mt * 256, nt * 256, smem, Cb, ldc);
  }
}

DI void post_row(const Params& p, int t, int lane) {
  const float* zr = p.out + O_Y + (size_t)t * ZRW;
  {
    f32x4 a = *(const f32x4*)(zr + lane * 4), b = *(const f32x4*)(zr + 256 + lane * 4);
    float ss = a[0] * a[0] + a[1] * a[1] + a[2] * a[2] + a[3] * a[3] + b[0] * b[0] + b[1] * b[1] + b[2] * b[2] + b[3] * b[3];
    ss = wave_sum(ss);
    float r = rsqrtf(ss * (1.f / 512.f) + 1e-6f);
    f32x4 ga = *(const f32x4*)(p.g_q + lane * 4), gb = *(const f32x4*)(p.g_q + 256 + lane * 4);
    u32x2 o;
    o[0] = cvtpk(a[0] * r * ga[0], a[1] * r * ga[1]); o[1] = cvtpk(a[2] * r * ga[2], a[3] * r * ga[3]);
    *(u32x2*)(p.CQ + (size_t)t * 512 + lane * 4) = o;
    o[0] = cvtpk(b[0] * r * gb[0], b[1] * r * gb[1]); o[1] = cvtpk(b[2] * r * gb[2], b[3] * r * gb[3]);
    *(u32x2*)(p.CQ + (size_t)t * 512 + 256 + lane * 4) = o;
  }
  const int kr_row = krow_of(t);
  {
    f32x4 a = *(const f32x4*)(zr + 512 + lane * 4);
    float ss = a[0] * a[0] + a[1] * a[1] + a[2] * a[2] + a[3] * a[3];
    ss = wave_sum(ss);
    float r = rsqrtf(ss * (1.f / 256.f) + 1e-6f);
    f32x4 g = *(const f32x4*)(p.g_kv + lane * 4);
    f32x4 o = {a[0] * r * g[0], a[1] * r * g[1], a[2] * r * g[2], a[3] * r * g[3]};
    float* od = t < MP ? p.out + O_CKVP + (size_t)t * 256 : p.out + O_CKVS + (size_t)(t - MP) * 256;
    *(f32x4*)(od + lane * 4) = o;
    u32x2 ob; ob[0] = cvtpk(o[0], o[1]); ob[1] = cvtpk(o[2], o[3]);
    *(u32x2*)(p.CKV + (size_t)kr_row * 256 + lane * 4) = ob;
  }
  if (lane < 32) {
    float x1 = zr[768 + lane], x2 = zr[768 + 32 + lane];
    float ang = (float)qpos_of(t) * inv_freq(lane);
    float cs = cosf(ang), sn = sinf(ang);
    p.CS[(size_t)t * 32 + lane] = cs; p.SN[(size_t)t * 32 + lane] = sn;
    float o1 = x1 * cs - x2 * sn, o2 = x1 * sn + x2 * cs;
    float* od = t < MP ? p.out + O_KRP + (size_t)t * 64 : p.out + O_KRS + (size_t)(t - MP) * 64;
    od[lane] = o1; od[lane + 32] = o2;
    p.KR[(size_t)kr_row * 64 + lane] = f2bf(o1);
    p.KR[(size_t)kr_row * 64 + lane + 32] = f2bf(o2);
  }
}

template <int CTRL> DI float dpp_add(float v) {
  int sft = __builtin_amdgcn_update_dpp(0, __float_as_int(v), CTRL, 0xf, 0xf, true);
  return v + __int_as_float(sft);
}
DI float row16_sum(float v) { v = dpp_add<0x111>(v); v = dpp_add<0x112>(v); v = dpp_add<0x114>(v); v = dpp_add<0x118>(v); return v; }
DI unsigned fkey(float f) { unsigned u = __float_as_uint(f); return (u & 0x80000000u) ? ~u : (u | 0x80000000u); }

DI void radix_select(unsigned* sc, int* hist, int* misc, int n, unsigned long long* sel, int tid, int lane, int w) {
  __syncthreads();
  unsigned prefix = 0;
  int remaining = 256;
#pragma unroll 1
  for (int pass = 0; pass < 3; ++pass) {
    const int shift = pass == 0 ? 21 : (pass == 1 ? 10 : 0);
    const int bits = pass == 2 ? 10 : 11;
    const unsigned bmask = (1u << bits) - 1u;
    if (pass > 0) {
      *(int4*)&hist[tid * 8] = make_int4(0, 0, 0, 0);
      *(int4*)&hist[tid * 8 + 4] = make_int4(0, 0, 0, 0);
      __syncthreads();
      const int hs = shift + bits;
      const unsigned want = prefix >> hs;
      for (int i = tid * 4; i < n; i += 256 * 4) {
        const u32x4 u4 = *(const u32x4*)(sc + i);
#pragma unroll
        for (int e = 0; e < 4; ++e)
          if ((u4[e] >> hs) == want) atomicAdd(&hist[(u4[e] >> shift) & bmask], 1);
      }
      __syncthreads();
    }
    const int4 h0 = *(const int4*)&hist[tid * 8], h1 = *(const int4*)&hist[tid * 8 + 4];
    const int s8 = h0.x + h0.y + h0.z + h0.w + h1.x + h1.y + h1.z + h1.w;
    int suf = s8;
#pragma unroll
    for (int d = 1; d < 64; d <<= 1) { int v = __shfl_down(suf, d); if (lane + d < 64) suf += v; }
    if (lane == 0) misc[w] = suf;
    __syncthreads();
    int above = 0;
    for (int ww = w + 1; ww < 4; ++ww) above += misc[ww];
    const int excl = above + suf - s8;
    if (excl < remaining && remaining <= excl + s8) {
      int c = excl, bin = 0, nrem = 0;
#define TK_STEP(val, idx) if (c < remaining && remaining <= c + (val)) { bin = tid * 8 + (idx); nrem = remaining - c; } c += (val);
      TK_STEP(h1.w, 7) TK_STEP(h1.z, 6) TK_STEP(h1.y, 5) TK_STEP(h1.x, 4) TK_STEP(h0.w, 3) TK_STEP(h0.z, 2) TK_STEP(h0.y, 1) TK_STEP(h0.x, 0)
#undef TK_STEP
      misc[4] = bin; misc[5] = nrem;
    }
    __syncthreads();
    prefix |= ((unsigned)misc[4]) << shift;
    remaining = misc[5];
    __syncthreads();
  }
  const unsigned T = prefix;
  const int seg = ((n + 255) >> 8) << 6;
  const int beg = w * seg;
  int ceq = 0;
  for (int i = beg + lane; i < beg + seg; i += 64) {
    bool in = i < n; unsigned u = in ? sc[i] : 0u;
    ceq += __popcll(__ballot(in && u == T));
  }
  if (lane == 0) misc[12 + w] = ceq;
  __syncthreads();
  int oe = 0;
  for (int ww = 0; ww < w; ++ww) oe += misc[12 + ww];
  const unsigned long long lt = (1ull << lane) - 1ull;
  for (int i0 = beg; i0 < beg + seg; i0 += 64) {
    const int i = i0 + lane;
    bool in = i < n; unsigned u = in ? sc[i] : 0u;
    bool g = in && u > T, e = in && u == T;
    unsigned long long be = __ballot(e);
    int pe = oe + __popcll(be & lt);
    unsigned long long sm = __ballot(g || (e && pe < remaining));
    if (lane == 0 && i0 < n) sel[i0 >> 6] = sm;
    oe += __popcll(be);
  }
}

constexpr int NQ = 4;
DI void topk_group(const Params& p, int t, char* smem, unsigned* scr1, unsigned* scr2, unsigned* scr3) {
  unsigned* sc = (unsigned*)smem;
  int* hist = (int*)(smem + 65536);
  int* misc = hist + 2048;
  const int tid = otid() & 255, lane = tid & 63, w = tid >> 6, fr = lane & 15, fq = lane >> 4;
  int n; const u16* ixk;
  if (t < MP) { n = 64 * ((t >> 6) + 1); ixk = p.IXK; }
  else { int b = (t - MP) >> 4; n = SK; ixk = p.IXK + (size_t)(MP + b * SK) * 64; }
  unsigned long long* sel = p.SEL + (size_t)t * 256;
  __syncthreads();
  if (n <= 256) {
    if (tid < 4) {
      unsigned long long v = (tid < (n >> 6)) ? ~0ull : 0ull;
#pragma unroll
      for (int qi = 0; qi < NQ; ++qi) sel[qi * 256 + tid] = v;
    }
    return;
  }
  *(int4*)&hist[tid * 8] = make_int4(0, 0, 0, 0);
  *(int4*)&hist[tid * 8 + 4] = make_int4(0, 0, 0, 0);
  __syncthreads();
  {
    const u16* q = p.IXQ + (size_t)t * 1024 + fr * 64 + fq * 8;
    bf16x8 a0[NQ], a1[NQ];
    f32x4 wv[NQ];
#pragma unroll
    for (int qi = 0; qi < NQ; ++qi) {
      a0[qi] = *(const bf16x8*)(q + qi * 1024); a1[qi] = *(const bf16x8*)(q + qi * 1024 + 32);
      wv[qi] = *(const f32x4*)(p.IXW + (size_t)(t + qi) * 16 + fq * 4);
    }
    const int ntile = n >> 4;
    for (int kt0 = w; kt0 < ntile; kt0 += 32) {
      bf16x8 b0[8], b1[8];
#pragma unroll
      for (int g = 0; g < 8; ++g) {
        const int kt = min(kt0 + g * 4, ntile - 1);
        const u16* kp = ixk + (size_t)(kt * 16 + fr) * 64 + fq * 8;
        b0[g] = *(const bf16x8*)kp; b1[g] = *(const bf16x8*)(kp + 32);
      }
      float pt[NQ][8];
#pragma unroll
      for (int g = 0; g < 8; ++g) {
#pragma unroll
        for (int qi = 0; qi < NQ; ++qi) {
          f32x4 c = {0.f, 0.f, 0.f, 0.f};
          c = __builtin_amdgcn_mfma_f32_16x16x32_bf16(a0[qi], b0[g], c, 0, 0, 0);
          c = __builtin_amdgcn_mfma_f32_16x16x32_bf16(a1[qi], b1[g], c, 0, 0, 0);
          pt[qi][g] = relu_i(c[0]) * wv[qi][0] + relu_i(c[1]) * wv[qi][1] + relu_i(c[2]) * wv[qi][2] + relu_i(c[3]) * wv[qi][3];
        }
      }
#pragma unroll
      for (int g = 0; g < 8; g += 2) {
        const int kt = kt0 + (g + (lane >> 5)) * 4;
        const bool st = (lane & 16) == 0 && kt < ntile;
#pragma unroll
        for (int qi = 0; qi < NQ; ++qi) {
          auto r32 = __builtin_amdgcn_permlane32_swap(__float_as_uint(pt[qi][g]), __float_as_uint(pt[qi][g + 1]), false, false);
          float s2 = __uint_as_float(r32[0]) + __uint_as_float(r32[1]);
          auto r16 = __builtin_amdgcn_permlane16_swap(__float_as_uint(s2), __float_as_uint(s2), false, false);
          float sv = __uint_as_float(r16[0]) + __uint_as_float(r16[1]);
          if (st) {
            unsigned u = fkey(sv);
            if (qi == 0) { sc[kt * 16 + fr] = u; atomicAdd(&hist[u >> 21], 1); }
            else if (qi == 1) scr1[kt * 16 + fr] = u;
            else if (qi == 2) scr2[kt * 16 + fr] = u;
            else scr3[kt * 16 + fr] = u;
          }
        }
      }
    }
  }
  radix_select(sc, hist, misc, n, sel, tid, lane, w);
#pragma unroll 1
  for (int qi = 1; qi < NQ; ++qi) {
    const unsigned* scr = qi == 1 ? scr1 : (qi == 2 ? scr2 : scr3);
    __syncthreads();
    *(int4*)&hist[tid * 8] = make_int4(0, 0, 0, 0);
    *(int4*)&hist[tid * 8 + 4] = make_int4(0, 0, 0, 0);
    __syncthreads();
    for (int i = tid * 4; i < n; i += 256 * 4) {
      const u32x4 u4 = *(const u32x4*)(scr + i);
      *(u32x4*)(sc + i) = u4;
#pragma unroll
      for (int e = 0; e < 4; ++e) atomicAdd(&hist[u4[e] >> 21], 1);
    }
    radix_select(sc, hist, misc, n, sel + qi * 256, tid, lane, w);
  }
}

constexpr int KSTR = 192;
constexpr int VSTR = 72;
DI float xq_max(float x) {
  auto a = __builtin_amdgcn_permlane16_swap(__float_as_uint(x), __float_as_uint(x), false, false);
  x = fmaxf(__uint_as_float(a[0]), __uint_as_float(a[1]));
  auto b = __builtin_amdgcn_permlane32_swap(__float_as_uint(x), __float_as_uint(x), false, false);
  return fmaxf(__uint_as_float(b[0]), __uint_as_float(b[1]));
}
DI float xq_sum(float x) {
  auto a = __builtin_amdgcn_permlane16_swap(__float_as_uint(x), __float_as_uint(x), false, false);
  x = __uint_as_float(a[0]) + __uint_as_float(a[1]);
  auto b = __builtin_amdgcn_permlane32_swap(__float_as_uint(x), __float_as_uint(x), false, false);
  return __uint_as_float(b[0]) + __uint_as_float(b[1]);
}

template <int MODE>
DI void attn_item(const Params& p, int item, char* smem, u16* gdst) {
  constexpr int NKS = MODE == 0 ? 6 : 4;
  constexpr int ASTAGE = 64 * KSTR + 128 * VSTR;
  u16* sbase = (u16*)smem;
  float* sBias = (float*)(sbase + 2 * ASTAGE);
  const int tid = otid(), lane = tid & 63, w = tid >> 6, fr = lane & 15, fq = lane >> 4;
  const int ksw = (fr >> 1) & 7, ko0 = (fq ^ ksw) * 8, ko1 = ((4 + fq) ^ ksw) * 8;
  int h, q0, nq, krow0, nkeys, ntiles, myt, b = 0, qpos0;
  const u16* vt; size_t vstride;
  const bool sample = item >= 1024;
  if (!sample) {
    const int i = 63 - (item >> 4);
    h = item & 15; q0 = i * 256; nq = 256; krow0 = 0; nkeys = q0 + 256; ntiles = 4 * i + 4; qpos0 = q0;
    vt = (MODE == 0 ? p.VBT_P : p.VAT) + (size_t)h * 128 * MP; vstride = MP;
    myt = ntiles - 3 + (w >> 1);
  } else {
    const int j = item - 1024; b = j >> 4;
    h = j & 15; q0 = MP + b * 16; nq = 16; krow0 = MP + b * SK; nkeys = SK; ntiles = 17; qpos0 = 1024;
    vt = p.VBT_S + ((size_t)b * 2048 + h * 128) * VSS; vstride = VSS;
    myt = ntiles;
  }
  const int wq0 = w * 32;
  const bool active = wq0 < nq;
  __syncthreads();
  if (MODE == 1) {
    for (int i = tid; i < 257; i += NTHREADS) {
      int rel = i - 128;
      int ret = rel > 0 ? 16 : 0;
      int n = rel < 0 ? -rel : rel;
      float lf = logf((float)max(n, 1) / 8.0f) / 2.772588722239781f * 8.0f;
      int large = min(8 + (int)lf, 15);
      int bk = ret + (n < 8 ? n : large);
      sBias[i] = (p.rel[bk * 16 + h] - p.rel[15 * 16 + h]) * 1.4426950408889634f;
    }
  }
  bf16x8 qf[2][NKS];
  int qrow[2];
#pragma unroll
  for (int qt = 0; qt < 2; ++qt) {
    const int qr = min(wq0 + qt * 16 + fr, nq - 1);
    qrow[qt] = qr;
    const u16* qp = (MODE == 0) ? p.QB + (size_t)(q0 + qr) * 3072 + h * 192 + fq * 8 : p.AQ + (size_t)(q0 + qr) * 2048 + h * 128 + fq * 8;
#pragma unroll
    for (int ks = 0; ks < NKS; ++ks) qf[qt][ks] = *(const bf16x8*)(qp + ks * 32);
  }
  f32x4 o[2][8];
#pragma unroll
  for (int qt = 0; qt < 2; ++qt)
#pragma unroll
    for (int dt = 0; dt < 8; ++dt) o[qt][dt] = (f32x4){0.f, 0.f, 0.f, 0.f};
  float mrow[2] = {-1e30f, -1e30f}, lrow[2] = {0.f, 0.f};
  const float SC = (MODE == 0 ? 0.07216878364870322f : 0.08838834764831845f) * 1.4426950408889634f;

  unsigned long long mqn[2] = {0ull, 0ull};
  if (MODE == 1) {
#pragma unroll
    for (int qt = 0; qt < 2; ++qt) mqn[qt] = p.SEL[(size_t)(q0 + qrow[qt]) * 256];
  }
  constexpr int NKL = MODE == 0 ? 3 : 2;
  const bool direct = (MODE == 1) && sample;
  u32x4 rk[NKL], rv[2];
#define KV_LOAD(JT) { const size_t kr0_ = (size_t)(krow0 + (JT) * 64); const u16* kb_ = (MODE == 0 ? p.KB : p.KA) + (kr0_ + (tid >> 4)) * 2048 + h * 128 + (tid & 15) * 8; \
    _Pragma("unroll") for (int i = 0; i < 2; ++i) rk[i] = *(const u32x4*)(kb_ + (size_t)i * 32 * 2048); \
    if (MODE == 0) rk[NKL - 1] = *(const u32x4*)(p.KR + (kr0_ + (tid >> 3)) * 64 + (tid & 7) * 8); \
    const u16* vp_ = vt + (size_t)(tid >> 3) * vstride + (JT) * 64 + (tid & 7) * 8; \
    _Pragma("unroll") for (int i = 0; i < 2; ++i) rv[i] = *(const u32x4*)(vp_ + (size_t)i * 64 * vstride); }
#define KV_STORE(ST) { u16* sk_ = sbase + (ST) * ASTAGE; u16* dk_ = sk_ + (tid >> 4) * KSTR + ((tid & 15) ^ ((tid >> 5) & 7)) * 8; \
    _Pragma("unroll") for (int i = 0; i < 2; ++i) *(u32x4*)(dk_ + i * 32 * KSTR) = rk[i]; \
    if (MODE == 0) *(u32x4*)(sk_ + (tid >> 3) * KSTR + 128 + ((tid & 7) ^ ((tid >> 4) & 7)) * 8) = rk[NKL - 1]; \
    u16* dv_ = sk_ + 64 * KSTR + (tid >> 3) * VSTR + (tid & 7) * 8; \
    _Pragma("unroll") for (int i = 0; i < 2; ++i) *(u32x4*)(dv_ + i * 64 * VSTR) = rv[i]; }
  if (!direct) {
    KV_LOAD(0)
    KV_STORE(0)
    KV_LOAD(min(1, ntiles - 1))
  }
  for (int jt = 0; jt < ntiles; ++jt) {
    const int key0 = jt * 64;
    u16* sK = sbase + (jt & 1) * ASTAGE;
    u16* sV = sK + 64 * KSTR;
    unsigned long long mq[2] = {mqn[0], mqn[1]};
    if (MODE == 1) {
      const int jn = min(jt + 1, ntiles - 1);
#pragma unroll
      for (int qt = 0; qt < 2; ++qt) mqn[qt] = p.SEL[(size_t)(q0 + qrow[qt]) * 256 + jn];
    }
    __syncthreads();
    if (!direct) {
      if (jt + 1 < ntiles) KV_STORE((jt + 1) & 1)
      KV_LOAD(min(jt + 2, ntiles - 1))
    } else {
#pragma unroll 2
      for (int i = 0; i < 4; ++i) {
        const int c = tid + i * NTHREADS;
        const int key = c >> 5, part = c & 31;
        const int s = key0 + key;
        const int sc_ = min(s, SK - 1);
        const size_t o1 = sc_ < 1024 ? ((size_t)b * 1024 + sc_) * 2048 : ((size_t)b * 16 + (sc_ - 1024)) * 2048;
        const float* kp = (sc_ < 1024 ? p.c_ak : p.out + O_AKS) + o1 + h * 128 + part * 4;
        const float* vp = (sc_ < 1024 ? p.c_av : p.out + O_AVS) + o1 + h * 128 + part * 4;
        f32x4 kv = *(const f32x4*)kp, vv = *(const f32x4*)vp;
        u32x2 kk; kk[0] = cvtpk(kv[0], kv[1]); kk[1] = cvtpk(kv[2], kv[3]);
        *(u32x2*)(sK + key * KSTR + (((part >> 1) ^ ((key >> 1) & 7)) * 8) + (part & 1) * 4) = kk;
        const bool ok = s < SK;
#pragma unroll
        for (int e = 0; e < 4; ++e) sV[(part * 4 + e) * VSTR + key] = ok ? f2bf(vv[e]) : (u16)0;
      }
      __syncthreads();
    }
    if (active && jt < myt) {
      f32x4 s[2][4];
#pragma unroll
      for (int qt = 0; qt < 2; ++qt) {
        const float nb_ = (jt == 0) ? 0.f : -mrow[qt];
#pragma unroll
        for (int kt = 0; kt < 4; ++kt) s[qt][kt] = (f32x4){nb_, nb_, nb_, nb_};
      }
      __builtin_amdgcn_s_setprio(1);
#pragma unroll
      for (int kt = 0; kt < 4; ++kt) {
#pragma unroll
        for (int ks = 0; ks < NKS; ++ks) {
          bf16x8 kf = *(const bf16x8*)(sK + (kt * 16 + fr) * KSTR + (ks >> 1) * 64 + ((ks & 1) ? ko1 : ko0));
          s[0][kt] = __builtin_amdgcn_mfma_f32_16x16x32_bf16(kf, qf[0][ks], s[0][kt], 0, 0, 0);
          s[1][kt] = __builtin_amdgcn_mfma_f32_16x16x32_bf16(kf, qf[1][ks], s[1][kt], 0, 0, 0);
        }
      }
      __builtin_amdgcn_s_setprio(0);
      unsigned mlo[2] = {0u, 0u}, mhi[2] = {0u, 0u};
      if (MODE == 0) {
        if (key0 + 64 > nkeys) {
#pragma unroll
          for (int kt = 0; kt < 4; ++kt)
#pragma unroll
            for (int j = 0; j < 4; ++j)
              if (key0 + kt * 16 + fq * 4 + j >= nkeys) { s[0][kt][j] = -1e30f; s[1][kt][j] = -1e30f; }
        }
      } else {
        const bool far = (key0 + 63) - (qpos0 + wq0) <= -128;
        if (!far) {
#pragma unroll
          for (int qt = 0; qt < 2; ++qt) {
            const int rb = key0 + fq * 4 - (qpos0 + qrow[qt]) + 128;
#pragma unroll
            for (int kt = 0; kt < 4; ++kt)
#pragma unroll
              for (int j = 0; j < 4; ++j) {
                int r = min(max(rb + kt * 16 + j, 0), 256);
                s[qt][kt][j] += sBias[r];
              }
          }
        }
#pragma unroll
        for (int qt = 0; qt < 2; ++qt) {
          const unsigned long long mm = mq[qt] >> (fq * 4);
          mlo[qt] = (unsigned)mm; mhi[qt] = (unsigned)(mm >> 32);
        }
      }
      bf16x8 pf[2][2];
#pragma unroll
      for (int qt = 0; qt < 2; ++qt) {
        float mx = -1e30f;
#pragma unroll
        for (int kt = 0; kt < 4; ++kt)
#pragma unroll
          for (int j = 0; j < 4; ++j) mx = fmaxf(mx, s[qt][kt][j]);
        mx = xq_max(mx);
        const float delta = (jt == 0) ? mx : fmaxf(mx, 0.f);
        mrow[qt] = (jt == 0) ? delta : mrow[qt] + delta;
        const bool grow = __ballot(delta != 0.f) != 0ull;
        float alpha = 1.f;
        if (grow) {
          alpha = __builtin_amdgcn_exp2f(-delta);
#pragma unroll
          for (int kt = 0; kt < 4; ++kt) s[qt][kt] -= delta;
        }
        float rs = 0.f;
#pragma unroll
        for (int kt = 0; kt < 4; ++kt)
#pragma unroll
          for (int j = 0; j < 4; ++j) {
            float pv = __builtin_amdgcn_exp2f(s[qt][kt][j]);
            if (MODE == 1) {
              int keep;
              asm("v_bfe_i32 %0, %1, %2, 1" : "=v"(keep) : "v"(kt < 2 ? mlo[qt] : mhi[qt]), "n"((kt & 1) * 16 + j));
              pv = __int_as_float(__float_as_int(pv) & keep);
            }
            s[qt][kt][j] = pv; rs += pv;
          }
        rs = xq_sum(rs);
        lrow[qt] = lrow[qt] * alpha + rs;
        if (grow) {
#pragma unroll
          for (int dt = 0; dt < 8; ++dt) o[qt][dt] *= alpha;
        }
#pragma unroll
        for (int s2 = 0; s2 < 2; ++s2) {
          u32x4 pk;
          pk[0] = cvtpk(s[qt][2 * s2][0], s[qt][2 * s2][1]);
          pk[1] = cvtpk(s[qt][2 * s2][2], s[qt][2 * s2][3]);
          pk[2] = cvtpk(s[qt][2 * s2 + 1][0], s[qt][2 * s2 + 1][1]);
          pk[3] = cvtpk(s[qt][2 * s2 + 1][2], s[qt][2 * s2 + 1][3]);
          pf[qt][s2] = __builtin_bit_cast(bf16x8, pk);
        }
      }
      __builtin_amdgcn_s_setprio(1);
#pragma unroll
      for (int dt = 0; dt < 8; ++dt) {
#pragma unroll
        for (int s2 = 0; s2 < 2; ++s2) {
          const u16* vp = sV + (dt * 16 + fr) * VSTR + fq * 4;
          u32x2 v0 = *(const u32x2*)(vp + (2 * s2) * 16);
          u32x2 v1 = *(const u32x2*)(vp + (2 * s2 + 1) * 16);
          u32x4 vv = {v0[0], v0[1], v1[0], v1[1]};
          bf16x8 vf = __builtin_bit_cast(bf16x8, vv);
          o[0][dt] = __builtin_amdgcn_mfma_f32_16x16x32_bf16(vf, pf[0][s2], o[0][dt], 0, 0, 0);
          o[1][dt] = __builtin_amdgcn_mfma_f32_16x16x32_bf16(vf, pf[1][s2], o[1][dt], 0, 0, 0);
        }
      }
      __builtin_amdgcn_s_setprio(0);
    }
  }
  if (active) {
#pragma unroll
    for (int qt = 0; qt < 2; ++qt) {
      const int qr = wq0 + qt * 16 + fr;
      if (qr < nq) {
        const float inv = 1.f / lrow[qt];
        const size_t row = (size_t)(q0 + qr);
#pragma unroll
        for (int dt = 0; dt < 8; ++dt) {
          const size_t off = row * 2048 + h * 128 + dt * 16 + fq * 4;
          u32x2 ga = *(const u32x2*)(p.GA + off);
          u32x2 r;
          if (MODE == 0) {
            u32x2 gb = *(const u32x2*)(p.GB + off);
            r[0] = cvtpk(bflo(gb[0]) * o[qt][dt][0] * inv + bflo(ga[0]), bfhi(gb[0]) * o[qt][dt][1] * inv + bfhi(ga[0]));
            r[1] = cvtpk(bflo(gb[1]) * o[qt][dt][2] * inv + bflo(ga[1]), bfhi(gb[1]) * o[qt][dt][3] * inv + bfhi(ga[1]));
          } else {
            r[0] = cvtpk(bflo(ga[0]) * o[qt][dt][0] * inv, bfhi(ga[0]) * o[qt][dt][1] * inv);
            r[1] = cvtpk(bflo(ga[1]) * o[qt][dt][2] * inv, bfhi(ga[1]) * o[qt][dt][3] * inv);
          }
          *(u32x2*)(gdst + off) = r;
        }
      }
    }
  }
}

#undef KV_LOAD
#undef KV_STORE
__global__ void __launch_bounds__(NTHREADS) fwd_megakernel(Params p) {
  extern __shared__ __attribute__((aligned(16))) char smem[];
  cg::grid_group grid = cg::this_grid();
#define IDS const int tid = otid(); const int lane = tid & 63, w = tid >> 6; const int bid = blockIdx.x, nb = gridDim.x; \
  const int gw = bid * 8 + w, ngw = nb * 8; (void)tid; (void)lane; (void)gw; (void)ngw; (void)bid; (void)nb;

#if PH & (1 << 0)
  { IDS
  {
    const int vb = tid >> 8;
    float* st = (float*)(smem + vb * VB_LDS);
    const int vbid = bid * 2 + vb, nvb = nb * 2;
    for (int t = vbid; t < 32 * 192; t += nvb) transpose_tile(p.w_in, 2048, INC, p.WT_IN, t, st);
    for (int t = vbid; t < 8 * 48; t += nvb) transpose_tile(p.w_uq, 512, 3072, p.WT_UQ, t, st);
    for (int t = vbid; t < 4 * 32; t += nvb) transpose_tile(p.w_uk, 256, 2048, p.WT_UK, t, st);
    for (int t = vbid; t < 4 * 32; t += nvb) transpose_tile(p.w_uv, 256, 2048, p.WT_UV, t, st);
    for (int t = vbid; t < 32 * 32; t += nvb) transpose_tile(p.w_out, 2048, 2048, p.WT_OUT, t, st);
    for (int t = vbid; t < 32 * 128; t += nvb) transpose_tile(p.w_up, 2048, 8192, p.WT_UP, t, st);
    for (int t = vbid; t < 128 * 32; t += nvb) transpose_tile(p.w_down, 8192, 2048, p.WT_DOWN, t, st);
    for (int r = gw; r < MT; r += ngw) {
      const float* x = r < MP ? p.x_p + (size_t)r * 2048 : p.x_s + (size_t)(r - MP) * 2048;
      rms_row_2048(x, p.g_mix, p.H + (size_t)r * 2048, lane);
    }
    const int gt = bid * NTHREADS + tid, ngt = nb * NTHREADS;
    for (int i = gt; i < 16 * 1024 * 64 / 4; i += ngt) {
      int e = i * 4; int b = e >> 16; int rem = e & 65535; int s = rem >> 6, c = rem & 63;
      size_t dst = (size_t)(MP + b * SK + s) * 64 + c;
      f32x4 a = *(const f32x4*)(p.c_idx + e), k = *(const f32x4*)(p.c_kr + e);
      u32x2 o; o[0] = cvtpk(a[0], a[1]); o[1] = cvtpk(a[2], a[3]);
      *(u32x2*)(p.IXK + dst) = o;
      o[0] = cvtpk(k[0], k[1]); o[1] = cvtpk(k[2], k[3]);
      *(u32x2*)(p.KR + dst) = o;
    }
    for (int i = gt; i < 16 * 1024 * 256 / 4; i += ngt) {
      int e = i * 4; int b = e >> 18; int rem = e & 262143; int s = rem >> 8, c = rem & 255;
      size_t dst = (size_t)(MP + b * SK + s) * 256 + c;
      f32x4 a = *(const f32x4*)(p.c_ckv + e);
      u32x2 o; o[0] = cvtpk(a[0], a[1]); o[1] = cvtpk(a[2], a[3]);
      *(u32x2*)(p.CKV + dst) = o;
    }
  }
  }
#endif
  grid.sync();
#if PH & (1 << 1)
  { IDS
  for (int rep = 0; rep < NREP(1); ++rep) gemm_phase<EPI_IN>(p, p.H, 2048, p.WT_IN, 2048, 2048, MT / 256, INP / 256, smem, nullptr, 0, bid, nb);
  }
#endif
  grid.sync();
#if PH & (1 << 2)
  { IDS
  for (int t = gw; t < MT; t += ngw) post_row(p, t, lane);
  {
    const int vb = tid >> 8, vbid = bid * 2 + vb;
    char* sm = smem + vb * VB_LDS;
    for (int rep = 0; rep < NREP(2); ++rep) for (int t = vbid * NQ; t < MT; t += nb * 2 * NQ)
      topk_group(p, t, sm, (unsigned*)(p.out + O_Y + 14000000) + (size_t)vbid * 16384, (unsigned*)(p.out + O_Y + 14000000) + (size_t)(512 + vbid) * 16384,
                 (unsigned*)p.H + (size_t)vbid * 16384);
  }
  }
#endif
  grid.sync();
#if PH & (1 << 3)
  { IDS
    const int total = 1024 + 256;
    for (int rep = 0; rep < NREP(3); ++rep) {
      u16* gdst = (rep + 1 < NREP(3)) ? (u16*)(p.out + O_Y) : p.GA;
      for (int r = 0;; ++r) {
        int id = (r & 1) ? r * nb + (nb - 1 - bid) : r * nb + bid;
        if (r * nb >= total) break;
        if (id < total) attn_item<1>(p, id, smem, gdst);
      }
    }
  }
#endif
  grid.sync();
#if PH & (1 << 4)
  { IDS
  {
    const int gt = bid * NTHREADS + tid, ngt = nb * NTHREADS;
    for (int i = gt; i < MS * 2048 / 4; i += ngt)
      *(f32x4*)(p.out + O_Y + (size_t)MP * 2048 + (size_t)i * 4) = *(const f32x4*)(p.x_s + (size_t)i * 4);
    for (int i = gt; i < 16 * 2048 * 6; i += ngt) {
      int r = i / 6, c = i - r * 6;
      *(u32x4*)(p.VBT_S + (size_t)r * VSS + SK + c * 8) = (u32x4){0u, 0u, 0u, 0u};
    }
    const int nqb = (MT / 256) * 12, nkb = (KROWS / 256) * 8;
    const int total = nqb + 2 * nkb;
    for (int id = bid; id < total; id += nb) {
      if (id < nqb) gemm_phase<EPI_QB>(p, p.CQ, 512, p.WT_UQ, 512, 512, MT / 256, 12, smem, p.QB, 3072, id, 1 << 30);
      else if (id < nqb + nkb) gemm_phase<EPI_BF16>(p, p.CKV, 256, p.WT_UK, 256, 256, KROWS / 256, 8, smem, p.KB, 2048, id - nqb, 1 << 30);
      else gemm_phase<EPI_VT>(p, p.CKV, 256, p.WT_UV, 256, 256, KROWS / 256, 8, smem, nullptr, 0, id - nqb - nkb, 1 << 30);
    }
  }
  }
#endif
  grid.sync();
#if PH & (1 << 5)
  { IDS
  {
    const int total = 1024 + 256;
    for (int rep = 0; rep < NREP(5); ++rep) {
      u16* gdst = (rep + 1 < NREP(5)) ? (u16*)(p.out + O_Y) : p.GB;
      for (int r = 0;; ++r) {
        int id = (r & 1) ? r * nb + (nb - 1 - bid) : r * nb + bid;
        if (r * nb >= total) break;
        if (id < total) attn_item<0>(p, id, smem, gdst);
      }
    }
  }
  }
#endif
  grid.sync();
#if PH & (1 << 6)
  { IDS
  gemm_phase<EPI_RES>(p, p.GB, 2048, p.WT_OUT, 2048, 2048, MT / 256 - 1, 8, smem, nullptr, 0, bid, nb);
  for (int id = bid; id < 128; id += nb) {
    const int nt = id & 7, kc = id >> 3;
    gemm_tile<EPI_ATOM>(p, p.GB + kc * 128, 2048, p.WT_OUT + kc * 128, 2048, 128, (MT / 256 - 1) * 256, nt * 256, smem, nullptr, 0);
  }
  }
#endif
  grid.sync();
#if PH & (1 << 7)
  { IDS
  for (int r = gw; r < MT; r += ngw) rms_row_2048(p.out + O_Y + (size_t)r * 2048, p.g_ffn, p.H2 + (size_t)r * 2048, lane);
  }
#endif
  grid.sync();
#if PH & (1 << 8)
  { IDS
  for (int rep = 0; rep < NREP(8); ++rep) gemm_phase<EPI_RELU2>(p, p.H2, 2048, p.WT_UP, 2048, 2048, MT / 256, 32, smem, nullptr, 0, bid, nb);
  }
#endif
  grid.sync();
#if PH & (1 << 9)
  { IDS
  gemm_phase<EPI_ACC>(p, p.U, DFF, p.WT_DOWN, DFF, DFF, MT / 256 - 1, 8, smem, nullptr, 0, bid, nb);
  for (int id = bid; id < 256; id += nb) {
    const int nt = id & 7, kc = id >> 3;
    gemm_tile<EPI_ATOM>(p, p.U + kc * 256, DFF, p.WT_DOWN + kc * 256, DFF, 256, (MT / 256 - 1) * 256, nt * 256, smem, nullptr, 0);
  }
  }
#endif
  grid.sync();
#if PH & (1 << 10)
  { IDS
  for (int r = gw; r < MT; r += ngw) {
    float* x = p.out + O_Y + (size_t)r * 2048;
    f32x4 v[8];
    float ss = 0.f;
#pragma unroll
    for (int i = 0; i < 8; ++i) {
      v[i] = *(const f32x4*)(x + i * 256 + lane * 4);
      ss += v[i][0] * v[i][0] + v[i][1] * v[i][1] + v[i][2] * v[i][2] + v[i][3] * v[i][3];
    }
    ss = wave_sum(ss);
    float rr = rsqrtf(ss * (1.f / 2048.f) + 1e-6f);
#pragma unroll
    for (int i = 0; i < 8; ++i) {
      f32x4 gg = *(const f32x4*)(p.g_fin + i * 256 + lane * 4);
      f32x4 o = {v[i][0] * rr * gg[0], v[i][1] * rr * gg[1], v[i][2] * rr * gg[2], v[i][3] * rr * gg[3]};
      *(f32x4*)(x + i * 256 + lane * 4) = o;
    }
  }
  }
#endif
}

extern "C" void kernel_launch(void* const* d_in, const int* in_sizes, int n_in, void* d_out, int out_size, void* d_ws, size_t ws_size,
                              hipStream_t stream) {
  static int grid_blocks = 0;
  if (!grid_blocks) {
    int dev = 0, cus = 0, per_cu = 0;
    hipGetDevice(&dev);
    hipDeviceGetAttribute(&cus, hipDeviceAttributeMultiprocessorCount, dev);
    if (hipFuncSetAttribute((const void*)fwd_megakernel, hipFuncAttributeMaxDynamicSharedMemorySize, LDS_BYTES) != hipSuccess)
      fprintf(stderr, "kernel_launch: hipFuncSetAttribute failed\n");
    hipOccupancyMaxActiveBlocksPerMultiprocessor(&per_cu, (const void*)fwd_megakernel, NTHREADS, LDS_BYTES);
    if (per_cu < 1) per_cu = 1;
    if (per_cu > 1) per_cu = 1;
    grid_blocks = cus * per_cu;
  }
  Params p{};
  const float* const* in = (const float* const*)d_in;
  p.x_p = in[0]; p.x_s = in[1]; p.c_ak = in[2]; p.c_av = in[3]; p.c_idx = in[4]; p.c_ckv = in[5]; p.c_kr = in[6]; p.rel = in[7];
  p.g_mix = in[8]; p.w_in = in[9]; p.g_q = in[10]; p.w_uq = in[11]; p.g_kv = in[12]; p.w_uk = in[13]; p.w_uv = in[14]; p.w_out = in[15];
  p.g_ffn = in[16]; p.w_up = in[17]; p.w_down = in[18]; p.g_fin = in[19];
  p.out = (float*)d_out;
  char* ws = (char*)d_ws;
  size_t off = 0;
  auto alloc = [&](size_t bytes) { char* r = ws + off; off += (bytes + 255) & ~(size_t)255; return r; };
  p.WT_UQ = (u16*)alloc((size_t)3072 * 512 * 2);
  p.WT_UK = (u16*)alloc((size_t)2048 * 256 * 2);
  p.WT_UV = (u16*)alloc((size_t)2048 * 256 * 2);
  p.WT_OUT = (u16*)alloc((size_t)2048 * 2048 * 2);
  p.WT_UP = (u16*)alloc((size_t)8192 * 2048 * 2);
  p.WT_DOWN = (u16*)alloc((size_t)2048 * 8192 * 2);
  p.CQ = (u16*)alloc((size_t)MT * 512 * 2);
  p.CKV = (u16*)alloc((size_t)KROWS * 256 * 2);
  p.KR = (u16*)alloc((size_t)KROWS * 64 * 2);
  p.GA = (u16*)alloc((size_t)MT * 2048 * 2);
  p.GB = (u16*)alloc((size_t)MT * 2048 * 2);
  p.CS = (float*)alloc((size_t)MT * 32 * 4);
  p.SN = (float*)alloc((size_t)MT * 32 * 4);
  const size_t ubase = off;
  p.WT_IN = (u16*)alloc((size_t)INP * 2048 * 2);
  p.H = (u16*)alloc((size_t)MT * 2048 * 2);
  p.AQ = (u16*)alloc((size_t)MT * 2048 * 2);
  p.KA = (u16*)alloc((size_t)MP * 2048 * 2);
  p.VAT = (u16*)alloc((size_t)MP * 2048 * 2);
  p.IXQ = (u16*)alloc((size_t)MT * 1024 * 2);
  p.IXK = (u16*)alloc((size_t)KROWS * 64 * 2);
  p.SEL = (unsigned long long*)alloc((size_t)MT * 256 * 8);
  p.IXW = (float*)alloc((size_t)MT * 16 * 4);
  const size_t endA = off;
  off = ubase;
  p.QB = (u16*)alloc((size_t)MT * 3072 * 2);
  p.KB = (u16*)alloc((size_t)KROWS * 2048 * 2);
  p.VBT_P = (u16*)alloc((size_t)2048 * MP * 2);
  p.VBT_S = (u16*)alloc((size_t)16 * 2048 * VSS * 2);
  const size_t endB = off;
  off = ubase;
  p.H2 = (u16*)alloc((size_t)MT * 2048 * 2);
  p.U = (u16*)alloc((size_t)MT * DFF * 2);
  const size_t endC = off;
  size_t need = endA > endB ? endA : endB;
  if (endC > need) need = endC;
  if (need > ws_size) { fprintf(stderr, "kernel_launch: workspace too small: need %zu have %zu\n", need, ws_size); return; }
  void* args[] = {&p};
  hipError_t e = hipLaunchCooperativeKernel((const void*)fwd_megakernel, dim3(grid_blocks), dim3(NTHREADS), args, LDS_BYTES, stream);
  if (e != hipSuccess) fprintf(stderr, "cooperative launch failed: %s (grid %d)\n", hipGetErrorString(e), grid_blocks);
}
```

```cpp
#include <hip/hip_runtime.h>
#include <hip/hip_cooperative_groups.h>
#include <cstdio>
#include <cstdint>
namespace cg = cooperative_groups;

typedef unsigned short u16;
typedef __attribute__((ext_vector_type(8))) short bf16x8;
typedef __attribute__((ext_vector_type(4))) short bf16x4;
typedef __attribute__((ext_vector_type(4))) float f32x4;
typedef __attribute__((ext_vector_type(2))) float f32x2;
typedef __attribute__((ext_vector_type(2))) __bf16 bf16x2_t;
typedef __attribute__((ext_vector_type(4))) unsigned u32x4;
typedef __attribute__((ext_vector_type(2))) unsigned u32x2;

#define DI __device__ __forceinline__

constexpr int MP = 16384;
constexpr int MS = 256;
constexpr int MT = MP + MS;
constexpr int DM = 2048;
constexpr int INC = 12176;
constexpr int INP = 12288;
constexpr int SK = 1040;
constexpr int KROWS = MP + 16 * SK;
constexpr int VSS = 1088;
constexpr int DFF = 8192;
constexpr int ZRW = 832;
#ifndef PH
#define PH 0x7ff
#endif
#ifndef REP
#define REP 0
#endif
#define NREP(k) (((REP >> (k)) & 1) + 1)
constexpr int NTHREADS = 512;
constexpr int VB_LDS = 75776;
constexpr int LDS_BYTES = 2 * VB_LDS;

constexpr size_t O_Y = 0;
constexpr size_t O_AKP = 34078720;
constexpr size_t O_AVP = 67633152;
constexpr size_t O_IDXP = 101187584;
constexpr size_t O_CKVP = 102236160;
constexpr size_t O_KRP = 106430464;
constexpr size_t O_AKS = 107479040;
constexpr size_t O_AVS = 108003328;
constexpr size_t O_IDXS = 108527616;
constexpr size_t O_CKVS = 108544000;
constexpr size_t O_KRS = 108609536;

struct Params {
  const float *x_p, *x_s, *c_ak, *c_av, *c_idx, *c_ckv, *c_kr, *rel, *g_mix, *w_in, *g_q, *w_uq, *g_kv, *w_uk, *w_uv, *w_out, *g_ffn, *w_up, *w_down, *g_fin;
  float* out;
  u16 *WT_UQ, *WT_UK, *WT_UV, *WT_OUT, *WT_UP, *WT_DOWN, *CQ, *CKV, *KR, *GA, *GB;
  float *CS, *SN;
  u16 *WT_IN, *H, *AQ, *KA, *VAT, *IXQ, *IXK;
  float* IXW;
  unsigned long long* SEL;
  u16 *QB, *KB, *VBT_P, *VBT_S;
  u16 *H2, *U;
};

DI int otid() { int t = threadIdx.x; asm volatile("" : "+v"(t)); return t; }
DI unsigned cvtpk(float lo, float hi) {
  f32x2 v = {lo, hi};
  bf16x2_t b = __builtin_convertvector(v, bf16x2_t);
  return __builtin_bit_cast(unsigned, b);
}
DI u16 f2bf(float x) { return (u16)(cvtpk(x, 0.f) & 0xffffu); }
DI float bf2f(u16 b) { return __uint_as_float(((unsigned)b) << 16); }
DI float bflo(unsigned w) { return __uint_as_float(w << 16); }
DI float bfhi(unsigned w) { return __uint_as_float(w & 0xffff0000u); }
DI float dot2bf(unsigned a, unsigned b, float c) {
  return __builtin_amdgcn_fdot2_f32_bf16(__builtin_bit_cast(bf16x2_t, a), __builtin_bit_cast(bf16x2_t, b), c, false);
}
DI float wave_sum(float v) {
#pragma unroll
  for (int o = 32; o > 0; o >>= 1) v += __shfl_xor(v, o);
  return v;
}
DI int qpos_of(int t) { return t < MP ? t : 1024 + ((t - MP) & 15); }
DI int krow_of(int t) { return t < MP ? t : MP + ((t - MP) >> 4) * SK + 1024 + ((t - MP) & 15); }
DI float inv_freq(int i) { return exp2f(-(float)i * 0.41524101186092029f); }

DI void transpose_tile(const float* __restrict__ W, int K, int N, u16* __restrict__ Wt, int tile, float* s  ) {
  const int nkt = K >> 6;
  const int kt = tile % nkt, nt = tile / nkt;
  const int k0 = kt << 6, n0 = nt << 6;
  const int tid = otid() & 255;
  const int c = tid & 63, r0 = tid >> 6;
  __syncthreads();
#pragma unroll
  for (int i = 0; i < 16; ++i) {
    int r = i * 4 + r0;
    float v = (n0 + c < N) ? W[(size_t)(k0 + r) * N + n0 + c] : 0.f;
    s[r * 65 + c] = v;
  }
  __syncthreads();
  const int kp = (tid & 31) * 2, rr0 = tid >> 5;
#pragma unroll
  for (int i = 0; i < 8; ++i) {
    int rr = i * 8 + rr0;
    unsigned pk = cvtpk(s[kp * 65 + rr], s[(kp + 1) * 65 + rr]);
    *(unsigned*)(Wt + (size_t)(n0 + rr) * K + k0 + kp) = pk;
  }
}

DI void rms_row_2048(const float* __restrict__ x, const float* __restrict__ g, u16* __restrict__ out, int lane) {
  f32x4 v[8];
  float ss = 0.f;
#pragma unroll
  for (int i = 0; i < 8; ++i) {
    v[i] = *(const f32x4*)(x + i * 256 + lane * 4);
    ss += v[i][0] * v[i][0] + v[i][1] * v[i][1] + v[i][2] * v[i][2] + v[i][3] * v[i][3];
  }
  ss = wave_sum(ss);
  float r = rsqrtf(ss * (1.f / 2048.f) + 1e-6f);
#pragma unroll
  for (int i = 0; i < 8; ++i) {
    f32x4 gg = *(const f32x4*)(g + i * 256 + lane * 4);
    u32x2 o;
    o[0] = cvtpk(v[i][0] * r * gg[0], v[i][1] * r * gg[1]);
    o[1] = cvtpk(v[i][2] * r * gg[2], v[i][3] * r * gg[3]);
    *(u32x2*)(out + i * 256 + lane * 4) = o;
  }
}

enum { EPI_IN = 0, EPI_QB, EPI_BF16, EPI_VT, EPI_RES, EPI_RELU2, EPI_ACC, EPI_ATOM };
constexpr float QSC = 0.07216878364870322f * 1.4426950408889634f;
constexpr int LSTR = 64;
#ifndef PFA
#define PFA 8
#endif

template <int EPI> struct EpiSwap { static constexpr bool v = (EPI != EPI_VT); };

DI u32x2 pack4(f32x4 v) { u32x2 r; r[0] = cvtpk(v[0], v[1]); r[1] = cvtpk(v[2], v[3]); return r; }
DI float relu_i(float x) { return __int_as_float(max(__float_as_int(x), 0)); }
DI float sigm(float v) { return __builtin_amdgcn_rcpf(1.f + __builtin_amdgcn_exp2f(v * -1.4426950408889634f)); }

template <int EPI>
DI void gemm_epilogue(const Params& p, f32x4 (&acc)[8][4], int m0, int n0, int wr, int wc, int fr, int fq, u16* Cb, int ldc) {
  const int cw = n0 + wc * 64;
  if (EPI == EPI_VT) {
#pragma clang loop unroll(full)
    for (int m = 0; m < 8; ++m) {
      const int rb = m0 + wr * 128 + m * 16 + fq * 4;
#pragma clang loop unroll(full)
      for (int n = 0; n < 4; ++n) {
        const int col = cw + n * 16 + fr;
        u16* dst;
        if (rb < MP) dst = p.VBT_P + (size_t)col * MP + rb;
        else { int r2 = rb - MP; int b = r2 / SK; int s = r2 - b * SK; dst = p.VBT_S + ((size_t)b * 2048 + col) * VSS + s; }
        *(u32x2*)dst = pack4(acc[m][n]);
      }
    }
    return;
  }
  const int rbase = m0 + wr * 128 + fr;
  const int c4 = fq * 4;
  if (EPI == EPI_QB) {
    if (cw % 192 == 128) {
#pragma clang loop unroll(full)
      for (int m = 0; m < 8; ++m) {
        const int row = rbase + m * 16;
#pragma clang loop unroll(full)
        for (int n = 0; n < 2; ++n) {
          const int i0 = n * 16 + c4;
          const f32x4 cs = *(const f32x4*)(p.CS + (size_t)row * 32 + i0), sn = *(const f32x4*)(p.SN + (size_t)row * 32 + i0);
          const f32x4 x1 = acc[m][n] * QSC, x2 = acc[m][n + 2] * QSC;
          *(u32x2*)(p.QB + (size_t)row * 3072 + cw + i0) = pack4(x1 * cs - x2 * sn);
          *(u32x2*)(p.QB + (size_t)row * 3072 + cw + i0 + 32) = pack4(x1 * sn + x2 * cs);
        }
      }
      return;
    }
  }
#pragma clang loop unroll(full)
  for (int n = 0; n < 4; ++n) {
    const int colt = cw + n * 16;
    const int col = colt + c4;
    if (EPI == EPI_IN) {
      const bool smp = m0 >= MP;
      if (colt < 2048) {
#pragma clang loop unroll(full)
        for (int m = 0; m < 8; ++m) *(u32x2*)(p.AQ + (size_t)(rbase + m * 16) * 2048 + col) = pack4(acc[m][n] * (0.08838834764831845f * 1.4426950408889634f));
      } else if (colt < 4096) {
        const int c = col - 2048;
#pragma clang loop unroll(full)
        for (int m = 0; m < 8; ++m) {
          const int row = rbase + m * 16;
          if (!smp) { *(f32x4*)(p.out + O_AKP + (size_t)row * 2048 + c) = acc[m][n]; *(u32x2*)(p.KA + (size_t)row * 2048 + c) = pack4(acc[m][n]); }
          else *(f32x4*)(p.out + O_AKS + (size_t)(row - MP) * 2048 + c) = acc[m][n];
        }
      } else if (colt < 6144) {
        const int c = col - 4096;
#pragma clang loop unroll(full)
        for (int m = 0; m < 8; ++m) {
          const int row = rbase + m * 16;
          if (!smp) {
            *(f32x4*)(p.out + O_AVP + (size_t)row * 2048 + c) = acc[m][n];
#pragma clang loop unroll(full)
            for (int j = 0; j < 4; ++j) p.VAT[(size_t)(c + j) * MP + row] = f2bf(acc[m][n][j]);
          } else *(f32x4*)(p.out + O_AVS + (size_t)(row - MP) * 2048 + c) = acc[m][n];
        }
      } else if (colt < 7168) {
#pragma clang loop unroll(full)
        for (int m = 0; m < 8; ++m) *(u32x2*)(p.IXQ + (size_t)(rbase + m * 16) * 1024 + (col - 6144)) = pack4(acc[m][n]);
      } else if (colt < 7232) {
        const int c = col - 7168;
#pragma clang loop unroll(full)
        for (int m = 0; m < 8; ++m) {
          const int row = rbase + m * 16;
          if (!smp) *(f32x4*)(p.out + O_IDXP + (size_t)row * 64 + c) = acc[m][n];
          else *(f32x4*)(p.out + O_IDXS + (size_t)(row - MP) * 64 + c) = acc[m][n];
          *(u32x2*)(p.IXK + (size_t)krow_of(row) * 64 + c) = pack4(acc[m][n]);
        }
      } else if (colt < 7248) {
#pragma clang loop unroll(full)
        for (int m = 0; m < 8; ++m) *(f32x4*)(p.IXW + (size_t)(rbase + m * 16) * 16 + (col - 7232)) = acc[m][n] * 0.25f;
      } else if (colt < 8080) {
#pragma clang loop unroll(full)
        for (int m = 0; m < 8; ++m) *(f32x4*)(p.out + O_Y + (size_t)(rbase + m * 16) * ZRW + (col - 7248)) = acc[m][n];
      } else if (colt < INC) {
        u16* G = colt < 10128 ? p.GA : p.GB;
        const int c = colt < 10128 ? col - 8080 : col - 10128;
#pragma clang loop unroll(full)
        for (int m = 0; m < 8; ++m) {
          f32x4 v = acc[m][n];
          f32x4 g = {sigm(v[0]), sigm(v[1]), sigm(v[2]), sigm(v[3])};
          *(u32x2*)(G + (size_t)(rbase + m * 16) * 2048 + c) = pack4(g);
        }
      }
    } else {
#pragma clang loop unroll(full)
      for (int m = 0; m < 8; ++m) {
        const int row = rbase + m * 16;
        const f32x4 v = acc[m][n];
        if (EPI == EPI_QB) {
          *(u32x2*)(Cb + (size_t)row * ldc + col) = pack4(v * QSC);
        } else if (EPI == EPI_BF16) {
          *(u32x2*)(Cb + (size_t)row * ldc + col) = pack4(v);
        } else if (EPI == EPI_RES) {
          const f32x4 xv = row < MP ? *(const f32x4*)(p.x_p + (size_t)row * 2048 + col) : *(const f32x4*)(p.x_s + (size_t)(row - MP) * 2048 + col);
          *(f32x4*)(p.out + O_Y + (size_t)row * 2048 + col) = xv + v;
          if ((m & 3) == 3) __builtin_amdgcn_sched_barrier(0);
        } else if (EPI == EPI_RELU2) {
          f32x4 r = {relu_i(v[0]), relu_i(v[1]), relu_i(v[2]), relu_i(v[3])};
          *(u32x2*)(p.U + (size_t)row * DFF + col) = pack4(r * r);
        } else if (EPI == EPI_ACC) {
          float* d = p.out + O_Y + (size_t)row * 2048 + col;
          *(f32x4*)d = *(const f32x4*)d + v;
          if ((m & 3) == 3) __builtin_amdgcn_sched_barrier(0);
        } else if (EPI == EPI_ATOM) {
#pragma clang loop unroll(full)
          for (int j = 0; j < 4; ++j) atomicAdd(p.out + O_Y + (size_t)row * 2048 + col + j, v[j]);
        }
      }
    }
  }
}

constexpr int GSTAGE = 512 * LSTR;
template <int EPI>
DI void gemm_tile(const Params& p, const u16* __restrict__ A, int lda, const u16* __restrict__ Bt, int ldb, int K, int m0, int n0,
                  char* smem, u16* Cb, int ldc) {
  u16* sbase = (u16*)smem;
  const int tid = otid(), lane = tid & 63, w = tid >> 6;
  const int wr = w >> 2, wc = w & 3, fr = lane & 15, fq = lane >> 4;
  f32x4 acc[8][4];
#pragma unroll
  for (int m = 0; m < 8; ++m)
#pragma unroll
    for (int n = 0; n < 4; ++n) acc[m][n] = (f32x4){0.f, 0.f, 0.f, 0.f};
  const int lr = tid >> 3, lk = (tid & 7) * 8;
  const int lkw = ((tid & 7) ^ ((lr >> 1) & 7)) * 8;
  const int fsw = (fr >> 1) & 7, fo0 = (fq ^ fsw) * 8, fo1 = ((4 + fq) ^ fsw) * 8;
  const u16* Ag = A + (size_t)(m0 + lr) * lda + lk;
  const u16* Bg = Bt + (size_t)(n0 + lr) * ldb + lk;
  const int nk = K >> 6;
  u32x4 ra[4], rb[4];
#define G_LOAD(T) { const int k_ = (T) << 6; _Pragma("unroll") for (int i = 0; i < 4; ++i) { \
    ra[i] = *(const u32x4*)(Ag + (size_t)(i * 64) * lda + k_); rb[i] = *(const u32x4*)(Bg + (size_t)(i * 64) * ldb + k_); } }
#define L_STORE(ST) { u16* dA_ = sbase + (ST) * GSTAGE + lr * LSTR + lkw; u16* dB_ = dA_ + 256 * LSTR; _Pragma("unroll") for (int i = 0; i < 4; ++i) { \
    *(u32x4*)(dA_ + i * 64 * LSTR) = ra[i]; *(u32x4*)(dB_ + i * 64 * LSTR) = rb[i]; } }
  G_LOAD(0)
  L_STORE(0)
  G_LOAD(1)
#pragma unroll 1
  for (int kt = 0; kt < nk; ++kt) {
    __syncthreads();
    if (kt + 1 < nk) L_STORE((kt + 1) & 1)
    G_LOAD(min(kt + 2, nk - 1))
    const u16* cA = sbase + (kt & 1) * GSTAGE + (wr * 128 + fr) * LSTR;
    const u16* cB = sbase + (kt & 1) * GSTAGE + 256 * LSTR + (wc * 64 + fr) * LSTR;
#pragma unroll
    for (int ks = 0; ks < 2; ++ks) {
      bf16x8 bfr[4];
#pragma unroll
      for (int n = 0; n < 4; ++n) bfr[n] = *(const bf16x8*)(cB + n * 16 * LSTR + (ks ? fo1 : fo0));
#pragma unroll
      for (int mh = 0; mh < 2; ++mh) {
        bf16x8 af[4];
#pragma unroll
        for (int m = 0; m < 4; ++m) af[m] = *(const bf16x8*)(cA + (mh * 4 + m) * 16 * LSTR + (ks ? fo1 : fo0));
        __builtin_amdgcn_s_setprio(1);
#pragma unroll
        for (int m = 0; m < 4; ++m)
#pragma unroll
          for (int n = 0; n < 4; ++n)
            acc[mh * 4 + m][n] = EpiSwap<EPI>::v ? __builtin_amdgcn_mfma_f32_16x16x32_bf16(bfr[n], af[m], acc[mh * 4 + m][n], 0, 0, 0)
                                                 : __builtin_amdgcn_mfma_f32_16x16x32_bf16(af[m], bfr[n], acc[mh * 4 + m][n], 0, 0, 0);
        __builtin_amdgcn_s_setprio(0);
      }
    }
  }
#undef G_LOAD
#undef L_STORE
  gemm_epilogue<EPI>(p, acc, m0, n0, wr, wc, fr, fq, Cb, ldc);
}

template <int EPI>
DI void gemm_phase(const Params& p, const u16* A, int lda, const u16* Bt, int ldb, int K, int mtiles, int ntiles, char* smem, u16* Cb, int ldc,
                   int start, int stride) {
  if (stride == 256) {
    const int gm = (mtiles + 3) >> 2, gn = (ntiles + 7) >> 3, nsg = gm * gn;
    const int xcd = start & 7, li = start >> 3;
    for (int sg = xcd; sg < nsg; sg += 8) {
      const int gni = sg / gm, gmi = sg - gni * gm;
      const int mt = gmi * 4 + (li & 3), nt = gni * 8 + (li >> 2);
      if (mt < mtiles && nt < ntiles) gemm_tile<EPI>(p, A, lda, Bt, ldb, K, mt * 256, nt * 256, smem, Cb, ldc);
    }
    return;
  }
  const int total = mtiles * ntiles;
  const int GM = 8;
  for (int id = start; id < total; id += stride) {
    const int per = GM * ntiles;
    const int g = id / per, rem = id - g * per;
    const int fm = g * GM;
    const int gsz = min(GM, mtiles - fm);
    const int mt = fm + rem % gsz, nt = rem / gsz;
    gemm_tile<EPI>(p, A, lda, Bt, ldb, K, mt * 256, nt * 256, smem, Cb, ldc);
  }
}

DI void post_row(const Params& p, int t, int lane) {
  const float* zr = p.out + O_Y + (size_t)t * ZRW;
  {
    f32x4 a = *(const f32x4*)(zr + lane * 4), b = *(const f32x4*)(zr + 256 + lane * 4);
    float ss = a[0] * a[0] + a[1] * a[1] + a[2] * a[2] + a[3] * a[3] + b[0] * b[0] + b[1] * b[1] + b[2] * b[2] + b[3] * b[3];
    ss = wave_sum(ss);
    float r = rsqrtf(ss * (1.f / 512.f) + 1e-6f);
    f32x4 ga = *(const f32x4*)(p.g_q + lane * 4), gb = *(const f32x4*)(p.g_q + 256 + lane * 4);
    u32x2 o;
    o[0] = cvtpk(a[0] * r * ga[0], a[1] * r * ga[1]); o[1] = cvtpk(a[2] * r * ga[2], a[3] * r * ga[3]);
    *(u32x2*)(p.CQ + (size_t)t * 512 + lane * 4) = o;
    o[0] = cvtpk(b[0] * r * gb[0], b[1] * r * gb[1]); o[1] = cvtpk(b[2] * r * gb[2], b[3] * r * gb[3]);
    *(u32x2*)(p.CQ + (size_t)t * 512 + 256 + lane * 4) = o;
  }
  const int kr_row = krow_of(t);
  {
    f32x4 a = *(const f32x4*)(zr + 512 + lane * 4);
    float ss = a[0] * a[0] + a[1] * a[1] + a[2] * a[2] + a[3] * a[3];
    ss = wave_sum(ss);
    float r = rsqrtf(ss * (1.f / 256.f) + 1e-6f);
    f32x4 g = *(const f32x4*)(p.g_kv + lane * 4);
    f32x4 o = {a[0] * r * g[0], a[1] * r * g[1], a[2] * r * g[2], a[3] * r * g[3]};
    float* od = t < MP ? p.out + O_CKVP + (size_t)t * 256 : p.out + O_CKVS + (size_t)(t - MP) * 256;
    *(f32x4*)(od + lane * 4) = o;
    u32x2 ob; ob[0] = cvtpk(o[0], o[1]); ob[1] = cvtpk(o[2], o[3]);
    *(u32x2*)(p.CKV + (size_t)kr_row * 256 + lane * 4) = ob;
  }
  if (lane < 32) {
    float x1 = zr[768 + lane], x2 = zr[768 + 32 + lane];
    float ang = (float)qpos_of(t) * inv_freq(lane);
    float cs = cosf(ang), sn = sinf(ang);
    p.CS[(size_t)t * 32 + lane] = cs; p.SN[(size_t)t * 32 + lane] = sn;
    float o1 = x1 * cs - x2 * sn, o2 = x1 * sn + x2 * cs;
    float* od = t < MP ? p.out + O_KRP + (size_t)t * 64 : p.out + O_KRS + (size_t)(t - MP) * 64;
    od[lane] = o1; od[lane + 32] = o2;
    p.KR[(size_t)kr_row * 64 + lane] = f2bf(o1);
    p.KR[(size_t)kr_row * 64 + lane + 32] = f2bf(o2);
  }
}

template <int CTRL> DI float dpp_add(float v) {
  int sft = __builtin_amdgcn_update_dpp(0, __float_as_int(v), CTRL, 0xf, 0xf, true);
  return v + __int_as_float(sft);
}
DI float row16_sum(float v) { v = dpp_add<0x111>(v); v = dpp_add<0x112>(v); v = dpp_add<0x114>(v); v = dpp_add<0x118>(v); return v; }
DI unsigned fkey(float f) { unsigned u = __float_as_uint(f); return (u & 0x80000000u) ? ~u : (u | 0x80000000u); }

DI void radix_select(unsigned* sc, int* hist, int* misc, int n, unsigned long long* sel, int tid, int lane, int w) {
  __syncthreads();
  unsigned prefix = 0;
  int remaining = 256, neq = 0;
#pragma unroll 1
  for (int pass = 0; pass < 3; ++pass) {
    const int shift = pass == 0 ? 21 : (pass == 1 ? 10 : 0);
    const int bits = pass == 2 ? 10 : 11;
    const unsigned bmask = (1u << bits) - 1u;
    if (pass > 0) {
      *(int4*)&hist[tid * 8] = make_int4(0, 0, 0, 0);
      *(int4*)&hist[tid * 8 + 4] = make_int4(0, 0, 0, 0);
      __syncthreads();
      const int hs = shift + bits;
      const unsigned want = prefix >> hs;
      for (int i = tid * 4; i < n; i += 256 * 4) {
        const u32x4 u4 = *(const u32x4*)(sc + i);
#pragma unroll
        for (int e = 0; e < 4; ++e)
          if ((u4[e] >> hs) == want) atomicAdd(&hist[(u4[e] >> shift) & bmask], 1);
      }
      __syncthreads();
    }
    const int4 h0 = *(const int4*)&hist[tid * 8], h1 = *(const int4*)&hist[tid * 8 + 4];
    const int s8 = h0.x + h0.y + h0.z + h0.w + h1.x + h1.y + h1.z + h1.w;
    int suf = s8;
#pragma unroll
    for (int d = 1; d < 64; d <<= 1) { int v = __shfl_down(suf, d); if (lane + d < 64) suf += v; }
    if (lane == 0) misc[w] = suf;
    __syncthreads();
    int above = 0;
    for (int ww = w + 1; ww < 4; ++ww) above += misc[ww];
    const int excl = above + suf - s8;
    if (excl < remaining && remaining <= excl + s8) {
      int c = excl, bin = 0, nrem = 0, bpop = 0;
#define TK_STEP(val, idx) if (c < remaining && remaining <= c + (val)) { bin = tid * 8 + (idx); nrem = remaining - c; bpop = (val); } c += (val);
      TK_STEP(h1.w, 7) TK_STEP(h1.z, 6) TK_STEP(h1.y, 5) TK_STEP(h1.x, 4) TK_STEP(h0.w, 3) TK_STEP(h0.z, 2) TK_STEP(h0.y, 1) TK_STEP(h0.x, 0)
#undef TK_STEP
      misc[4] = bin; misc[5] = nrem; misc[6] = bpop;
    }
    __syncthreads();
    prefix |= ((unsigned)misc[4]) << shift;
    remaining = misc[5];
    neq = misc[6];
    __syncthreads();
  }
  const unsigned T = prefix;
  const int seg = ((n + 255) >> 8) << 6;
  const int beg = w * seg;
  if (neq == remaining) {
    for (int i0 = beg; i0 < beg + seg; i0 += 64) {
      const int i = i0 + lane;
      const bool in = i < n; const unsigned u = in ? sc[i] : 0u;
      const unsigned long long sm = __ballot(in && u >= T);
      if (lane == 0 && i0 < n) sel[i0 >> 6] = sm;
    }
    __syncthreads();
    return;
  }
  int ceq = 0;
  for (int i = beg + lane; i < beg + seg; i += 64) {
    bool in = i < n; unsigned u = in ? sc[i] : 0u;
    ceq += __popcll(__ballot(in && u == T));
  }
  if (lane == 0) misc[12 + w] = ceq;
  __syncthreads();
  int oe = 0;
  for (int ww = 0; ww < w; ++ww) oe += misc[12 + ww];
  const unsigned long long lt = (1ull << lane) - 1ull;
  for (int i0 = beg; i0 < beg + seg; i0 += 64) {
    const int i = i0 + lane;
    bool in = i < n; unsigned u = in ? sc[i] : 0u;
    bool g = in && u > T, e = in && u == T;
    unsigned long long be = __ballot(e);
    int pe = oe + __popcll(be & lt);
    unsigned long long sm = __ballot(g || (e && pe < remaining));
    if (lane == 0 && i0 < n) sel[i0 >> 6] = sm;
    oe += __popcll(be);
  }
}

constexpr int NQ = 4;
DI void topk_group(const Params& p, int t, char* smem, unsigned* scr1, unsigned* scr2, unsigned* scr3) {
  unsigned* sc = (unsigned*)smem;
  int* hist = (int*)(smem + 65536);
  int* misc = hist + 2048;
  const int tid = otid() & 255, lane = tid & 63, w = tid >> 6, fr = lane & 15, fq = lane >> 4;
  int n; const u16* ixk;
  if (t < MP) { n = 64 * ((t >> 6) + 1); ixk = p.IXK; }
  else { int b = (t - MP) >> 4; n = SK; ixk = p.IXK + (size_t)(MP + b * SK) * 64; }
  unsigned long long* sel = p.SEL + (size_t)t * 256;
  __syncthreads();
  if (n <= 256) {
    if (tid < 4) {
      unsigned long long v = (tid < (n >> 6)) ? ~0ull : 0ull;
#pragma unroll
      for (int qi = 0; qi < NQ; ++qi) sel[qi * 256 + tid] = v;
    }
    return;
  }
  *(int4*)&hist[tid * 8] = make_int4(0, 0, 0, 0);
  *(int4*)&hist[tid * 8 + 4] = make_int4(0, 0, 0, 0);
  __syncthreads();
  {
    const u16* q = p.IXQ + (size_t)t * 1024 + fr * 64 + fq * 8;
    bf16x8 a0[NQ], a1[NQ];
    f32x4 wv[NQ];
#pragma unroll
    for (int qi = 0; qi < NQ; ++qi) {
      a0[qi] = *(const bf16x8*)(q + qi * 1024); a1[qi] = *(const bf16x8*)(q + qi * 1024 + 32);
      wv[qi] = *(const f32x4*)(p.IXW + (size_t)(t + qi) * 16 + fq * 4);
    }
    const int ntile = n >> 4;
    for (int kt0 = w; kt0 < ntile; kt0 += 32) {
      bf16x8 b0[8], b1[8];
#pragma unroll
      for (int g = 0; g < 8; ++g) {
        const int kt = min(kt0 + g * 4, ntile - 1);
        const u16* kp = ixk + (size_t)(kt * 16 + fr) * 64 + fq * 8;
        b0[g] = *(const bf16x8*)kp; b1[g] = *(const bf16x8*)(kp + 32);
      }
      float pt[NQ][8];
#pragma unroll
      for (int g = 0; g < 8; ++g) {
#pragma unroll
        for (int qi = 0; qi < NQ; ++qi) {
          f32x4 c = {0.f, 0.f, 0.f, 0.f};
          c = __builtin_amdgcn_mfma_f32_16x16x32_bf16(a0[qi], b0[g], c, 0, 0, 0);
          c = __builtin_amdgcn_mfma_f32_16x16x32_bf16(a1[qi], b1[g], c, 0, 0, 0);
          pt[qi][g] = relu_i(c[0]) * wv[qi][0] + relu_i(c[1]) * wv[qi][1] + relu_i(c[2]) * wv[qi][2] + relu_i(c[3]) * wv[qi][3];
        }
      }
#pragma unroll
      for (int g = 0; g < 8; g += 2) {
        const int kt = kt0 + (g + (lane >> 5)) * 4;
        const bool st = (lane & 16) == 0 && kt < ntile;
#pragma unroll
        for (int qi = 0; qi < NQ; ++qi) {
          auto r32 = __builtin_amdgcn_permlane32_swap(__float_as_uint(pt[qi][g]), __float_as_uint(pt[qi][g + 1]), false, false);
          float s2 = __uint_as_float(r32[0]) + __uint_as_float(r32[1]);
          auto r16 = __builtin_amdgcn_permlane16_swap(__float_as_uint(s2), __float_as_uint(s2), false, false);
          float sv = __uint_as_float(r16[0]) + __uint_as_float(r16[1]);
          if (st) {
            unsigned u = fkey(sv);
            if (qi == 0) { sc[kt * 16 + fr] = u; atomicAdd(&hist[u >> 21], 1); }
            else if (qi == 1) scr1[kt * 16 + fr] = u;
            else if (qi == 2) scr2[kt * 16 + fr] = u;
            else scr3[kt * 16 + fr] = u;
          }
        }
      }
    }
  }
  radix_select(sc, hist, misc, n, sel, tid, lane, w);
#pragma unroll 1
  for (int qi = 1; qi < NQ; ++qi) {
    const unsigned* scr = qi == 1 ? scr1 : (qi == 2 ? scr2 : scr3);
    __syncthreads();
    *(int4*)&hist[tid * 8] = make_int4(0, 0, 0, 0);
    *(int4*)&hist[tid * 8 + 4] = make_int4(0, 0, 0, 0);
    __syncthreads();
    for (int i = tid * 4; i < n; i += 256 * 4) {
      const u32x4 u4 = *(const u32x4*)(scr + i);
      *(u32x4*)(sc + i) = u4;
#pragma unroll
      for (int e = 0; e < 4; ++e) atomicAdd(&hist[u4[e] >> 21], 1);
    }
    radix_select(sc, hist, misc, n, sel + qi * 256, tid, lane, w);
  }
}

constexpr int KSTR = 192;
constexpr int VSTR = 72;
DI float xq_max(float x) {
  auto a = __builtin_amdgcn_permlane16_swap(__float_as_uint(x), __float_as_uint(x), false, false);
  x = fmaxf(__uint_as_float(a[0]), __uint_as_float(a[1]));
  auto b = __builtin_amdgcn_permlane32_swap(__float_as_uint(x), __float_as_uint(x), false, false);
  return fmaxf(__uint_as_float(b[0]), __uint_as_float(b[1]));
}
DI float xq_sum(float x) {
  auto a = __builtin_amdgcn_permlane16_swap(__float_as_uint(x), __float_as_uint(x), false, false);
  x = __uint_as_float(a[0]) + __uint_as_float(a[1]);
  auto b = __builtin_amdgcn_permlane32_swap(__float_as_uint(x), __float_as_uint(x), false, false);
  return __uint_as_float(b[0]) + __uint_as_float(b[1]);
}

template <int MODE>
DI void attn_item(const Params& p, int item, char* smem, u16* gdst) {
  constexpr int NKS = MODE == 0 ? 6 : 4;
  constexpr int ASTAGE = 64 * KSTR + 128 * VSTR;
  u16* sbase = (u16*)smem;
  float* sBias = (float*)(sbase + 2 * ASTAGE);
  const int tid = otid(), lane = tid & 63, w = tid >> 6, fr = lane & 15, fq = lane >> 4;
  const int ksw = (fr >> 1) & 7, ko0 = (fq ^ ksw) * 8, ko1 = ((4 + fq) ^ ksw) * 8;
  int h, q0, nq, krow0, nkeys, ntiles, myt, b = 0, qpos0;
  const u16* vt; size_t vstride;
  const bool sample = item >= 1024;
  if (!sample) {
    const int i = 63 - (item >> 4);
    h = item & 15; q0 = i * 256; nq = 256; krow0 = 0; nkeys = q0 + 256; ntiles = 4 * i + 4; qpos0 = q0;
    vt = (MODE == 0 ? p.VBT_P : p.VAT) + (size_t)h * 128 * MP; vstride = MP;
    myt = ntiles - 3 + (w >> 1);
  } else {
    const int j = item - 1024; b = j >> 4;
    h = j & 15; q0 = MP + b * 16; nq = 16; krow0 = MP + b * SK; nkeys = SK; ntiles = 17; qpos0 = 1024;
    vt = p.VBT_S + ((size_t)b * 2048 + h * 128) * VSS; vstride = VSS;
    myt = ntiles;
  }
  const int wq0 = w * 32;
  const bool active = wq0 < nq;
  __syncthreads();
  if (MODE == 1) {
    for (int i = tid; i < 257; i += NTHREADS) {
      int rel = i - 128;
      int ret = rel > 0 ? 16 : 0;
      int n = rel < 0 ? -rel : rel;
      float lf = logf((float)max(n, 1) / 8.0f) / 2.772588722239781f * 8.0f;
      int large = min(8 + (int)lf, 15);
      int bk = ret + (n < 8 ? n : large);
      sBias[i] = (p.rel[bk * 16 + h] - p.rel[15 * 16 + h]) * 1.4426950408889634f;
    }
  }
  bf16x8 qf[2][NKS];
  int qrow[2];
#pragma unroll
  for (int qt = 0; qt < 2; ++qt) {
    const int qr = min(wq0 + qt * 16 + fr, nq - 1);
    qrow[qt] = qr;
    const u16* qp = (MODE == 0) ? p.QB + (size_t)(q0 + qr) * 3072 + h * 192 + fq * 8 : p.AQ + (size_t)(q0 + qr) * 2048 + h * 128 + fq * 8;
#pragma unroll
    for (int ks = 0; ks < NKS; ++ks) qf[qt][ks] = *(const bf16x8*)(qp + ks * 32);
  }
  f32x4 o[2][8];
#pragma unroll
  for (int qt = 0; qt < 2; ++qt)
#pragma unroll
    for (int dt = 0; dt < 8; ++dt) o[qt][dt] = (f32x4){0.f, 0.f, 0.f, 0.f};
  float mrow[2] = {-1e30f, -1e30f}, lrow[2] = {0.f, 0.f};
  const float SC = (MODE == 0 ? 0.07216878364870322f : 0.08838834764831845f) * 1.4426950408889634f;

  unsigned long long mqn[2] = {0ull, 0ull};
  if (MODE == 1) {
#pragma unroll
    for (int qt = 0; qt < 2; ++qt) mqn[qt] = p.SEL[(size_t)(q0 + qrow[qt]) * 256];
  }
  constexpr int NKL = MODE == 0 ? 3 : 2;
  const bool direct = (MODE == 1) && sample;
  u32x4 rk[NKL], rv[2];
#define KV_LOAD(JT) { const size_t kr0_ = (size_t)(krow0 + (JT) * 64); const u16* kb_ = (MODE == 0 ? p.KB : p.KA) + (kr0_ + (tid >> 4)) * 2048 + h * 128 + (tid & 15) * 8; \
    _Pragma("unroll") for (int i = 0; i < 2; ++i) rk[i] = *(const u32x4*)(kb_ + (size_t)i * 32 * 2048); \
    if (MODE == 0) rk[NKL - 1] = *(const u32x4*)(p.KR + (kr0_ + (tid >> 3)) * 64 + (tid & 7) * 8); \
    const u16* vp_ = vt + (size_t)(tid >> 3) * vstride + (JT) * 64 + (tid & 7) * 8; \
    _Pragma("unroll") for (int i = 0; i < 2; ++i) rv[i] = *(const u32x4*)(vp_ + (size_t)i * 64 * vstride); }
#define KV_STORE(ST) { u16* sk_ = sbase + (ST) * ASTAGE; u16* dk_ = sk_ + (tid >> 4) * KSTR + ((tid & 15) ^ ((tid >> 5) & 7)) * 8; \
    _Pragma("unroll") for (int i = 0; i < 2; ++i) *(u32x4*)(dk_ + i * 32 * KSTR) = rk[i]; \
    if (MODE == 0) *(u32x4*)(sk_ + (tid >> 3) * KSTR + 128 + ((tid & 7) ^ ((tid >> 4) & 7)) * 8) = rk[NKL - 1]; \
    u16* dv_ = sk_ + 64 * KSTR + (tid >> 3) * VSTR + (tid & 7) * 8; \
    _Pragma("unroll") for (int i = 0; i < 2; ++i) *(u32x4*)(dv_ + i * 64 * VSTR) = rv[i]; }
  if (!direct) {
    KV_LOAD(0)
    KV_STORE(0)
    KV_LOAD(min(1, ntiles - 1))
  }
  for (int jt = 0; jt < ntiles; ++jt) {
    const int key0 = jt * 64;
    u16* sK = sbase + (jt & 1) * ASTAGE;
    u16* sV = sK + 64 * KSTR;
    unsigned long long mq[2] = {mqn[0], mqn[1]};
    if (MODE == 1) {
      const int jn = min(jt + 1, ntiles - 1);
#pragma unroll
      for (int qt = 0; qt < 2; ++qt) mqn[qt] = p.SEL[(size_t)(q0 + qrow[qt]) * 256 + jn];
    }
    __syncthreads();
    if (!direct) {
      if (jt + 1 < ntiles) KV_STORE((jt + 1) & 1)
      KV_LOAD(min(jt + 2, ntiles - 1))
    } else {
#pragma unroll 2
      for (int i = 0; i < 4; ++i) {
        const int c = tid + i * NTHREADS;
        const int key = c >> 5, part = c & 31;
        const int s = key0 + key;
        const int sc_ = min(s, SK - 1);
        const size_t o1 = sc_ < 1024 ? ((size_t)b * 1024 + sc_) * 2048 : ((size_t)b * 16 + (sc_ - 1024)) * 2048;
        const float* kp = (sc_ < 1024 ? p.c_ak : p.out + O_AKS) + o1 + h * 128 + part * 4;
        const float* vp = (sc_ < 1024 ? p.c_av : p.out + O_AVS) + o1 + h * 128 + part * 4;
        f32x4 kv = *(const f32x4*)kp, vv = *(const f32x4*)vp;
        u32x2 kk; kk[0] = cvtpk(kv[0], kv[1]); kk[1] = cvtpk(kv[2], kv[3]);
        *(u32x2*)(sK + key * KSTR + (((part >> 1) ^ ((key >> 1) & 7)) * 8) + (part & 1) * 4) = kk;
        const bool ok = s < SK;
#pragma unroll
        for (int e = 0; e < 4; ++e) sV[(part * 4 + e) * VSTR + key] = ok ? f2bf(vv[e]) : (u16)0;
      }
      __syncthreads();
    }
    if (active && jt < myt) {
      f32x4 s[2][4];
#pragma unroll
      for (int qt = 0; qt < 2; ++qt) {
        const float nb_ = (jt == 0) ? 0.f : -mrow[qt];
#pragma unroll
        for (int kt = 0; kt < 4; ++kt) s[qt][kt] = (f32x4){nb_, nb_, nb_, nb_};
      }
      __builtin_amdgcn_s_setprio(1);
#pragma unroll
      for (int kt = 0; kt < 4; ++kt) {
#pragma unroll
        for (int ks = 0; ks < NKS; ++ks) {
          bf16x8 kf = *(const bf16x8*)(sK + (kt * 16 + fr) * KSTR + (ks >> 1) * 64 + ((ks & 1) ? ko1 : ko0));
          s[0][kt] = __builtin_amdgcn_mfma_f32_16x16x32_bf16(kf, qf[0][ks], s[0][kt], 0, 0, 0);
          s[1][kt] = __builtin_amdgcn_mfma_f32_16x16x32_bf16(kf, qf[1][ks], s[1][kt], 0, 0, 0);
        }
      }
      __builtin_amdgcn_s_setprio(0);
      unsigned mlo[2] = {0u, 0u}, mhi[2] = {0u, 0u};
      if (MODE == 0) {
        if (key0 + 64 > nkeys) {
#pragma unroll
          for (int kt = 0; kt < 4; ++kt)
#pragma unroll
            for (int j = 0; j < 4; ++j)
              if (key0 + kt * 16 + fq * 4 + j >= nkeys) { s[0][kt][j] = -1e30f; s[1][kt][j] = -1e30f; }
        }
      } else {
        const bool far = (key0 + 63) - (qpos0 + wq0) <= -128;
        if (!far) {
#pragma unroll
          for (int qt = 0; qt < 2; ++qt) {
            const int rb = key0 + fq * 4 - (qpos0 + qrow[qt]) + 128;
#pragma unroll
            for (int kt = 0; kt < 4; ++kt)
#pragma unroll
              for (int j = 0; j < 4; ++j) {
                int r = min(max(rb + kt * 16 + j, 0), 256);
                s[qt][kt][j] += sBias[r];
              }
          }
        }
#pragma unroll
        for (int qt = 0; qt < 2; ++qt) {
          const unsigned long long mm = mq[qt] >> (fq * 4);
          mlo[qt] = (unsigned)mm; mhi[qt] = (unsigned)(mm >> 32);
        }
      }
      bf16x8 pf[2][2];
#pragma unroll
      for (int qt = 0; qt < 2; ++qt) {
        float mx = -1e30f;
#pragma unroll
        for (int kt = 0; kt < 4; ++kt)
#pragma unroll
          for (int j = 0; j < 4; ++j) mx = fmaxf(mx, s[qt][kt][j]);
        mx = xq_max(mx);
        const float delta = (jt == 0) ? mx : fmaxf(mx, 0.f);
        mrow[qt] = (jt == 0) ? delta : mrow[qt] + delta;
        const bool grow = __ballot(delta != 0.f) != 0ull;
        float alpha = 1.f;
        if (grow) {
          alpha = __builtin_amdgcn_exp2f(-delta);
#pragma unroll
          for (int kt = 0; kt < 4; ++kt) s[qt][kt] -= delta;
        }
        float rs = 0.f;
#pragma unroll
        for (int kt = 0; kt < 4; ++kt)
#pragma unroll
          for (int j = 0; j < 4; ++j) {
            float pv = __builtin_amdgcn_exp2f(s[qt][kt][j]);
            if (MODE == 1) {
              int keep;
              asm("v_bfe_i32 %0, %1, %2, 1" : "=v"(keep) : "v"(kt < 2 ? mlo[qt] : mhi[qt]), "n"((kt & 1) * 16 + j));
              pv = __int_as_float(__float_as_int(pv) & keep);
            }
            s[qt][kt][j] = pv; rs += pv;
          }
        rs = xq_sum(rs);
        lrow[qt] = lrow[qt] * alpha + rs;
        if (grow) {
#pragma unroll
          for (int dt = 0; dt < 8; ++dt) o[qt][dt] *= alpha;
        }
#pragma unroll
        for (int s2 = 0; s2 < 2; ++s2) {
          u32x4 pk;
          pk[0] = cvtpk(s[qt][2 * s2][0], s[qt][2 * s2][1]);
          pk[1] = cvtpk(s[qt][2 * s2][2], s[qt][2 * s2][3]);
          pk[2] = cvtpk(s[qt][2 * s2 + 1][0], s[qt][2 * s2 + 1][1]);
          pk[3] = cvtpk(s[qt][2 * s2 + 1][2], s[qt][2 * s2 + 1][3]);
          pf[qt][s2] = __builtin_bit_cast(bf16x8, pk);
        }
      }
      __builtin_amdgcn_s_setprio(1);
#pragma unroll
      for (int dt = 0; dt < 8; ++dt) {
#pragma unroll
        for (int s2 = 0; s2 < 2; ++s2) {
          const u16* vp = sV + (dt * 16 + fr) * VSTR + fq * 4;
          u32x2 v0 = *(const u32x2*)(vp + (2 * s2) * 16);
          u32x2 v1 = *(const u32x2*)(vp + (2 * s2 + 1) * 16);
          u32x4 vv = {v0[0], v0[1], v1[0], v1[1]};
          bf16x8 vf = __builtin_bit_cast(bf16x8, vv);
          o[0][dt] = __builtin_amdgcn_mfma_f32_16x16x32_bf16(vf, pf[0][s2], o[0][dt], 0, 0, 0);
          o[1][dt] = __builtin_amdgcn_mfma_f32_16x16x32_bf16(vf, pf[1][s2], o[1][dt], 0, 0, 0);
        }
      }
      __builtin_amdgcn_s_setprio(0);
    }
  }
  if (active) {
#pragma unroll
    for (int qt = 0; qt < 2; ++qt) {
      const int qr = wq0 + qt * 16 + fr;
      if (qr < nq) {
        const float inv = 1.f / lrow[qt];
        const size_t row = (size_t)(q0 + qr);
#pragma unroll
        for (int dt = 0; dt < 8; ++dt) {
          const size_t off = row * 2048 + h * 128 + dt * 16 + fq * 4;
          u32x2 ga = *(const u32x2*)(p.GA + off);
          u32x2 r;
          if (MODE == 0) {
            u32x2 gb = *(const u32x2*)(p.GB + off);
            r[0] = cvtpk(bflo(gb[0]) * o[qt][dt][0] * inv + bflo(ga[0]), bfhi(gb[0]) * o[qt][dt][1] * inv + bfhi(ga[0]));
            r[1] = cvtpk(bflo(gb[1]) * o[qt][dt][2] * inv + bflo(ga[1]), bfhi(gb[1]) * o[qt][dt][3] * inv + bfhi(ga[1]));
          } else {
            r[0] = cvtpk(bflo(ga[0]) * o[qt][dt][0] * inv, bfhi(ga[0]) * o[qt][dt][1] * inv);
            r[1] = cvtpk(bflo(ga[1]) * o[qt][dt][2] * inv, bfhi(ga[1]) * o[qt][dt][3] * inv);
          }
          *(u32x2*)(gdst + off) = r;
        }
      }
    }
  }
}

#undef KV_LOAD
#undef KV_STORE
__global__ void __launch_bounds__(NTHREADS) fwd_megakernel(Params p) {
  extern __shared__ __attribute__((aligned(16))) char smem[];
  cg::grid_group grid = cg::this_grid();
#define IDS const int tid = otid(); const int lane = tid & 63, w = tid >> 6; const int bid = blockIdx.x, nb = gridDim.x; \
  const int gw = bid * 8 + w, ngw = nb * 8; (void)tid; (void)lane; (void)gw; (void)ngw; (void)bid; (void)nb;

#if PH & (1 << 0)
  { IDS
  {
    const int vb = tid >> 8;
    float* st = (float*)(smem + vb * VB_LDS);
    const int vbid = bid * 2 + vb, nvb = nb * 2;
    for (int t = vbid; t < 32 * 192; t += nvb) transpose_tile(p.w_in, 2048, INC, p.WT_IN, t, st);
    for (int t = vbid; t < 8 * 48; t += nvb) transpose_tile(p.w_uq, 512, 3072, p.WT_UQ, t, st);
    for (int t = vbid; t < 4 * 32; t += nvb) transpose_tile(p.w_uk, 256, 2048, p.WT_UK, t, st);
    for (int t = vbid; t < 4 * 32; t += nvb) transpose_tile(p.w_uv, 256, 2048, p.WT_UV, t, st);
    for (int t = vbid; t < 32 * 32; t += nvb) transpose_tile(p.w_out, 2048, 2048, p.WT_OUT, t, st);
    for (int t = vbid; t < 32 * 128; t += nvb) transpose_tile(p.w_up, 2048, 8192, p.WT_UP, t, st);
    for (int t = vbid; t < 128 * 32; t += nvb) transpose_tile(p.w_down, 8192, 2048, p.WT_DOWN, t, st);
    for (int r = gw; r < MT; r += ngw) {
      const float* x = r < MP ? p.x_p + (size_t)r * 2048 : p.x_s + (size_t)(r - MP) * 2048;
      rms_row_2048(x, p.g_mix, p.H + (size_t)r * 2048, lane);
    }
    const int gt = bid * NTHREADS + tid, ngt = nb * NTHREADS;
    for (int i = gt; i < 16 * 1024 * 64 / 4; i += ngt) {
      int e = i * 4; int b = e >> 16; int rem = e & 65535; int s = rem >> 6, c = rem & 63;
      size_t dst = (size_t)(MP + b * SK + s) * 64 + c;
      f32x4 a = *(const f32x4*)(p.c_idx + e), k = *(const f32x4*)(p.c_kr + e);
      u32x2 o; o[0] = cvtpk(a[0], a[1]); o[1] = cvtpk(a[2], a[3]);
      *(u32x2*)(p.IXK + dst) = o;
      o[0] = cvtpk(k[0], k[1]); o[1] = cvtpk(k[2], k[3]);
      *(u32x2*)(p.KR + dst) = o;
    }
    for (int i = gt; i < 16 * 1024 * 256 / 4; i += ngt) {
      int e = i * 4; int b = e >> 18; int rem = e & 262143; int s = rem >> 8, c = rem & 255;
      size_t dst = (size_t)(MP + b * SK + s) * 256 + c;
      f32x4 a = *(const f32x4*)(p.c_ckv + e);
      u32x2 o; o[0] = cvtpk(a[0], a[1]); o[1] = cvtpk(a[2], a[3]);
      *(u32x2*)(p.CKV + dst) = o;
    }
  }
  }
#endif
  grid.sync();
#if PH & (1 << 1)
  { IDS
  for (int rep = 0; rep < NREP(1); ++rep) gemm_phase<EPI_IN>(p, p.H, 2048, p.WT_IN, 2048, 2048, MT / 256, INP / 256, smem, nullptr, 0, bid, nb);
  }
#endif
  grid.sync();
#if PH & (1 << 2)
  { IDS
  for (int t = gw; t < MT; t += ngw) post_row(p, t, lane);
  {
    const int vb = tid >> 8, vbid = bid * 2 + vb;
    char* sm = smem + vb * VB_LDS;
    for (int rep = 0; rep < NREP(2); ++rep) for (int t = vbid * NQ; t < MT; t += nb * 2 * NQ)
      topk_group(p, t, sm, (unsigned*)(p.out + O_Y + 14000000) + (size_t)vbid * 16384, (unsigned*)(p.out + O_Y + 14000000) + (size_t)(512 + vbid) * 16384,
                 (unsigned*)p.H + (size_t)vbid * 16384);
  }
  }
#endif
  grid.sync();
#if PH & (1 << 3)
  { IDS
    const int total = 1024 + 256;
    for (int rep = 0; rep < NREP(3); ++rep) {
      u16* gdst = (rep + 1 < NREP(3)) ? (u16*)(p.out + O_Y) : p.GA;
      for (int r = 0;; ++r) {
        int id = (r & 1) ? r * nb + (nb - 1 - bid) : r * nb + bid;
        if (r * nb >= total) break;
        if (id < total) attn_item<1>(p, id, smem, gdst);
      }
    }
  }
#endif
  grid.sync();
#if PH & (1 << 4)
  { IDS
  {
    const int gt = bid * NTHREADS + tid, ngt = nb * NTHREADS;
    for (int i = gt; i < MS * 2048 / 4; i += ngt)
      *(f32x4*)(p.out + O_Y + (size_t)MP * 2048 + (size_t)i * 4) = *(const f32x4*)(p.x_s + (size_t)i * 4);
    for (int i = gt; i < 16 * 2048 * 6; i += ngt) {
      int r = i / 6, c = i - r * 6;
      *(u32x4*)(p.VBT_S + (size_t)r * VSS + SK + c * 8) = (u32x4){0u, 0u, 0u, 0u};
    }
    const int nqb = (MT / 256) * 12, nkb = (KROWS / 256) * 8;
    const int total = nqb + 2 * nkb;
    for (int id = bid; id < total; id += nb) {
      if (id < nqb) gemm_phase<EPI_QB>(p, p.CQ, 512, p.WT_UQ, 512, 512, MT / 256, 12, smem, p.QB, 3072, id, 1 << 30);
      else if (id < nqb + nkb) gemm_phase<EPI_BF16>(p, p.CKV, 256, p.WT_UK, 256, 256, KROWS / 256, 8, smem, p.KB, 2048, id - nqb, 1 << 30);
      else gemm_phase<EPI_VT>(p, p.CKV, 256, p.WT_UV, 256, 256, KROWS / 256, 8, smem, nullptr, 0, id - nqb - nkb, 1 << 30);
    }
  }
  }
#endif
  grid.sync();
#if PH & (1 << 5)
  { IDS
  {
    const int total = 1024 + 256;
    for (int rep = 0; rep < NREP(5); ++rep) {
      u16* gdst = (rep + 1 < NREP(5)) ? (u16*)(p.out + O_Y) : p.GB;
      for (int r = 0;; ++r) {
        int id = (r & 1) ? r * nb + (nb - 1 - bid) : r * nb + bid;
        if (r * nb >= total) break;
        if (id < total) attn_item<0>(p, id, smem, gdst);
      }
    }
  }
  }
#endif
  grid.sync();
#if PH & (1 << 6)
  { IDS
  gemm_phase<EPI_RES>(p, p.GB, 2048, p.WT_OUT, 2048, 2048, MT / 256 - 1, 8, smem, nullptr, 0, bid, nb);
  for (int id = bid; id < 128; id += nb) {
    const int nt = id & 7, kc = id >> 3;
    gemm_tile<EPI_ATOM>(p, p.GB + kc * 128, 2048, p.WT_OUT + kc * 128, 2048, 128, (MT / 256 - 1) * 256, nt * 256, smem, nullptr, 0);
  }
  }
#endif
  grid.sync();
#if PH & (1 << 7)
  { IDS
  for (int r = gw; r < MT; r += ngw) rms_row_2048(p.out + O_Y + (size_t)r * 2048, p.g_ffn, p.H2 + (size_t)r * 2048, lane);
  }
#endif
  grid.sync();
#if PH & (1 << 8)
  { IDS
  for (int rep = 0; rep < NREP(8); ++rep) gemm_phase<EPI_RELU2>(p, p.H2, 2048, p.WT_UP, 2048, 2048, MT / 256, 32, smem, nullptr, 0, bid, nb);
  }
#endif
  grid.sync();
#if PH & (1 << 9)
  { IDS
  gemm_phase<EPI_ACC>(p, p.U, DFF, p.WT_DOWN, DFF, DFF, MT / 256 - 1, 8, smem, nullptr, 0, bid, nb);
  for (int id = bid; id < 256; id += nb) {
    const int nt = id & 7, kc = id >> 3;
    gemm_tile<EPI_ATOM>(p, p.U + kc * 256, DFF, p.WT_DOWN + kc * 256, DFF, 256, (MT / 256 - 1) * 256, nt * 256, smem, nullptr, 0);
  }
  }
#endif
  grid.sync();
#if PH & (1 << 10)
  { IDS
  for (int r = gw; r < MT; r += ngw) {
    float* x = p.out + O_Y + (size_t)r * 2048;
    f32x4 v[8];
    float ss = 0.f;
#pragma unroll
    for (int i = 0; i < 8; ++i) {
      v[i] = *(const f32x4*)(x + i * 256 + lane * 4);
      ss += v[i][0] * v[i][0] + v[i][1] * v[i][1] + v[i][2] * v[i][2] + v[i][3] * v[i][3];
    }
    ss = wave_sum(ss);
    float rr = rsqrtf(ss * (1.f / 2048.f) + 1e-6f);
#pragma unroll
    for (int i = 0; i < 8; ++i) {
      f32x4 gg = *(const f32x4*)(p.g_fin + i * 256 + lane * 4);
      f32x4 o = {v[i][0] * rr * gg[0], v[i][1] * rr * gg[1], v[i][2] * rr * gg[2], v[i][3] * rr * gg[3]};
      *(f32x4*)(x + i * 256 + lane * 4) = o;
    }
  }
  }
#endif
}

extern "C" void kernel_launch(void* const* d_in, const int* in_sizes, int n_in, void* d_out, int out_size, void* d_ws, size_t ws_size,
                              hipStream_t stream) {
  static int grid_blocks = 0;
  if (!grid_blocks) {
    int dev = 0, cus = 0, per_cu = 0;
    hipGetDevice(&dev);
    hipDeviceGetAttribute(&cus, hipDeviceAttributeMultiprocessorCount, dev);
    if (hipFuncSetAttribute((const void*)fwd_megakernel, hipFuncAttributeMaxDynamicSharedMemorySize, LDS_BYTES) != hipSuccess)
      fprintf(stderr, "kernel_launch: hipFuncSetAttribute failed\n");
    hipOccupancyMaxActiveBlocksPerMultiprocessor(&per_cu, (const void*)fwd_megakernel, NTHREADS, LDS_BYTES);
    if (per_cu < 1) per_cu = 1;
    if (per_cu > 1) per_cu = 1;
    grid_blocks = cus * per_cu;
  }
  Params p{};
  const float* const* in = (const float* const*)d_in;
  p.x_p = in[0]; p.x_s = in[1]; p.c_ak = in[2]; p.c_av = in[3]; p.c_idx = in[4]; p.c_ckv = in[5]; p.c_kr = in[6]; p.rel = in[7];
  p.g_mix = in[8]; p.w_in = in[9]; p.g_q = in[10]; p.w_uq = in[11]; p.g_kv = in[12]; p.w_uk = in[13]; p.w_uv = in[14]; p.w_out = in[15];
  p.g_ffn = in[16]; p.w_up = in[17]; p.w_down = in[18]; p.g_fin = in[19];
  p.out = (float*)d_out;
  char* ws = (char*)d_ws;
  size_t off = 0;
  auto alloc = [&](size_t bytes) { char* r = ws + off; off += (bytes + 255) & ~(size_t)255; return r; };
  p.WT_UQ = (u16*)alloc((size_t)3072 * 512 * 2);
  p.WT_UK = (u16*)alloc((size_t)2048 * 256 * 2);
  p.WT_UV = (u16*)alloc((size_t)2048 * 256 * 2);
  p.WT_OUT = (u16*)alloc((size_t)2048 * 2048 * 2);
  p.WT_UP = (u16*)alloc((size_t)8192 * 2048 * 2);
  p.WT_DOWN = (u16*)alloc((size_t)2048 * 8192 * 2);
  p.CQ = (u16*)alloc((size_t)MT * 512 * 2);
  p.CKV = (u16*)alloc((size_t)KROWS * 256 * 2);
  p.KR = (u16*)alloc((size_t)KROWS * 64 * 2);
  p.GA = (u16*)alloc((size_t)MT * 2048 * 2);
  p.GB = (u16*)alloc((size_t)MT * 2048 * 2);
  p.CS = (float*)alloc((size_t)MT * 32 * 4);
  p.SN = (float*)alloc((size_t)MT * 32 * 4);
  const size_t ubase = off;
  p.WT_IN = (u16*)alloc((size_t)INP * 2048 * 2);
  p.H = (u16*)alloc((size_t)MT * 2048 * 2);
  p.AQ = (u16*)alloc((size_t)MT * 2048 * 2);
  p.KA = (u16*)alloc((size_t)MP * 2048 * 2);
  p.VAT = (u16*)alloc((size_t)MP * 2048 * 2);
  p.IXQ = (u16*)alloc((size_t)MT * 1024 * 2);
  p.IXK = (u16*)alloc((size_t)KROWS * 64 * 2);
  p.SEL = (unsigned long long*)alloc((size_t)MT * 256 * 8);
  p.IXW = (float*)alloc((size_t)MT * 16 * 4);
  const size_t endA = off;
  off = ubase;
  p.QB = (u16*)alloc((size_t)MT * 3072 * 2);
  p.KB = (u16*)alloc((size_t)KROWS * 2048 * 2);
  p.VBT_P = (u16*)alloc((size_t)2048 * MP * 2);
  p.VBT_S = (u16*)alloc((size_t)16 * 2048 * VSS * 2);
  const size_t endB = off;
  off = ubase;
  p.H2 = (u16*)alloc((size_t)MT * 2048 * 2);
  p.U = (u16*)alloc((size_t)MT * DFF * 2);
  const size_t endC = off;
  size_t need = endA > endB ? endA : endB;
  if (endC > need) need = endC;
  if (need > ws_size) { fprintf(stderr, "kernel_launch: workspace too small: need %zu have %zu\n", need, ws_size); return; }
  void* args[] = {&p};
  hipError_t e = hipLaunchCooperativeKernel((const void*)fwd_megakernel, dim3(grid_blocks), dim3(NTHREADS), args, LDS_BYTES, stream);
  if (e != hipSuccess) fprintf(stderr, "cooperative launch failed: %s (grid %d)\n", hipGetErrorString(e), grid_blocks);
}
```

```cpp
#include <hip/hip_runtime.h>
#include <hip/hip_cooperative_groups.h>
#include <cstdio>
#include <cstdint>
namespace cg = cooperative_groups;

typedef unsigned short u16;
typedef __attribute__((ext_vector_type(8))) short bf16x8;
typedef __attribute__((ext_vector_type(4))) short bf16x4;
typedef __attribute__((ext_vector_type(4))) float f32x4;
typedef __attribute__((ext_vector_type(2))) float f32x2;
typedef __attribute__((ext_vector_type(2))) __bf16 bf16x2_t;
typedef __attribute__((ext_vector_type(4))) unsigned u32x4;
typedef __attribute__((ext_vector_type(2))) unsigned u32x2;

#define DI __device__ __forceinline__

constexpr int MP = 16384;
constexpr int MS = 256;
constexpr int MT = MP + MS;
constexpr int DM = 2048;
constexpr int INC = 12176;
constexpr int INP = 12288;
constexpr int SK = 1040;
constexpr int KROWS = MP + 16 * SK;
constexpr int VSS = 1088;
constexpr int DFF = 8192;
constexpr int ZRW = 832;
#ifndef PH
#define PH 0x7ff
#endif
#ifndef REP
#define REP 0
#endif
#define NREP(k) (((REP >> (k)) & 1) + 1)
constexpr int NTHREADS = 512;
constexpr int VB_LDS = 75776;
constexpr int LDS_BYTES = 2 * VB_LDS;

constexpr size_t O_Y = 0;
constexpr size_t O_AKP = 34078720;
constexpr size_t O_AVP = 67633152;
constexpr size_t O_IDXP = 101187584;
constexpr size_t O_CKVP = 102236160;
constexpr size_t O_KRP = 106430464;
constexpr size_t O_AKS = 107479040;
constexpr size_t O_AVS = 108003328;
constexpr size_t O_IDXS = 108527616;
constexpr size_t O_CKVS = 108544000;
constexpr size_t O_KRS = 108609536;

struct Params {
  const float *x_p, *x_s, *c_ak, *c_av, *c_idx, *c_ckv, *c_kr, *rel, *g_mix, *w_in, *g_q, *w_uq, *g_kv, *w_uk, *w_uv, *w_out, *g_ffn, *w_up, *w_down, *g_fin;
  float* out;
  u16 *WT_UQ, *WT_UK, *WT_UV, *WT_OUT, *WT_UP, *WT_DOWN, *CQ, *CKV, *KR, *GA, *GB;
  float *CS, *SN;
  u16 *WT_IN, *H, *AQ, *KA, *VAT, *IXQ, *IXK;
  float* IXW;
  unsigned long long* SEL;
  u16 *QB, *KB, *VBT_P, *VBT_S;
  u16 *H2, *U;
};

DI int otid() { int t = threadIdx.x; asm volatile("" : "+v"(t)); return t; }
DI unsigned cvtpk(float lo, float hi) {
  f32x2 v = {lo, hi};
  bf16x2_t b = __builtin_convertvector(v, bf16x2_t);
  return __builtin_bit_cast(unsigned, b);
}
DI u16 f2bf(float x) { return (u16)(cvtpk(x, 0.f) & 0xffffu); }
DI float bf2f(u16 b) { return __uint_as_float(((unsigned)b) << 16); }
DI float bflo(unsigned w) { return __uint_as_float(w << 16); }
DI float bfhi(unsigned w) { return __uint_as_float(w & 0xffff0000u); }
DI float dot2bf(unsigned a, unsigned b, float c) {
  return __builtin_amdgcn_fdot2_f32_bf16(__builtin_bit_cast(bf16x2_t, a), __builtin_bit_cast(bf16x2_t, b), c, false);
}
DI float wave_sum(float v) {
#pragma unroll
  for (int o = 32; o > 0; o >>= 1) v += __shfl_xor(v, o);
  return v;
}
DI int qpos_of(int t) { return t < MP ? t : 1024 + ((t - MP) & 15); }
DI int krow_of(int t) { return t < MP ? t : MP + ((t - MP) >> 4) * SK + 1024 + ((t - MP) & 15); }
DI float inv_freq(int i) { return exp2f(-(float)i * 0.41524101186092029f); }

DI void transpose_tile(const float* __restrict__ W, int K, int N, u16* __restrict__ Wt, int tile, float* s  ) {
  const int nkt = K >> 6;
  const int kt = tile % nkt, nt = tile / nkt;
  const int k0 = kt << 6, n0 = nt << 6;
  const int tid = otid() & 255;
  const int c = tid & 63, r0 = tid >> 6;
  __syncthreads();
#pragma unroll
  for (int i = 0; i < 16; ++i) {
    int r = i * 4 + r0;
    float v = (n0 + c < N) ? W[(size_t)(k0 + r) * N + n0 + c] : 0.f;
    s[r * 65 + c] = v;
  }
  __syncthreads();
  const int kp = (tid & 31) * 2, rr0 = tid >> 5;
#pragma unroll
  for (int i = 0; i < 8; ++i) {
    int rr = i * 8 + rr0;
    unsigned pk = cvtpk(s[kp * 65 + rr], s[(kp + 1) * 65 + rr]);
    *(unsigned*)(Wt + (size_t)(n0 + rr) * K + k0 + kp) = pk;
  }
}

DI void rms_row_2048(const float* __restrict__ x, const float* __restrict__ g, u16* __restrict__ out, int lane) {
  f32x4 v[8];
  float ss = 0.f;
#pragma unroll
  for (int i = 0; i < 8; ++i) {
    v[i] = *(const f32x4*)(x + i * 256 + lane * 4);
    ss += v[i][0] * v[i][0] + v[i][1] * v[i][1] + v[i][2] * v[i][2] + v[i][3] * v[i][3];
  }
  ss = wave_sum(ss);
  float r = rsqrtf(ss * (1.f / 2048.f) + 1e-6f);
#pragma unroll
  for (int i = 0; i < 8; ++i) {
    f32x4 gg = *(const f32x4*)(g + i * 256 + lane * 4);
    u32x2 o;
    o[0] = cvtpk(v[i][0] * r * gg[0], v[i][1] * r * gg[1]);
    o[1] = cvtpk(v[i][2] * r * gg[2], v[i][3] * r * gg[3]);
    *(u32x2*)(out + i * 256 + lane * 4) = o;
  }
}

enum { EPI_IN = 0, EPI_QB, EPI_BF16, EPI_VT, EPI_RES, EPI_RELU2, EPI_ACC, EPI_ATOM };
constexpr float QSC = 0.07216878364870322f * 1.4426950408889634f;
constexpr int LSTR = 64;
#ifndef PFA
#define PFA 8
#endif

template <int EPI> struct EpiSwap { static constexpr bool v = (EPI != EPI_VT); };

DI u32x2 pack4(f32x4 v) { u32x2 r; r[0] = cvtpk(v[0], v[1]); r[1] = cvtpk(v[2], v[3]); return r; }
DI float relu_i(float x) { return __int_as_float(max(__float_as_int(x), 0)); }
DI float sigm(float v) { return __builtin_amdgcn_rcpf(1.f + __builtin_amdgcn_exp2f(v * -1.4426950408889634f)); }

template <int EPI>
DI void gemm_epilogue(const Params& p, f32x4 (&acc)[8][4], int m0, int n0, int wr, int wc, int fr, int fq, u16* Cb, int ldc) {
  const int cw = n0 + wc * 64;
  if (EPI == EPI_VT) {
#pragma clang loop unroll(full)
    for (int m = 0; m < 8; ++m) {
      const int rb = m0 + wr * 128 + m * 16 + fq * 4;
#pragma clang loop unroll(full)
      for (int n = 0; n < 4; ++n) {
        const int col = cw + n * 16 + fr;
        u16* dst;
        if (rb < MP) dst = p.VBT_P + (size_t)col * MP + rb;
        else { int r2 = rb - MP; int b = r2 / SK; int s = r2 - b * SK; dst = p.VBT_S + ((size_t)b * 2048 + col) * VSS + s; }
        *(u32x2*)dst = pack4(acc[m][n]);
      }
    }
    return;
  }
  const int rbase = m0 + wr * 128 + fr;
  const int c4 = fq * 4;
  if (EPI == EPI_QB) {
    if (cw % 192 == 128) {
#pragma clang loop unroll(full)
      for (int m = 0; m < 8; ++m) {
        const int row = rbase + m * 16;
#pragma clang loop unroll(full)
        for (int n = 0; n < 2; ++n) {
          const int i0 = n * 16 + c4;
          const f32x4 cs = *(const f32x4*)(p.CS + (size_t)row * 32 + i0), sn = *(const f32x4*)(p.SN + (size_t)row * 32 + i0);
          const f32x4 x1 = acc[m][n] * QSC, x2 = acc[m][n + 2] * QSC;
          *(u32x2*)(p.QB + (size_t)row * 3072 + cw + i0) = pack4(x1 * cs - x2 * sn);
          *(u32x2*)(p.QB + (size_t)row * 3072 + cw + i0 + 32) = pack4(x1 * sn + x2 * cs);
        }
      }
      return;
    }
  }
#pragma clang loop unroll(full)
  for (int n = 0; n < 4; ++n) {
    const int colt = cw + n * 16;
    const int col = colt + c4;
    if (EPI == EPI_IN) {
      const bool smp = m0 >= MP;
      if (colt < 2048) {
#pragma clang loop unroll(full)
        for (int m = 0; m < 8; ++m) *(u32x2*)(p.AQ + (size_t)(rbase + m * 16) * 2048 + col) = pack4(acc[m][n] * (0.08838834764831845f * 1.4426950408889634f));
      } else if (colt < 4096) {
        const int c = col - 2048;
#pragma clang loop unroll(full)
        for (int m = 0; m < 8; ++m) {
          const int row = rbase + m * 16;
          if (!smp) { *(f32x4*)(p.out + O_AKP + (size_t)row * 2048 + c) = acc[m][n]; *(u32x2*)(p.KA + (size_t)row * 2048 + c) = pack4(acc[m][n]); }
          else *(f32x4*)(p.out + O_AKS + (size_t)(row - MP) * 2048 + c) = acc[m][n];
        }
      } else if (colt < 6144) {
        const int c = col - 4096;
#pragma clang loop unroll(full)
        for (int m = 0; m < 8; ++m) {
          const int row = rbase + m * 16;
          if (!smp) {
            *(f32x4*)(p.out + O_AVP + (size_t)row * 2048 + c) = acc[m][n];
#pragma clang loop unroll(full)
            for (int j = 0; j < 4; ++j) p.VAT[(size_t)(c + j) * MP + row] = f2bf(acc[m][n][j]);
          } else *(f32x4*)(p.out + O_AVS + (size_t)(row - MP) * 2048 + c) = acc[m][n];
        }
      } else if (colt < 7168) {
#pragma clang loop unroll(full)
        for (int m = 0; m < 8; ++m) *(u32x2*)(p.IXQ + (size_t)(rbase + m * 16) * 1024 + (col - 6144)) = pack4(acc[m][n]);
      } else if (colt < 7232) {
        const int c = col - 7168;
#pragma clang loop unroll(full)
        for (int m = 0; m < 8; ++m) {
          const int row = rbase + m * 16;
          if (!smp) *(f32x4*)(p.out + O_IDXP + (size_t)row * 64 + c) = acc[m][n];
          else *(f32x4*)(p.out + O_IDXS + (size_t)(row - MP) * 64 + c) = acc[m][n];
          *(u32x2*)(p.IXK + (size_t)krow_of(row) * 64 + c) = pack4(acc[m][n]);
        }
      } else if (colt < 7248) {
#pragma clang loop unroll(full)
        for (int m = 0; m < 8; ++m) *(f32x4*)(p.IXW + (size_t)(rbase + m * 16) * 16 + (col - 7232)) = acc[m][n] * 0.25f;
      } else if (colt < 8080) {
#pragma clang loop unroll(full)
        for (int m = 0; m < 8; ++m) *(f32x4*)(p.out + O_Y + (size_t)(rbase + m * 16) * ZRW + (col - 7248)) = acc[m][n];
      } else if (colt < INC) {
        u16* G = colt < 10128 ? p.GA : p.GB;
        const int c = colt < 10128 ? col - 8080 : col - 10128;
#pragma clang loop unroll(full)
        for (int m = 0; m < 8; ++m) {
          f32x4 v = acc[m][n];
          f32x4 g = {sigm(v[0]), sigm(v[1]), sigm(v[2]), sigm(v[3])};
          *(u32x2*)(G + (size_t)(rbase + m * 16) * 2048 + c) = pack4(g);
        }
      }
    } else {
#pragma clang loop unroll(full)
      for (int m = 0; m < 8; ++m) {
        const int row = rbase + m * 16;
        const f32x4 v = acc[m][n];
        if (EPI == EPI_QB) {
          *(u32x2*)(Cb + (size_t)row * ldc + col) = pack4(v * QSC);
        } else if (EPI == EPI_BF16) {
          *(u32x2*)(Cb + (size_t)row * ldc + col) = pack4(v);
        } else if (EPI == EPI_RES) {
          const f32x4 xv = row < MP ? *(const f32x4*)(p.x_p + (size_t)row * 2048 + col) : *(const f32x4*)(p.x_s + (size_t)(row - MP) * 2048 + col);
          *(f32x4*)(p.out + O_Y + (size_t)row * 2048 + col) = xv + v;
          if ((m & 3) == 3) __builtin_amdgcn_sched_barrier(0);
        } else if (EPI == EPI_RELU2) {
          f32x4 r = {relu_i(v[0]), relu_i(v[1]), relu_i(v[2]), relu_i(v[3])};
          *(u32x2*)(p.U + (size_t)row * DFF + col) = pack4(r * r);
        } else if (EPI == EPI_ACC) {
          float* d = p.out + O_Y + (size_t)row * 2048 + col;
          *(f32x4*)d = *(const f32x4*)d + v;
          if ((m & 3) == 3) __builtin_amdgcn_sched_barrier(0);
        } else if (EPI == EPI_ATOM) {
#pragma clang loop unroll(full)
          for (int j = 0; j < 4; ++j) atomicAdd(p.out + O_Y + (size_t)row * 2048 + col + j, v[j]);
        }
      }
    }
  }
}

constexpr int GSTAGE = 512 * LSTR;
template <int EPI>
DI void gemm_tile(const Params& p, const u16* __restrict__ A, int lda, const u16* __restrict__ Bt, int ldb, int K, int m0, int n0,
                  char* smem, u16* Cb, int ldc) {
  u16* sbase = (u16*)smem;
  const int tid = otid(), lane = tid & 63, w = tid >> 6;
  const int wr = w >> 2, wc = w & 3, fr = lane & 15, fq = lane >> 4;
  f32x4 acc[8][4];
#pragma unroll
  for (int m = 0; m < 8; ++m)
#pragma unroll
    for (int n = 0; n < 4; ++n) acc[m][n] = (f32x4){0.f, 0.f, 0.f, 0.f};
  const int lr = tid >> 3, lk = (tid & 7) * 8;
  const int lkw = ((tid & 7) ^ ((lr >> 1) & 7)) * 8;
  const int fsw = (fr >> 1) & 7, fo0 = (fq ^ fsw) * 8, fo1 = ((4 + fq) ^ fsw) * 8;
  const u16* Ag = A + (size_t)(m0 + lr) * lda + lk;
  const u16* Bg = Bt + (size_t)(n0 + lr) * ldb + lk;
  const int nk = K >> 6;
  u32x4 ra[4], rb[4];
#define G_LOAD(T) { const int k_ = (T) << 6; _Pragma("unroll") for (int i = 0; i < 4; ++i) { \
    ra[i] = *(const u32x4*)(Ag + (size_t)(i * 64) * lda + k_); rb[i] = *(const u32x4*)(Bg + (size_t)(i * 64) * ldb + k_); } }
#define L_STORE(ST) { u16* dA_ = sbase + (ST) * GSTAGE + lr * LSTR + lkw; u16* dB_ = dA_ + 256 * LSTR; _Pragma("unroll") for (int i = 0; i < 4; ++i) { \
    *(u32x4*)(dA_ + i * 64 * LSTR) = ra[i]; *(u32x4*)(dB_ + i * 64 * LSTR) = rb[i]; } }
  G_LOAD(0)
  L_STORE(0)
  G_LOAD(1)
#pragma unroll 1
  for (int kt = 0; kt < nk; ++kt) {
    __syncthreads();
    if (kt + 1 < nk) L_STORE((kt + 1) & 1)
    G_LOAD(min(kt + 2, nk - 1))
    const u16* cA = sbase + (kt & 1) * GSTAGE + (wr * 128 + fr) * LSTR;
    const u16* cB = sbase + (kt & 1) * GSTAGE + 256 * LSTR + (wc * 64 + fr) * LSTR;
#pragma unroll
    for (int ks = 0; ks < 2; ++ks) {
      bf16x8 bfr[4];
#pragma unroll
      for (int n = 0; n < 4; ++n) bfr[n] = *(const bf16x8*)(cB + n * 16 * LSTR + (ks ? fo1 : fo0));
#pragma unroll
      for (int mh = 0; mh < 2; ++mh) {
        bf16x8 af[4];
#pragma unroll
        for (int m = 0; m < 4; ++m) af[m] = *(const bf16x8*)(cA + (mh * 4 + m) * 16 * LSTR + (ks ? fo1 : fo0));
        __builtin_amdgcn_s_setprio(1);
#pragma unroll
        for (int m = 0; m < 4; ++m)
#pragma unroll
          for (int n = 0; n < 4; ++n)
            acc[mh * 4 + m][n] = EpiSwap<EPI>::v ? __builtin_amdgcn_mfma_f32_16x16x32_bf16(bfr[n], af[m], acc[mh * 4 + m][n], 0, 0, 0)
                                                 : __builtin_amdgcn_mfma_f32_16x16x32_bf16(af[m], bfr[n], acc[mh * 4 + m][n], 0, 0, 0);
        __builtin_amdgcn_s_setprio(0);
      }
    }
  }
#undef G_LOAD
#undef L_STORE
  gemm_epilogue<EPI>(p, acc, m0, n0, wr, wc, fr, fq, Cb, ldc);
}

template <int EPI>
DI void gemm_phase(const Params& p, const u16* A, int lda, const u16* Bt, int ldb, int K, int mtiles, int ntiles, char* smem, u16* Cb, int ldc,
                   int start, int stride) {
  if (stride == 256) {
    const int gm = (mtiles + 3) >> 2, gn = (ntiles + 7) >> 3, nsg = gm * gn;
    const int xcd = start & 7, li = start >> 3;
    for (int sg = xcd; sg < nsg; sg += 8) {
      const int gni = sg / gm, gmi = sg - gni * gm;
      const int mt = gmi * 4 + (li & 3), nt = gni * 8 + (li >> 2);
      if (mt < mtiles && nt < ntiles) gemm_tile<EPI>(p, A, lda, Bt, ldb, K, mt * 256, nt * 256, smem, Cb, ldc);
    }
    return;
  }
  const int total = mtiles * ntiles;
  const int GM = 8;
  for (int id = start; id < total; id += stride) {
    const int per = GM * ntiles;
    const int g = id / per, rem = id - g * per;
    const int fm = g * GM;
    const int gsz = min(GM, mtiles - fm);
    const int mt = fm + rem % gsz, nt = rem / gsz;
    gemm_tile<EPI>(p, A, lda, Bt, ldb, K, mt * 256, nt * 256, smem, Cb, ldc);
  }
}

DI void post_row(const Params& p, int t, int lane) {
  const float* zr = p.out + O_Y + (size_t)t * ZRW;
  {
    f32x4 a = *(const f32x4*)(zr + lane * 4), b = *(const f32x4*)(zr + 256 + lane * 4);
    float ss = a[0] * a[0] + a[1] * a[1] + a[2] * a[2] + a[3] * a[3] + b[0] * b[0] + b[1] * b[1] + b[2] * b[2] + b[3] * b[3];
    ss = wave_sum(ss);
    float r = rsqrtf(ss * (1.f / 512.f) + 1e-6f);
    f32x4 ga = *(const f32x4*)(p.g_q + lane * 4), gb = *(const f32x4*)(p.g_q + 256 + lane * 4);
    u32x2 o;
    o[0] = cvtpk(a[0] * r * ga[0], a[1] * r * ga[1]); o[1] = cvtpk(a[2] * r * ga[2], a[3] * r * ga[3]);
    *(u32x2*)(p.CQ + (size_t)t * 512 + lane * 4) = o;
    o[0] = cvtpk(b[0] * r * gb[0], b[1] * r * gb[1]); o[1] = cvtpk(b[2] * r * gb[2], b[3] * r * gb[3]);
    *(u32x2*)(p.CQ + (size_t)t * 512 + 256 + lane * 4) = o;
  }
  const int kr_row = krow_of(t);
  {
    f32x4 a = *(const f32x4*)(zr + 512 + lane * 4);
    float ss = a[0] * a[0] + a[1] * a[1] + a[2] * a[2] + a[3] * a[3];
    ss = wave_sum(ss);
    float r = rsqrtf(ss * (1.f / 256.f) + 1e-6f);
    f32x4 g = *(const f32x4*)(p.g_kv + lane * 4);
    f32x4 o = {a[0] * r * g[0], a[1] * r * g[1], a[2] * r * g[2], a[3] * r * g[3]};
    float* od = t < MP ? p.out + O_CKVP + (size_t)t * 256 : p.out + O_CKVS + (size_t)(t - MP) * 256;
    *(f32x4*)(od + lane * 4) = o;
    u32x2 ob; ob[0] = cvtpk(o[0], o[1]); ob[1] = cvtpk(o[2], o[3]);
    *(u32x2*)(p.CKV + (size_t)kr_row * 256 + lane * 4) = ob;
  }
  if (lane < 32) {
    float x1 = zr[768 + lane], x2 = zr[768 + 32 + lane];
    float ang = (float)qpos_of(t) * inv_freq(lane);
    float cs = cosf(ang), sn = sinf(ang);
    p.CS[(size_t)t * 32 + lane] = cs; p.SN[(size_t)t * 32 + lane] = sn;
    float o1 = x1 * cs - x2 * sn, o2 = x1 * sn + x2 * cs;
    float* od = t < MP ? p.out + O_KRP + (size_t)t * 64 : p.out + O_KRS + (size_t)(t - MP) * 64;
    od[lane] = o1; od[lane + 32] = o2;
    p.KR[(size_t)kr_row * 64 + lane] = f2bf(o1);
    p.KR[(size_t)kr_row * 64 + lane + 32] = f2bf(o2);
  }
}

template <int CTRL> DI float dpp_add(float v) {
  int sft = __builtin_amdgcn_update_dpp(0, __float_as_int(v), CTRL, 0xf, 0xf, true);
  return v + __int_as_float(sft);
}
DI float row16_sum(float v) { v = dpp_add<0x111>(v); v = dpp_add<0x112>(v); v = dpp_add<0x114>(v); v = dpp_add<0x118>(v); return v; }
DI unsigned fkey(float f) { unsigned u = __float_as_uint(f); return (u & 0x80000000u) ? ~u : (u | 0x80000000u); }

DI void radix_select(unsigned* sc, int* hist, int* misc, int n, unsigned long long* sel, int tid, int lane, int w) {
  __syncthreads();
  unsigned prefix = 0;
  int remaining = 256, neq = 0;
  bool done = false;
#pragma unroll 1
  for (int pass = 0; pass < 3; ++pass) {
    const int shift = pass == 0 ? 21 : (pass == 1 ? 10 : 0);
    const int bits = pass == 2 ? 10 : 11;
    const unsigned bmask = (1u << bits) - 1u;
    if (done) {
      __syncthreads(); __syncthreads(); __syncthreads(); __syncthreads(); __syncthreads();
      continue;
    }
    if (pass > 0) {
      *(int4*)&hist[tid * 8] = make_int4(0, 0, 0, 0);
      *(int4*)&hist[tid * 8 + 4] = make_int4(0, 0, 0, 0);
      __syncthreads();
      const int hs = shift + bits;
      const unsigned want = prefix >> hs;
      for (int i = tid * 4; i < n; i += 256 * 4) {
        const u32x4 u4 = *(const u32x4*)(sc + i);
#pragma unroll
        for (int e = 0; e < 4; ++e)
          if ((u4[e] >> hs) == want) atomicAdd(&hist[(u4[e] >> shift) & bmask], 1);
      }
      __syncthreads();
    }
    const int4 h0 = *(const int4*)&hist[tid * 8], h1 = *(const int4*)&hist[tid * 8 + 4];
    const int s8 = h0.x + h0.y + h0.z + h0.w + h1.x + h1.y + h1.z + h1.w;
    int suf = s8;
#pragma unroll
    for (int d = 1; d < 64; d <<= 1) { int v = __shfl_down(suf, d); if (lane + d < 64) suf += v; }
    if (lane == 0) misc[w] = suf;
    __syncthreads();
    int above = 0;
    for (int ww = w + 1; ww < 4; ++ww) above += misc[ww];
    const int excl = above + suf - s8;
    if (excl < remaining && remaining <= excl + s8) {
      int c = excl, bin = 0, nrem = 0, bpop = 0;
#define TK_STEP(val, idx) if (c < remaining && remaining <= c + (val)) { bin = tid * 8 + (idx); nrem = remaining - c; bpop = (val); } c += (val);
      TK_STEP(h1.w, 7) TK_STEP(h1.z, 6) TK_STEP(h1.y, 5) TK_STEP(h1.x, 4) TK_STEP(h0.w, 3) TK_STEP(h0.z, 2) TK_STEP(h0.y, 1) TK_STEP(h0.x, 0)
#undef TK_STEP
      misc[4] = bin; misc[5] = nrem; misc[6] = bpop;
    }
    __syncthreads();
    prefix |= ((unsigned)misc[4]) << shift;
    remaining = misc[5];
    neq = misc[6];
    done = (neq == remaining);
    __syncthreads();
  }
  const unsigned T = prefix;
  const int seg = ((n + 255) >> 8) << 6;
  const int beg = w * seg;
  if (neq == remaining) {
    for (int i0 = beg; i0 < beg + seg; i0 += 64) {
      const int i = i0 + lane;
      const bool in = i < n; const unsigned u = in ? sc[i] : 0u;
      const unsigned long long sm = __ballot(in && u >= T);
      if (lane == 0 && i0 < n) sel[i0 >> 6] = sm;
    }
    __syncthreads();
    return;
  }
  int ceq = 0;
  for (int i = beg + lane; i < beg + seg; i += 64) {
    bool in = i < n; unsigned u = in ? sc[i] : 0u;
    ceq += __popcll(__ballot(in && u == T));
  }
  if (lane == 0) misc[12 + w] = ceq;
  __syncthreads();
  int oe = 0;
  for (int ww = 0; ww < w; ++ww) oe += misc[12 + ww];
  const unsigned long long lt = (1ull << lane) - 1ull;
  for (int i0 = beg; i0 < beg + seg; i0 += 64) {
    const int i = i0 + lane;
    bool in = i < n; unsigned u = in ? sc[i] : 0u;
    bool g = in && u > T, e = in && u == T;
    unsigned long long be = __ballot(e);
    int pe = oe + __popcll(be & lt);
    unsigned long long sm = __ballot(g || (e && pe < remaining));
    if (lane == 0 && i0 < n) sel[i0 >> 6] = sm;
    oe += __popcll(be);
  }
}

constexpr int NQ = 4;
DI void topk_group(const Params& p, int t, char* smem, unsigned* scr1, unsigned* scr2, unsigned* scr3) {
  unsigned* sc = (unsigned*)smem;
  int* hist = (int*)(smem + 65536);
  int* misc = hist + 2048;
  const int tid = otid() & 255, lane = tid & 63, w = tid >> 6, fr = lane & 15, fq = lane >> 4;
  int n; const u16* ixk;
  if (t < MP) { n = 64 * ((t >> 6) + 1); ixk = p.IXK; }
  else { int b = (t - MP) >> 4; n = SK; ixk = p.IXK + (size_t)(MP + b * SK) * 64; }
  unsigned long long* sel = p.SEL + (size_t)t * 256;
  __syncthreads();
  if (n <= 256) {
    if (tid < 4) {
      unsigned long long v = (tid < (n >> 6)) ? ~0ull : 0ull;
#pragma unroll
      for (int qi = 0; qi < NQ; ++qi) sel[qi * 256 + tid] = v;
    }
    return;
  }
  *(int4*)&hist[tid * 8] = make_int4(0, 0, 0, 0);
  *(int4*)&hist[tid * 8 + 4] = make_int4(0, 0, 0, 0);
  __syncthreads();
  {
    const u16* q = p.IXQ + (size_t)t * 1024 + fr * 64 + fq * 8;
    bf16x8 a0[NQ], a1[NQ];
    f32x4 wv[NQ];
#pragma unroll
    for (int qi = 0; qi < NQ; ++qi) {
      a0[qi] = *(const bf16x8*)(q + qi * 1024); a1[qi] = *(const bf16x8*)(q + qi * 1024 + 32);
      wv[qi] = *(const f32x4*)(p.IXW + (size_t)(t + qi) * 16 + fq * 4);
    }
    const int ntile = n >> 4;
    for (int kt0 = w; kt0 < ntile; kt0 += 32) {
      bf16x8 b0[8], b1[8];
#pragma unroll
      for (int g = 0; g < 8; ++g) {
        const int kt = min(kt0 + g * 4, ntile - 1);
        const u16* kp = ixk + (size_t)(kt * 16 + fr) * 64 + fq * 8;
        b0[g] = *(const bf16x8*)kp; b1[g] = *(const bf16x8*)(kp + 32);
      }
      float pt[NQ][8];
#pragma unroll
      for (int g = 0; g < 8; ++g) {
#pragma unroll
        for (int qi = 0; qi < NQ; ++qi) {
          f32x4 c = {0.f, 0.f, 0.f, 0.f};
          c = __builtin_amdgcn_mfma_f32_16x16x32_bf16(a0[qi], b0[g], c, 0, 0, 0);
          c = __builtin_amdgcn_mfma_f32_16x16x32_bf16(a1[qi], b1[g], c, 0, 0, 0);
          pt[qi][g] = relu_i(c[0]) * wv[qi][0] + relu_i(c[1]) * wv[qi][1] + relu_i(c[2]) * wv[qi][2] + relu_i(c[3]) * wv[qi][3];
        }
      }
#pragma unroll
      for (int g = 0; g < 8; g += 2) {
        const int kt = kt0 + (g + (lane >> 5)) * 4;
        const bool st = (lane & 16) == 0 && kt < ntile;
#pragma unroll
        for (int qi = 0; qi < NQ; ++qi) {
          auto r32 = __builtin_amdgcn_permlane32_swap(__float_as_uint(pt[qi][g]), __float_as_uint(pt[qi][g + 1]), false, false);
          float s2 = __uint_as_float(r32[0]) + __uint_as_float(r32[1]);
          auto r16 = __builtin_amdgcn_permlane16_swap(__float_as_uint(s2), __float_as_uint(s2), false, false);
          float sv = __uint_as_float(r16[0]) + __uint_as_float(r16[1]);
          if (st) {
            unsigned u = fkey(sv);
            if (qi == 0) { sc[kt * 16 + fr] = u; atomicAdd(&hist[u >> 21], 1); }
            else if (qi == 1) scr1[kt * 16 + fr] = u;
            else if (qi == 2) scr2[kt * 16 + fr] = u;
            else scr3[kt * 16 + fr] = u;
          }
        }
      }
    }
  }
  radix_select(sc, hist, misc, n, sel, tid, lane, w);
#pragma unroll 1
  for (int qi = 1; qi < NQ; ++qi) {
    const unsigned* scr = qi == 1 ? scr1 : (qi == 2 ? scr2 : scr3);
    __syncthreads();
    *(int4*)&hist[tid * 8] = make_int4(0, 0, 0, 0);
    *(int4*)&hist[tid * 8 + 4] = make_int4(0, 0, 0, 0);
    __syncthreads();
    for (int i = tid * 4; i < n; i += 256 * 4) {
      const u32x4 u4 = *(const u32x4*)(scr + i);
      *(u32x4*)(sc + i) = u4;
#pragma unroll
      for (int e = 0; e < 4; ++e) atomicAdd(&hist[u4[e] >> 21], 1);
    }
    radix_select(sc, hist, misc, n, sel + qi * 256, tid, lane, w);
  }
}

constexpr int KSTR = 192;
constexpr int VSTR = 72;
DI float xq_max(float x) {
  auto a = __builtin_amdgcn_permlane16_swap(__float_as_uint(x), __float_as_uint(x), false, false);
  x = fmaxf(__uint_as_float(a[0]), __uint_as_float(a[1]));
  auto b = __builtin_amdgcn_permlane32_swap(__float_as_uint(x), __float_as_uint(x), false, false);
  return fmaxf(__uint_as_float(b[0]), __uint_as_float(b[1]));
}
DI float xq_sum(float x) {
  auto a = __builtin_amdgcn_permlane16_swap(__float_as_uint(x), __float_as_uint(x), false, false);
  x = __uint_as_float(a[0]) + __uint_as_float(a[1]);
  auto b = __builtin_amdgcn_permlane32_swap(__float_as_uint(x), __float_as_uint(x), false, false);
  return __uint_as_float(b[0]) + __uint_as_float(b[1]);
}

template <int MODE>
DI void attn_item(const Params& p, int item, char* smem, u16* gdst) {
  constexpr int NKS = MODE == 0 ? 6 : 4;
  constexpr int ASTAGE = 64 * KSTR + 128 * VSTR;
  u16* sbase = (u16*)smem;
  float* sBias = (float*)(sbase + 2 * ASTAGE);
  const int tid = otid(), lane = tid & 63, w = tid >> 6, fr = lane & 15, fq = lane >> 4;
  const int ksw = (fr >> 1) & 7, ko0 = (fq ^ ksw) * 8, ko1 = ((4 + fq) ^ ksw) * 8;
  int h, q0, nq, krow0, nkeys, ntiles, myt, b = 0, qpos0;
  const u16* vt; size_t vstride;
  const bool sample = item >= 1024;
  if (!sample) {
    const int i = 63 - (item >> 4);
    h = item & 15; q0 = i * 256; nq = 256; krow0 = 0; nkeys = q0 + 256; ntiles = 4 * i + 4; qpos0 = q0;
    vt = (MODE == 0 ? p.VBT_P : p.VAT) + (size_t)h * 128 * MP; vstride = MP;
    myt = ntiles - 3 + (w >> 1);
  } else {
    const int j = item - 1024; b = j >> 4;
    h = j & 15; q0 = MP + b * 16; nq = 16; krow0 = MP + b * SK; nkeys = SK; ntiles = 17; qpos0 = 1024;
    vt = p.VBT_S + ((size_t)b * 2048 + h * 128) * VSS; vstride = VSS;
    myt = ntiles;
  }
  const int wq0 = w * 32;
  const bool active = wq0 < nq;
  __syncthreads();
  if (MODE == 1) {
    for (int i = tid; i < 257; i += NTHREADS) {
      int rel = i - 128;
      int ret = rel > 0 ? 16 : 0;
      int n = rel < 0 ? -rel : rel;
      float lf = logf((float)max(n, 1) / 8.0f) / 2.772588722239781f * 8.0f;
      int large = min(8 + (int)lf, 15);
      int bk = ret + (n < 8 ? n : large);
      sBias[i] = (p.rel[bk * 16 + h] - p.rel[15 * 16 + h]) * 1.4426950408889634f;
    }
  }
  bf16x8 qf[2][NKS];
  int qrow[2];
#pragma unroll
  for (int qt = 0; qt < 2; ++qt) {
    const int qr = min(wq0 + qt * 16 + fr, nq - 1);
    qrow[qt] = qr;
    const u16* qp = (MODE == 0) ? p.QB + (size_t)(q0 + qr) * 3072 + h * 192 + fq * 8 : p.AQ + (size_t)(q0 + qr) * 2048 + h * 128 + fq * 8;
#pragma unroll
    for (int ks = 0; ks < NKS; ++ks) qf[qt][ks] = *(const bf16x8*)(qp + ks * 32);
  }
  f32x4 o[2][8];
#pragma unroll
  for (int qt = 0; qt < 2; ++qt)
#pragma unroll
    for (int dt = 0; dt < 8; ++dt) o[qt][dt] = (f32x4){0.f, 0.f, 0.f, 0.f};
  float mrow[2] = {-1e30f, -1e30f}, lrow[2] = {0.f, 0.f};
  const float SC = (MODE == 0 ? 0.07216878364870322f : 0.08838834764831845f) * 1.4426950408889634f;

  unsigned long long mqn[2] = {0ull, 0ull};
  if (MODE == 1) {
#pragma unroll
    for (int qt = 0; qt < 2; ++qt) mqn[qt] = p.SEL[(size_t)(q0 + qrow[qt]) * 256];
  }
  constexpr int NKL = MODE == 0 ? 3 : 2;
  const bool direct = (MODE == 1) && sample;
  u32x4 rk[NKL], rv[2];
#define KV_LOAD(JT) { const size_t kr0_ = (size_t)(krow0 + (JT) * 64); const u16* kb_ = (MODE == 0 ? p.KB : p.KA) + (kr0_ + (tid >> 4)) * 2048 + h * 128 + (tid & 15) * 8; \
    _Pragma("unroll") for (int i = 0; i < 2; ++i) rk[i] = *(const u32x4*)(kb_ + (size_t)i * 32 * 2048); \
    if (MODE == 0) rk[NKL - 1] = *(const u32x4*)(p.KR + (kr0_ + (tid >> 3)) * 64 + (tid & 7) * 8); \
    const u16* vp_ = vt + (size_t)(tid >> 3) * vstride + (JT) * 64 + (tid & 7) * 8; \
    _Pragma("unroll") for (int i = 0; i < 2; ++i) rv[i] = *(const u32x4*)(vp_ + (size_t)i * 64 * vstride); }
#define KV_STORE(ST) { u16* sk_ = sbase + (ST) * ASTAGE; u16* dk_ = sk_ + (tid >> 4) * KSTR + ((tid & 15) ^ ((tid >> 5) & 7)) * 8; \
    _Pragma("unroll") for (int i = 0; i < 2; ++i) *(u32x4*)(dk_ + i * 32 * KSTR) = rk[i]; \
    if (MODE == 0) *(u32x4*)(sk_ + (tid >> 3) * KSTR + 128 + ((tid & 7) ^ ((tid >> 4) & 7)) * 8) = rk[NKL - 1]; \
    u16* dv_ = sk_ + 64 * KSTR + (tid >> 3) * VSTR + (tid & 7) * 8; \
    _Pragma("unroll") for (int i = 0; i < 2; ++i) *(u32x4*)(dv_ + i * 64 * VSTR) = rv[i]; }
  if (!direct) {
    KV_LOAD(0)
    KV_STORE(0)
    KV_LOAD(min(1, ntiles - 1))
  }
  for (int jt = 0; jt < ntiles; ++jt) {
    const int key0 = jt * 64;
    u16* sK = sbase + (jt & 1) * ASTAGE;
    u16* sV = sK + 64 * KSTR;
    unsigned long long mq[2] = {mqn[0], mqn[1]};
    if (MODE == 1) {
      const int jn = min(jt + 1, ntiles - 1);
#pragma unroll
      for (int qt = 0; qt < 2; ++qt) mqn[qt] = p.SEL[(size_t)(q0 + qrow[qt]) * 256 + jn];
    }
    __syncthreads();
    if (!direct) {
      if (jt + 1 < ntiles) KV_STORE((jt + 1) & 1)
      KV_LOAD(min(jt + 2, ntiles - 1))
    } else {
#pragma unroll 2
      for (int i = 0; i < 4; ++i) {
        const int c = tid + i * NTHREADS;
        const int key = c >> 5, part = c & 31;
        const int s = key0 + key;
        const int sc_ = min(s, SK - 1);
        const size_t o1 = sc_ < 1024 ? ((size_t)b * 1024 + sc_) * 2048 : ((size_t)b * 16 + (sc_ - 1024)) * 2048;
        const float* kp = (sc_ < 1024 ? p.c_ak : p.out + O_AKS) + o1 + h * 128 + part * 4;
        const float* vp = (sc_ < 1024 ? p.c_av : p.out + O_AVS) + o1 + h * 128 + part * 4;
        f32x4 kv = *(const f32x4*)kp, vv = *(const f32x4*)vp;
        u32x2 kk; kk[0] = cvtpk(kv[0], kv[1]); kk[1] = cvtpk(kv[2], kv[3]);
        *(u32x2*)(sK + key * KSTR + (((part >> 1) ^ ((key >> 1) & 7)) * 8) + (part & 1) * 4) = kk;
        const bool ok = s < SK;
#pragma unroll
        for (int e = 0; e < 4; ++e) sV[(part * 4 + e) * VSTR + key] = ok ? f2bf(vv[e]) : (u16)0;
      }
      __syncthreads();
    }
    if (active && jt < myt) {
      f32x4 s[2][4];
#pragma unroll
      for (int qt = 0; qt < 2; ++qt) {
        const float nb_ = (jt == 0) ? 0.f : -mrow[qt];
#pragma unroll
        for (int kt = 0; kt < 4; ++kt) s[qt][kt] = (f32x4){nb_, nb_, nb_, nb_};
      }
      __builtin_amdgcn_s_setprio(1);
#pragma unroll
      for (int kt = 0; kt < 4; ++kt) {
#pragma unroll
        for (int ks = 0; ks < NKS; ++ks) {
          bf16x8 kf = *(const bf16x8*)(sK + (kt * 16 + fr) * KSTR + (ks >> 1) * 64 + ((ks & 1) ? ko1 : ko0));
          s[0][kt] = __builtin_amdgcn_mfma_f32_16x16x32_bf16(kf, qf[0][ks], s[0][kt], 0, 0, 0);
          s[1][kt] = __builtin_amdgcn_mfma_f32_16x16x32_bf16(kf, qf[1][ks], s[1][kt], 0, 0, 0);
        }
      }
      __builtin_amdgcn_s_setprio(0);
      unsigned mlo[2] = {0u, 0u}, mhi[2] = {0u, 0u};
      if (MODE == 0) {
        if (key0 + 64 > nkeys) {
#pragma unroll
          for (int kt = 0; kt < 4; ++kt)
#pragma unroll
            for (int j = 0; j < 4; ++j)
              if (key0 + kt * 16 + fq * 4 + j >= nkeys) { s[0][kt][j] = -1e30f; s[1][kt][j] = -1e30f; }
        }
      } else {
        const bool far = (key0 + 63) - (qpos0 + wq0) <= -128;
        if (!far) {
#pragma unroll
          for (int qt = 0; qt < 2; ++qt) {
            const int rb = key0 + fq * 4 - (qpos0 + qrow[qt]) + 128;
#pragma unroll
            for (int kt = 0; kt < 4; ++kt)
#pragma unroll
              for (int j = 0; j < 4; ++j) {
                int r = min(max(rb + kt * 16 + j, 0), 256);
                s[qt][kt][j] += sBias[r];
              }
          }
        }
#pragma unroll
        for (int qt = 0; qt < 2; ++qt) {
          const unsigned long long mm = mq[qt] >> (fq * 4);
          mlo[qt] = (unsigned)mm; mhi[qt] = (unsigned)(mm >> 32);
        }
      }
      bf16x8 pf[2][2];
#pragma unroll
      for (int qt = 0; qt < 2; ++qt) {
        float mx = -1e30f;
#pragma unroll
        for (int kt = 0; kt < 4; ++kt)
#pragma unroll
          for (int j = 0; j < 4; ++j) mx = fmaxf(mx, s[qt][kt][j]);
        mx = xq_max(mx);
        const float delta = (jt == 0) ? mx : fmaxf(mx, 0.f);
        mrow[qt] = (jt == 0) ? delta : mrow[qt] + delta;
        const bool grow = __ballot(delta != 0.f) != 0ull;
        float alpha = 1.f;
        if (grow) {
          alpha = __builtin_amdgcn_exp2f(-delta);
#pragma unroll
          for (int kt = 0; kt < 4; ++kt) s[qt][kt] -= delta;
        }
        float rs = 0.f;
#pragma unroll
        for (int kt = 0; kt < 4; ++kt)
#pragma unroll
          for (int j = 0; j < 4; ++j) {
            float pv = __builtin_amdgcn_exp2f(s[qt][kt][j]);
            if (MODE == 1) {
              int keep;
              asm("v_bfe_i32 %0, %1, %2, 1" : "=v"(keep) : "v"(kt < 2 ? mlo[qt] : mhi[qt]), "n"((kt & 1) * 16 + j));
              pv = __int_as_float(__float_as_int(pv) & keep);
            }
            s[qt][kt][j] = pv; rs += pv;
          }
        rs = xq_sum(rs);
        lrow[qt] = lrow[qt] * alpha + rs;
        if (grow) {
#pragma unroll
          for (int dt = 0; dt < 8; ++dt) o[qt][dt] *= alpha;
        }
#pragma unroll
        for (int s2 = 0; s2 < 2; ++s2) {
          u32x4 pk;
          pk[0] = cvtpk(s[qt][2 * s2][0], s[qt][2 * s2][1]);
          pk[1] = cvtpk(s[qt][2 * s2][2], s[qt][2 * s2][3]);
          pk[2] = cvtpk(s[qt][2 * s2 + 1][0], s[qt][2 * s2 + 1][1]);
          pk[3] = cvtpk(s[qt][2 * s2 + 1][2], s[qt][2 * s2 + 1][3]);
          pf[qt][s2] = __builtin_bit_cast(bf16x8, pk);
        }
      }
      __builtin_amdgcn_s_setprio(1);
#pragma unroll
      for (int dt = 0; dt < 8; ++dt) {
#pragma unroll
        for (int s2 = 0; s2 < 2; ++s2) {
          const u16* vp = sV + (dt * 16 + fr) * VSTR + fq * 4;
          u32x2 v0 = *(const u32x2*)(vp + (2 * s2) * 16);
          u32x2 v1 = *(const u32x2*)(vp + (2 * s2 + 1) * 16);
          u32x4 vv = {v0[0], v0[1], v1[0], v1[1]};
          bf16x8 vf = __builtin_bit_cast(bf16x8, vv);
          o[0][dt] = __builtin_amdgcn_mfma_f32_16x16x32_bf16(vf, pf[0][s2], o[0][dt], 0, 0, 0);
          o[1][dt] = __builtin_amdgcn_mfma_f32_16x16x32_bf16(vf, pf[1][s2], o[1][dt], 0, 0, 0);
        }
      }
      __builtin_amdgcn_s_setprio(0);
    }
  }
  if (active) {
#pragma unroll
    for (int qt = 0; qt < 2; ++qt) {
      const int qr = wq0 + qt * 16 + fr;
      if (qr < nq) {
        const float inv = 1.f / lrow[qt];
        const size_t row = (size_t)(q0 + qr);
#pragma unroll
        for (int dt = 0; dt < 8; ++dt) {
          const size_t off = row * 2048 + h * 128 + dt * 16 + fq * 4;
          u32x2 ga = *(const u32x2*)(p.GA + off);
          u32x2 r;
          if (MODE == 0) {
            u32x2 gb = *(const u32x2*)(p.GB + off);
            r[0] = cvtpk(bflo(gb[0]) * o[qt][dt][0] * inv + bflo(ga[0]), bfhi(gb[0]) * o[qt][dt][1] * inv + bfhi(ga[0]));
            r[1] = cvtpk(bflo(gb[1]) * o[qt][dt][2] * inv + bflo(ga[1]), bfhi(gb[1]) * o[qt][dt][3] * inv + bfhi(ga[1]));
          } else {
            r[0] = cvtpk(bflo(ga[0]) * o[qt][dt][0] * inv, bfhi(ga[0]) * o[qt][dt][1] * inv);
            r[1] = cvtpk(bflo(ga[1]) * o[qt][dt][2] * inv, bfhi(ga[1]) * o[qt][dt][3] * inv);
          }
          *(u32x2*)(gdst + off) = r;
        }
      }
    }
  }
}

#undef KV_LOAD
#undef KV_STORE
__global__ void __launch_bounds__(NTHREADS) fwd_megakernel(Params p) {
  extern __shared__ __attribute__((aligned(16))) char smem[];
  cg::grid_group grid = cg::this_grid();
#define IDS const int tid = otid(); const int lane = tid & 63, w = tid >> 6; const int bid = blockIdx.x, nb = gridDim.x; \
  const int gw = bid * 8 + w, ngw = nb * 8; (void)tid; (void)lane; (void)gw; (void)ngw; (void)bid; (void)nb;

#if PH & (1 << 0)
  { IDS
  {
    const int vb = tid >> 8;
    float* st = (float*)(smem + vb * VB_LDS);
    const int vbid = bid * 2 + vb, nvb = nb * 2;
    for (int t = vbid; t < 32 * 192; t += nvb) transpose_tile(p.w_in, 2048, INC, p.WT_IN, t, st);
    for (int t = vbid; t < 8 * 48; t += nvb) transpose_tile(p.w_uq, 512, 3072, p.WT_UQ, t, st);
    for (int t = vbid; t < 4 * 32; t += nvb) transpose_tile(p.w_uk, 256, 2048, p.WT_UK, t, st);
    for (int t = vbid; t < 4 * 32; t += nvb) transpose_tile(p.w_uv, 256, 2048, p.WT_UV, t, st);
    for (int t = vbid; t < 32 * 32; t += nvb) transpose_tile(p.w_out, 2048, 2048, p.WT_OUT, t, st);
    for (int t = vbid; t < 32 * 128; t += nvb) transpose_tile(p.w_up, 2048, 8192, p.WT_UP, t, st);
    for (int t = vbid; t < 128 * 32; t += nvb) transpose_tile(p.w_down, 8192, 2048, p.WT_DOWN, t, st);
    for (int r = gw; r < MT; r += ngw) {
      const float* x = r < MP ? p.x_p + (size_t)r * 2048 : p.x_s + (size_t)(r - MP) * 2048;
      rms_row_2048(x, p.g_mix, p.H + (size_t)r * 2048, lane);
    }
    const int gt = bid * NTHREADS + tid, ngt = nb * NTHREADS;
    for (int i = gt; i < 16 * 1024 * 64 / 4; i += ngt) {
      int e = i * 4; int b = e >> 16; int rem = e & 65535; int s = rem >> 6, c = rem & 63;
      size_t dst = (size_t)(MP + b * SK + s) * 64 + c;
      f32x4 a = *(const f32x4*)(p.c_idx + e), k = *(const f32x4*)(p.c_kr + e);
      u32x2 o; o[0] = cvtpk(a[0], a[1]); o[1] = cvtpk(a[2], a[3]);
      *(u32x2*)(p.IXK + dst) = o;
      o[0] = cvtpk(k[0], k[1]); o[1] = cvtpk(k[2], k[3]);
      *(u32x2*)(p.KR + dst) = o;
    }
    for (int i = gt; i < 16 * 1024 * 256 / 4; i += ngt) {
      int e = i * 4; int b = e >> 18; int rem = e & 262143; int s = rem >> 8, c = rem & 255;
      size_t dst = (size_t)(MP + b * SK + s) * 256 + c;
      f32x4 a = *(const f32x4*)(p.c_ckv + e);
      u32x2 o; o[0] = cvtpk(a[0], a[1]); o[1] = cvtpk(a[2], a[3]);
      *(u32x2*)(p.CKV + dst) = o;
    }
  }
  }
#endif
  grid.sync();
#if PH & (1 << 1)
  { IDS
  for (int rep = 0; rep < NREP(1); ++rep) gemm_phase<EPI_IN>(p, p.H, 2048, p.WT_IN, 2048, 2048, MT / 256, INP / 256, smem, nullptr, 0, bid, nb);
  }
#endif
  grid.sync();
#if PH & (1 << 2)
  { IDS
  for (int t = gw; t < MT; t += ngw) post_row(p, t, lane);
  {
    const int vb = tid >> 8, vbid = bid * 2 + vb;
    char* sm = smem + vb * VB_LDS;
    for (int rep = 0; rep < NREP(2); ++rep) for (int t = vbid * NQ; t < MT; t += nb * 2 * NQ)
      topk_group(p, t, sm, (unsigned*)(p.out + O_Y + 14000000) + (size_t)vbid * 16384, (unsigned*)(p.out + O_Y + 14000000) + (size_t)(512 + vbid) * 16384,
                 (unsigned*)p.H + (size_t)vbid * 16384);
  }
  }
#endif
  grid.sync();
#if PH & (1 << 3)
  { IDS
    const int total = 1024 + 256;
    for (int rep = 0; rep < NREP(3); ++rep) {
      u16* gdst = (rep + 1 < NREP(3)) ? (u16*)(p.out + O_Y) : p.GA;
      for (int r = 0;; ++r) {
        int id = (r & 1) ? r * nb + (nb - 1 - bid) : r * nb + bid;
        if (r * nb >= total) break;
        if (id < total) attn_item<1>(p, id, smem, gdst);
      }
    }
  }
#endif
  grid.sync();
#if PH & (1 << 4)
  { IDS
  {
    const int gt = bid * NTHREADS + tid, ngt = nb * NTHREADS;
    for (int i = gt; i < MS * 2048 / 4; i += ngt)
      *(f32x4*)(p.out + O_Y + (size_t)MP * 2048 + (size_t)i * 4) = *(const f32x4*)(p.x_s + (size_t)i * 4);
    for (int i = gt; i < 16 * 2048 * 6; i += ngt) {
      int r = i / 6, c = i - r * 6;
      *(u32x4*)(p.VBT_S + (size_t)r * VSS + SK + c * 8) = (u32x4){0u, 0u, 0u, 0u};
    }
    const int nqb = (MT / 256) * 12, nkb = (KROWS / 256) * 8;
    const int total = nqb + 2 * nkb;
    for (int id = bid; id < total; id += nb) {
      if (id < nqb) gemm_phase<EPI_QB>(p, p.CQ, 512, p.WT_UQ, 512, 512, MT / 256, 12, smem, p.QB, 3072, id, 1 << 30);
      else if (id < nqb + nkb) gemm_phase<EPI_BF16>(p, p.CKV, 256, p.WT_UK, 256, 256, KROWS / 256, 8, smem, p.KB, 2048, id - nqb, 1 << 30);
      else gemm_phase<EPI_VT>(p, p.CKV, 256, p.WT_UV, 256, 256, KROWS / 256, 8, smem, nullptr, 0, id - nqb - nkb, 1 << 30);
    }
  }
  }
#endif
  grid.sync();
#if PH & (1 << 5)
  { IDS
  {
    const int total = 1024 + 256;
    for (int rep = 0; rep < NREP(5); ++rep) {
      u16* gdst = (rep + 1 < NREP(5)) ? (u16*)(p.out + O_Y) : p.GB;
      for (int r = 0;; ++r) {
        int id = (r & 1) ? r * nb + (nb - 1 - bid) : r * nb + bid;
        if (r * nb >= total) break;
        if (id < total) attn_item<0>(p, id, smem, gdst);
      }
    }
  }
  }
#endif
  grid.sync();
#if PH & (1 << 6)
  { IDS
  gemm_phase<EPI_RES>(p, p.GB, 2048, p.WT_OUT, 2048, 2048, MT / 256 - 1, 8, smem, nullptr, 0, bid, nb);
  for (int id = bid; id < 128; id += nb) {
    const int nt = id & 7, kc = id >> 3;
    gemm_tile<EPI_ATOM>(p, p.GB + kc * 128, 2048, p.WT_OUT + kc * 128, 2048, 128, (MT / 256 - 1) * 256, nt * 256, smem, nullptr, 0);
  }
  }
#endif
  grid.sync();
#if PH & (1 << 7)
  { IDS
  for (int r = gw; r < MT; r += ngw) rms_row_2048(p.out + O_Y + (size_t)r * 2048, p.g_ffn, p.H2 + (size_t)r * 2048, lane);
  }
#endif
  grid.sync();
#if PH & (1 << 8)
  { IDS
  for (int rep = 0; rep < NREP(8); ++rep) gemm_phase<EPI_RELU2>(p, p.H2, 2048, p.WT_UP, 2048, 2048, MT / 256, 32, smem, nullptr, 0, bid, nb);
  }
#endif
  grid.sync();
#if PH & (1 << 9)
  { IDS
  gemm_phase<EPI_ACC>(p, p.U, DFF, p.WT_DOWN, DFF, DFF, MT / 256 - 1, 8, smem, nullptr, 0, bid, nb);
  for (int id = bid; id < 256; id += nb) {
    const int nt = id & 7, kc = id >> 3;
    gemm_tile<EPI_ATOM>(p, p.U + kc * 256, DFF, p.WT_DOWN + kc * 256, DFF, 256, (MT / 256 - 1) * 256, nt * 256, smem, nullptr, 0);
  }
  }
#endif
  grid.sync();
#if PH & (1 << 10)
  { IDS
  for (int r = gw; r < MT; r += ngw) {
    float* x = p.out + O_Y + (size_t)r * 2048;
    f32x4 v[8];
    float ss = 0.f;
#pragma unroll
    for (int i = 0; i < 8; ++i) {
      v[i] = *(const f32x4*)(x + i * 256 + lane * 4);
      ss += v[i][0] * v[i][0] + v[i][1] * v[i][1] + v[i][2] * v[i][2] + v[i][3] * v[i][3];
    }
    ss = wave_sum(ss);
    float rr = rsqrtf(ss * (1.f / 2048.f) + 1e-6f);
#pragma unroll
    for (int i = 0; i < 8; ++i) {
      f32x4 gg = *(const f32x4*)(p.g_fin + i * 256 + lane * 4);
      f32x4 o = {v[i][0] * rr * gg[0], v[i][1] * rr * gg[1], v[i][2] * rr * gg[2], v[i][3] * rr * gg[3]};
      *(f32x4*)(x + i * 256 + lane * 4) = o;
    }
  }
  }
#endif
}

extern "C" void kernel_launch(void* const* d_in, const int* in_sizes, int n_in, void* d_out, int out_size, void* d_ws, size_t ws_size,
                              hipStream_t stream) {
  static int grid_blocks = 0;
  if (!grid_blocks) {
    int dev = 0, cus = 0, per_cu = 0;
    hipGetDevice(&dev);
    hipDeviceGetAttribute(&cus, hipDeviceAttributeMultiprocessorCount, dev);
    if (hipFuncSetAttribute((const void*)fwd_megakernel, hipFuncAttributeMaxDynamicSharedMemorySize, LDS_BYTES) != hipSuccess)
      fprintf(stderr, "kernel_launch: hipFuncSetAttribute failed\n");
    hipOccupancyMaxActiveBlocksPerMultiprocessor(&per_cu, (const void*)fwd_megakernel, NTHREADS, LDS_BYTES);
    if (per_cu < 1) per_cu = 1;
    if (per_cu > 1) per_cu = 1;
    grid_blocks = cus * per_cu;
  }
  Params p{};
  const float* const* in = (const float* const*)d_in;
  p.x_p = in[0]; p.x_s = in[1]; p.c_ak = in[2]; p.c_av = in[3]; p.c_idx = in[4]; p.c_ckv = in[5]; p.c_kr = in[6]; p.rel = in[7];
  p.g_mix = in[8]; p.w_in = in[9]; p.g_q = in[10]; p.w_uq = in[11]; p.g_kv = in[12]; p.w_uk = in[13]; p.w_uv = in[14]; p.w_out = in[15];
  p.g_ffn = in[16]; p.w_up = in[17]; p.w_down = in[18]; p.g_fin = in[19];
  p.out = (float*)d_out;
  char* ws = (char*)d_ws;
  size_t off = 0;
  auto alloc = [&](size_t bytes) { char* r = ws + off; off += (bytes + 255) & ~(size_t)255; return r; };
  p.WT_UQ = (u16*)alloc((size_t)3072 * 512 * 2);
  p.WT_UK = (u16*)alloc((size_t)2048 * 256 * 2);
  p.WT_UV = (u16*)alloc((size_t)2048 * 256 * 2);
  p.WT_OUT = (u16*)alloc((size_t)2048 * 2048 * 2);
  p.WT_UP = (u16*)alloc((size_t)8192 * 2048 * 2);
  p.WT_DOWN = (u16*)alloc((size_t)2048 * 8192 * 2);
  p.CQ = (u16*)alloc((size_t)MT * 512 * 2);
  p.CKV = (u16*)alloc((size_t)KROWS * 256 * 2);
  p.KR = (u16*)alloc((size_t)KROWS * 64 * 2);
  p.GA = (u16*)alloc((size_t)MT * 2048 * 2);
  p.GB = (u16*)alloc((size_t)MT * 2048 * 2);
  p.CS = (float*)alloc((size_t)MT * 32 * 4);
  p.SN = (float*)alloc((size_t)MT * 32 * 4);
  const size_t ubase = off;
  p.WT_IN = (u16*)alloc((size_t)INP * 2048 * 2);
  p.H = (u16*)alloc((size_t)MT * 2048 * 2);
  p.AQ = (u16*)alloc((size_t)MT * 2048 * 2);
  p.KA = (u16*)alloc((size_t)MP * 2048 * 2);
  p.VAT = (u16*)alloc((size_t)MP * 2048 * 2);
  p.IXQ = (u16*)alloc((size_t)MT * 1024 * 2);
  p.IXK = (u16*)alloc((size_t)KROWS * 64 * 2);
  p.SEL = (unsigned long long*)alloc((size_t)MT * 256 * 8);
  p.IXW = (float*)alloc((size_t)MT * 16 * 4);
  const size_t endA = off;
  off = ubase;
  p.QB = (u16*)alloc((size_t)MT * 3072 * 2);
  p.KB = (u16*)alloc((size_t)KROWS * 2048 * 2);
  p.VBT_P = (u16*)alloc((size_t)2048 * MP * 2);
  p.VBT_S = (u16*)alloc((size_t)16 * 2048 * VSS * 2);
  const size_t endB = off;
  off = ubase;
  p.H2 = (u16*)alloc((size_t)MT * 2048 * 2);
  p.U = (u16*)alloc((size_t)MT * DFF * 2);
  const size_t endC = off;
  size_t need = endA > endB ? endA : endB;
  if (endC > need) need = endC;
  if (need > ws_size) { fprintf(stderr, "kernel_launch: workspace too small: need %zu have %zu\n", need, ws_size); return; }
  void* args[] = {&p};
  hipError_t e = hipLaunchCooperativeKernel((const void*)fwd_megakernel, dim3(grid_blocks), dim3(NTHREADS), args, LDS_BYTES, stream);
  if (e != hipSuccess) fprintf(stderr, "cooperative launch failed: %s (grid %d)\n", hipGetErrorString(e), grid_blocks);
}
```

```cpp
#include <hip/hip_runtime.h>
#include <hip/hip_cooperative_groups.h>
#include <cstdio>
#include <cstdint>
namespace cg = cooperative_groups;

typedef unsigned short u16;
typedef __attribute__((ext_vector_type(8))) short bf16x8;
typedef __attribute__((ext_vector_type(4))) short bf16x4;
typedef __attribute__((ext_vector_type(4))) float f32x4;
typedef __attribute__((ext_vector_type(2))) float f32x2;
typedef __attribute__((ext_vector_type(2))) __bf16 bf16x2_t;
typedef __attribute__((ext_vector_type(4))) unsigned u32x4;
typedef __attribute__((ext_vector_type(2))) unsigned u32x2;

#define DI __device__ __forceinline__

constexpr int MP = 16384;
constexpr int MS = 256;
constexpr int MT = MP + MS;
constexpr int DM = 2048;
constexpr int INC = 12176;
constexpr int INP = 12288;
constexpr int SK = 1040;
constexpr int KROWS = MP + 16 * SK;
constexpr int VSS = 1088;
constexpr int DFF = 8192;
constexpr int ZRW = 832;
#ifndef PH
#define PH 0x7ff
#endif
#ifndef REP
#define REP 0
#endif
#define NREP(k) (((REP >> (k)) & 1) + 1)
constexpr int NTHREADS = 512;
constexpr int VB_LDS = 75776;
constexpr int LDS_BYTES = 2 * VB_LDS;

constexpr size_t O_Y = 0;
constexpr size_t O_AKP = 34078720;
constexpr size_t O_AVP = 67633152;
constexpr size_t O_IDXP = 101187584;
constexpr size_t O_CKVP = 102236160;
constexpr size_t O_KRP = 106430464;
constexpr size_t O_AKS = 107479040;
constexpr size_t O_AVS = 108003328;
constexpr size_t O_IDXS = 108527616;
constexpr size_t O_CKVS = 108544000;
constexpr size_t O_KRS = 108609536;

struct Params {
  const float *x_p, *x_s, *c_ak, *c_av, *c_idx, *c_ckv, *c_kr, *rel, *g_mix, *w_in, *g_q, *w_uq, *g_kv, *w_uk, *w_uv, *w_out, *g_ffn, *w_up, *w_down, *g_fin;
  float* out;
  u16 *WT_UQ, *WT_UK, *WT_UV, *WT_OUT, *WT_UP, *WT_DOWN, *CQ, *CKV, *KR, *GA, *GB;
  float *CS, *SN;
  u16 *WT_IN, *H, *AQ, *KA, *VAT, *IXQ, *IXK;
  float* IXW;
  unsigned long long* SEL;
  u16 *QB, *KB, *VBT_P, *VBT_S;
  u16 *H2, *U;
};

DI int otid() { int t = threadIdx.x; asm volatile("" : "+v"(t)); return t; }
DI unsigned cvtpk(float lo, float hi) {
  f32x2 v = {lo, hi};
  bf16x2_t b = __builtin_convertvector(v, bf16x2_t);
  return __builtin_bit_cast(unsigned, b);
}
DI u16 f2bf(float x) { return (u16)(cvtpk(x, 0.f) & 0xffffu); }
DI float bf2f(u16 b) { return __uint_as_float(((unsigned)b) << 16); }
DI float bflo(unsigned w) { return __uint_as_float(w << 16); }
DI float bfhi(unsigned w) { return __uint_as_float(w & 0xffff0000u); }
DI float dot2bf(unsigned a, unsigned b, float c) {
  return __builtin_amdgcn_fdot2_f32_bf16(__builtin_bit_cast(bf16x2_t, a), __builtin_bit_cast(bf16x2_t, b), c, false);
}
DI float wave_sum(float v) {
#pragma unroll
  for (int o = 32; o > 0; o >>= 1) v += __shfl_xor(v, o);
  return v;
}
DI int qpos_of(int t) { return t < MP ? t : 1024 + ((t - MP) & 15); }
DI int krow_of(int t) { return t < MP ? t : MP + ((t - MP) >> 4) * SK + 1024 + ((t - MP) & 15); }
DI float inv_freq(int i) { return exp2f(-(float)i * 0.41524101186092029f); }

DI void transpose_tile(const float* __restrict__ W, int K, int N, u16* __restrict__ Wt, int tile, float* s  ) {
  const int nkt = K >> 6;
  const int kt = tile % nkt, nt = tile / nkt;
  const int k0 = kt << 6, n0 = nt << 6;
  const int tid = otid() & 255;
  const int c = tid & 63, r0 = tid >> 6;
  __syncthreads();
#pragma unroll
  for (int i = 0; i < 16; ++i) {
    int r = i * 4 + r0;
    float v = (n0 + c < N) ? W[(size_t)(k0 + r) * N + n0 + c] : 0.f;
    s[r * 65 + c] = v;
  }
  __syncthreads();
  const int kp = (tid & 31) * 2, rr0 = tid >> 5;
#pragma unroll
  for (int i = 0; i < 8; ++i) {
    int rr = i * 8 + rr0;
    unsigned pk = cvtpk(s[kp * 65 + rr], s[(kp + 1) * 65 + rr]);
    *(unsigned*)(Wt + (size_t)(n0 + rr) * K + k0 + kp) = pk;
  }
}

DI void rms_row_2048(const float* __restrict__ x, const float* __restrict__ g, u16* __restrict__ out, int lane) {
  f32x4 v[8];
  float ss = 0.f;
#pragma unroll
  for (int i = 0; i < 8; ++i) {
    v[i] = *(const f32x4*)(x + i * 256 + lane * 4);
    ss += v[i][0] * v[i][0] + v[i][1] * v[i][1] + v[i][2] * v[i][2] + v[i][3] * v[i][3];
  }
  ss = wave_sum(ss);
  float r = rsqrtf(ss * (1.f / 2048.f) + 1e-6f);
#pragma unroll
  for (int i = 0; i < 8; ++i) {
    f32x4 gg = *(const f32x4*)(g + i * 256 + lane * 4);
    u32x2 o;
    o[0] = cvtpk(v[i][0] * r * gg[0], v[i][1] * r * gg[1]);
    o[1] = cvtpk(v[i][2] * r * gg[2], v[i][3] * r * gg[3]);
    *(u32x2*)(out + i * 256 + lane * 4) = o;
  }
}

enum { EPI_IN = 0, EPI_QB, EPI_BF16, EPI_VT, EPI_RES, EPI_RELU2, EPI_ACC, EPI_ATOM };
constexpr float QSC = 0.07216878364870322f * 1.4426950408889634f;
constexpr int LSTR = 64;
#ifndef PFA
#define PFA 8
#endif

template <int EPI> struct EpiSwap { static constexpr bool v = (EPI != EPI_VT); };

DI u32x2 pack4(f32x4 v) { u32x2 r; r[0] = cvtpk(v[0], v[1]); r[1] = cvtpk(v[2], v[3]); return r; }
DI float relu_i(float x) { return __int_as_float(max(__float_as_int(x), 0)); }
DI float sigm(float v) { return __builtin_amdgcn_rcpf(1.f + __builtin_amdgcn_exp2f(v * -1.4426950408889634f)); }

template <int EPI>
DI void gemm_epilogue(const Params& p, f32x4 (&acc)[8][4], int m0, int n0, int wr, int wc, int fr, int fq, u16* Cb, int ldc) {
  const int cw = n0 + wc * 64;
  if (EPI == EPI_VT) {
#pragma clang loop unroll(full)
    for (int m = 0; m < 8; ++m) {
      const int rb = m0 + wr * 128 + m * 16 + fq * 4;
#pragma clang loop unroll(full)
      for (int n = 0; n < 4; ++n) {
        const int col = cw + n * 16 + fr;
        u16* dst;
        if (rb < MP) dst = p.VBT_P + (size_t)col * MP + rb;
        else { int r2 = rb - MP; int b = r2 / SK; int s = r2 - b * SK; dst = p.VBT_S + ((size_t)b * 2048 + col) * VSS + s; }
        *(u32x2*)dst = pack4(acc[m][n]);
      }
    }
    return;
  }
  const int rbase = m0 + wr * 128 + fr;
  const int c4 = fq * 4;
  if (EPI == EPI_QB) {
    if (cw % 192 == 128) {
#pragma clang loop unroll(full)
      for (int m = 0; m < 8; ++m) {
        const int row = rbase + m * 16;
#pragma clang loop unroll(full)
        for (int n = 0; n < 2; ++n) {
          const int i0 = n * 16 + c4;
          const f32x4 cs = *(const f32x4*)(p.CS + (size_t)row * 32 + i0), sn = *(const f32x4*)(p.SN + (size_t)row * 32 + i0);
          const f32x4 x1 = acc[m][n] * QSC, x2 = acc[m][n + 2] * QSC;
          *(u32x2*)(p.QB + (size_t)row * 3072 + cw + i0) = pack4(x1 * cs - x2 * sn);
          *(u32x2*)(p.QB + (size_t)row * 3072 + cw + i0 + 32) = pack4(x1 * sn + x2 * cs);
        }
      }
      return;
    }
  }
#pragma clang loop unroll(full)
  for (int n = 0; n < 4; ++n) {
    const int colt = cw + n * 16;
    const int col = colt + c4;
    if (EPI == EPI_IN) {
      const bool smp = m0 >= MP;
      if (colt < 2048) {
#pragma clang loop unroll(full)
        for (int m = 0; m < 8; ++m) *(u32x2*)(p.AQ + (size_t)(rbase + m * 16) * 2048 + col) = pack4(acc[m][n] * (0.08838834764831845f * 1.4426950408889634f));
      } else if (colt < 4096) {
        const int c = col - 2048;
#pragma clang loop unroll(full)
        for (int m = 0; m < 8; ++m) {
          const int row = rbase + m * 16;
          if (!smp) { *(f32x4*)(p.out + O_AKP + (size_t)row * 2048 + c) = acc[m][n]; *(u32x2*)(p.KA + (size_t)row * 2048 + c) = pack4(acc[m][n]); }
          else *(f32x4*)(p.out + O_AKS + (size_t)(row - MP) * 2048 + c) = acc[m][n];
        }
      } else if (colt < 6144) {
        const int c = col - 4096;
#pragma clang loop unroll(full)
        for (int m = 0; m < 8; ++m) {
          const int row = rbase + m * 16;
          if (!smp) {
            *(f32x4*)(p.out + O_AVP + (size_t)row * 2048 + c) = acc[m][n];
#pragma clang loop unroll(full)
            for (int j = 0; j < 4; ++j) p.VAT[(size_t)(c + j) * MP + row] = f2bf(acc[m][n][j]);
          } else *(f32x4*)(p.out + O_AVS + (size_t)(row - MP) * 2048 + c) = acc[m][n];
        }
      } else if (colt < 7168) {
#pragma clang loop unroll(full)
        for (int m = 0; m < 8; ++m) *(u32x2*)(p.IXQ + (size_t)(rbase + m * 16) * 1024 + (col - 6144)) = pack4(acc[m][n]);
      } else if (colt < 7232) {
        const int c = col - 7168;
#pragma clang loop unroll(full)
        for (int m = 0; m < 8; ++m) {
          const int row = rbase + m * 16;
          if (!smp) *(f32x4*)(p.out + O_IDXP + (size_t)row * 64 + c) = acc[m][n];
          else *(f32x4*)(p.out + O_IDXS + (size_t)(row - MP) * 64 + c) = acc[m][n];
          *(u32x2*)(p.IXK + (size_t)krow_of(row) * 64 + c) = pack4(acc[m][n]);
        }
      } else if (colt < 7248) {
#pragma clang loop unroll(full)
        for (int m = 0; m < 8; ++m) *(f32x4*)(p.IXW + (size_t)(rbase + m * 16) * 16 + (col - 7232)) = acc[m][n] * 0.25f;
      } else if (colt < 8080) {
#pragma clang loop unroll(full)
        for (int m = 0; m < 8; ++m) *(f32x4*)(p.out + O_Y + (size_t)(rbase + m * 16) * ZRW + (col - 7248)) = acc[m][n];
      } else if (colt < INC) {
        u16* G = colt < 10128 ? p.GA : p.GB;
        const int c = colt < 10128 ? col - 8080 : col - 10128;
#pragma clang loop unroll(full)
        for (int m = 0; m < 8; ++m) {
          f32x4 v = acc[m][n];
          f32x4 g = {sigm(v[0]), sigm(v[1]), sigm(v[2]), sigm(v[3])};
          *(u32x2*)(G + (size_t)(rbase + m * 16) * 2048 + c) = pack4(g);
        }
      }
    } else {
#pragma clang loop unroll(full)
      for (int m = 0; m < 8; ++m) {
        const int row = rbase + m * 16;
        const f32x4 v = acc[m][n];
        if (EPI == EPI_QB) {
          *(u32x2*)(Cb + (size_t)row * ldc + col) = pack4(v * QSC);
        } else if (EPI == EPI_BF16) {
          *(u32x2*)(Cb + (size_t)row * ldc + col) = pack4(v);
        } else if (EPI == EPI_RES) {
          const f32x4 xv = row < MP ? *(const f32x4*)(p.x_p + (size_t)row * 2048 + col) : *(const f32x4*)(p.x_s + (size_t)(row - MP) * 2048 + col);
          *(f32x4*)(p.out + O_Y + (size_t)row * 2048 + col) = xv + v;
          if ((m & 3) == 3) __builtin_amdgcn_sched_barrier(0);
        } else if (EPI == EPI_RELU2) {
          f32x4 r = {relu_i(v[0]), relu_i(v[1]), relu_i(v[2]), relu_i(v[3])};
          *(u32x2*)(p.U + (size_t)row * DFF + col) = pack4(r * r);
        } else if (EPI == EPI_ACC) {
          float* d = p.out + O_Y + (size_t)row * 2048 + col;
          *(f32x4*)d = *(const f32x4*)d + v;
          if ((m & 3) == 3) __builtin_amdgcn_sched_barrier(0);
        } else if (EPI == EPI_ATOM) {
#pragma clang loop unroll(full)
          for (int j = 0; j < 4; ++j) atomicAdd(p.out + O_Y + (size_t)row * 2048 + col + j, v[j]);
        }
      }
    }
  }
}

constexpr int GSTAGE = 512 * LSTR;
template <int EPI>
DI void gemm_tile(const Params& p, const u16* __restrict__ A, int lda, const u16* __restrict__ Bt, int ldb, int K, int m0, int n0,
                  char* smem, u16* Cb, int ldc) {
  u16* sbase = (u16*)smem;
  const int tid = otid(), lane = tid & 63, w = tid >> 6;
  const int wr = w >> 2, wc = w & 3, fr = lane & 15, fq = lane >> 4;
  f32x4 acc[8][4];
#pragma unroll
  for (int m = 0; m < 8; ++m)
#pragma unroll
    for (int n = 0; n < 4; ++n) acc[m][n] = (f32x4){0.f, 0.f, 0.f, 0.f};
  const int lr = tid >> 3, lk = (tid & 7) * 8;
  const int lkw = ((tid & 7) ^ ((lr >> 1) & 7)) * 8;
  const int fsw = (fr >> 1) & 7, fo0 = (fq ^ fsw) * 8, fo1 = ((4 + fq) ^ fsw) * 8;
  const u16* Ag = A + (size_t)(m0 + lr) * lda + lk;
  const u16* Bg = Bt + (size_t)(n0 + lr) * ldb + lk;
  const int nk = K >> 6;
  u32x4 ra[4], rb[4];
#define G_LOAD(T) { const int k_ = (T) << 6; _Pragma("unroll") for (int i = 0; i < 4; ++i) { \
    ra[i] = *(const u32x4*)(Ag + (size_t)(i * 64) * lda + k_); rb[i] = *(const u32x4*)(Bg + (size_t)(i * 64) * ldb + k_); } }
#define L_STORE(ST) { u16* dA_ = sbase + (ST) * GSTAGE + lr * LSTR + lkw; u16* dB_ = dA_ + 256 * LSTR; _Pragma("unroll") for (int i = 0; i < 4; ++i) { \
    *(u32x4*)(dA_ + i * 64 * LSTR) = ra[i]; *(u32x4*)(dB_ + i * 64 * LSTR) = rb[i]; } }
  G_LOAD(0)
  L_STORE(0)
  G_LOAD(1)
#pragma unroll 1
  for (int kt = 0; kt < nk; ++kt) {
    __syncthreads();
    if (kt + 1 < nk) L_STORE((kt + 1) & 1)
    G_LOAD(min(kt + 2, nk - 1))
    const u16* cA = sbase + (kt & 1) * GSTAGE + (wr * 128 + fr) * LSTR;
    const u16* cB = sbase + (kt & 1) * GSTAGE + 256 * LSTR + (wc * 64 + fr) * LSTR;
#pragma unroll
    for (int ks = 0; ks < 2; ++ks) {
      bf16x8 bfr[4];
#pragma unroll
      for (int n = 0; n < 4; ++n) bfr[n] = *(const bf16x8*)(cB + n * 16 * LSTR + (ks ? fo1 : fo0));
#pragma unroll
      for (int mh = 0; mh < 2; ++mh) {
        bf16x8 af[4];
#pragma unroll
        for (int m = 0; m < 4; ++m) af[m] = *(const bf16x8*)(cA + (mh * 4 + m) * 16 * LSTR + (ks ? fo1 : fo0));
        __builtin_amdgcn_s_setprio(1);
#pragma unroll
        for (int m = 0; m < 4; ++m)
#pragma unroll
          for (int n = 0; n < 4; ++n)
            acc[mh * 4 + m][n] = EpiSwap<EPI>::v ? __builtin_amdgcn_mfma_f32_16x16x32_bf16(bfr[n], af[m], acc[mh * 4 + m][n], 0, 0, 0)
                                                 : __builtin_amdgcn_mfma_f32_16x16x32_bf16(af[m], bfr[n], acc[mh * 4 + m][n], 0, 0, 0);
        __builtin_amdgcn_s_setprio(0);
      }
    }
  }
#undef G_LOAD
#undef L_STORE
  gemm_epilogue<EPI>(p, acc, m0, n0, wr, wc, fr, fq, Cb, ldc);
}

template <int EPI>
DI void gemm_phase(const Params& p, const u16* A, int lda, const u16* Bt, int ldb, int K, int mtiles, int ntiles, char* smem, u16* Cb, int ldc,
                   int start, int stride) {
  if (stride == 256) {
    const int gm = (mtiles + 3) >> 2, gn = (ntiles + 7) >> 3, nsg = gm * gn;
    const int xcd = start & 7, li = start >> 3;
    for (int sg = xcd; sg < nsg; sg += 8) {
      const int gni = sg / gm, gmi = sg - gni * gm;
      const int mt = gmi * 4 + (li & 3), nt = gni * 8 + (li >> 2);
      if (mt < mtiles && nt < ntiles) gemm_tile<EPI>(p, A, lda, Bt, ldb, K, mt * 256, nt * 256, smem, Cb, ldc);
    }
    return;
  }
  const int total = mtiles * ntiles;
  const int GM = 8;
  for (int id = start; id < total; id += stride) {
    const int per = GM * ntiles;
    const int g = id / per, rem = id - g * per;
    const int fm = g * GM;
    const int gsz = min(GM, mtiles - fm);
    const int mt = fm + rem % gsz, nt = rem / gsz;
    gemm_tile<EPI>(p, A, lda, Bt, ldb, K, mt * 256, nt * 256, smem, Cb, ldc);
  }
}

DI void post_row(const Params& p, int t, int lane) {
  const float* zr = p.out + O_Y + (size_t)t * ZRW;
  {
    f32x4 a = *(const f32x4*)(zr + lane * 4), b = *(const f32x4*)(zr + 256 + lane * 4);
    float ss = a[0] * a[0] + a[1] * a[1] + a[2] * a[2] + a[3] * a[3] + b[0] * b[0] + b[1] * b[1] + b[2] * b[2] + b[3] * b[3];
    ss = wave_sum(ss);
    float r = rsqrtf(ss * (1.f / 512.f) + 1e-6f);
    f32x4 ga = *(const f32x4*)(p.g_q + lane * 4), gb = *(const f32x4*)(p.g_q + 256 + lane * 4);
    u32x2 o;
    o[0] = cvtpk(a[0] * r * ga[0], a[1] * r * ga[1]); o[1] = cvtpk(a[2] * r * ga[2], a[3] * r * ga[3]);
    *(u32x2*)(p.CQ + (size_t)t * 512 + lane * 4) = o;
    o[0] = cvtpk(b[0] * r * gb[0], b[1] * r * gb[1]); o[1] = cvtpk(b[2] * r * gb[2], b[3] * r * gb[3]);
    *(u32x2*)(p.CQ + (size_t)t * 512 + 256 + lane * 4) = o;
  }
  const int kr_row = krow_of(t);
  {
    f32x4 a = *(const f32x4*)(zr + 512 + lane * 4);
    float ss = a[0] * a[0] + a[1] * a[1] + a[2] * a[2] + a[3] * a[3];
    ss = wave_sum(ss);
    float r = rsqrtf(ss * (1.f / 256.f) + 1e-6f);
    f32x4 g = *(const f32x4*)(p.g_kv + lane * 4);
    f32x4 o = {a[0] * r * g[0], a[1] * r * g[1], a[2] * r * g[2], a[3] * r * g[3]};
    float* od = t < MP ? p.out + O_CKVP + (size_t)t * 256 : p.out + O_CKVS + (size_t)(t - MP) * 256;
    *(f32x4*)(od + lane * 4) = o;
    u32x2 ob; ob[0] = cvtpk(o[0], o[1]); ob[1] = cvtpk(o[2], o[3]);
    *(u32x2*)(p.CKV + (size_t)kr_row * 256 + lane * 4) = ob;
  }
  if (lane < 32) {
    float x1 = zr[768 + lane], x2 = zr[768 + 32 + lane];
    float ang = (float)qpos_of(t) * inv_freq(lane);
    float cs = cosf(ang), sn = sinf(ang);
    p.CS[(size_t)t * 32 + lane] = cs; p.SN[(size_t)t * 32 + lane] = sn;
    float o1 = x1 * cs - x2 * sn, o2 = x1 * sn + x2 * cs;
    float* od = t < MP ? p.out + O_KRP + (size_t)t * 64 : p.out + O_KRS + (size_t)(t - MP) * 64;
    od[lane] = o1; od[lane + 32] = o2;
    p.KR[(size_t)kr_row * 64 + lane] = f2bf(o1);
    p.KR[(size_t)kr_row * 64 + lane + 32] = f2bf(o2);
  }
}

template <int CTRL> DI float dpp_add(float v) {
  int sft = __builtin_amdgcn_update_dpp(0, __float_as_int(v), CTRL, 0xf, 0xf, true);
  return v + __int_as_float(sft);
}
DI float row16_sum(float v) { v = dpp_add<0x111>(v); v = dpp_add<0x112>(v); v = dpp_add<0x114>(v); v = dpp_add<0x118>(v); return v; }
DI unsigned fkey(float f) { unsigned u = __float_as_uint(f); return (u & 0x80000000u) ? ~u : (u | 0x80000000u); }

DI void radix_select(unsigned* sc, int* hist, int* misc, int n, unsigned long long* sel, int tid, int lane, int w) {
  __syncthreads();
  unsigned prefix = 0;
  int remaining = 256, neq = 0;
  bool done = false;
#pragma unroll 1
  for (int pass = 0; pass < 3; ++pass) {
    const int shift = pass == 0 ? 21 : (pass == 1 ? 10 : 0);
    const int bits = pass == 2 ? 10 : 11;
    const unsigned bmask = (1u << bits) - 1u;
    if (done) {
      __syncthreads(); __syncthreads(); __syncthreads(); __syncthreads(); __syncthreads();
      continue;
    }
    if (pass > 0) {
      *(int4*)&hist[tid * 8] = make_int4(0, 0, 0, 0);
      *(int4*)&hist[tid * 8 + 4] = make_int4(0, 0, 0, 0);
      __syncthreads();
      const int hs = shift + bits;
      const unsigned want = prefix >> hs;
      for (int i = tid * 4; i < n; i += 256 * 4) {
        const u32x4 u4 = *(const u32x4*)(sc + i);
#pragma unroll
        for (int e = 0; e < 4; ++e)
          if ((u4[e] >> hs) == want) atomicAdd(&hist[(u4[e] >> shift) & bmask], 1);
      }
      __syncthreads();
    }
    const int4 h0 = *(const int4*)&hist[tid * 8], h1 = *(const int4*)&hist[tid * 8 + 4];
    const int s8 = h0.x + h0.y + h0.z + h0.w + h1.x + h1.y + h1.z + h1.w;
    int suf = s8;
#pragma unroll
    for (int d = 1; d < 64; d <<= 1) { int v = __shfl_down(suf, d); if (lane + d < 64) suf += v; }
    if (lane == 0) misc[w] = suf;
    __syncthreads();
    int above = 0;
    for (int ww = w + 1; ww < 4; ++ww) above += misc[ww];
    const int excl = above + suf - s8;
    if (excl < remaining && remaining <= excl + s8) {
      int c = excl, bin = 0, nrem = 0, bpop = 0;
#define TK_STEP(val, idx) if (c < remaining && remaining <= c + (val)) { bin = tid * 8 + (idx); nrem = remaining - c; bpop = (val); } c += (val);
      TK_STEP(h1.w, 7) TK_STEP(h1.z, 6) TK_STEP(h1.y, 5) TK_STEP(h1.x, 4) TK_STEP(h0.w, 3) TK_STEP(h0.z, 2) TK_STEP(h0.y, 1) TK_STEP(h0.x, 0)
#undef TK_STEP
      misc[4] = bin; misc[5] = nrem; misc[6] = bpop;
    }
    __syncthreads();
    prefix |= ((unsigned)misc[4]) << shift;
    remaining = misc[5];
    neq = misc[6];
    done = (neq == remaining);
    __syncthreads();
  }
  const unsigned T = prefix;
  const int seg = ((n + 255) >> 8) << 6;
  const int beg = w * seg;
  if (neq == remaining) {
    for (int i0 = beg; i0 < beg + seg; i0 += 64) {
      const int i = i0 + lane;
      const bool in = i < n; const unsigned u = in ? sc[i] : 0u;
      const unsigned long long sm = __ballot(in && u >= T);
      if (lane == 0 && i0 < n) sel[i0 >> 6] = sm;
    }
    __syncthreads();
    return;
  }
  int ceq = 0;
  for (int i = beg + lane; i < beg + seg; i += 64) {
    bool in = i < n; unsigned u = in ? sc[i] : 0u;
    ceq += __popcll(__ballot(in && u == T));
  }
  if (lane == 0) misc[12 + w] = ceq;
  __syncthreads();
  int oe = 0;
  for (int ww = 0; ww < w; ++ww) oe += misc[12 + ww];
  const unsigned long long lt = (1ull << lane) - 1ull;
  for (int i0 = beg; i0 < beg + seg; i0 += 64) {
    const int i = i0 + lane;
    bool in = i < n; unsigned u = in ? sc[i] : 0u;
    bool g = in && u > T, e = in && u == T;
    unsigned long long be = __ballot(e);
    int pe = oe + __popcll(be & lt);
    unsigned long long sm = __ballot(g || (e && pe < remaining));
    if (lane == 0 && i0 < n) sel[i0 >> 6] = sm;
    oe += __popcll(be);
  }
}

constexpr int NQ = 4;
DI void topk_group(const Params& p, int t, char* smem, unsigned* scr1, unsigned* scr2, unsigned* scr3) {
  unsigned* sc = (unsigned*)smem;
  int* hist = (int*)(smem + 65536);
  int* misc = hist + 2048;
  const int tid = otid() & 255, lane = tid & 63, w = tid >> 6, fr = lane & 15, fq = lane >> 4;
  int n; const u16* ixk;
  if (t < MP) { n = 64 * ((t >> 6) + 1); ixk = p.IXK; }
  else { int b = (t - MP) >> 4; n = SK; ixk = p.IXK + (size_t)(MP + b * SK) * 64; }
  unsigned long long* sel = p.SEL + (size_t)t * 256;
  __syncthreads();
  if (n <= 256) {
    if (tid < 4) {
      unsigned long long v = (tid < (n >> 6)) ? ~0ull : 0ull;
#pragma unroll
      for (int qi = 0; qi < NQ; ++qi) sel[qi * 256 + tid] = v;
    }
    return;
  }
  *(int4*)&hist[tid * 8] = make_int4(0, 0, 0, 0);
  *(int4*)&hist[tid * 8 + 4] = make_int4(0, 0, 0, 0);
  __syncthreads();
  {
    const u16* q = p.IXQ + (size_t)t * 1024 + fr * 64 + fq * 8;
    bf16x8 a0[NQ], a1[NQ];
    f32x4 wv[NQ];
#pragma unroll
    for (int qi = 0; qi < NQ; ++qi) {
      a0[qi] = *(const bf16x8*)(q + qi * 1024); a1[qi] = *(const bf16x8*)(q + qi * 1024 + 32);
      wv[qi] = *(const f32x4*)(p.IXW + (size_t)(t + qi) * 16 + fq * 4);
    }
    const int ntile = n >> 4;
    for (int kt0 = w; kt0 < ntile; kt0 += 32) {
      bf16x8 b0[8], b1[8];
#pragma unroll
      for (int g = 0; g < 8; ++g) {
        const int kt = min(kt0 + g * 4, ntile - 1);
        const u16* kp = ixk + (size_t)(kt * 16 + fr) * 64 + fq * 8;
        b0[g] = *(const bf16x8*)kp; b1[g] = *(const bf16x8*)(kp + 32);
      }
      float pt[NQ][8];
#pragma unroll
      for (int g = 0; g < 8; ++g) {
#pragma unroll
        for (int qi = 0; qi < NQ; ++qi) {
          f32x4 c = {0.f, 0.f, 0.f, 0.f};
          c = __builtin_amdgcn_mfma_f32_16x16x32_bf16(a0[qi], b0[g], c, 0, 0, 0);
          c = __builtin_amdgcn_mfma_f32_16x16x32_bf16(a1[qi], b1[g], c, 0, 0, 0);
          pt[qi][g] = relu_i(c[0]) * wv[qi][0] + relu_i(c[1]) * wv[qi][1] + relu_i(c[2]) * wv[qi][2] + relu_i(c[3]) * wv[qi][3];
        }
      }
#pragma unroll
      for (int g = 0; g < 8; g += 2) {
        const int kt = kt0 + (g + (lane >> 5)) * 4;
        const bool st = (lane & 16) == 0 && kt < ntile;
#pragma unroll
        for (int qi = 0; qi < NQ; ++qi) {
          auto r32 = __builtin_amdgcn_permlane32_swap(__float_as_uint(pt[qi][g]), __float_as_uint(pt[qi][g + 1]), false, false);
          float s2 = __uint_as_float(r32[0]) + __uint_as_float(r32[1]);
          auto r16 = __builtin_amdgcn_permlane16_swap(__float_as_uint(s2), __float_as_uint(s2), false, false);
          float sv = __uint_as_float(r16[0]) + __uint_as_float(r16[1]);
          if (st) {
            unsigned u = fkey(sv);
            if (qi == 0) { sc[kt * 16 + fr] = u; atomicAdd(&hist[u >> 21], 1); }
            else if (qi == 1) scr1[kt * 16 + fr] = u;
            else if (qi == 2) scr2[kt * 16 + fr] = u;
            else scr3[kt * 16 + fr] = u;
          }
        }
      }
    }
  }
  radix_select(sc, hist, misc, n, sel, tid, lane, w);
#pragma unroll 1
  for (int qi = 1; qi < NQ; ++qi) {
    const unsigned* scr = qi == 1 ? scr1 : (qi == 2 ? scr2 : scr3);
    __syncthreads();
    *(int4*)&hist[tid * 8] = make_int4(0, 0, 0, 0);
    *(int4*)&hist[tid * 8 + 4] = make_int4(0, 0, 0, 0);
    __syncthreads();
    for (int i = tid * 4; i < n; i += 256 * 4) {
      const u32x4 u4 = *(const u32x4*)(scr + i);
      *(u32x4*)(sc + i) = u4;
#pragma unroll
      for (int e = 0; e < 4; ++e) atomicAdd(&hist[u4[e] >> 21], 1);
    }
    radix_select(sc, hist, misc, n, sel + qi * 256, tid, lane, w);
  }
}

constexpr int KSTR = 192;
constexpr int VSTR = 72;
DI float xq_max(float x) {
  auto a = __builtin_amdgcn_permlane16_swap(__float_as_uint(x), __float_as_uint(x), false, false);
  x = fmaxf(__uint_as_float(a[0]), __uint_as_float(a[1]));
  auto b = __builtin_amdgcn_permlane32_swap(__float_as_uint(x), __float_as_uint(x), false, false);
  return fmaxf(__uint_as_float(b[0]), __uint_as_float(b[1]));
}
DI float xq_sum(float x) {
  auto a = __builtin_amdgcn_permlane16_swap(__float_as_uint(x), __float_as_uint(x), false, false);
  x = __uint_as_float(a[0]) + __uint_as_float(a[1]);
  auto b = __builtin_amdgcn_permlane32_swap(__float_as_uint(x), __float_as_uint(x), false, false);
  return __uint_as_float(b[0]) + __uint_as_float(b[1]);
}

template <int MODE>
DI void attn_item(const Params& p, int item, char* smem, u16* gdst) {
  constexpr int NKS = MODE == 0 ? 6 : 4;
  constexpr int ASTAGE = 64 * KSTR + 128 * VSTR;
  u16* sbase = (u16*)smem;
  float* sBias = (float*)(sbase + 2 * ASTAGE);
  const int tid = otid(), lane = tid & 63, w = tid >> 6, fr = lane & 15, fq = lane >> 4;
  const int ksw = (fr >> 1) & 7, ko0 = (fq ^ ksw) * 8, ko1 = ((4 + fq) ^ ksw) * 8;
  int h, q0, nq, krow0, nkeys, ntiles, myt, b = 0, qpos0;
  const u16* vt; size_t vstride;
  const bool sample = item >= 1024;
  if (!sample) {
    const int i = 63 - (item >> 4);
    h = item & 15; q0 = i * 256; nq = 256; krow0 = 0; nkeys = q0 + 256; ntiles = 4 * i + 4; qpos0 = q0;
    vt = (MODE == 0 ? p.VBT_P : p.VAT) + (size_t)h * 128 * MP; vstride = MP;
    myt = ntiles - 3 + (w >> 1);
  } else {
    const int j = item - 1024; b = j >> 4;
    h = j & 15; q0 = MP + b * 16; nq = 16; krow0 = MP + b * SK; nkeys = SK; ntiles = 17; qpos0 = 1024;
    vt = p.VBT_S + ((size_t)b * 2048 + h * 128) * VSS; vstride = VSS;
    myt = ntiles;
  }
  const int wq0 = w * 32;
  const bool active = wq0 < nq;
  __syncthreads();
  if (MODE == 1) {
    for (int i = tid; i < 257; i += NTHREADS) {
      int rel = i - 128;
      int ret = rel > 0 ? 16 : 0;
      int n = rel < 0 ? -rel : rel;
      float lf = logf((float)max(n, 1) / 8.0f) / 2.772588722239781f * 8.0f;
      int large = min(8 + (int)lf, 15);
      int bk = ret + (n < 8 ? n : large);
      sBias[i] = (p.rel[bk * 16 + h] - p.rel[15 * 16 + h]) * 1.4426950408889634f;
    }
  }
  bf16x8 qf[2][NKS];
  int qrow[2];
#pragma unroll
  for (int qt = 0; qt < 2; ++qt) {
    const int qr = min(wq0 + qt * 16 + fr, nq - 1);
    qrow[qt] = qr;
    const u16* qp = (MODE == 0) ? p.QB + (size_t)(q0 + qr) * 3072 + h * 192 + fq * 8 : p.AQ + (size_t)(q0 + qr) * 2048 + h * 128 + fq * 8;
#pragma unroll
    for (int ks = 0; ks < NKS; ++ks) qf[qt][ks] = *(const bf16x8*)(qp + ks * 32);
  }
  f32x4 o[2][8];
#pragma unroll
  for (int qt = 0; qt < 2; ++qt)
#pragma unroll
    for (int dt = 0; dt < 8; ++dt) o[qt][dt] = (f32x4){0.f, 0.f, 0.f, 0.f};
  float mrow[2] = {-1e30f, -1e30f}, lrow[2] = {0.f, 0.f};
  const float SC = (MODE == 0 ? 0.07216878364870322f : 0.08838834764831845f) * 1.4426950408889634f;

  unsigned long long mqn[2] = {0ull, 0ull};
  if (MODE == 1) {
#pragma unroll
    for (int qt = 0; qt < 2; ++qt) mqn[qt] = p.SEL[(size_t)(q0 + qrow[qt]) * 256];
  }
  constexpr int NKL = MODE == 0 ? 3 : 2;
  const bool direct = (MODE == 1) && sample;
  u32x4 rk[NKL], rv[2];
#define KV_LOAD(JT) { const size_t kr0_ = (size_t)(krow0 + (JT) * 64); const u16* kb_ = (MODE == 0 ? p.KB : p.KA) + (kr0_ + (tid >> 4)) * 2048 + h * 128 + (tid & 15) * 8; \
    _Pragma("unroll") for (int i = 0; i < 2; ++i) rk[i] = *(const u32x4*)(kb_ + (size_t)i * 32 * 2048); \
    if (MODE == 0) rk[NKL - 1] = *(const u32x4*)(p.KR + (kr0_ + (tid >> 3)) * 64 + (tid & 7) * 8); \
    const u16* vp_ = vt + (size_t)(tid >> 3) * vstride + (JT) * 64 + (tid & 7) * 8; \
    _Pragma("unroll") for (int i = 0; i < 2; ++i) rv[i] = *(const u32x4*)(vp_ + (size_t)i * 64 * vstride); }
#define KV_STORE(ST) { u16* sk_ = sbase + (ST) * ASTAGE; u16* dk_ = sk_ + (tid >> 4) * KSTR + ((tid & 15) ^ ((tid >> 5) & 7)) * 8; \
    _Pragma("unroll") for (int i = 0; i < 2; ++i) *(u32x4*)(dk_ + i * 32 * KSTR) = rk[i]; \
    if (MODE == 0) *(u32x4*)(sk_ + (tid >> 3) * KSTR + 128 + ((tid & 7) ^ ((tid >> 4) & 7)) * 8) = rk[NKL - 1]; \
    u16* dv_ = sk_ + 64 * KSTR + (tid >> 3) * VSTR + (tid & 7) * 8; \
    _Pragma("unroll") for (int i = 0; i < 2; ++i) *(u32x4*)(dv_ + i * 64 * VSTR) = rv[i]; }
  if (!direct) {
    KV_LOAD(0)
    KV_STORE(0)
    KV_LOAD(min(1, ntiles - 1))
  }
  for (int jt = 0; jt < ntiles; ++jt) {
    const int key0 = jt * 64;
    u16* sK = sbase + (jt & 1) * ASTAGE;
    u16* sV = sK + 64 * KSTR;
    unsigned long long mq[2] = {mqn[0], mqn[1]};
    if (MODE == 1) {
      const int jn = min(jt + 1, ntiles - 1);
#pragma unroll
      for (int qt = 0; qt < 2; ++qt) mqn[qt] = p.SEL[(size_t)(q0 + qrow[qt]) * 256 + jn];
    }
    __syncthreads();
    if (!direct) {
      if (jt + 1 < ntiles) KV_STORE((jt + 1) & 1)
      KV_LOAD(min(jt + 2, ntiles - 1))
    } else {
#pragma unroll 2
      for (int i = 0; i < 4; ++i) {
        const int c = tid + i * NTHREADS;
        const int key = c >> 5, part = c & 31;
        const int s = key0 + key;
        const int sc_ = min(s, SK - 1);
        const size_t o1 = sc_ < 1024 ? ((size_t)b * 1024 + sc_) * 2048 : ((size_t)b * 16 + (sc_ - 1024)) * 2048;
        const float* kp = (sc_ < 1024 ? p.c_ak : p.out + O_AKS) + o1 + h * 128 + part * 4;
        const float* vp = (sc_ < 1024 ? p.c_av : p.out + O_AVS) + o1 + h * 128 + part * 4;
        f32x4 kv = *(const f32x4*)kp, vv = *(const f32x4*)vp;
        u32x2 kk; kk[0] = cvtpk(kv[0], kv[1]); kk[1] = cvtpk(kv[2], kv[3]);
        *(u32x2*)(sK + key * KSTR + (((part >> 1) ^ ((key >> 1) & 7)) * 8) + (part & 1) * 4) = kk;
        const bool ok = s < SK;
#pragma unroll
        for (int e = 0; e < 4; ++e) sV[(part * 4 + e) * VSTR + key] = ok ? f2bf(vv[e]) : (u16)0;
      }
      __syncthreads();
    }
    if (active && jt < myt) {
      f32x4 s[2][4];
#pragma unroll
      for (int qt = 0; qt < 2; ++qt) {
        const float nb_ = (jt == 0) ? 0.f : -mrow[qt];
#pragma unroll
        for (int kt = 0; kt < 4; ++kt) s[qt][kt] = (f32x4){nb_, nb_, nb_, nb_};
      }
#pragma unroll
      for (int kt = 0; kt < 4; ++kt) {
#pragma unroll
        for (int ks = 0; ks < NKS; ++ks) {
          bf16x8 kf = *(const bf16x8*)(sK + (kt * 16 + fr) * KSTR + (ks >> 1) * 64 + ((ks & 1) ? ko1 : ko0));
          s[0][kt] = __builtin_amdgcn_mfma_f32_16x16x32_bf16(kf, qf[0][ks], s[0][kt], 0, 0, 0);
          s[1][kt] = __builtin_amdgcn_mfma_f32_16x16x32_bf16(kf, qf[1][ks], s[1][kt], 0, 0, 0);
        }
      }
      unsigned mlo[2] = {0u, 0u}, mhi[2] = {0u, 0u};
      if (MODE == 0) {
        if (key0 + 64 > nkeys) {
#pragma unroll
          for (int kt = 0; kt < 4; ++kt)
#pragma unroll
            for (int j = 0; j < 4; ++j)
              if (key0 + kt * 16 + fq * 4 + j >= nkeys) { s[0][kt][j] = -1e30f; s[1][kt][j] = -1e30f; }
        }
      } else {
        const bool far = (key0 + 63) - (qpos0 + wq0) <= -128;
        if (!far) {
#pragma unroll
          for (int qt = 0; qt < 2; ++qt) {
            const int rb = key0 + fq * 4 - (qpos0 + qrow[qt]) + 128;
#pragma unroll
            for (int kt = 0; kt < 4; ++kt)
#pragma unroll
              for (int j = 0; j < 4; ++j) {
                int r = min(max(rb + kt * 16 + j, 0), 256);
                s[qt][kt][j] += sBias[r];
              }
          }
        }
#pragma unroll
        for (int qt = 0; qt < 2; ++qt) {
          const unsigned long long mm = mq[qt] >> (fq * 4);
          mlo[qt] = (unsigned)mm; mhi[qt] = (unsigned)(mm >> 32);
        }
      }
      bf16x8 pf[2][2];
#pragma unroll
      for (int qt = 0; qt < 2; ++qt) {
        float mx = -1e30f;
#pragma unroll
        for (int kt = 0; kt < 4; ++kt)
#pragma unroll
          for (int j = 0; j < 4; ++j) mx = fmaxf(mx, s[qt][kt][j]);
        mx = xq_max(mx);
        const float delta = (jt == 0) ? mx : fmaxf(mx, 0.f);
        mrow[qt] = (jt == 0) ? delta : mrow[qt] + delta;
        const bool grow = __ballot(delta != 0.f) != 0ull;
        float alpha = 1.f;
        if (grow) {
          alpha = __builtin_amdgcn_exp2f(-delta);
#pragma unroll
          for (int kt = 0; kt < 4; ++kt) s[qt][kt] -= delta;
        }
        float rs = 0.f;
#pragma unroll
        for (int kt = 0; kt < 4; ++kt)
#pragma unroll
          for (int j = 0; j < 4; ++j) {
            float pv = __builtin_amdgcn_exp2f(s[qt][kt][j]);
            if (MODE == 1) {
              int keep;
              asm("v_bfe_i32 %0, %1, %2, 1" : "=v"(keep) : "v"(kt < 2 ? mlo[qt] : mhi[qt]), "n"((kt & 1) * 16 + j));
              pv = __int_as_float(__float_as_int(pv) & keep);
            }
            s[qt][kt][j] = pv; rs += pv;
          }
        rs = xq_sum(rs);
        lrow[qt] = lrow[qt] * alpha + rs;
        if (grow) {
#pragma unroll
          for (int dt = 0; dt < 8; ++dt) o[qt][dt] *= alpha;
        }
#pragma unroll
        for (int s2 = 0; s2 < 2; ++s2) {
          u32x4 pk;
          pk[0] = cvtpk(s[qt][2 * s2][0], s[qt][2 * s2][1]);
          pk[1] = cvtpk(s[qt][2 * s2][2], s[qt][2 * s2][3]);
          pk[2] = cvtpk(s[qt][2 * s2 + 1][0], s[qt][2 * s2 + 1][1]);
          pk[3] = cvtpk(s[qt][2 * s2 + 1][2], s[qt][2 * s2 + 1][3]);
          pf[qt][s2] = __builtin_bit_cast(bf16x8, pk);
        }
      }
#pragma unroll
      for (int dt = 0; dt < 8; ++dt) {
#pragma unroll
        for (int s2 = 0; s2 < 2; ++s2) {
          const u16* vp = sV + (dt * 16 + fr) * VSTR + fq * 4;
          u32x2 v0 = *(const u32x2*)(vp + (2 * s2) * 16);
          u32x2 v1 = *(const u32x2*)(vp + (2 * s2 + 1) * 16);
          u32x4 vv = {v0[0], v0[1], v1[0], v1[1]};
          bf16x8 vf = __builtin_bit_cast(bf16x8, vv);
          o[0][dt] = __builtin_amdgcn_mfma_f32_16x16x32_bf16(vf, pf[0][s2], o[0][dt], 0, 0, 0);
          o[1][dt] = __builtin_amdgcn_mfma_f32_16x16x32_bf16(vf, pf[1][s2], o[1][dt], 0, 0, 0);
        }
      }
    }
  }
  if (active) {
#pragma unroll
    for (int qt = 0; qt < 2; ++qt) {
      const int qr = wq0 + qt * 16 + fr;
      if (qr < nq) {
        const float inv = 1.f / lrow[qt];
        const size_t row = (size_t)(q0 + qr);
#pragma unroll
        for (int dt = 0; dt < 8; ++dt) {
          const size_t off = row * 2048 + h * 128 + dt * 16 + fq * 4;
          u32x2 ga = *(const u32x2*)(p.GA + off);
          u32x2 r;
          if (MODE == 0) {
            u32x2 gb = *(const u32x2*)(p.GB + off);
            r[0] = cvtpk(bflo(gb[0]) * o[qt][dt][0] * inv + bflo(ga[0]), bfhi(gb[0]) * o[qt][dt][1] * inv + bfhi(ga[0]));
            r[1] = cvtpk(bflo(gb[1]) * o[qt][dt][2] * inv + bflo(ga[1]), bfhi(gb[1]) * o[qt][dt][3] * inv + bfhi(ga[1]));
          } else {
            r[0] = cvtpk(bflo(ga[0]) * o[qt][dt][0] * inv, bfhi(ga[0]) * o[qt][dt][1] * inv);
            r[1] = cvtpk(bflo(ga[1]) * o[qt][dt][2] * inv, bfhi(ga[1]) * o[qt][dt][3] * inv);
          }
          *(u32x2*)(gdst + off) = r;
        }
      }
    }
  }
}

#undef KV_LOAD
#undef KV_STORE
__global__ void __launch_bounds__(NTHREADS) fwd_megakernel(Params p) {
  extern __shared__ __attribute__((aligned(16))) char smem[];
  cg::grid_group grid = cg::this_grid();
#define IDS const int tid = otid(); const int lane = tid & 63, w = tid >> 6; const int bid = blockIdx.x, nb = gridDim.x; \
  const int gw = bid * 8 + w, ngw = nb * 8; (void)tid; (void)lane; (void)gw; (void)ngw; (void)bid; (void)nb;

#if PH & (1 << 0)
  { IDS
  {
    const int vb = tid >> 8;
    float* st = (float*)(smem + vb * VB_LDS);
    const int vbid = bid * 2 + vb, nvb = nb * 2;
    for (int t = vbid; t < 32 * 192; t += nvb) transpose_tile(p.w_in, 2048, INC, p.WT_IN, t, st);
    for (int t = vbid; t < 8 * 48; t += nvb) transpose_tile(p.w_uq, 512, 3072, p.WT_UQ, t, st);
    for (int t = vbid; t < 4 * 32; t += nvb) transpose_tile(p.w_uk, 256, 2048, p.WT_UK, t, st);
    for (int t = vbid; t < 4 * 32; t += nvb) transpose_tile(p.w_uv, 256, 2048, p.WT_UV, t, st);
    for (int t = vbid; t < 32 * 32; t += nvb) transpose_tile(p.w_out, 2048, 2048, p.WT_OUT, t, st);
    for (int t = vbid; t < 32 * 128; t += nvb) transpose_tile(p.w_up, 2048, 8192, p.WT_UP, t, st);
    for (int t = vbid; t < 128 * 32; t += nvb) transpose_tile(p.w_down, 8192, 2048, p.WT_DOWN, t, st);
    for (int r = gw; r < MT; r += ngw) {
      const float* x = r < MP ? p.x_p + (size_t)r * 2048 : p.x_s + (size_t)(r - MP) * 2048;
      rms_row_2048(x, p.g_mix, p.H + (size_t)r * 2048, lane);
    }
    const int gt = bid * NTHREADS + tid, ngt = nb * NTHREADS;
    for (int i = gt; i < 16 * 1024 * 64 / 4; i += ngt) {
      int e = i * 4; int b = e >> 16; int rem = e & 65535; int s = rem >> 6, c = rem & 63;
      size_t dst = (size_t)(MP + b * SK + s) * 64 + c;
      f32x4 a = *(const f32x4*)(p.c_idx + e), k = *(const f32x4*)(p.c_kr + e);
      u32x2 o; o[0] = cvtpk(a[0], a[1]); o[1] = cvtpk(a[2], a[3]);
      *(u32x2*)(p.IXK + dst) = o;
      o[0] = cvtpk(k[0], k[1]); o[1] = cvtpk(k[2], k[3]);
      *(u32x2*)(p.KR + dst) = o;
    }
    for (int i = gt; i < 16 * 1024 * 256 / 4; i += ngt) {
      int e = i * 4; int b = e >> 18; int rem = e & 262143; int s = rem >> 8, c = rem & 255;
      size_t dst = (size_t)(MP + b * SK + s) * 256 + c;
      f32x4 a = *(const f32x4*)(p.c_ckv + e);
      u32x2 o; o[0] = cvtpk(a[0], a[1]); o[1] = cvtpk(a[2], a[3]);
      *(u32x2*)(p.CKV + dst) = o;
    }
  }
  }
#endif
  grid.sync();
#if PH & (1 << 1)
  { IDS
  for (int rep = 0; rep < NREP(1); ++rep) gemm_phase<EPI_IN>(p, p.H, 2048, p.WT_IN, 2048, 2048, MT / 256, INP / 256, smem, nullptr, 0, bid, nb);
  }
#endif
  grid.sync();
#if PH & (1 << 2)
  { IDS
  for (int t = gw; t < MT; t += ngw) post_row(p, t, lane);
  {
    const int vb = tid >> 8, vbid = bid * 2 + vb;
    char* sm = smem + vb * VB_LDS;
    for (int rep = 0; rep < NREP(2); ++rep) for (int t = vbid * NQ; t < MT; t += nb * 2 * NQ)
      topk_group(p, t, sm, (unsigned*)(p.out + O_Y + 14000000) + (size_t)vbid * 16384, (unsigned*)(p.out + O_Y + 14000000) + (size_t)(512 + vbid) * 16384,
                 (unsigned*)p.H + (size_t)vbid * 16384);
  }
  }
#endif
  grid.sync();
#if PH & (1 << 3)
  { IDS
    const int total = 1024 + 256;
    for (int rep = 0; rep < NREP(3); ++rep) {
      u16* gdst = (rep + 1 < NREP(3)) ? (u16*)(p.out + O_Y) : p.GA;
      for (int r = 0;; ++r) {
        int id = (r & 1) ? r * nb + (nb - 1 - bid) : r * nb + bid;
        if (r * nb >= total) break;
        if (id < total) attn_item<1>(p, id, smem, gdst);
      }
    }
  }
#endif
  grid.sync();
#if PH & (1 << 4)
  { IDS
  {
    const int gt = bid * NTHREADS + tid, ngt = nb * NTHREADS;
    for (int i = gt; i < MS * 2048 / 4; i += ngt)
      *(f32x4*)(p.out + O_Y + (size_t)MP * 2048 + (size_t)i * 4) = *(const f32x4*)(p.x_s + (size_t)i * 4);
    for (int i = gt; i < 16 * 2048 * 6; i += ngt) {
      int r = i / 6, c = i - r * 6;
      *(u32x4*)(p.VBT_S + (size_t)r * VSS + SK + c * 8) = (u32x4){0u, 0u, 0u, 0u};
    }
    const int nqb = (MT / 256) * 12, nkb = (KROWS / 256) * 8;
    const int total = nqb + 2 * nkb;
    for (int id = bid; id < total; id += nb) {
      if (id < nqb) gemm_phase<EPI_QB>(p, p.CQ, 512, p.WT_UQ, 512, 512, MT / 256, 12, smem, p.QB, 3072, id, 1 << 30);
      else if (id < nqb + nkb) gemm_phase<EPI_BF16>(p, p.CKV, 256, p.WT_UK, 256, 256, KROWS / 256, 8, smem, p.KB, 2048, id - nqb, 1 << 30);
      else gemm_phase<EPI_VT>(p, p.CKV, 256, p.WT_UV, 256, 256, KROWS / 256, 8, smem, nullptr, 0, id - nqb - nkb, 1 << 30);
    }
  }
  }
#endif
  grid.sync();
#if PH & (1 << 5)
  { IDS
  {
    const int total = 1024 + 256;
    for (int rep = 0; rep < NREP(5); ++rep) {
      u16* gdst = (rep + 1 < NREP(5)) ? (u16*)(p.out + O_Y) : p.GB;
      for (int r = 0;; ++r) {
        int id = (r & 1) ? r * nb + (nb - 1 - bid) : r * nb + bid;
        if (r * nb >= total) break;
        if (id < total) attn_item<0>(p, id, smem, gdst);
      }
    }
  }
  }
#endif
  grid.sync();
#if PH & (1 << 6)
  { IDS
  gemm_phase<EPI_RES>(p, p.GB, 2048, p.WT_OUT, 2048, 2048, MT / 256 - 1, 8, smem, nullptr, 0, bid, nb);
  for (int id = bid; id < 128; id += nb) {
    const int nt = id & 7, kc = id >> 3;
    gemm_tile<EPI_ATOM>(p, p.GB + kc * 128, 2048, p.WT_OUT + kc * 128, 2048, 128, (MT / 256 - 1) * 256, nt * 256, smem, nullptr, 0);
  }
  }
#endif
  grid.sync();
#if PH & (1 << 7)
  { IDS
  for (int r = gw; r < MT; r += ngw) rms_row_2048(p.out + O_Y + (size_t)r * 2048, p.g_ffn, p.H2 + (size_t)r * 2048, lane);
  }
#endif
  grid.sync();
#if PH & (1 << 8)
  { IDS
  for (int rep = 0; rep < NREP(8); ++rep) gemm_phase<EPI_RELU2>(p, p.H2, 2048, p.WT_UP, 2048, 2048, MT / 256, 32, smem, nullptr, 0, bid, nb);
  }
#endif
  grid.sync();
#if PH & (1 << 9)
  { IDS
  gemm_phase<EPI_ACC>(p, p.U, DFF, p.WT_DOWN, DFF, DFF, MT / 256 - 1, 8, smem, nullptr, 0, bid, nb);
  for (int id = bid; id < 256; id += nb) {
    const int nt = id & 7, kc = id >> 3;
    gemm_tile<EPI_ATOM>(p, p.U + kc * 256, DFF, p.WT_DOWN + kc * 256, DFF, 256, (MT / 256 - 1) * 256, nt * 256, smem, nullptr, 0);
  }
  }
#endif
  grid.sync();
#if PH & (1 << 10)
  { IDS
  for (int r = gw; r < MT; r += ngw) {
    float* x = p.out + O_Y + (size_t)r * 2048;
    f32x4 v[8];
    float ss = 0.f;
#pragma unroll
    for (int i = 0; i < 8; ++i) {
      v[i] = *(const f32x4*)(x + i * 256 + lane * 4);
      ss += v[i][0] * v[i][0] + v[i][1] * v[i][1] + v[i][2] * v[i][2] + v[i][3] * v[i][3];
    }
    ss = wave_sum(ss);
    float rr = rsqrtf(ss * (1.f / 2048.f) + 1e-6f);
#pragma unroll
    for (int i = 0; i < 8; ++i) {
      f32x4 gg = *(const f32x4*)(p.g_fin + i * 256 + lane * 4);
      f32x4 o = {v[i][0] * rr * gg[0], v[i][1] * rr * gg[1], v[i][2] * rr * gg[2], v[i][3] * rr * gg[3]};
      *(f32x4*)(x + i * 256 + lane * 4) = o;
    }
  }
  }
#endif
}

extern "C" void kernel_launch(void* const* d_in, const int* in_sizes, int n_in, void* d_out, int out_size, void* d_ws, size_t ws_size,
                              hipStream_t stream) {
  static int grid_blocks = 0;
  if (!grid_blocks) {
    int dev = 0, cus = 0, per_cu = 0;
    hipGetDevice(&dev);
    hipDeviceGetAttribute(&cus, hipDeviceAttributeMultiprocessorCount, dev);
    if (hipFuncSetAttribute((const void*)fwd_megakernel, hipFuncAttributeMaxDynamicSharedMemorySize, LDS_BYTES) != hipSuccess)
      fprintf(stderr, "kernel_launch: hipFuncSetAttribute failed\n");
    hipOccupancyMaxActiveBlocksPerMultiprocessor(&per_cu, (const void*)fwd_megakernel, NTHREADS, LDS_BYTES);
    if (per_cu < 1) per_cu = 1;
    if (per_cu > 1) per_cu = 1;
    grid_blocks = cus * per_cu;
  }
  Params p{};
  const float* const* in = (const float* const*)d_in;
  p.x_p = in[0]; p.x_s = in[1]; p.c_ak = in[2]; p.c_av = in[3]; p.c_idx = in[4]; p.c_ckv = in[5]; p.c_kr = in[6]; p.rel = in[7];
  p.g_mix = in[8]; p.w_in = in[9]; p.g_q = in[10]; p.w_uq = in[11]; p.g_kv = in[12]; p.w_uk = in[13]; p.w_uv = in[14]; p.w_out = in[15];
  p.g_ffn = in[16]; p.w_up = in[17]; p.w_down = in[18]; p.g_fin = in[19];
  p.out = (float*)d_out;
  char* ws = (char*)d_ws;
  size_t off = 0;
  auto alloc = [&](size_t bytes) { char* r = ws + off; off += (bytes + 255) & ~(size_t)255; return r; };
  p.WT_UQ = (u16*)alloc((size_t)3072 * 512 * 2);
  p.WT_UK = (u16*)alloc((size_t)2048 * 256 * 2);
  p.WT_UV = (u16*)alloc((size_t)2048 * 256 * 2);
  p.WT_OUT = (u16*)alloc((size_t)2048 * 2048 * 2);
  p.WT_UP = (u16*)alloc((size_t)8192 * 2048 * 2);
  p.WT_DOWN = (u16*)alloc((size_t)2048 * 8192 * 2);
  p.CQ = (u16*)alloc((size_t)MT * 512 * 2);
  p.CKV = (u16*)alloc((size_t)KROWS * 256 * 2);
  p.KR = (u16*)alloc((size_t)KROWS * 64 * 2);
  p.GA = (u16*)alloc((size_t)MT * 2048 * 2);
  p.GB = (u16*)alloc((size_t)MT * 2048 * 2);
  p.CS = (float*)alloc((size_t)MT * 32 * 4);
  p.SN = (float*)alloc((size_t)MT * 32 * 4);
  const size_t ubase = off;
  p.WT_IN = (u16*)alloc((size_t)INP * 2048 * 2);
  p.H = (u16*)alloc((size_t)MT * 2048 * 2);
  p.AQ = (u16*)alloc((size_t)MT * 2048 * 2);
  p.KA = (u16*)alloc((size_t)MP * 2048 * 2);
  p.VAT = (u16*)alloc((size_t)MP * 2048 * 2);
  p.IXQ = (u16*)alloc((size_t)MT * 1024 * 2);
  p.IXK = (u16*)alloc((size_t)KROWS * 64 * 2);
  p.SEL = (unsigned long long*)alloc((size_t)MT * 256 * 8);
  p.IXW = (float*)alloc((size_t)MT * 16 * 4);
  const size_t endA = off;
  off = ubase;
  p.QB = (u16*)alloc((size_t)MT * 3072 * 2);
  p.KB = (u16*)alloc((size_t)KROWS * 2048 * 2);
  p.VBT_P = (u16*)alloc((size_t)2048 * MP * 2);
  p.VBT_S = (u16*)alloc((size_t)16 * 2048 * VSS * 2);
  const size_t endB = off;
  off = ubase;
  p.H2 = (u16*)alloc((size_t)MT * 2048 * 2);
  p.U = (u16*)alloc((size_t)MT * DFF * 2);
  const size_t endC = off;
  size_t need = endA > endB ? endA : endB;
  if (endC > need) need = endC;
  if (need > ws_size) { fprintf(stderr, "kernel_launch: workspace too small: need %zu have %zu\n", need, ws_size); return; }
  void* args[] = {&p};
  hipError_t e = hipLaunchCooperativeKernel((const void*)fwd_megakernel, dim3(grid_blocks), dim3(NTHREADS), args, LDS_BYTES, stream);
  if (e != hipSuccess) fprintf(stderr, "cooperative launch failed: %s (grid %d)\n", hipGetErrorString(e), grid_blocks);
}
```

```cpp
#include <hip/hip_runtime.h>
#include <hip/hip_cooperative_groups.h>
#include <cstdio>
#include <cstdint>
namespace cg = cooperative_groups;

typedef unsigned short u16;
typedef __attribute__((ext_vector_type(8))) short bf16x8;
typedef __attribute__((ext_vector_type(4))) short bf16x4;
typedef __attribute__((ext_vector_type(4))) float f32x4;
typedef __attribute__((ext_vector_type(2))) float f32x2;
typedef __attribute__((ext_vector_type(2))) __bf16 bf16x2_t;
typedef __attribute__((ext_vector_type(4))) unsigned u32x4;
typedef __attribute__((ext_vector_type(2))) unsigned u32x2;

#define DI __device__ __forceinline__

constexpr int MP = 16384;
constexpr int MS = 256;
constexpr int MT = MP + MS;
constexpr int DM = 2048;
constexpr int INC = 12176;
constexpr int INP = 12288;
constexpr int SK = 1040;
constexpr int KROWS = MP + 16 * SK;
constexpr int VSS = 1088;
constexpr int DFF = 8192;
constexpr int ZRW = 832;
#ifndef PH
#define PH 0x7ff
#endif
#ifndef REP
#define REP 0
#endif
#define NREP(k) (((REP >> (k)) & 1) + 1)
constexpr int NTHREADS = 512;
constexpr int VB_LDS = 75776;
constexpr int LDS_BYTES = 2 * VB_LDS;

constexpr size_t O_Y = 0;
constexpr size_t O_AKP = 34078720;
constexpr size_t O_AVP = 67633152;
constexpr size_t O_IDXP = 101187584;
constexpr size_t O_CKVP = 102236160;
constexpr size_t O_KRP = 106430464;
constexpr size_t O_AKS = 107479040;
constexpr size_t O_AVS = 108003328;
constexpr size_t O_IDXS = 108527616;
constexpr size_t O_CKVS = 108544000;
constexpr size_t O_KRS = 108609536;

struct Params {
  const float *x_p, *x_s, *c_ak, *c_av, *c_idx, *c_ckv, *c_kr, *rel, *g_mix, *w_in, *g_q, *w_uq, *g_kv, *w_uk, *w_uv, *w_out, *g_ffn, *w_up, *w_down, *g_fin;
  float* out;
  u16 *WT_UQ, *WT_UK, *WT_UV, *WT_OUT, *WT_UP, *WT_DOWN, *CQ, *CKV, *KR, *GA, *GB;
  float *CS, *SN;
  u16 *WT_IN, *H, *AQ, *KA, *VAT, *IXQ, *IXK;
  float* IXW;
  unsigned long long* SEL;
  u16 *QB, *KB, *VBT_P, *VBT_S;
  u16 *H2, *U;
};

DI int otid() { int t = threadIdx.x; asm volatile("" : "+v"(t)); return t; }
DI unsigned cvtpk(float lo, float hi) {
  f32x2 v = {lo, hi};
  bf16x2_t b = __builtin_convertvector(v, bf16x2_t);
  return __builtin_bit_cast(unsigned, b);
}
DI u16 f2bf(float x) { return (u16)(cvtpk(x, 0.f) & 0xffffu); }
DI float bf2f(u16 b) { return __uint_as_float(((unsigned)b) << 16); }
DI float bflo(unsigned w) { return __uint_as_float(w << 16); }
DI float bfhi(unsigned w) { return __uint_as_float(w & 0xffff0000u); }
DI float dot2bf(unsigned a, unsigned b, float c) {
  return __builtin_amdgcn_fdot2_f32_bf16(__builtin_bit_cast(bf16x2_t, a), __builtin_bit_cast(bf16x2_t, b), c, false);
}
DI float wave_sum(float v) {
#pragma unroll
  for (int o = 32; o > 0; o >>= 1) v += __shfl_xor(v, o);
  return v;
}
DI int qpos_of(int t) { return t < MP ? t : 1024 + ((t - MP) & 15); }
DI int krow_of(int t) { return t < MP ? t : MP + ((t - MP) >> 4) * SK + 1024 + ((t - MP) & 15); }
DI float inv_freq(int i) { return exp2f(-(float)i * 0.41524101186092029f); }

DI void transpose_tile2(const float* __restrict__ W, int K, int N, u16* __restrict__ Wt, int tileA, int tileB, float* s  ) {
  const int nkt = K >> 6;
  const int tid = otid() & 255;
  const int c = tid & 63, r0 = tid >> 6;
  const bool hasB = tileB >= 0;
  const int tb = hasB ? tileB : tileA;
  const int kA = (tileA % nkt) << 6, nA = (tileA / nkt) << 6, kB = (tb % nkt) << 6, nB = (tb / nkt) << 6;
  float va[16], vb[16];
#pragma unroll
  for (int i = 0; i < 16; ++i) va[i] = (nA + c < N) ? W[(size_t)(kA + i * 4 + r0) * N + nA + c] : 0.f;
#pragma unroll
  for (int i = 0; i < 16; ++i) vb[i] = (nB + c < N) ? W[(size_t)(kB + i * 4 + r0) * N + nB + c] : 0.f;
  __syncthreads();
#pragma unroll
  for (int i = 0; i < 16; ++i) { s[(i * 4 + r0) * 65 + c] = va[i]; s[4160 + (i * 4 + r0) * 65 + c] = vb[i]; }
  __syncthreads();
  const int kp = (tid & 31) * 2, rr0 = tid >> 5;
#pragma unroll
  for (int i = 0; i < 8; ++i) {
    const int rr = i * 8 + rr0;
    *(unsigned*)(Wt + (size_t)(nA + rr) * K + kA + kp) = cvtpk(s[kp * 65 + rr], s[(kp + 1) * 65 + rr]);
    if (hasB) *(unsigned*)(Wt + (size_t)(nB + rr) * K + kB + kp) = cvtpk(s[4160 + kp * 65 + rr], s[4160 + (kp + 1) * 65 + rr]);
  }
}

DI void rms_row_2048(const float* __restrict__ x, const float* __restrict__ g, u16* __restrict__ out, int lane) {
  f32x4 v[8];
  float ss = 0.f;
#pragma unroll
  for (int i = 0; i < 8; ++i) {
    v[i] = *(const f32x4*)(x + i * 256 + lane * 4);
    ss += v[i][0] * v[i][0] + v[i][1] * v[i][1] + v[i][2] * v[i][2] + v[i][3] * v[i][3];
  }
  ss = wave_sum(ss);
  float r = rsqrtf(ss * (1.f / 2048.f) + 1e-6f);
#pragma unroll
  for (int i = 0; i < 8; ++i) {
    f32x4 gg = *(const f32x4*)(g + i * 256 + lane * 4);
    u32x2 o;
    o[0] = cvtpk(v[i][0] * r * gg[0], v[i][1] * r * gg[1]);
    o[1] = cvtpk(v[i][2] * r * gg[2], v[i][3] * r * gg[3]);
    *(u32x2*)(out + i * 256 + lane * 4) = o;
  }
}

enum { EPI_IN = 0, EPI_QB, EPI_BF16, EPI_VT, EPI_RES, EPI_RELU2, EPI_ACC, EPI_ATOM };
constexpr float QSC = 0.07216878364870322f * 1.4426950408889634f;
constexpr int LSTR = 64;
#ifndef PFA
#define PFA 8
#endif

template <int EPI> struct EpiSwap { static constexpr bool v = (EPI != EPI_VT); };

DI u32x2 pack4(f32x4 v) { u32x2 r; r[0] = cvtpk(v[0], v[1]); r[1] = cvtpk(v[2], v[3]); return r; }
DI float relu_i(float x) { return __int_as_float(max(__float_as_int(x), 0)); }
DI float sigm(float v) { return __builtin_amdgcn_rcpf(1.f + __builtin_amdgcn_exp2f(v * -1.4426950408889634f)); }

template <int EPI>
DI void gemm_epilogue(const Params& p, f32x4 (&acc)[8][4], int m0, int n0, int wr, int wc, int fr, int fq, u16* Cb, int ldc) {
  const int cw = n0 + wc * 64;
  if (EPI == EPI_VT) {
#pragma clang loop unroll(full)
    for (int m = 0; m < 8; ++m) {
      const int rb = m0 + wr * 128 + m * 16 + fq * 4;
#pragma clang loop unroll(full)
      for (int n = 0; n < 4; ++n) {
        const int col = cw + n * 16 + fr;
        u16* dst;
        if (rb < MP) dst = p.VBT_P + (size_t)col * MP + rb;
        else { int r2 = rb - MP; int b = r2 / SK; int s = r2 - b * SK; dst = p.VBT_S + ((size_t)b * 2048 + col) * VSS + s; }
        *(u32x2*)dst = pack4(acc[m][n]);
      }
    }
    return;
  }
  const int rbase = m0 + wr * 128 + fr;
  const int c4 = fq * 4;
  if (EPI == EPI_QB) {
    if (cw % 192 == 128) {
#pragma clang loop unroll(full)
      for (int m = 0; m < 8; ++m) {
        const int row = rbase + m * 16;
#pragma clang loop unroll(full)
        for (int n = 0; n < 2; ++n) {
          const int i0 = n * 16 + c4;
          const f32x4 cs = *(const f32x4*)(p.CS + (size_t)row * 32 + i0), sn = *(const f32x4*)(p.SN + (size_t)row * 32 + i0);
          const f32x4 x1 = acc[m][n] * QSC, x2 = acc[m][n + 2] * QSC;
          *(u32x2*)(p.QB + (size_t)row * 3072 + cw + i0) = pack4(x1 * cs - x2 * sn);
          *(u32x2*)(p.QB + (size_t)row * 3072 + cw + i0 + 32) = pack4(x1 * sn + x2 * cs);
        }
      }
      return;
    }
  }
#pragma clang loop unroll(full)
  for (int n = 0; n < 4; ++n) {
    const int colt = cw + n * 16;
    const int col = colt + c4;
    if (EPI == EPI_IN) {
      const bool smp = m0 >= MP;
      if (colt < 2048) {
#pragma clang loop unroll(full)
        for (int m = 0; m < 8; ++m) *(u32x2*)(p.AQ + (size_t)(rbase + m * 16) * 2048 + col) = pack4(acc[m][n] * (0.08838834764831845f * 1.4426950408889634f));
      } else if (colt < 4096) {
        const int c = col - 2048;
#pragma clang loop unroll(full)
        for (int m = 0; m < 8; ++m) {
          const int row = rbase + m * 16;
          if (!smp) { *(f32x4*)(p.out + O_AKP + (size_t)row * 2048 + c) = acc[m][n]; *(u32x2*)(p.KA + (size_t)row * 2048 + c) = pack4(acc[m][n]); }
          else *(f32x4*)(p.out + O_AKS + (size_t)(row - MP) * 2048 + c) = acc[m][n];
        }
      } else if (colt < 6144) {
        const int c = col - 4096;
#pragma clang loop unroll(full)
        for (int m = 0; m < 8; ++m) {
          const int row = rbase + m * 16;
          if (!smp) {
            *(f32x4*)(p.out + O_AVP + (size_t)row * 2048 + c) = acc[m][n];
#pragma clang loop unroll(full)
            for (int j = 0; j < 4; ++j) p.VAT[(size_t)(c + j) * MP + row] = f2bf(acc[m][n][j]);
          } else *(f32x4*)(p.out + O_AVS + (size_t)(row - MP) * 2048 + c) = acc[m][n];
        }
      } else if (colt < 7168) {
#pragma clang loop unroll(full)
        for (int m = 0; m < 8; ++m) *(u32x2*)(p.IXQ + (size_t)(rbase + m * 16) * 1024 + (col - 6144)) = pack4(acc[m][n]);
      } else if (colt < 7232) {
        const int c = col - 7168;
#pragma clang loop unroll(full)
        for (int m = 0; m < 8; ++m) {
          const int row = rbase + m * 16;
          if (!smp) *(f32x4*)(p.out + O_IDXP + (size_t)row * 64 + c) = acc[m][n];
          else *(f32x4*)(p.out + O_IDXS + (size_t)(row - MP) * 64 + c) = acc[m][n];
          *(u32x2*)(p.IXK + (size_t)krow_of(row) * 64 + c) = pack4(acc[m][n]);
        }
      } else if (colt < 7248) {
#pragma clang loop unroll(full)
        for (int m = 0; m < 8; ++m) *(f32x4*)(p.IXW + (size_t)(rbase + m * 16) * 16 + (col - 7232)) = acc[m][n] * 0.25f;
      } else if (colt < 8080) {
#pragma clang loop unroll(full)
        for (int m = 0; m < 8; ++m) *(f32x4*)(p.out + O_Y + (size_t)(rbase + m * 16) * ZRW + (col - 7248)) = acc[m][n];
      } else if (colt < INC) {
        u16* G = colt < 10128 ? p.GA : p.GB;
        const int c = colt < 10128 ? col - 8080 : col - 10128;
#pragma clang loop unroll(full)
        for (int m = 0; m < 8; ++m) {
          f32x4 v = acc[m][n];
          f32x4 g = {sigm(v[0]), sigm(v[1]), sigm(v[2]), sigm(v[3])};
          *(u32x2*)(G + (size_t)(rbase + m * 16) * 2048 + c) = pack4(g);
        }
      }
    } else {
#pragma clang loop unroll(full)
      for (int m = 0; m < 8; ++m) {
        const int row = rbase + m * 16;
        const f32x4 v = acc[m][n];
        if (EPI == EPI_QB) {
          *(u32x2*)(Cb + (size_t)row * ldc + col) = pack4(v * QSC);
        } else if (EPI == EPI_BF16) {
          *(u32x2*)(Cb + (size_t)row * ldc + col) = pack4(v);
        } else if (EPI == EPI_RES) {
          const f32x4 xv = row < MP ? *(const f32x4*)(p.x_p + (size_t)row * 2048 + col) : *(const f32x4*)(p.x_s + (size_t)(row - MP) * 2048 + col);
          *(f32x4*)(p.out + O_Y + (size_t)row * 2048 + col) = xv + v;
          if ((m & 3) == 3) __builtin_amdgcn_sched_barrier(0);
        } else if (EPI == EPI_RELU2) {
          f32x4 r = {relu_i(v[0]), relu_i(v[1]), relu_i(v[2]), relu_i(v[3])};
          *(u32x2*)(p.U + (size_t)row * DFF + col) = pack4(r * r);
        } else if (EPI == EPI_ACC) {
          float* d = p.out + O_Y + (size_t)row * 2048 + col;
          *(f32x4*)d = *(const f32x4*)d + v;
          if ((m & 3) == 3) __builtin_amdgcn_sched_barrier(0);
        } else if (EPI == EPI_ATOM) {
#pragma clang loop unroll(full)
          for (int j = 0; j < 4; ++j) atomicAdd(p.out + O_Y + (size_t)row * 2048 + col + j, v[j]);
        }
      }
    }
  }
}

constexpr int GSTAGE = 512 * LSTR;
template <int EPI>
DI void gemm_tile(const Params& p, const u16* __restrict__ A, int lda, const u16* __restrict__ Bt, int ldb, int K, int m0, int n0,
                  char* smem, u16* Cb, int ldc) {
  u16* sbase = (u16*)smem;
  const int tid = otid(), lane = tid & 63, w = tid >> 6;
  const int wr = w >> 2, wc = w & 3, fr = lane & 15, fq = lane >> 4;
  f32x4 acc[8][4];
#pragma unroll
  for (int m = 0; m < 8; ++m)
#pragma unroll
    for (int n = 0; n < 4; ++n) acc[m][n] = (f32x4){0.f, 0.f, 0.f, 0.f};
  const int lr = tid >> 3, lk = (tid & 7) * 8;
  const int lkw = ((tid & 7) ^ ((lr >> 1) & 7)) * 8;
  const int fsw = (fr >> 1) & 7, fo0 = (fq ^ fsw) * 8, fo1 = ((4 + fq) ^ fsw) * 8;
  const u16* Ag = A + (size_t)(m0 + lr) * lda + lk;
  const u16* Bg = Bt + (size_t)(n0 + lr) * ldb + lk;
  const int nk = K >> 6;
  u32x4 ra[4], rb[4];
#define G_LOAD(T) { const int k_ = (T) << 6; _Pragma("unroll") for (int i = 0; i < 4; ++i) { \
    ra[i] = *(const u32x4*)(Ag + (size_t)(i * 64) * lda + k_); rb[i] = *(const u32x4*)(Bg + (size_t)(i * 64) * ldb + k_); } }
#define L_STORE(ST) { u16* dA_ = sbase + (ST) * GSTAGE + lr * LSTR + lkw; u16* dB_ = dA_ + 256 * LSTR; _Pragma("unroll") for (int i = 0; i < 4; ++i) { \
    *(u32x4*)(dA_ + i * 64 * LSTR) = ra[i]; *(u32x4*)(dB_ + i * 64 * LSTR) = rb[i]; } }
  G_LOAD(0)
  L_STORE(0)
  G_LOAD(1)
#pragma unroll 1
  for (int kt = 0; kt < nk; ++kt) {
    __syncthreads();
    if (kt + 1 < nk) L_STORE((kt + 1) & 1)
    G_LOAD(min(kt + 2, nk - 1))
    const u16* cA = sbase + (kt & 1) * GSTAGE + (wr * 128 + fr) * LSTR;
    const u16* cB = sbase + (kt & 1) * GSTAGE + 256 * LSTR + (wc * 64 + fr) * LSTR;
#pragma unroll
    for (int ks = 0; ks < 2; ++ks) {
      bf16x8 bfr[4];
#pragma unroll
      for (int n = 0; n < 4; ++n) bfr[n] = *(const bf16x8*)(cB + n * 16 * LSTR + (ks ? fo1 : fo0));
#pragma unroll
      for (int mh = 0; mh < 2; ++mh) {
        bf16x8 af[4];
#pragma unroll
        for (int m = 0; m < 4; ++m) af[m] = *(const bf16x8*)(cA + (mh * 4 + m) * 16 * LSTR + (ks ? fo1 : fo0));
        __builtin_amdgcn_s_setprio(1);
#pragma unroll
        for (int m = 0; m < 4; ++m)
#pragma unroll
          for (int n = 0; n < 4; ++n)
            acc[mh * 4 + m][n] = EpiSwap<EPI>::v ? __builtin_amdgcn_mfma_f32_16x16x32_bf16(bfr[n], af[m], acc[mh * 4 + m][n], 0, 0, 0)
                                                 : __builtin_amdgcn_mfma_f32_16x16x32_bf16(af[m], bfr[n], acc[mh * 4 + m][n], 0, 0, 0);
        __builtin_amdgcn_s_setprio(0);
      }
    }
  }
#undef G_LOAD
#undef L_STORE
  gemm_epilogue<EPI>(p, acc, m0, n0, wr, wc, fr, fq, Cb, ldc);
}

template <int EPI>
DI void gemm_phase(const Params& p, const u16* A, int lda, const u16* Bt, int ldb, int K, int mtiles, int ntiles, char* smem, u16* Cb, int ldc,
                   int start, int stride) {
  if (stride == 256) {
    const int gm = (mtiles + 3) >> 2, gn = (ntiles + 7) >> 3, nsg = gm * gn;
    const int xcd = start & 7, li = start >> 3;
    for (int sg = xcd; sg < nsg; sg += 8) {
      const int gni = sg / gm, gmi = sg - gni * gm;
      const int mt = gmi * 4 + (li & 3), nt = gni * 8 + (li >> 2);
      if (mt < mtiles && nt < ntiles) gemm_tile<EPI>(p, A, lda, Bt, ldb, K, mt * 256, nt * 256, smem, Cb, ldc);
    }
    return;
  }
  const int total = mtiles * ntiles;
  const int GM = 8;
  for (int id = start; id < total; id += stride) {
    const int per = GM * ntiles;
    const int g = id / per, rem = id - g * per;
    const int fm = g * GM;
    const int gsz = min(GM, mtiles - fm);
    const int mt = fm + rem % gsz, nt = rem / gsz;
    gemm_tile<EPI>(p, A, lda, Bt, ldb, K, mt * 256, nt * 256, smem, Cb, ldc);
  }
}

DI void post_row(const Params& p, int t, int lane) {
  const float* zr = p.out + O_Y + (size_t)t * ZRW;
  {
    f32x4 a = *(const f32x4*)(zr + lane * 4), b = *(const f32x4*)(zr + 256 + lane * 4);
    float ss = a[0] * a[0] + a[1] * a[1] + a[2] * a[2] + a[3] * a[3] + b[0] * b[0] + b[1] * b[1] + b[2] * b[2] + b[3] * b[3];
    ss = wave_sum(ss);
    float r = rsqrtf(ss * (1.f / 512.f) + 1e-6f);
    f32x4 ga = *(const f32x4*)(p.g_q + lane * 4), gb = *(const f32x4*)(p.g_q + 256 + lane * 4);
    u32x2 o;
    o[0] = cvtpk(a[0] * r * ga[0], a[1] * r * ga[1]); o[1] = cvtpk(a[2] * r * ga[2], a[3] * r * ga[3]);
    *(u32x2*)(p.CQ + (size_t)t * 512 + lane * 4) = o;
    o[0] = cvtpk(b[0] * r * gb[0], b[1] * r * gb[1]); o[1] = cvtpk(b[2] * r * gb[2], b[3] * r * gb[3]);
    *(u32x2*)(p.CQ + (size_t)t * 512 + 256 + lane * 4) = o;
  }
  const int kr_row = krow_of(t);
  {
    f32x4 a = *(const f32x4*)(zr + 512 + lane * 4);
    float ss = a[0] * a[0] + a[1] * a[1] + a[2] * a[2] + a[3] * a[3];
    ss = wave_sum(ss);
    float r = rsqrtf(ss * (1.f / 256.f) + 1e-6f);
    f32x4 g = *(const f32x4*)(p.g_kv + lane * 4);
    f32x4 o = {a[0] * r * g[0], a[1] * r * g[1], a[2] * r * g[2], a[3] * r * g[3]};
    float* od = t < MP ? p.out + O_CKVP + (size_t)t * 256 : p.out + O_CKVS + (size_t)(t - MP) * 256;
    *(f32x4*)(od + lane * 4) = o;
    u32x2 ob; ob[0] = cvtpk(o[0], o[1]); ob[1] = cvtpk(o[2], o[3]);
    *(u32x2*)(p.CKV + (size_t)kr_row * 256 + lane * 4) = ob;
  }
  if (lane < 32) {
    float x1 = zr[768 + lane], x2 = zr[768 + 32 + lane];
    float ang = (float)qpos_of(t) * inv_freq(lane);
    float cs = cosf(ang), sn = sinf(ang);
    p.CS[(size_t)t * 32 + lane] = cs; p.SN[(size_t)t * 32 + lane] = sn;
    float o1 = x1 * cs - x2 * sn, o2 = x1 * sn + x2 * cs;
    float* od = t < MP ? p.out + O_KRP + (size_t)t * 64 : p.out + O_KRS + (size_t)(t - MP) * 64;
    od[lane] = o1; od[lane + 32] = o2;
    p.KR[(size_t)kr_row * 64 + lane] = f2bf(o1);
    p.KR[(size_t)kr_row * 64 + lane + 32] = f2bf(o2);
  }
}

template <int CTRL> DI float dpp_add(float v) {
  int sft = __builtin_amdgcn_update_dpp(0, __float_as_int(v), CTRL, 0xf, 0xf, true);
  return v + __int_as_float(sft);
}
DI float row16_sum(float v) { v = dpp_add<0x111>(v); v = dpp_add<0x112>(v); v = dpp_add<0x114>(v); v = dpp_add<0x118>(v); return v; }
DI unsigned fkey(float f) { unsigned u = __float_as_uint(f); return (u & 0x80000000u) ? ~u : (u | 0x80000000u); }

DI void radix_select(unsigned* sc, int* hist, int* misc, int n, unsigned long long* sel, int tid, int lane, int w) {
  __syncthreads();
  unsigned prefix = 0;
  int remaining = 256, neq = 0;
  bool done = false;
#pragma unroll 1
  for (int pass = 0; pass < 3; ++pass) {
    const int shift = pass == 0 ? 21 : (pass == 1 ? 10 : 0);
    const int bits = pass == 2 ? 10 : 11;
    const unsigned bmask = (1u << bits) - 1u;
    if (done) {
      __syncthreads(); __syncthreads(); __syncthreads(); __syncthreads(); __syncthreads();
      continue;
    }
    if (pass > 0) {
      *(int4*)&hist[tid * 8] = make_int4(0, 0, 0, 0);
      *(int4*)&hist[tid * 8 + 4] = make_int4(0, 0, 0, 0);
      __syncthreads();
      const int hs = shift + bits;
      const unsigned want = prefix >> hs;
      for (int i = tid * 4; i < n; i += 256 * 4) {
        const u32x4 u4 = *(const u32x4*)(sc + i);
#pragma unroll
        for (int e = 0; e < 4; ++e)
          if ((u4[e] >> hs) == want) atomicAdd(&hist[(u4[e] >> shift) & bmask], 1);
      }
      __syncthreads();
    }
    const int4 h0 = *(const int4*)&hist[tid * 8], h1 = *(const int4*)&hist[tid * 8 + 4];
    const int s8 = h0.x + h0.y + h0.z + h0.w + h1.x + h1.y + h1.z + h1.w;
    int suf = s8;
#pragma unroll
    for (int d = 1; d < 64; d <<= 1) { int v = __shfl_down(suf, d); if (lane + d < 64) suf += v; }
    if (lane == 0) misc[w] = suf;
    __syncthreads();
    int above = 0;
    for (int ww = w + 1; ww < 4; ++ww) above += misc[ww];
    const int excl = above + suf - s8;
    if (excl < remaining && remaining <= excl + s8) {
      int c = excl, bin = 0, nrem = 0, bpop = 0;
#define TK_STEP(val, idx) if (c < remaining && remaining <= c + (val)) { bin = tid * 8 + (idx); nrem = remaining - c; bpop = (val); } c += (val);
      TK_STEP(h1.w, 7) TK_STEP(h1.z, 6) TK_STEP(h1.y, 5) TK_STEP(h1.x, 4) TK_STEP(h0.w, 3) TK_STEP(h0.z, 2) TK_STEP(h0.y, 1) TK_STEP(h0.x, 0)
#undef TK_STEP
      misc[4] = bin; misc[5] = nrem; misc[6] = bpop;
    }
    __syncthreads();
    prefix |= ((unsigned)misc[4]) << shift;
    remaining = misc[5];
    neq = misc[6];
    done = (neq == remaining);
    __syncthreads();
  }
  const unsigned T = prefix;
  const int seg = ((n + 255) >> 8) << 6;
  const int beg = w * seg;
  if (neq == remaining) {
    for (int i0 = beg; i0 < beg + seg; i0 += 64) {
      const int i = i0 + lane;
      const bool in = i < n; const unsigned u = in ? sc[i] : 0u;
      const unsigned long long sm = __ballot(in && u >= T);
      if (lane == 0 && i0 < n) sel[i0 >> 6] = sm;
    }
    __syncthreads();
    return;
  }
  int ceq = 0;
  for (int i = beg + lane; i < beg + seg; i += 64) {
    bool in = i < n; unsigned u = in ? sc[i] : 0u;
    ceq += __popcll(__ballot(in && u == T));
  }
  if (lane == 0) misc[12 + w] = ceq;
  __syncthreads();
  int oe = 0;
  for (int ww = 0; ww < w; ++ww) oe += misc[12 + ww];
  const unsigned long long lt = (1ull << lane) - 1ull;
  for (int i0 = beg; i0 < beg + seg; i0 += 64) {
    const int i = i0 + lane;
    bool in = i < n; unsigned u = in ? sc[i] : 0u;
    bool g = in && u > T, e = in && u == T;
    unsigned long long be = __ballot(e);
    int pe = oe + __popcll(be & lt);
    unsigned long long sm = __ballot(g || (e && pe < remaining));
    if (lane == 0 && i0 < n) sel[i0 >> 6] = sm;
    oe += __popcll(be);
  }
}

constexpr int NQ = 4;
DI void topk_group(const Params& p, int t, char* smem, unsigned* scr1, unsigned* scr2, unsigned* scr3) {
  unsigned* sc = (unsigned*)smem;
  int* hist = (int*)(smem + 65536);
  int* misc = hist + 2048;
  const int tid = otid() & 255, lane = tid & 63, w = tid >> 6, fr = lane & 15, fq = lane >> 4;
  int n; const u16* ixk;
  if (t < MP) { n = 64 * ((t >> 6) + 1); ixk = p.IXK; }
  else { int b = (t - MP) >> 4; n = SK; ixk = p.IXK + (size_t)(MP + b * SK) * 64; }
  unsigned long long* sel = p.SEL + (size_t)t * 256;
  __syncthreads();
  if (n <= 256) {
    if (tid < 4) {
      unsigned long long v = (tid < (n >> 6)) ? ~0ull : 0ull;
#pragma unroll
      for (int qi = 0; qi < NQ; ++qi) sel[qi * 256 + tid] = v;
    }
    return;
  }
  *(int4*)&hist[tid * 8] = make_int4(0, 0, 0, 0);
  *(int4*)&hist[tid * 8 + 4] = make_int4(0, 0, 0, 0);
  __syncthreads();
  {
    const u16* q = p.IXQ + (size_t)t * 1024 + fr * 64 + fq * 8;
    bf16x8 a0[NQ], a1[NQ];
    f32x4 wv[NQ];
#pragma unroll
    for (int qi = 0; qi < NQ; ++qi) {
      a0[qi] = *(const bf16x8*)(q + qi * 1024); a1[qi] = *(const bf16x8*)(q + qi * 1024 + 32);
      wv[qi] = *(const f32x4*)(p.IXW + (size_t)(t + qi) * 16 + fq * 4);
    }
    const int ntile = n >> 4;
    for (int kt0 = w; kt0 < ntile; kt0 += 32) {
      bf16x8 b0[8], b1[8];
#pragma unroll
      for (int g = 0; g < 8; ++g) {
        const int kt = min(kt0 + g * 4, ntile - 1);
        const u16* kp = ixk + (size_t)(kt * 16 + fr) * 64 + fq * 8;
        b0[g] = *(const bf16x8*)kp; b1[g] = *(const bf16x8*)(kp + 32);
      }
      float pt[NQ][8];
#pragma unroll
      for (int g = 0; g < 8; ++g) {
#pragma unroll
        for (int qi = 0; qi < NQ; ++qi) {
          f32x4 c = {0.f, 0.f, 0.f, 0.f};
          c = __builtin_amdgcn_mfma_f32_16x16x32_bf16(a0[qi], b0[g], c, 0, 0, 0);
          c = __builtin_amdgcn_mfma_f32_16x16x32_bf16(a1[qi], b1[g], c, 0, 0, 0);
          pt[qi][g] = relu_i(c[0]) * wv[qi][0] + relu_i(c[1]) * wv[qi][1] + relu_i(c[2]) * wv[qi][2] + relu_i(c[3]) * wv[qi][3];
        }
      }
#pragma unroll
      for (int g = 0; g < 8; g += 2) {
        const int kt = kt0 + (g + (lane >> 5)) * 4;
        const bool st = (lane & 16) == 0 && kt < ntile;
#pragma unroll
        for (int qi = 0; qi < NQ; ++qi) {
          auto r32 = __builtin_amdgcn_permlane32_swap(__float_as_uint(pt[qi][g]), __float_as_uint(pt[qi][g + 1]), false, false);
          float s2 = __uint_as_float(r32[0]) + __uint_as_float(r32[1]);
          auto r16 = __builtin_amdgcn_permlane16_swap(__float_as_uint(s2), __float_as_uint(s2), false, false);
          float sv = __uint_as_float(r16[0]) + __uint_as_float(r16[1]);
          if (st) {
            unsigned u = fkey(sv);
            if (qi == 0) { sc[kt * 16 + fr] = u; atomicAdd(&hist[u >> 21], 1); }
            else if (qi == 1) scr1[kt * 16 + fr] = u;
            else if (qi == 2) scr2[kt * 16 + fr] = u;
            else scr3[kt * 16 + fr] = u;
          }
        }
      }
    }
  }
  radix_select(sc, hist, misc, n, sel, tid, lane, w);
#pragma unroll 1
  for (int qi = 1; qi < NQ; ++qi) {
    const unsigned* scr = qi == 1 ? scr1 : (qi == 2 ? scr2 : scr3);
    __syncthreads();
    *(int4*)&hist[tid * 8] = make_int4(0, 0, 0, 0);
    *(int4*)&hist[tid * 8 + 4] = make_int4(0, 0, 0, 0);
    __syncthreads();
    for (int i = tid * 4; i < n; i += 256 * 4) {
      const u32x4 u4 = *(const u32x4*)(scr + i);
      *(u32x4*)(sc + i) = u4;
#pragma unroll
      for (int e = 0; e < 4; ++e) atomicAdd(&hist[u4[e] >> 21], 1);
    }
    radix_select(sc, hist, misc, n, sel + qi * 256, tid, lane, w);
  }
}

constexpr int KSTR = 192;
constexpr int VSTR = 72;
DI float xq_max(float x) {
  auto a = __builtin_amdgcn_permlane16_swap(__float_as_uint(x), __float_as_uint(x), false, false);
  x = fmaxf(__uint_as_float(a[0]), __uint_as_float(a[1]));
  auto b = __builtin_amdgcn_permlane32_swap(__float_as_uint(x), __float_as_uint(x), false, false);
  return fmaxf(__uint_as_float(b[0]), __uint_as_float(b[1]));
}
DI float xq_sum(float x) {
  auto a = __builtin_amdgcn_permlane16_swap(__float_as_uint(x), __float_as_uint(x), false, false);
  x = __uint_as_float(a[0]) + __uint_as_float(a[1]);
  auto b = __builtin_amdgcn_permlane32_swap(__float_as_uint(x), __float_as_uint(x), false, false);
  return __uint_as_float(b[0]) + __uint_as_float(b[1]);
}

template <int MODE>
DI void attn_item(const Params& p, int item, char* smem, u16* gdst) {
  constexpr int NKS = MODE == 0 ? 6 : 4;
  constexpr int ASTAGE = 64 * KSTR + 128 * VSTR;
  u16* sbase = (u16*)smem;
  float* sBias = (float*)(sbase + 2 * ASTAGE);
  const int tid = otid(), lane = tid & 63, w = tid >> 6, fr = lane & 15, fq = lane >> 4;
  const int ksw = (fr >> 1) & 7, ko0 = (fq ^ ksw) * 8, ko1 = ((4 + fq) ^ ksw) * 8;
  int h, q0, nq, krow0, nkeys, ntiles, myt, b = 0, qpos0;
  const u16* vt; size_t vstride;
  const bool sample = item >= 1024;
  if (!sample) {
    const int i = 63 - (item >> 4);
    h = item & 15; q0 = i * 256; nq = 256; krow0 = 0; nkeys = q0 + 256; ntiles = 4 * i + 4; qpos0 = q0;
    vt = (MODE == 0 ? p.VBT_P : p.VAT) + (size_t)h * 128 * MP; vstride = MP;
    myt = ntiles - 3 + (w >> 1);
  } else {
    const int j = item - 1024; b = j >> 4;
    h = j & 15; q0 = MP + b * 16; nq = 16; krow0 = MP + b * SK; nkeys = SK; ntiles = 17; qpos0 = 1024;
    vt = p.VBT_S + ((size_t)b * 2048 + h * 128) * VSS; vstride = VSS;
    myt = ntiles;
  }
  const int wq0 = w * 32;
  const bool active = wq0 < nq;
  __syncthreads();
  if (MODE == 1) {
    for (int i = tid; i < 257; i += NTHREADS) {
      int rel = i - 128;
      int ret = rel > 0 ? 16 : 0;
      int n = rel < 0 ? -rel : rel;
      float lf = logf((float)max(n, 1) / 8.0f) / 2.772588722239781f * 8.0f;
      int large = min(8 + (int)lf, 15);
      int bk = ret + (n < 8 ? n : large);
      sBias[i] = (p.rel[bk * 16 + h] - p.rel[15 * 16 + h]) * 1.4426950408889634f;
    }
  }
  bf16x8 qf[2][NKS];
  int qrow[2];
#pragma unroll
  for (int qt = 0; qt < 2; ++qt) {
    const int qr = min(wq0 + qt * 16 + fr, nq - 1);
    qrow[qt] = qr;
    const u16* qp = (MODE == 0) ? p.QB + (size_t)(q0 + qr) * 3072 + h * 192 + fq * 8 : p.AQ + (size_t)(q0 + qr) * 2048 + h * 128 + fq * 8;
#pragma unroll
    for (int ks = 0; ks < NKS; ++ks) qf[qt][ks] = *(const bf16x8*)(qp + ks * 32);
  }
  f32x4 o[2][8];
#pragma unroll
  for (int qt = 0; qt < 2; ++qt)
#pragma unroll
    for (int dt = 0; dt < 8; ++dt) o[qt][dt] = (f32x4){0.f, 0.f, 0.f, 0.f};
  float mrow[2] = {-1e30f, -1e30f}, lrow[2] = {0.f, 0.f};
  const float SC = (MODE == 0 ? 0.07216878364870322f : 0.08838834764831845f) * 1.4426950408889634f;

  unsigned long long mqn[2] = {0ull, 0ull};
  if (MODE == 1) {
#pragma unroll
    for (int qt = 0; qt < 2; ++qt) mqn[qt] = p.SEL[(size_t)(q0 + qrow[qt]) * 256];
  }
  constexpr int NKL = MODE == 0 ? 3 : 2;
  const bool direct = (MODE == 1) && sample;
  u32x4 rk[NKL], rv[2];
#define KV_LOAD(JT) { const size_t kr0_ = (size_t)(krow0 + (JT) * 64); const u16* kb_ = (MODE == 0 ? p.KB : p.KA) + (kr0_ + (tid >> 4)) * 2048 + h * 128 + (tid & 15) * 8; \
    _Pragma("unroll") for (int i = 0; i < 2; ++i) rk[i] = *(const u32x4*)(kb_ + (size_t)i * 32 * 2048); \
    if (MODE == 0) rk[NKL - 1] = *(const u32x4*)(p.KR + (kr0_ + (tid >> 3)) * 64 + (tid & 7) * 8); \
    const u16* vp_ = vt + (size_t)(tid >> 3) * vstride + (JT) * 64 + (tid & 7) * 8; \
    _Pragma("unroll") for (int i = 0; i < 2; ++i) rv[i] = *(const u32x4*)(vp_ + (size_t)i * 64 * vstride); }
#define KV_STORE(ST) { u16* sk_ = sbase + (ST) * ASTAGE; u16* dk_ = sk_ + (tid >> 4) * KSTR + ((tid & 15) ^ ((tid >> 5) & 7)) * 8; \
    _Pragma("unroll") for (int i = 0; i < 2; ++i) *(u32x4*)(dk_ + i * 32 * KSTR) = rk[i]; \
    if (MODE == 0) *(u32x4*)(sk_ + (tid >> 3) * KSTR + 128 + ((tid & 7) ^ ((tid >> 4) & 7)) * 8) = rk[NKL - 1]; \
    u16* dv_ = sk_ + 64 * KSTR + (tid >> 3) * VSTR + (tid & 7) * 8; \
    _Pragma("unroll") for (int i = 0; i < 2; ++i) *(u32x4*)(dv_ + i * 64 * VSTR) = rv[i]; }
  if (!direct) {
    KV_LOAD(0)
    KV_STORE(0)
    KV_LOAD(min(1, ntiles - 1))
  }
  for (int jt = 0; jt < ntiles; ++jt) {
    const int key0 = jt * 64;
    u16* sK = sbase + (jt & 1) * ASTAGE;
    u16* sV = sK + 64 * KSTR;
    unsigned long long mq[2] = {mqn[0], mqn[1]};
    if (MODE == 1) {
      const int jn = min(jt + 1, ntiles - 1);
#pragma unroll
      for (int qt = 0; qt < 2; ++qt) mqn[qt] = p.SEL[(size_t)(q0 + qrow[qt]) * 256 + jn];
    }
    __syncthreads();
    if (!direct) {
      if (jt + 1 < ntiles) KV_STORE((jt + 1) & 1)
      KV_LOAD(min(jt + 2, ntiles - 1))
    } else {
#pragma unroll 2
      for (int i = 0; i < 4; ++i) {
        const int c = tid + i * NTHREADS;
        const int key = c >> 5, part = c & 31;
        const int s = key0 + key;
        const int sc_ = min(s, SK - 1);
        const size_t o1 = sc_ < 1024 ? ((size_t)b * 1024 + sc_) * 2048 : ((size_t)b * 16 + (sc_ - 1024)) * 2048;
        const float* kp = (sc_ < 1024 ? p.c_ak : p.out + O_AKS) + o1 + h * 128 + part * 4;
        const float* vp = (sc_ < 1024 ? p.c_av : p.out + O_AVS) + o1 + h * 128 + part * 4;
        f32x4 kv = *(const f32x4*)kp, vv = *(const f32x4*)vp;
        u32x2 kk; kk[0] = cvtpk(kv[0], kv[1]); kk[1] = cvtpk(kv[2], kv[3]);
        *(u32x2*)(sK + key * KSTR + (((part >> 1) ^ ((key >> 1) & 7)) * 8) + (part & 1) * 4) = kk;
        const bool ok = s < SK;
#pragma unroll
        for (int e = 0; e < 4; ++e) sV[(part * 4 + e) * VSTR + key] = ok ? f2bf(vv[e]) : (u16)0;
      }
      __syncthreads();
    }
    if (active && jt < myt) {
      f32x4 s[2][4];
#pragma unroll
      for (int qt = 0; qt < 2; ++qt) {
        const float nb_ = (jt == 0) ? 0.f : -mrow[qt];
#pragma unroll
        for (int kt = 0; kt < 4; ++kt) s[qt][kt] = (f32x4){nb_, nb_, nb_, nb_};
      }
#pragma unroll
      for (int kt = 0; kt < 4; ++kt) {
#pragma unroll
        for (int ks = 0; ks < NKS; ++ks) {
          bf16x8 kf = *(const bf16x8*)(sK + (kt * 16 + fr) * KSTR + (ks >> 1) * 64 + ((ks & 1) ? ko1 : ko0));
          s[0][kt] = __builtin_amdgcn_mfma_f32_16x16x32_bf16(kf, qf[0][ks], s[0][kt], 0, 0, 0);
          s[1][kt] = __builtin_amdgcn_mfma_f32_16x16x32_bf16(kf, qf[1][ks], s[1][kt], 0, 0, 0);
        }
      }
      unsigned mlo[2] = {0u, 0u}, mhi[2] = {0u, 0u};
      if (MODE == 0) {
        if (key0 + 64 > nkeys) {
#pragma unroll
          for (int kt = 0; kt < 4; ++kt)
#pragma unroll
            for (int j = 0; j < 4; ++j)
              if (key0 + kt * 16 + fq * 4 + j >= nkeys) { s[0][kt][j] = -1e30f; s[1][kt][j] = -1e30f; }
        }
      } else {
        const bool far = (key0 + 63) - (qpos0 + wq0) <= -128;
        if (!far) {
#pragma unroll
          for (int qt = 0; qt < 2; ++qt) {
            const int rb = key0 + fq * 4 - (qpos0 + qrow[qt]) + 128;
#pragma unroll
            for (int kt = 0; kt < 4; ++kt)
#pragma unroll
              for (int j = 0; j < 4; ++j) {
                int r = min(max(rb + kt * 16 + j, 0), 256);
                s[qt][kt][j] += sBias[r];
              }
          }
        }
#pragma unroll
        for (int qt = 0; qt < 2; ++qt) {
          const unsigned long long mm = mq[qt] >> (fq * 4);
          mlo[qt] = (unsigned)mm; mhi[qt] = (unsigned)(mm >> 32);
        }
      }
      bf16x8 pf[2][2];
#pragma unroll
      for (int qt = 0; qt < 2; ++qt) {
        float mx = -1e30f;
#pragma unroll
        for (int kt = 0; kt < 4; ++kt)
#pragma unroll
          for (int j = 0; j < 4; ++j) mx = fmaxf(mx, s[qt][kt][j]);
        mx = xq_max(mx);
        const float delta = (jt == 0) ? mx : fmaxf(mx, 0.f);
        mrow[qt] = (jt == 0) ? delta : mrow[qt] + delta;
        const bool grow = __ballot(delta != 0.f) != 0ull;
        float alpha = 1.f;
        if (grow) {
          alpha = __builtin_amdgcn_exp2f(-delta);
#pragma unroll
          for (int kt = 0; kt < 4; ++kt) s[qt][kt] -= delta;
        }
        float rs = 0.f;
#pragma unroll
        for (int kt = 0; kt < 4; ++kt)
#pragma unroll
          for (int j = 0; j < 4; ++j) {
            float pv = __builtin_amdgcn_exp2f(s[qt][kt][j]);
            if (MODE == 1) {
              int keep;
              asm("v_bfe_i32 %0, %1, %2, 1" : "=v"(keep) : "v"(kt < 2 ? mlo[qt] : mhi[qt]), "n"((kt & 1) * 16 + j));
              pv = __int_as_float(__float_as_int(pv) & keep);
            }
            s[qt][kt][j] = pv; rs += pv;
          }
        rs = xq_sum(rs);
        lrow[qt] = lrow[qt] * alpha + rs;
        if (grow) {
#pragma unroll
          for (int dt = 0; dt < 8; ++dt) o[qt][dt] *= alpha;
        }
#pragma unroll
        for (int s2 = 0; s2 < 2; ++s2) {
          u32x4 pk;
          pk[0] = cvtpk(s[qt][2 * s2][0], s[qt][2 * s2][1]);
          pk[1] = cvtpk(s[qt][2 * s2][2], s[qt][2 * s2][3]);
          pk[2] = cvtpk(s[qt][2 * s2 + 1][0], s[qt][2 * s2 + 1][1]);
          pk[3] = cvtpk(s[qt][2 * s2 + 1][2], s[qt][2 * s2 + 1][3]);
          pf[qt][s2] = __builtin_bit_cast(bf16x8, pk);
        }
      }
#pragma unroll
      for (int dt = 0; dt < 8; ++dt) {
#pragma unroll
        for (int s2 = 0; s2 < 2; ++s2) {
          const u16* vp = sV + (dt * 16 + fr) * VSTR + fq * 4;
          u32x2 v0 = *(const u32x2*)(vp + (2 * s2) * 16);
          u32x2 v1 = *(const u32x2*)(vp + (2 * s2 + 1) * 16);
          u32x4 vv = {v0[0], v0[1], v1[0], v1[1]};
          bf16x8 vf = __builtin_bit_cast(bf16x8, vv);
          o[0][dt] = __builtin_amdgcn_mfma_f32_16x16x32_bf16(vf, pf[0][s2], o[0][dt], 0, 0, 0);
          o[1][dt] = __builtin_amdgcn_mfma_f32_16x16x32_bf16(vf, pf[1][s2], o[1][dt], 0, 0, 0);
        }
      }
    }
  }
  if (active) {
#pragma unroll
    for (int qt = 0; qt < 2; ++qt) {
      const int qr = wq0 + qt * 16 + fr;
      if (qr < nq) {
        const float inv = 1.f / lrow[qt];
        const size_t row = (size_t)(q0 + qr);
#pragma unroll
        for (int dt = 0; dt < 8; ++dt) {
          const size_t off = row * 2048 + h * 128 + dt * 16 + fq * 4;
          u32x2 ga = *(const u32x2*)(p.GA + off);
          u32x2 r;
          if (MODE == 0) {
            u32x2 gb = *(const u32x2*)(p.GB + off);
            r[0] = cvtpk(bflo(gb[0]) * o[qt][dt][0] * inv + bflo(ga[0]), bfhi(gb[0]) * o[qt][dt][1] * inv + bfhi(ga[0]));
            r[1] = cvtpk(bflo(gb[1]) * o[qt][dt][2] * inv + bflo(ga[1]), bfhi(gb[1]) * o[qt][dt][3] * inv + bfhi(ga[1]));
          } else {
            r[0] = cvtpk(bflo(ga[0]) * o[qt][dt][0] * inv, bfhi(ga[0]) * o[qt][dt][1] * inv);
            r[1] = cvtpk(bflo(ga[1]) * o[qt][dt][2] * inv, bfhi(ga[1]) * o[qt][dt][3] * inv);
          }
          *(u32x2*)(gdst + off) = r;
        }
      }
    }
  }
}

#undef KV_LOAD
#undef KV_STORE
__global__ void __launch_bounds__(NTHREADS) fwd_megakernel(Params p) {
  extern __shared__ __attribute__((aligned(16))) char smem[];
  cg::grid_group grid = cg::this_grid();
#define IDS const int tid = otid(); const int lane = tid & 63, w = tid >> 6; const int bid = blockIdx.x, nb = gridDim.x; \
  const int gw = bid * 8 + w, ngw = nb * 8; (void)tid; (void)lane; (void)gw; (void)ngw; (void)bid; (void)nb;

#if PH & (1 << 0)
  { IDS
  {
    const int vb = tid >> 8;
    float* st = (float*)(smem + vb * VB_LDS);
    const int vbid = bid * 2 + vb, nvb = nb * 2;
    for (int t = vbid; t < 32 * 192; t += 2 * nvb) transpose_tile2(p.w_in, 2048, INC, p.WT_IN, t, (t + nvb < 32 * 192) ? t + nvb : -1, st);
    for (int t = vbid; t < 8 * 48; t += 2 * nvb) transpose_tile2(p.w_uq, 512, 3072, p.WT_UQ, t, (t + nvb < 8 * 48) ? t + nvb : -1, st);
    for (int t = vbid; t < 4 * 32; t += 2 * nvb) transpose_tile2(p.w_uk, 256, 2048, p.WT_UK, t, (t + nvb < 4 * 32) ? t + nvb : -1, st);
    for (int t = vbid; t < 4 * 32; t += 2 * nvb) transpose_tile2(p.w_uv, 256, 2048, p.WT_UV, t, (t + nvb < 4 * 32) ? t + nvb : -1, st);
    for (int t = vbid; t < 32 * 32; t += 2 * nvb) transpose_tile2(p.w_out, 2048, 2048, p.WT_OUT, t, (t + nvb < 32 * 32) ? t + nvb : -1, st);
    for (int t = vbid; t < 32 * 128; t += 2 * nvb) transpose_tile2(p.w_up, 2048, 8192, p.WT_UP, t, (t + nvb < 32 * 128) ? t + nvb : -1, st);
    for (int t = vbid; t < 128 * 32; t += 2 * nvb) transpose_tile2(p.w_down, 8192, 2048, p.WT_DOWN, t, (t + nvb < 128 * 32) ? t + nvb : -1, st);
    for (int r = gw; r < MT; r += ngw) {
      const float* x = r < MP ? p.x_p + (size_t)r * 2048 : p.x_s + (size_t)(r - MP) * 2048;
      rms_row_2048(x, p.g_mix, p.H + (size_t)r * 2048, lane);
    }
    const int gt = bid * NTHREADS + tid, ngt = nb * NTHREADS;
    for (int i = gt; i < 16 * 1024 * 64 / 4; i += ngt) {
      int e = i * 4; int b = e >> 16; int rem = e & 65535; int s = rem >> 6, c = rem & 63;
      size_t dst = (size_t)(MP + b * SK + s) * 64 + c;
      f32x4 a = *(const f32x4*)(p.c_idx + e), k = *(const f32x4*)(p.c_kr + e);
      u32x2 o; o[0] = cvtpk(a[0], a[1]); o[1] = cvtpk(a[2], a[3]);
      *(u32x2*)(p.IXK + dst) = o;
      o[0] = cvtpk(k[0], k[1]); o[1] = cvtpk(k[2], k[3]);
      *(u32x2*)(p.KR + dst) = o;
    }
    for (int i = gt; i < 16 * 1024 * 256 / 4; i += ngt) {
      int e = i * 4; int b = e >> 18; int rem = e & 262143; int s = rem >> 8, c = rem & 255;
      size_t dst = (size_t)(MP + b * SK + s) * 256 + c;
      f32x4 a = *(const f32x4*)(p.c_ckv + e);
      u32x2 o; o[0] = cvtpk(a[0], a[1]); o[1] = cvtpk(a[2], a[3]);
      *(u32x2*)(p.CKV + dst) = o;
    }
  }
  }
#endif
  grid.sync();
#if PH & (1 << 1)
  { IDS
  for (int rep = 0; rep < NREP(1); ++rep) gemm_phase<EPI_IN>(p, p.H, 2048, p.WT_IN, 2048, 2048, MT / 256, INP / 256, smem, nullptr, 0, bid, nb);
  }
#endif
  grid.sync();
#if PH & (1 << 2)
  { IDS
  for (int t = gw; t < MT; t += ngw) post_row(p, t, lane);
  {
    const int vb = tid >> 8, vbid = bid * 2 + vb;
    char* sm = smem + vb * VB_LDS;
    for (int rep = 0; rep < NREP(2); ++rep) for (int t = vbid * NQ; t < MT; t += nb * 2 * NQ)
      topk_group(p, t, sm, (unsigned*)(p.out + O_Y + 14000000) + (size_t)vbid * 16384, (unsigned*)(p.out + O_Y + 14000000) + (size_t)(512 + vbid) * 16384,
                 (unsigned*)p.H + (size_t)vbid * 16384);
  }
  }
#endif
  grid.sync();
#if PH & (1 << 3)
  { IDS
    const int total = 1024 + 256;
    for (int rep = 0; rep < NREP(3); ++rep) {
      u16* gdst = (rep + 1 < NREP(3)) ? (u16*)(p.out + O_Y) : p.GA;
      for (int r = 0;; ++r) {
        int id = (r & 1) ? r * nb + (nb - 1 - bid) : r * nb + bid;
        if (r * nb >= total) break;
        if (id < total) attn_item<1>(p, id, smem, gdst);
      }
    }
  }
#endif
  grid.sync();
#if PH & (1 << 4)
  { IDS
  {
    const int gt = bid * NTHREADS + tid, ngt = nb * NTHREADS;
    for (int i = gt; i < MS * 2048 / 4; i += ngt)
      *(f32x4*)(p.out + O_Y + (size_t)MP * 2048 + (size_t)i * 4) = *(const f32x4*)(p.x_s + (size_t)i * 4);
    for (int i = gt; i < 16 * 2048 * 6; i += ngt) {
      int r = i / 6, c = i - r * 6;
      *(u32x4*)(p.VBT_S + (size_t)r * VSS + SK + c * 8) = (u32x4){0u, 0u, 0u, 0u};
    }
    const int nqb = (MT / 256) * 12, nkb = (KROWS / 256) * 8;
    const int total = nqb + 2 * nkb;
    for (int id = bid; id < total; id += nb) {
      if (id < nqb) gemm_phase<EPI_QB>(p, p.CQ, 512, p.WT_UQ, 512, 512, MT / 256, 12, smem, p.QB, 3072, id, 1 << 30);
      else if (id < nqb + nkb) gemm_phase<EPI_BF16>(p, p.CKV, 256, p.WT_UK, 256, 256, KROWS / 256, 8, smem, p.KB, 2048, id - nqb, 1 << 30);
      else gemm_phase<EPI_VT>(p, p.CKV, 256, p.WT_UV, 256, 256, KROWS / 256, 8, smem, nullptr, 0, id - nqb - nkb, 1 << 30);
    }
  }
  }
#endif
  grid.sync();
#if PH & (1 << 5)
  { IDS
  {
    const int total = 1024 + 256;
    for (int rep = 0; rep < NREP(5); ++rep) {
      u16* gdst = (rep + 1 < NREP(5)) ? (u16*)(p.out + O_Y) : p.GB;
      for (int r = 0;; ++r) {
        int id = (r & 1) ? r * nb + (nb - 1 - bid) : r * nb + bid;
        if (r * nb >= total) break;
        if (id < total) attn_item<0>(p, id, smem, gdst);
      }
    }
  }
  }
#endif
  grid.sync();
#if PH & (1 << 6)
  { IDS
  gemm_phase<EPI_RES>(p, p.GB, 2048, p.WT_OUT, 2048, 2048, MT / 256 - 1, 8, smem, nullptr, 0, bid, nb);
  for (int id = bid; id < 128; id += nb) {
    const int nt = id & 7, kc = id >> 3;
    gemm_tile<EPI_ATOM>(p, p.GB + kc * 128, 2048, p.WT_OUT + kc * 128, 2048, 128, (MT / 256 - 1) * 256, nt * 256, smem, nullptr, 0);
  }
  }
#endif
  grid.sync();
#if PH & (1 << 7)
  { IDS
  for (int r = gw; r < MT; r += ngw) rms_row_2048(p.out + O_Y + (size_t)r * 2048, p.g_ffn, p.H2 + (size_t)r * 2048, lane);
  }
#endif
  grid.sync();
#if PH & (1 << 8)
  { IDS
  for (int rep = 0; rep < NREP(8); ++rep) gemm_phase<EPI_RELU2>(p, p.H2, 2048, p.WT_UP, 2048, 2048, MT / 256, 32, smem, nullptr, 0, bid, nb);
  }
#endif
  grid.sync();
#if PH & (1 << 9)
  { IDS
  gemm_phase<EPI_ACC>(p, p.U, DFF, p.WT_DOWN, DFF, DFF, MT / 256 - 1, 8, smem, nullptr, 0, bid, nb);
  for (int id = bid; id < 256; id += nb) {
    const int nt = id & 7, kc = id >> 3;
    gemm_tile<EPI_ATOM>(p, p.U + kc * 256, DFF, p.WT_DOWN + kc * 256, DFF, 256, (MT / 256 - 1) * 256, nt * 256, smem, nullptr, 0);
  }
  }
#endif
  grid.sync();
#if PH & (1 << 10)
  { IDS
  for (int r = gw; r < MT; r += ngw) {
    float* x = p.out + O_Y + (size_t)r * 2048;
    f32x4 v[8];
    float ss = 0.f;
#pragma unroll
    for (int i = 0; i < 8; ++i) {
      v[i] = *(const f32x4*)(x + i * 256 + lane * 4);
      ss += v[i][0] * v[i][0] + v[i][1] * v[i][1] + v[i][2] * v[i][2] + v[i][3] * v[i][3];
    }
    ss = wave_sum(ss);
    float rr = rsqrtf(ss * (1.f / 2048.f) + 1e-6f);
#pragma unroll
    for (int i = 0; i < 8; ++i) {
      f32x4 gg = *(const f32x4*)(p.g_fin + i * 256 + lane * 4);
      f32x4 o = {v[i][0] * rr * gg[0], v[i][1] * rr * gg[1], v[i][2] * rr * gg[2], v[i][3] * rr * gg[3]};
      *(f32x4*)(x + i * 256 + lane * 4) = o;
    }
  }
  }
#endif
}

extern "C" void kernel_launch(void* const* d_in, const int* in_sizes, int n_in, void* d_out, int out_size, void* d_ws, size_t ws_size,
                              hipStream_t stream) {
  static int grid_blocks = 0;
  if (!grid_blocks) {
    int dev = 0, cus = 0, per_cu = 0;
    hipGetDevice(&dev);
    hipDeviceGetAttribute(&cus, hipDeviceAttributeMultiprocessorCount, dev);
    if (hipFuncSetAttribute((const void*)fwd_megakernel, hipFuncAttributeMaxDynamicSharedMemorySize, LDS_BYTES) != hipSuccess)
      fprintf(stderr, "kernel_launch: hipFuncSetAttribute failed\n");
    hipOccupancyMaxActiveBlocksPerMultiprocessor(&per_cu, (const void*)fwd_megakernel, NTHREADS, LDS_BYTES);
    if (per_cu < 1) per_cu = 1;
    if (per_cu > 1) per_cu = 1;
    grid_blocks = cus * per_cu;
  }
  Params p{};
  const float* const* in = (const float* const*)d_in;
  p.x_p = in[0]; p.x_s = in[1]; p.c_ak = in[2]; p.c_av = in[3]; p.c_idx = in[4]; p.c_ckv = in[5]; p.c_kr = in[6]; p.rel = in[7];
  p.g_mix = in[8]; p.w_in = in[9]; p.g_q = in[10]; p.w_uq = in[11]; p.g_kv = in[12]; p.w_uk = in[13]; p.w_uv = in[14]; p.w_out = in[15];
  p.g_ffn = in[16]; p.w_up = in[17]; p.w_down = in[18]; p.g_fin = in[19];
  p.out = (float*)d_out;
  char* ws = (char*)d_ws;
  size_t off = 0;
  auto alloc = [&](size_t bytes) { char* r = ws + off; off += (bytes + 255) & ~(size_t)255; return r; };
  p.WT_UQ = (u16*)alloc((size_t)3072 * 512 * 2);
  p.WT_UK = (u16*)alloc((size_t)2048 * 256 * 2);
  p.WT_UV = (u16*)alloc((size_t)2048 * 256 * 2);
  p.WT_OUT = (u16*)alloc((size_t)2048 * 2048 * 2);
  p.WT_UP = (u16*)alloc((size_t)8192 * 2048 * 2);
  p.WT_DOWN = (u16*)alloc((size_t)2048 * 8192 * 2);
  p.CQ = (u16*)alloc((size_t)MT * 512 * 2);
  p.CKV = (u16*)alloc((size_t)KROWS * 256 * 2);
  p.KR = (u16*)alloc((size_t)KROWS * 64 * 2);
  p.GA = (u16*)alloc((size_t)MT * 2048 * 2);
  p.GB = (u16*)alloc((size_t)MT * 2048 * 2);
  p.CS = (float*)alloc((size_t)MT * 32 * 4);
  p.SN = (float*)alloc((size_t)MT * 32 * 4);
  const size_t ubase = off;
  p.WT_IN = (u16*)alloc((size_t)INP * 2048 * 2);
  p.H = (u16*)alloc((size_t)MT * 2048 * 2);
  p.AQ = (u16*)alloc((size_t)MT * 2048 * 2);
  p.KA = (u16*)alloc((size_t)MP * 2048 * 2);
  p.VAT = (u16*)alloc((size_t)MP * 2048 * 2);
  p.IXQ = (u16*)alloc((size_t)MT * 1024 * 2);
  p.IXK = (u16*)alloc((size_t)KROWS * 64 * 2);
  p.SEL = (unsigned long long*)alloc((size_t)MT * 256 * 8);
  p.IXW = (float*)alloc((size_t)MT * 16 * 4);
  const size_t endA = off;
  off = ubase;
  p.QB = (u16*)alloc((size_t)MT * 3072 * 2);
  p.KB = (u16*)alloc((size_t)KROWS * 2048 * 2);
  p.VBT_P = (u16*)alloc((size_t)2048 * MP * 2);
  p.VBT_S = (u16*)alloc((size_t)16 * 2048 * VSS * 2);
  const size_t endB = off;
  off = ubase;
  p.H2 = (u16*)alloc((size_t)MT * 2048 * 2);
  p.U = (u16*)alloc((size_t)MT * DFF * 2);
  const size_t endC = off;
  size_t need = endA > endB ? endA : endB;
  if (endC > need) need = endC;
  if (need > ws_size) { fprintf(stderr, "kernel_launch: workspace too small: need %zu have %zu\n", need, ws_size); return; }
  void* args[] = {&p};
  hipError_t e = hipLaunchCooperativeKernel((const void*)fwd_megakernel, dim3(grid_blocks), dim3(NTHREADS), args, LDS_BYTES, stream);
  if (e != hipSuccess) fprintf(stderr, "cooperative launch failed: %s (grid %d)\n", hipGetErrorString(e), grid_blocks);
}
```

```cpp
#include <hip/hip_runtime.h>
#include <hip/hip_cooperative_groups.h>
#include <cstdio>
#include <cstdint>
namespace cg = cooperative_groups;

typedef unsigned short u16;
typedef __attribute__((ext_vector_type(8))) short bf16x8;
typedef __attribute__((ext_vector_type(4))) short bf16x4;
typedef __attribute__((ext_vector_type(4))) float f32x4;
typedef __attribute__((ext_vector_type(2))) float f32x2;
typedef __attribute__((ext_vector_type(2))) __bf16 bf16x2_t;
typedef __attribute__((ext_vector_type(4))) unsigned u32x4;
typedef __attribute__((ext_vector_type(2))) unsigned u32x2;

#define DI __device__ __forceinline__

constexpr int MP = 16384;
constexpr int MS = 256;
constexpr int MT = MP + MS;
constexpr int DM = 2048;
constexpr int INC = 12176;
constexpr int INP = 12288;
constexpr int SK = 1040;
constexpr int KROWS = MP + 16 * SK;
constexpr int VSS = 1088;
constexpr int DFF = 8192;
constexpr int ZRW = 832;
#ifndef PH
#define PH 0x7ff
#endif
#ifndef REP
#define REP 0
#endif
#define NREP(k) (((REP >> (k)) & 1) + 1)
constexpr int NTHREADS = 512;
constexpr int VB_LDS = 75776;
constexpr int LDS_BYTES = 2 * VB_LDS;

constexpr size_t O_Y = 0;
constexpr size_t O_AKP = 34078720;
constexpr size_t O_AVP = 67633152;
constexpr size_t O_IDXP = 101187584;
constexpr size_t O_CKVP = 102236160;
constexpr size_t O_KRP = 106430464;
constexpr size_t O_AKS = 107479040;
constexpr size_t O_AVS = 108003328;
constexpr size_t O_IDXS = 108527616;
constexpr size_t O_CKVS = 108544000;
constexpr size_t O_KRS = 108609536;

struct Params {
  const float *x_p, *x_s, *c_ak, *c_av, *c_idx, *c_ckv, *c_kr, *rel, *g_mix, *w_in, *g_q, *w_uq, *g_kv, *w_uk, *w_uv, *w_out, *g_ffn, *w_up, *w_down, *g_fin;
  float* out;
  u16 *WT_UQ, *WT_UK, *WT_UV, *WT_OUT, *WT_UP, *WT_DOWN, *CQ, *CKV, *KR, *GA, *GB;
  float *CS, *SN;
  u16 *WT_IN, *H, *AQ, *KA, *VAT, *IXQ, *IXK;
  float* IXW;
  unsigned long long* SEL;
  u16 *QB, *KB, *VBT_P, *VBT_S;
  u16 *H2, *U;
};

DI int otid() { int t = threadIdx.x; asm volatile("" : "+v"(t)); return t; }
DI unsigned cvtpk(float lo, float hi) {
  f32x2 v = {lo, hi};
  bf16x2_t b = __builtin_convertvector(v, bf16x2_t);
  return __builtin_bit_cast(unsigned, b);
}
DI u16 f2bf(float x) { return (u16)(cvtpk(x, 0.f) & 0xffffu); }
DI float bf2f(u16 b) { return __uint_as_float(((unsigned)b) << 16); }
DI float bflo(unsigned w) { return __uint_as_float(w << 16); }
DI float bfhi(unsigned w) { return __uint_as_float(w & 0xffff0000u); }
DI float dot2bf(unsigned a, unsigned b, float c) {
  return __builtin_amdgcn_fdot2_f32_bf16(__builtin_bit_cast(bf16x2_t, a), __builtin_bit_cast(bf16x2_t, b), c, false);
}
DI float wave_sum(float v) {
#pragma unroll
  for (int o = 32; o > 0; o >>= 1) v += __shfl_xor(v, o);
  return v;
}
DI int qpos_of(int t) { return t < MP ? t : 1024 + ((t - MP) & 15); }
DI int krow_of(int t) { return t < MP ? t : MP + ((t - MP) >> 4) * SK + 1024 + ((t - MP) & 15); }
DI float inv_freq(int i) { return exp2f(-(float)i * 0.41524101186092029f); }

DI void transpose_tile2(const float* __restrict__ W, int K, int N, u16* __restrict__ Wt, int tileA, int tileB, float* s  ) {
  const int nkt = K >> 6;
  const int tid = otid() & 255;
  const int c = tid & 63, r0 = tid >> 6;
  const bool hasB = tileB >= 0;
  const int tb = hasB ? tileB : tileA;
  const int kA = (tileA % nkt) << 6, nA = (tileA / nkt) << 6, kB = (tb % nkt) << 6, nB = (tb / nkt) << 6;
  float va[16], vb[16];
#pragma unroll
  for (int i = 0; i < 16; ++i) va[i] = (nA + c < N) ? W[(size_t)(kA + i * 4 + r0) * N + nA + c] : 0.f;
#pragma unroll
  for (int i = 0; i < 16; ++i) vb[i] = (nB + c < N) ? W[(size_t)(kB + i * 4 + r0) * N + nB + c] : 0.f;
  __syncthreads();
#pragma unroll
  for (int i = 0; i < 16; ++i) { s[(i * 4 + r0) * 65 + c] = va[i]; s[4160 + (i * 4 + r0) * 65 + c] = vb[i]; }
  __syncthreads();
  const int kp = (tid & 31) * 2, rr0 = tid >> 5;
#pragma unroll
  for (int i = 0; i < 8; ++i) {
    const int rr = i * 8 + rr0;
    *(unsigned*)(Wt + (size_t)(nA + rr) * K + kA + kp) = cvtpk(s[kp * 65 + rr], s[(kp + 1) * 65 + rr]);
    if (hasB) *(unsigned*)(Wt + (size_t)(nB + rr) * K + kB + kp) = cvtpk(s[4160 + kp * 65 + rr], s[4160 + (kp + 1) * 65 + rr]);
  }
}

DI void rms_row_2048(const float* __restrict__ x, const float* __restrict__ g, u16* __restrict__ out, int lane) {
  f32x4 v[8];
  float ss = 0.f;
#pragma unroll
  for (int i = 0; i < 8; ++i) {
    v[i] = *(const f32x4*)(x + i * 256 + lane * 4);
    ss += v[i][0] * v[i][0] + v[i][1] * v[i][1] + v[i][2] * v[i][2] + v[i][3] * v[i][3];
  }
  ss = wave_sum(ss);
  float r = rsqrtf(ss * (1.f / 2048.f) + 1e-6f);
#pragma unroll
  for (int i = 0; i < 8; ++i) {
    f32x4 gg = *(const f32x4*)(g + i * 256 + lane * 4);
    u32x2 o;
    o[0] = cvtpk(v[i][0] * r * gg[0], v[i][1] * r * gg[1]);
    o[1] = cvtpk(v[i][2] * r * gg[2], v[i][3] * r * gg[3]);
    *(u32x2*)(out + i * 256 + lane * 4) = o;
  }
}

enum { EPI_IN = 0, EPI_QB, EPI_BF16, EPI_VT, EPI_RES, EPI_RELU2, EPI_ACC, EPI_ATOM };
constexpr float QSC = 0.07216878364870322f * 1.4426950408889634f;
constexpr int LSTR = 64;
#ifndef PFA
#define PFA 8
#endif

template <int EPI> struct EpiSwap { static constexpr bool v = (EPI != EPI_VT); };

DI u32x2 pack4(f32x4 v) { u32x2 r; r[0] = cvtpk(v[0], v[1]); r[1] = cvtpk(v[2], v[3]); return r; }
DI float relu_i(float x) { return __int_as_float(max(__float_as_int(x), 0)); }
DI float sigm(float v) { return __builtin_amdgcn_rcpf(1.f + __builtin_amdgcn_exp2f(v * -1.4426950408889634f)); }

template <int EPI>
DI void gemm_epilogue(const Params& p, f32x4 (&acc)[8][4], int m0, int n0, int wr, int wc, int fr, int fq, u16* Cb, int ldc) {
  const int cw = n0 + wc * 64;
  if (EPI == EPI_VT) {
#pragma clang loop unroll(full)
    for (int m = 0; m < 8; ++m) {
      const int rb = m0 + wr * 128 + m * 16 + fq * 4;
#pragma clang loop unroll(full)
      for (int n = 0; n < 4; ++n) {
        const int col = cw + n * 16 + fr;
        u16* dst;
        if (rb < MP) dst = p.VBT_P + (size_t)col * MP + rb;
        else { int r2 = rb - MP; int b = r2 / SK; int s = r2 - b * SK; dst = p.VBT_S + ((size_t)b * 2048 + col) * VSS + s; }
        *(u32x2*)dst = pack4(acc[m][n]);
      }
    }
    return;
  }
  const int rbase = m0 + wr * 128 + fr;
  const int c4 = fq * 4;
  if (EPI == EPI_QB) {
    if (cw % 192 == 128) {
#pragma clang loop unroll(full)
      for (int m = 0; m < 8; ++m) {
        const int row = rbase + m * 16;
#pragma clang loop unroll(full)
        for (int n = 0; n < 2; ++n) {
          const int i0 = n * 16 + c4;
          const f32x4 cs = *(const f32x4*)(p.CS + (size_t)row * 32 + i0), sn = *(const f32x4*)(p.SN + (size_t)row * 32 + i0);
          const f32x4 x1 = acc[m][n] * QSC, x2 = acc[m][n + 2] * QSC;
          *(u32x2*)(p.QB + (size_t)row * 3072 + cw + i0) = pack4(x1 * cs - x2 * sn);
          *(u32x2*)(p.QB + (size_t)row * 3072 + cw + i0 + 32) = pack4(x1 * sn + x2 * cs);
        }
      }
      return;
    }
  }
#pragma clang loop unroll(full)
  for (int n = 0; n < 4; ++n) {
    const int colt = cw + n * 16;
    const int col = colt + c4;
    if (EPI == EPI_IN) {
      const bool smp = m0 >= MP;
      if (colt < 2048) {
#pragma clang loop unroll(full)
        for (int m = 0; m < 8; ++m) *(u32x2*)(p.AQ + (size_t)(rbase + m * 16) * 2048 + col) = pack4(acc[m][n] * (0.08838834764831845f * 1.4426950408889634f));
      } else if (colt < 4096) {
        const int c = col - 2048;
#pragma clang loop unroll(full)
        for (int m = 0; m < 8; ++m) {
          const int row = rbase + m * 16;
          if (!smp) { *(f32x4*)(p.out + O_AKP + (size_t)row * 2048 + c) = acc[m][n]; *(u32x2*)(p.KA + (size_t)row * 2048 + c) = pack4(acc[m][n]); }
          else *(f32x4*)(p.out + O_AKS + (size_t)(row - MP) * 2048 + c) = acc[m][n];
        }
      } else if (colt < 6144) {
        const int c = col - 4096;
#pragma clang loop unroll(full)
        for (int m = 0; m < 8; ++m) {
          const int row = rbase + m * 16;
          if (!smp) {
            *(f32x4*)(p.out + O_AVP + (size_t)row * 2048 + c) = acc[m][n];
#pragma clang loop unroll(full)
            for (int j = 0; j < 4; ++j) p.VAT[(size_t)(c + j) * MP + row] = f2bf(acc[m][n][j]);
          } else *(f32x4*)(p.out + O_AVS + (size_t)(row - MP) * 2048 + c) = acc[m][n];
        }
      } else if (colt < 7168) {
#pragma clang loop unroll(full)
        for (int m = 0; m < 8; ++m) *(u32x2*)(p.IXQ + (size_t)(rbase + m * 16) * 1024 + (col - 6144)) = pack4(acc[m][n]);
      } else if (colt < 7232) {
        const int c = col - 7168;
#pragma clang loop unroll(full)
        for (int m = 0; m < 8; ++m) {
          const int row = rbase + m * 16;
          if (!smp) *(f32x4*)(p.out + O_IDXP + (size_t)row * 64 + c) = acc[m][n];
          else *(f32x4*)(p.out + O_IDXS + (size_t)(row - MP) * 64 + c) = acc[m][n];
          *(u32x2*)(p.IXK + (size_t)krow_of(row) * 64 + c) = pack4(acc[m][n]);
        }
      } else if (colt < 7248) {
#pragma clang loop unroll(full)
        for (int m = 0; m < 8; ++m) *(f32x4*)(p.IXW + (size_t)(rbase + m * 16) * 16 + (col - 7232)) = acc[m][n] * 0.25f;
      } else if (colt < 8080) {
#pragma clang loop unroll(full)
        for (int m = 0; m < 8; ++m) *(f32x4*)(p.out + O_Y + (size_t)(rbase + m * 16) * ZRW + (col - 7248)) = acc[m][n];
      } else if (colt < INC) {
        u16* G = colt < 10128 ? p.GA : p.GB;
        const int c = colt < 10128 ? col - 8080 : col - 10128;
#pragma clang loop unroll(full)
        for (int m = 0; m < 8; ++m) {
          f32x4 v = acc[m][n];
          f32x4 g = {sigm(v[0]), sigm(v[1]), sigm(v[2]), sigm(v[3])};
          *(u32x2*)(G + (size_t)(rbase + m * 16) * 2048 + c) = pack4(g);
        }
      }
    } else {
#pragma clang loop unroll(full)
      for (int m = 0; m < 8; ++m) {
        const int row = rbase + m * 16;
        const f32x4 v = acc[m][n];
        if (EPI == EPI_QB) {
          *(u32x2*)(Cb + (size_t)row * ldc + col) = pack4(v * QSC);
        } else if (EPI == EPI_BF16) {
          *(u32x2*)(Cb + (size_t)row * ldc + col) = pack4(v);
        } else if (EPI == EPI_RES) {
          const f32x4 xv = row < MP ? *(const f32x4*)(p.x_p + (size_t)row * 2048 + col) : *(const f32x4*)(p.x_s + (size_t)(row - MP) * 2048 + col);
          *(f32x4*)(p.out + O_Y + (size_t)row * 2048 + col) = xv + v;
          if ((m & 3) == 3) __builtin_amdgcn_sched_barrier(0);
        } else if (EPI == EPI_RELU2) {
          f32x4 r = {relu_i(v[0]), relu_i(v[1]), relu_i(v[2]), relu_i(v[3])};
          *(u32x2*)(p.U + (size_t)row * DFF + col) = pack4(r * r);
        } else if (EPI == EPI_ACC) {
          float* d = p.out + O_Y + (size_t)row * 2048 + col;
          *(f32x4*)d = *(const f32x4*)d + v;
          if ((m & 3) == 3) __builtin_amdgcn_sched_barrier(0);
        } else if (EPI == EPI_ATOM) {
#pragma clang loop unroll(full)
          for (int j = 0; j < 4; ++j) atomicAdd(p.out + O_Y + (size_t)row * 2048 + col + j, v[j]);
        }
      }
    }
  }
}

constexpr int GSTAGE = 512 * LSTR;
template <int EPI>
DI void gemm_tile(const Params& p, const u16* __restrict__ A, int lda, const u16* __restrict__ Bt, int ldb, int K, int m0, int n0,
                  char* smem, u16* Cb, int ldc) {
  u16* sbase = (u16*)smem;
  const int tid = otid(), lane = tid & 63, w = tid >> 6;
  const int wr = w >> 2, wc = w & 3, fr = lane & 15, fq = lane >> 4;
  f32x4 acc[8][4];
#pragma unroll
  for (int m = 0; m < 8; ++m)
#pragma unroll
    for (int n = 0; n < 4; ++n) acc[m][n] = (f32x4){0.f, 0.f, 0.f, 0.f};
  const int lr = tid >> 3, lk = (tid & 7) * 8;
  const int lkw = ((tid & 7) ^ ((lr >> 1) & 7)) * 8;
  const int fsw = (fr >> 1) & 7, fo0 = (fq ^ fsw) * 8, fo1 = ((4 + fq) ^ fsw) * 8;
  const u16* Ag = A + (size_t)(m0 + lr) * lda + lk;
  const u16* Bg = Bt + (size_t)(n0 + lr) * ldb + lk;
  const int nk = K >> 6;
  u32x4 ra[4], rb[4];
#define G_LOAD(T) { const int k_ = (T) << 6; _Pragma("unroll") for (int i = 0; i < 4; ++i) { \
    ra[i] = *(const u32x4*)(Ag + (size_t)(i * 64) * lda + k_); rb[i] = *(const u32x4*)(Bg + (size_t)(i * 64) * ldb + k_); } }
#define L_STORE(ST) { u16* dA_ = sbase + (ST) * GSTAGE + lr * LSTR + lkw; u16* dB_ = dA_ + 256 * LSTR; _Pragma("unroll") for (int i = 0; i < 4; ++i) { \
    *(u32x4*)(dA_ + i * 64 * LSTR) = ra[i]; *(u32x4*)(dB_ + i * 64 * LSTR) = rb[i]; } }
  G_LOAD(0)
  L_STORE(0)
  G_LOAD(1)
#pragma unroll 1
  for (int kt = 0; kt < nk; ++kt) {
    __syncthreads();
    if (kt + 1 < nk) L_STORE((kt + 1) & 1)
    G_LOAD(min(kt + 2, nk - 1))
    const u16* cA = sbase + (kt & 1) * GSTAGE + (wr * 128 + fr) * LSTR;
    const u16* cB = sbase + (kt & 1) * GSTAGE + 256 * LSTR + (wc * 64 + fr) * LSTR;
#pragma unroll
    for (int ks = 0; ks < 2; ++ks) {
      bf16x8 bfr[4];
#pragma unroll
      for (int n = 0; n < 4; ++n) bfr[n] = *(const bf16x8*)(cB + n * 16 * LSTR + (ks ? fo1 : fo0));
#pragma unroll
      for (int mh = 0; mh < 2; ++mh) {
        bf16x8 af[4];
#pragma unroll
        for (int m = 0; m < 4; ++m) af[m] = *(const bf16x8*)(cA + (mh * 4 + m) * 16 * LSTR + (ks ? fo1 : fo0));
        __builtin_amdgcn_s_setprio(1);
#pragma unroll
        for (int m = 0; m < 4; ++m)
#pragma unroll
          for (int n = 0; n < 4; ++n)
            acc[mh * 4 + m][n] = EpiSwap<EPI>::v ? __builtin_amdgcn_mfma_f32_16x16x32_bf16(bfr[n], af[m], acc[mh * 4 + m][n], 0, 0, 0)
                                                 : __builtin_amdgcn_mfma_f32_16x16x32_bf16(af[m], bfr[n], acc[mh * 4 + m][n], 0, 0, 0);
        __builtin_amdgcn_s_setprio(0);
      }
    }
  }
#undef G_LOAD
#undef L_STORE
  gemm_epilogue<EPI>(p, acc, m0, n0, wr, wc, fr, fq, Cb, ldc);
}

template <int EPI>
DI void gemm_phase(const Params& p, const u16* A, int lda, const u16* Bt, int ldb, int K, int mtiles, int ntiles, char* smem, u16* Cb, int ldc,
                   int start, int stride) {
  if (stride == 256) {
    const int gm = (mtiles + 3) >> 2, gn = (ntiles + 7) >> 3, nsg = gm * gn;
    const int xcd = start & 7, li = start >> 3;
    for (int sg = xcd; sg < nsg; sg += 8) {
      const int gni = sg / gm, gmi = sg - gni * gm;
      const int mt = gmi * 4 + (li & 3), nt = gni * 8 + (li >> 2);
      if (mt < mtiles && nt < ntiles) gemm_tile<EPI>(p, A, lda, Bt, ldb, K, mt * 256, nt * 256, smem, Cb, ldc);
    }
    return;
  }
  const int total = mtiles * ntiles;
  const int GM = 8;
  for (int id = start; id < total; id += stride) {
    const int per = GM * ntiles;
    const int g = id / per, rem = id - g * per;
    const int fm = g * GM;
    const int gsz = min(GM, mtiles - fm);
    const int mt = fm + rem % gsz, nt = rem / gsz;
    gemm_tile<EPI>(p, A, lda, Bt, ldb, K, mt * 256, nt * 256, smem, Cb, ldc);
  }
}

DI void post_row(const Params& p, int t, int lane) {
  const float* zr = p.out + O_Y + (size_t)t * ZRW;
  {
    f32x4 a = *(const f32x4*)(zr + lane * 4), b = *(const f32x4*)(zr + 256 + lane * 4);
    float ss = a[0] * a[0] + a[1] * a[1] + a[2] * a[2] + a[3] * a[3] + b[0] * b[0] + b[1] * b[1] + b[2] * b[2] + b[3] * b[3];
    ss = wave_sum(ss);
    float r = rsqrtf(ss * (1.f / 512.f) + 1e-6f);
    f32x4 ga = *(const f32x4*)(p.g_q + lane * 4), gb = *(const f32x4*)(p.g_q + 256 + lane * 4);
    u32x2 o;
    o[0] = cvtpk(a[0] * r * ga[0], a[1] * r * ga[1]); o[1] = cvtpk(a[2] * r * ga[2], a[3] * r * ga[3]);
    *(u32x2*)(p.CQ + (size_t)t * 512 + lane * 4) = o;
    o[0] = cvtpk(b[0] * r * gb[0], b[1] * r * gb[1]); o[1] = cvtpk(b[2] * r * gb[2], b[3] * r * gb[3]);
    *(u32x2*)(p.CQ + (size_t)t * 512 + 256 + lane * 4) = o;
  }
  const int kr_row = krow_of(t);
  {
    f32x4 a = *(const f32x4*)(zr + 512 + lane * 4);
    float ss = a[0] * a[0] + a[1] * a[1] + a[2] * a[2] + a[3] * a[3];
    ss = wave_sum(ss);
    float r = rsqrtf(ss * (1.f / 256.f) + 1e-6f);
    f32x4 g = *(const f32x4*)(p.g_kv + lane * 4);
    f32x4 o = {a[0] * r * g[0], a[1] * r * g[1], a[2] * r * g[2], a[3] * r * g[3]};
    float* od = t < MP ? p.out + O_CKVP + (size_t)t * 256 : p.out + O_CKVS + (size_t)(t - MP) * 256;
    *(f32x4*)(od + lane * 4) = o;
    u32x2 ob; ob[0] = cvtpk(o[0], o[1]); ob[1] = cvtpk(o[2], o[3]);
    *(u32x2*)(p.CKV + (size_t)kr_row * 256 + lane * 4) = ob;
  }
  if (lane < 32) {
    float x1 = zr[768 + lane], x2 = zr[768 + 32 + lane];
    float ang = (float)qpos_of(t) * inv_freq(lane);
    float cs = cosf(ang), sn = sinf(ang);
    p.CS[(size_t)t * 32 + lane] = cs; p.SN[(size_t)t * 32 + lane] = sn;
    float o1 = x1 * cs - x2 * sn, o2 = x1 * sn + x2 * cs;
    float* od = t < MP ? p.out + O_KRP + (size_t)t * 64 : p.out + O_KRS + (size_t)(t - MP) * 64;
    od[lane] = o1; od[lane + 32] = o2;
    p.KR[(size_t)kr_row * 64 + lane] = f2bf(o1);
    p.KR[(size_t)kr_row * 64 + lane + 32] = f2bf(o2);
  }
}

template <int CTRL> DI float dpp_add(float v) {
  int sft = __builtin_amdgcn_update_dpp(0, __float_as_int(v), CTRL, 0xf, 0xf, true);
  return v + __int_as_float(sft);
}
DI float row16_sum(float v) { v = dpp_add<0x111>(v); v = dpp_add<0x112>(v); v = dpp_add<0x114>(v); v = dpp_add<0x118>(v); return v; }
DI unsigned fkey(float f) { unsigned u = __float_as_uint(f); return (u & 0x80000000u) ? ~u : (u | 0x80000000u); }

DI void radix_select(unsigned* sc, int* hist, int* misc, int n, unsigned long long* sel, int tid, int lane, int w) {
  __syncthreads();
  unsigned prefix = 0;
  int remaining = 256, neq = 0;
  bool done = false;
#pragma unroll 1
  for (int pass = 0; pass < 3; ++pass) {
    const int shift = pass == 0 ? 21 : (pass == 1 ? 10 : 0);
    const int bits = pass == 2 ? 10 : 11;
    const unsigned bmask = (1u << bits) - 1u;
    if (done) {
      __syncthreads(); __syncthreads(); __syncthreads(); __syncthreads(); __syncthreads();
      continue;
    }
    if (pass > 0) {
      *(int4*)&hist[tid * 8] = make_int4(0, 0, 0, 0);
      *(int4*)&hist[tid * 8 + 4] = make_int4(0, 0, 0, 0);
      __syncthreads();
      const int hs = shift + bits;
      const unsigned want = prefix >> hs;
      for (int i = tid * 4; i < n; i += 256 * 4) {
        const u32x4 u4 = *(const u32x4*)(sc + i);
#pragma unroll
        for (int e = 0; e < 4; ++e)
          if ((u4[e] >> hs) == want) atomicAdd(&hist[(u4[e] >> shift) & bmask], 1);
      }
      __syncthreads();
    }
    const int4 h0 = *(const int4*)&hist[tid * 8], h1 = *(const int4*)&hist[tid * 8 + 4];
    const int s8 = h0.x + h0.y + h0.z + h0.w + h1.x + h1.y + h1.z + h1.w;
    int suf = s8;
#pragma unroll
    for (int d = 1; d < 64; d <<= 1) { int v = __shfl_down(suf, d); if (lane + d < 64) suf += v; }
    if (lane == 0) misc[w] = suf;
    __syncthreads();
    int above = 0;
    for (int ww = w + 1; ww < 4; ++ww) above += misc[ww];
    const int excl = above + suf - s8;
    if (excl < remaining && remaining <= excl + s8) {
      int c = excl, bin = 0, nrem = 0, bpop = 0;
#define TK_STEP(val, idx) if (c < remaining && remaining <= c + (val)) { bin = tid * 8 + (idx); nrem = remaining - c; bpop = (val); } c += (val);
      TK_STEP(h1.w, 7) TK_STEP(h1.z, 6) TK_STEP(h1.y, 5) TK_STEP(h1.x, 4) TK_STEP(h0.w, 3) TK_STEP(h0.z, 2) TK_STEP(h0.y, 1) TK_STEP(h0.x, 0)
#undef TK_STEP
      misc[4] = bin; misc[5] = nrem; misc[6] = bpop;
    }
    __syncthreads();
    prefix |= ((unsigned)misc[4]) << shift;
    remaining = misc[5];
    neq = misc[6];
    done = (neq == remaining);
    __syncthreads();
  }
  const unsigned T = prefix;
  const int seg = ((n + 255) >> 8) << 6;
  const int beg = w * seg;
  if (neq == remaining) {
    for (int i0 = beg; i0 < beg + seg; i0 += 256) {
      unsigned u[4]; bool in[4];
#pragma unroll
      for (int c = 0; c < 4; ++c) {
        const int ib = i0 + c * 64, i = ib + lane;
        in[c] = (ib < beg + seg) && (i < n);
        u[c] = in[c] ? sc[i] : 0u;
      }
#pragma unroll
      for (int c = 0; c < 4; ++c) {
        const int ib = i0 + c * 64;
        const unsigned long long sm = __ballot(in[c] && u[c] >= T);
        if (lane == 0 && ib < beg + seg && ib < n) sel[ib >> 6] = sm;
      }
    }
    __syncthreads();
    return;
  }
  int ceq = 0;
  for (int i = beg + lane; i < beg + seg; i += 64) {
    bool in = i < n; unsigned u = in ? sc[i] : 0u;
    ceq += __popcll(__ballot(in && u == T));
  }
  if (lane == 0) misc[12 + w] = ceq;
  __syncthreads();
  int oe = 0;
  for (int ww = 0; ww < w; ++ww) oe += misc[12 + ww];
  const unsigned long long lt = (1ull << lane) - 1ull;
  for (int i0 = beg; i0 < beg + seg; i0 += 64) {
    const int i = i0 + lane;
    bool in = i < n; unsigned u = in ? sc[i] : 0u;
    bool g = in && u > T, e = in && u == T;
    unsigned long long be = __ballot(e);
    int pe = oe + __popcll(be & lt);
    unsigned long long sm = __ballot(g || (e && pe < remaining));
    if (lane == 0 && i0 < n) sel[i0 >> 6] = sm;
    oe += __popcll(be);
  }
}

constexpr int NQ = 4;
DI void topk_group(const Params& p, int t, char* smem, unsigned* scr1, unsigned* scr2, unsigned* scr3) {
  unsigned* sc = (unsigned*)smem;
  int* hist = (int*)(smem + 65536);
  int* misc = hist + 2048;
  const int tid = otid() & 255, lane = tid & 63, w = tid >> 6, fr = lane & 15, fq = lane >> 4;
  int n; const u16* ixk;
  if (t < MP) { n = 64 * ((t >> 6) + 1); ixk = p.IXK; }
  else { int b = (t - MP) >> 4; n = SK; ixk = p.IXK + (size_t)(MP + b * SK) * 64; }
  unsigned long long* sel = p.SEL + (size_t)t * 256;
  __syncthreads();
  if (n <= 256) {
    if (tid < 4) {
      unsigned long long v = (tid < (n >> 6)) ? ~0ull : 0ull;
#pragma unroll
      for (int qi = 0; qi < NQ; ++qi) sel[qi * 256 + tid] = v;
    }
    return;
  }
  *(int4*)&hist[tid * 8] = make_int4(0, 0, 0, 0);
  *(int4*)&hist[tid * 8 + 4] = make_int4(0, 0, 0, 0);
  __syncthreads();
  {
    const u16* q = p.IXQ + (size_t)t * 1024 + fr * 64 + fq * 8;
    bf16x8 a0[NQ], a1[NQ];
    f32x4 wv[NQ];
#pragma unroll
    for (int qi = 0; qi < NQ; ++qi) {
      a0[qi] = *(const bf16x8*)(q + qi * 1024); a1[qi] = *(const bf16x8*)(q + qi * 1024 + 32);
      wv[qi] = *(const f32x4*)(p.IXW + (size_t)(t + qi) * 16 + fq * 4);
    }
    const int ntile = n >> 4;
    for (int kt0 = w; kt0 < ntile; kt0 += 32) {
      bf16x8 b0[8], b1[8];
#pragma unroll
      for (int g = 0; g < 8; ++g) {
        const int kt = min(kt0 + g * 4, ntile - 1);
        const u16* kp = ixk + (size_t)(kt * 16 + fr) * 64 + fq * 8;
        b0[g] = *(const bf16x8*)kp; b1[g] = *(const bf16x8*)(kp + 32);
      }
      float pt[NQ][8];
#pragma unroll
      for (int g = 0; g < 8; ++g) {
#pragma unroll
        for (int qi = 0; qi < NQ; ++qi) {
          f32x4 c = {0.f, 0.f, 0.f, 0.f};
          c = __builtin_amdgcn_mfma_f32_16x16x32_bf16(a0[qi], b0[g], c, 0, 0, 0);
          c = __builtin_amdgcn_mfma_f32_16x16x32_bf16(a1[qi], b1[g], c, 0, 0, 0);
          pt[qi][g] = relu_i(c[0]) * wv[qi][0] + relu_i(c[1]) * wv[qi][1] + relu_i(c[2]) * wv[qi][2] + relu_i(c[3]) * wv[qi][3];
        }
      }
#pragma unroll
      for (int g = 0; g < 8; g += 2) {
        const int kt = kt0 + (g + (lane >> 5)) * 4;
        const bool st = (lane & 16) == 0 && kt < ntile;
#pragma unroll
        for (int qi = 0; qi < NQ; ++qi) {
          auto r32 = __builtin_amdgcn_permlane32_swap(__float_as_uint(pt[qi][g]), __float_as_uint(pt[qi][g + 1]), false, false);
          float s2 = __uint_as_float(r32[0]) + __uint_as_float(r32[1]);
          auto r16 = __builtin_amdgcn_permlane16_swap(__float_as_uint(s2), __float_as_uint(s2), false, false);
          float sv = __uint_as_float(r16[0]) + __uint_as_float(r16[1]);
          if (st) {
            unsigned u = fkey(sv);
            if (qi == 0) { sc[kt * 16 + fr] = u; atomicAdd(&hist[u >> 21], 1); }
            else if (qi == 1) scr1[kt * 16 + fr] = u;
            else if (qi == 2) scr2[kt * 16 + fr] = u;
            else scr3[kt * 16 + fr] = u;
          }
        }
      }
    }
  }
  radix_select(sc, hist, misc, n, sel, tid, lane, w);
#pragma unroll 1
  for (int qi = 1; qi < NQ; ++qi) {
    const unsigned* scr = qi == 1 ? scr1 : (qi == 2 ? scr2 : scr3);
    __syncthreads();
    *(int4*)&hist[tid * 8] = make_int4(0, 0, 0, 0);
    *(int4*)&hist[tid * 8 + 4] = make_int4(0, 0, 0, 0);
    __syncthreads();
    for (int i = tid * 4; i < n; i += 256 * 4) {
      const u32x4 u4 = *(const u32x4*)(scr + i);
      *(u32x4*)(sc + i) = u4;
#pragma unroll
      for (int e = 0; e < 4; ++e) atomicAdd(&hist[u4[e] >> 21], 1);
    }
    radix_select(sc, hist, misc, n, sel + qi * 256, tid, lane, w);
  }
}

constexpr int KSTR = 192;
constexpr int VSTR = 72;
DI float xq_max(float x) {
  auto a = __builtin_amdgcn_permlane16_swap(__float_as_uint(x), __float_as_uint(x), false, false);
  x = fmaxf(__uint_as_float(a[0]), __uint_as_float(a[1]));
  auto b = __builtin_amdgcn_permlane32_swap(__float_as_uint(x), __float_as_uint(x), false, false);
  return fmaxf(__uint_as_float(b[0]), __uint_as_float(b[1]));
}
DI float xq_sum(float x) {
  auto a = __builtin_amdgcn_permlane16_swap(__float_as_uint(x), __float_as_uint(x), false, false);
  x = __uint_as_float(a[0]) + __uint_as_float(a[1]);
  auto b = __builtin_amdgcn_permlane32_swap(__float_as_uint(x), __float_as_uint(x), false, false);
  return __uint_as_float(b[0]) + __uint_as_float(b[1]);
}

template <int MODE>
DI void attn_item(const Params& p, int item, char* smem, u16* gdst) {
  constexpr int NKS = MODE == 0 ? 6 : 4;
  constexpr int ASTAGE = 64 * KSTR + 128 * VSTR;
  u16* sbase = (u16*)smem;
  float* sBias = (float*)(sbase + 2 * ASTAGE);
  const int tid = otid(), lane = tid & 63, w = tid >> 6, fr = lane & 15, fq = lane >> 4;
  const int ksw = (fr >> 1) & 7, ko0 = (fq ^ ksw) * 8, ko1 = ((4 + fq) ^ ksw) * 8;
  int h, q0, nq, krow0, nkeys, ntiles, myt, b = 0, qpos0;
  const u16* vt; size_t vstride;
  const bool sample = item >= 1024;
  if (!sample) {
    const int i = 63 - (item >> 4);
    h = item & 15; q0 = i * 256; nq = 256; krow0 = 0; nkeys = q0 + 256; ntiles = 4 * i + 4; qpos0 = q0;
    vt = (MODE == 0 ? p.VBT_P : p.VAT) + (size_t)h * 128 * MP; vstride = MP;
    myt = ntiles - 3 + (w >> 1);
  } else {
    const int j = item - 1024; b = j >> 4;
    h = j & 15; q0 = MP + b * 16; nq = 16; krow0 = MP + b * SK; nkeys = SK; ntiles = 17; qpos0 = 1024;
    vt = p.VBT_S + ((size_t)b * 2048 + h * 128) * VSS; vstride = VSS;
    myt = ntiles;
  }
  const int wq0 = w * 32;
  const bool active = wq0 < nq;
  __syncthreads();
  if (MODE == 1) {
    for (int i = tid; i < 257; i += NTHREADS) {
      int rel = i - 128;
      int ret = rel > 0 ? 16 : 0;
      int n = rel < 0 ? -rel : rel;
      float lf = logf((float)max(n, 1) / 8.0f) / 2.772588722239781f * 8.0f;
      int large = min(8 + (int)lf, 15);
      int bk = ret + (n < 8 ? n : large);
      sBias[i] = (p.rel[bk * 16 + h] - p.rel[15 * 16 + h]) * 1.4426950408889634f;
    }
  }
  bf16x8 qf[2][NKS];
  int qrow[2];
#pragma unroll
  for (int qt = 0; qt < 2; ++qt) {
    const int qr = min(wq0 + qt * 16 + fr, nq - 1);
    qrow[qt] = qr;
    const u16* qp = (MODE == 0) ? p.QB + (size_t)(q0 + qr) * 3072 + h * 192 + fq * 8 : p.AQ + (size_t)(q0 + qr) * 2048 + h * 128 + fq * 8;
#pragma unroll
    for (int ks = 0; ks < NKS; ++ks) qf[qt][ks] = *(const bf16x8*)(qp + ks * 32);
  }
  f32x4 o[2][8];
#pragma unroll
  for (int qt = 0; qt < 2; ++qt)
#pragma unroll
    for (int dt = 0; dt < 8; ++dt) o[qt][dt] = (f32x4){0.f, 0.f, 0.f, 0.f};
  float mrow[2] = {-1e30f, -1e30f}, lrow[2] = {0.f, 0.f};
  const float SC = (MODE == 0 ? 0.07216878364870322f : 0.08838834764831845f) * 1.4426950408889634f;

  unsigned long long mqn[2] = {0ull, 0ull};
  if (MODE == 1) {
#pragma unroll
    for (int qt = 0; qt < 2; ++qt) mqn[qt] = p.SEL[(size_t)(q0 + qrow[qt]) * 256];
  }
  constexpr int NKL = MODE == 0 ? 3 : 2;
  const bool direct = (MODE == 1) && sample;
  u32x4 rk[NKL], rv[2];
#define KV_LOAD(JT) { const size_t kr0_ = (size_t)(krow0 + (JT) * 64); const u16* kb_ = (MODE == 0 ? p.KB : p.KA) + (kr0_ + (tid >> 4)) * 2048 + h * 128 + (tid & 15) * 8; \
    _Pragma("unroll") for (int i = 0; i < 2; ++i) rk[i] = *(const u32x4*)(kb_ + (size_t)i * 32 * 2048); \
    if (MODE == 0) rk[NKL - 1] = *(const u32x4*)(p.KR + (kr0_ + (tid >> 3)) * 64 + (tid & 7) * 8); \
    const u16* vp_ = vt + (size_t)(tid >> 3) * vstride + (JT) * 64 + (tid & 7) * 8; \
    _Pragma("unroll") for (int i = 0; i < 2; ++i) rv[i] = *(const u32x4*)(vp_ + (size_t)i * 64 * vstride); }
#define KV_STORE(ST) { u16* sk_ = sbase + (ST) * ASTAGE; u16* dk_ = sk_ + (tid >> 4) * KSTR + ((tid & 15) ^ ((tid >> 5) & 7)) * 8; \
    _Pragma("unroll") for (int i = 0; i < 2; ++i) *(u32x4*)(dk_ + i * 32 * KSTR) = rk[i]; \
    if (MODE == 0) *(u32x4*)(sk_ + (tid >> 3) * KSTR + 128 + ((tid & 7) ^ ((tid >> 4) & 7)) * 8) = rk[NKL - 1]; \
    u16* dv_ = sk_ + 64 * KSTR + (tid >> 3) * VSTR + (tid & 7) * 8; \
    _Pragma("unroll") for (int i = 0; i < 2; ++i) *(u32x4*)(dv_ + i * 64 * VSTR) = rv[i]; }
  if (!direct) {
    KV_LOAD(0)
    KV_STORE(0)
    KV_LOAD(min(1, ntiles - 1))
  }
  for (int jt = 0; jt < ntiles; ++jt) {
    const int key0 = jt * 64;
    u16* sK = sbase + (jt & 1) * ASTAGE;
    u16* sV = sK + 64 * KSTR;
    unsigned long long mq[2] = {mqn[0], mqn[1]};
    if (MODE == 1) {
      const int jn = min(jt + 1, ntiles - 1);
#pragma unroll
      for (int qt = 0; qt < 2; ++qt) mqn[qt] = p.SEL[(size_t)(q0 + qrow[qt]) * 256 + jn];
    }
    __syncthreads();
    if (!direct) {
      if (jt + 1 < ntiles) KV_STORE((jt + 1) & 1)
      KV_LOAD(min(jt + 2, ntiles - 1))
    } else {
#pragma unroll 2
      for (int i = 0; i < 4; ++i) {
        const int c = tid + i * NTHREADS;
        const int key = c >> 5, part = c & 31;
        const int s = key0 + key;
        const int sc_ = min(s, SK - 1);
        const size_t o1 = sc_ < 1024 ? ((size_t)b * 1024 + sc_) * 2048 : ((size_t)b * 16 + (sc_ - 1024)) * 2048;
        const float* kp = (sc_ < 1024 ? p.c_ak : p.out + O_AKS) + o1 + h * 128 + part * 4;
        const float* vp = (sc_ < 1024 ? p.c_av : p.out + O_AVS) + o1 + h * 128 + part * 4;
        f32x4 kv = *(const f32x4*)kp, vv = *(const f32x4*)vp;
        u32x2 kk; kk[0] = cvtpk(kv[0], kv[1]); kk[1] = cvtpk(kv[2], kv[3]);
        *(u32x2*)(sK + key * KSTR + (((part >> 1) ^ ((key >> 1) & 7)) * 8) + (part & 1) * 4) = kk;
        const bool ok = s < SK;
#pragma unroll
        for (int e = 0; e < 4; ++e) sV[(part * 4 + e) * VSTR + key] = ok ? f2bf(vv[e]) : (u16)0;
      }
      __syncthreads();
    }
    if (active && jt < myt) {
      f32x4 s[2][4];
#pragma unroll
      for (int qt = 0; qt < 2; ++qt) {
        const float nb_ = (jt == 0) ? 0.f : -mrow[qt];
#pragma unroll
        for (int kt = 0; kt < 4; ++kt) s[qt][kt] = (f32x4){nb_, nb_, nb_, nb_};
      }
#pragma unroll
      for (int kt = 0; kt < 4; ++kt) {
#pragma unroll
        for (int ks = 0; ks < NKS; ++ks) {
          bf16x8 kf = *(const bf16x8*)(sK + (kt * 16 + fr) * KSTR + (ks >> 1) * 64 + ((ks & 1) ? ko1 : ko0));
          s[0][kt] = __builtin_amdgcn_mfma_f32_16x16x32_bf16(kf, qf[0][ks], s[0][kt], 0, 0, 0);
          s[1][kt] = __builtin_amdgcn_mfma_f32_16x16x32_bf16(kf, qf[1][ks], s[1][kt], 0, 0, 0);
        }
      }
      unsigned mlo[2] = {0u, 0u}, mhi[2] = {0u, 0u};
      if (MODE == 0) {
        if (key0 + 64 > nkeys) {
#pragma unroll
          for (int kt = 0; kt < 4; ++kt)
#pragma unroll
            for (int j = 0; j < 4; ++j)
              if (key0 + kt * 16 + fq * 4 + j >= nkeys) { s[0][kt][j] = -1e30f; s[1][kt][j] = -1e30f; }
        }
      } else {
        const bool far = (key0 + 63) - (qpos0 + wq0) <= -128;
        if (!far) {
#pragma unroll
          for (int qt = 0; qt < 2; ++qt) {
            const int rb = key0 + fq * 4 - (qpos0 + qrow[qt]) + 128;
#pragma unroll
            for (int kt = 0; kt < 4; ++kt)
#pragma unroll
              for (int j = 0; j < 4; ++j) {
                int r = min(max(rb + kt * 16 + j, 0), 256);
                s[qt][kt][j] += sBias[r];
              }
          }
        }
#pragma unroll
        for (int qt = 0; qt < 2; ++qt) {
          const unsigned long long mm = mq[qt] >> (fq * 4);
          mlo[qt] = (unsigned)mm; mhi[qt] = (unsigned)(mm >> 32);
        }
      }
      bf16x8 pf[2][2];
#pragma unroll
      for (int qt = 0; qt < 2; ++qt) {
        float mx = -1e30f;
#pragma unroll
        for (int kt = 0; kt < 4; ++kt)
#pragma unroll
          for (int j = 0; j < 4; ++j) mx = fmaxf(mx, s[qt][kt][j]);
        mx = xq_max(mx);
        const float delta = (jt == 0) ? mx : fmaxf(mx, 0.f);
        mrow[qt] = (jt == 0) ? delta : mrow[qt] + delta;
        const bool grow = __ballot(delta != 0.f) != 0ull;
        float alpha = 1.f;
        if (grow) {
          alpha = __builtin_amdgcn_exp2f(-delta);
#pragma unroll
          for (int kt = 0; kt < 4; ++kt) s[qt][kt] -= delta;
        }
        float rs = 0.f;
#pragma unroll
        for (int kt = 0; kt < 4; ++kt)
#pragma unroll
          for (int j = 0; j < 4; ++j) {
            float pv = __builtin_amdgcn_exp2f(s[qt][kt][j]);
            if (MODE == 1) {
              int keep;
              asm("v_bfe_i32 %0, %1, %2, 1" : "=v"(keep) : "v"(kt < 2 ? mlo[qt] : mhi[qt]), "n"((kt & 1) * 16 + j));
              pv = __int_as_float(__float_as_int(pv) & keep);
            }
            s[qt][kt][j] = pv; rs += pv;
          }
        rs = xq_sum(rs);
        lrow[qt] = lrow[qt] * alpha + rs;
        if (grow) {
#pragma unroll
          for (int dt = 0; dt < 8; ++dt) o[qt][dt] *= alpha;
        }
#pragma unroll
        for (int s2 = 0; s2 < 2; ++s2) {
          u32x4 pk;
          pk[0] = cvtpk(s[qt][2 * s2][0], s[qt][2 * s2][1]);
          pk[1] = cvtpk(s[qt][2 * s2][2], s[qt][2 * s2][3]);
          pk[2] = cvtpk(s[qt][2 * s2 + 1][0], s[qt][2 * s2 + 1][1]);
          pk[3] = cvtpk(s[qt][2 * s2 + 1][2], s[qt][2 * s2 + 1][3]);
          pf[qt][s2] = __builtin_bit_cast(bf16x8, pk);
        }
      }
#pragma unroll
      for (int dt = 0; dt < 8; ++dt) {
#pragma unroll
        for (int s2 = 0; s2 < 2; ++s2) {
          const u16* vp = sV + (dt * 16 + fr) * VSTR + fq * 4;
          u32x2 v0 = *(const u32x2*)(vp + (2 * s2) * 16);
          u32x2 v1 = *(const u32x2*)(vp + (2 * s2 + 1) * 16);
          u32x4 vv = {v0[0], v0[1], v1[0], v1[1]};
          bf16x8 vf = __builtin_bit_cast(bf16x8, vv);
          o[0][dt] = __builtin_amdgcn_mfma_f32_16x16x32_bf16(vf, pf[0][s2], o[0][dt], 0, 0, 0);
          o[1][dt] = __builtin_amdgcn_mfma_f32_16x16x32_bf16(vf, pf[1][s2], o[1][dt], 0, 0, 0);
        }
      }
    }
  }
  if (active) {
#pragma unroll
    for (int qt = 0; qt < 2; ++qt) {
      const int qr = wq0 + qt * 16 + fr;
      if (qr < nq) {
        const float inv = 1.f / lrow[qt];
        const size_t row = (size_t)(q0 + qr);
#pragma unroll
        for (int dt = 0; dt < 8; ++dt) {
          const size_t off = row * 2048 + h * 128 + dt * 16 + fq * 4;
          u32x2 ga = *(const u32x2*)(p.GA + off);
          u32x2 r;
          if (MODE == 0) {
            u32x2 gb = *(const u32x2*)(p.GB + off);
            r[0] = cvtpk(bflo(gb[0]) * o[qt][dt][0] * inv + bflo(ga[0]), bfhi(gb[0]) * o[qt][dt][1] * inv + bfhi(ga[0]));
            r[1] = cvtpk(bflo(gb[1]) * o[qt][dt][2] * inv + bflo(ga[1]), bfhi(gb[1]) * o[qt][dt][3] * inv + bfhi(ga[1]));
          } else {
            r[0] = cvtpk(bflo(ga[0]) * o[qt][dt][0] * inv, bfhi(ga[0]) * o[qt][dt][1] * inv);
            r[1] = cvtpk(bflo(ga[1]) * o[qt][dt][2] * inv, bfhi(ga[1]) * o[qt][dt][3] * inv);
          }
          *(u32x2*)(gdst + off) = r;
        }
      }
    }
  }
}

#undef KV_LOAD
#undef KV_STORE
__global__ void __launch_bounds__(NTHREADS) fwd_megakernel(Params p) {
  extern __shared__ __attribute__((aligned(16))) char smem[];
  cg::grid_group grid = cg::this_grid();
#define IDS const int tid = otid(); const int lane = tid & 63, w = tid >> 6; const int bid = blockIdx.x, nb = gridDim.x; \
  const int gw = bid * 8 + w, ngw = nb * 8; (void)tid; (void)lane; (void)gw; (void)ngw; (void)bid; (void)nb;

#if PH & (1 << 0)
  { IDS
  {
    const int vb = tid >> 8;
    float* st = (float*)(smem + vb * VB_LDS);
    const int vbid = bid * 2 + vb, nvb = nb * 2;
    for (int t = vbid; t < 32 * 192; t += 2 * nvb) transpose_tile2(p.w_in, 2048, INC, p.WT_IN, t, (t + nvb < 32 * 192) ? t + nvb : -1, st);
    for (int t = vbid; t < 8 * 48; t += 2 * nvb) transpose_tile2(p.w_uq, 512, 3072, p.WT_UQ, t, (t + nvb < 8 * 48) ? t + nvb : -1, st);
    for (int t = vbid; t < 4 * 32; t += 2 * nvb) transpose_tile2(p.w_uk, 256, 2048, p.WT_UK, t, (t + nvb < 4 * 32) ? t + nvb : -1, st);
    for (int t = vbid; t < 4 * 32; t += 2 * nvb) transpose_tile2(p.w_uv, 256, 2048, p.WT_UV, t, (t + nvb < 4 * 32) ? t + nvb : -1, st);
    for (int t = vbid; t < 32 * 32; t += 2 * nvb) transpose_tile2(p.w_out, 2048, 2048, p.WT_OUT, t, (t + nvb < 32 * 32) ? t + nvb : -1, st);
    for (int t = vbid; t < 32 * 128; t += 2 * nvb) transpose_tile2(p.w_up, 2048, 8192, p.WT_UP, t, (t + nvb < 32 * 128) ? t + nvb : -1, st);
    for (int t = vbid; t < 128 * 32; t += 2 * nvb) transpose_tile2(p.w_down, 8192, 2048, p.WT_DOWN, t, (t + nvb < 128 * 32) ? t + nvb : -1, st);
    for (int r = gw; r < MT; r += ngw) {
      const float* x = r < MP ? p.x_p + (size_t)r * 2048 : p.x_s + (size_t)(r - MP) * 2048;
      rms_row_2048(x, p.g_mix, p.H + (size_t)r * 2048, lane);
    }
    const int gt = bid * NTHREADS + tid, ngt = nb * NTHREADS;
    for (int i = gt; i < 16 * 1024 * 64 / 4; i += ngt) {
      int e = i * 4; int b = e >> 16; int rem = e & 65535; int s = rem >> 6, c = rem & 63;
      size_t dst = (size_t)(MP + b * SK + s) * 64 + c;
      f32x4 a = *(const f32x4*)(p.c_idx + e), k = *(const f32x4*)(p.c_kr + e);
      u32x2 o; o[0] = cvtpk(a[0], a[1]); o[1] = cvtpk(a[2], a[3]);
      *(u32x2*)(p.IXK + dst) = o;
      o[0] = cvtpk(k[0], k[1]); o[1] = cvtpk(k[2], k[3]);
      *(u32x2*)(p.KR + dst) = o;
    }
    for (int i = gt; i < 16 * 1024 * 256 / 4; i += ngt) {
      int e = i * 4; int b = e >> 18; int rem = e & 262143; int s = rem >> 8, c = rem & 255;
      size_t dst = (size_t)(MP + b * SK + s) * 256 + c;
      f32x4 a = *(const f32x4*)(p.c_ckv + e);
      u32x2 o; o[0] = cvtpk(a[0], a[1]); o[1] = cvtpk(a[2], a[3]);
      *(u32x2*)(p.CKV + dst) = o;
    }
  }
  }
#endif
  grid.sync();
#if PH & (1 << 1)
  { IDS
  for (int rep = 0; rep < NREP(1); ++rep) gemm_phase<EPI_IN>(p, p.H, 2048, p.WT_IN, 2048, 2048, MT / 256, INP / 256, smem, nullptr, 0, bid, nb);
  }
#endif
  grid.sync();
#if PH & (1 << 2)
  { IDS
  for (int t = gw; t < MT; t += ngw) post_row(p, t, lane);
  {
    const int vb = tid >> 8, vbid = bid * 2 + vb;
    char* sm = smem + vb * VB_LDS;
    for (int rep = 0; rep < NREP(2); ++rep) for (int t = vbid * NQ; t < MT; t += nb * 2 * NQ)
      topk_group(p, t, sm, (unsigned*)(p.out + O_Y + 14000000) + (size_t)vbid * 16384, (unsigned*)(p.out + O_Y + 14000000) + (size_t)(512 + vbid) * 16384,
                 (unsigned*)p.H + (size_t)vbid * 16384);
  }
  }
#endif
  grid.sync();
#if PH & (1 << 3)
  { IDS
    const int total = 1024 + 256;
    for (int rep = 0; rep < NREP(3); ++rep) {
      u16* gdst = (rep + 1 < NREP(3)) ? (u16*)(p.out + O_Y) : p.GA;
      for (int r = 0;; ++r) {
        int id = (r & 1) ? r * nb + (nb - 1 - bid) : r * nb + bid;
        if (r * nb >= total) break;
        if (id < total) attn_item<1>(p, id, smem, gdst);
      }
    }
  }
#endif
  grid.sync();
#if PH & (1 << 4)
  { IDS
  {
    const int gt = bid * NTHREADS + tid, ngt = nb * NTHREADS;
    for (int i = gt; i < MS * 2048 / 4; i += ngt)
      *(f32x4*)(p.out + O_Y + (size_t)MP * 2048 + (size_t)i * 4) = *(const f32x4*)(p.x_s + (size_t)i * 4);
    for (int i = gt; i < 16 * 2048 * 6; i += ngt) {
      int r = i / 6, c = i - r * 6;
      *(u32x4*)(p.VBT_S + (size_t)r * VSS + SK + c * 8) = (u32x4){0u, 0u, 0u, 0u};
    }
    const int nqb = (MT / 256) * 12, nkb = (KROWS / 256) * 8;
    const int total = nqb + 2 * nkb;
    for (int id = bid; id < total; id += nb) {
      if (id < nqb) gemm_phase<EPI_QB>(p, p.CQ, 512, p.WT_UQ, 512, 512, MT / 256, 12, smem, p.QB, 3072, id, 1 << 30);
      else if (id < nqb + nkb) gemm_phase<EPI_BF16>(p, p.CKV, 256, p.WT_UK, 256, 256, KROWS / 256, 8, smem, p.KB, 2048, id - nqb, 1 << 30);
      else gemm_phase<EPI_VT>(p, p.CKV, 256, p.WT_UV, 256, 256, KROWS / 256, 8, smem, nullptr, 0, id - nqb - nkb, 1 << 30);
    }
  }
  }
#endif
  grid.sync();
#if PH & (1 << 5)
  { IDS
  {
    const int total = 1024 + 256;
    for (int rep = 0; rep < NREP(5); ++rep) {
      u16* gdst = (rep + 1 < NREP(5)) ? (u16*)(p.out + O_Y) : p.GB;
      for (int r = 0;; ++r) {
        int id = (r & 1) ? r * nb + (nb - 1 - bid) : r * nb + bid;
        if (r * nb >= total) break;
        if (id < total) attn_item<0>(p, id, smem, gdst);
      }
    }
  }
  }
#endif
  grid.sync();
#if PH & (1 << 6)
  { IDS
  gemm_phase<EPI_RES>(p, p.GB, 2048, p.WT_OUT, 2048, 2048, MT / 256 - 1, 8, smem, nullptr, 0, bid, nb);
  for (int id = bid; id < 128; id += nb) {
    const int nt = id & 7, kc = id >> 3;
    gemm_tile<EPI_ATOM>(p, p.GB + kc * 128, 2048, p.WT_OUT + kc * 128, 2048, 128, (MT / 256 - 1) * 256, nt * 256, smem, nullptr, 0);
  }
  }
#endif
  grid.sync();
#if PH & (1 << 7)
  { IDS
  for (int r = gw; r < MT; r += ngw) rms_row_2048(p.out + O_Y + (size_t)r * 2048, p.g_ffn, p.H2 + (size_t)r * 2048, lane);
  }
#endif
  grid.sync();
#if PH & (1 << 8)
  { IDS
  for (int rep = 0; rep < NREP(8); ++rep) gemm_phase<EPI_RELU2>(p, p.H2, 2048, p.WT_UP, 2048, 2048, MT / 256, 32, smem, nullptr, 0, bid, nb);
  }
#endif
  grid.sync();
#if PH & (1 << 9)
  { IDS
  gemm_phase<EPI_ACC>(p, p.U, DFF, p.WT_DOWN, DFF, DFF, MT / 256 - 1, 8, smem, nullptr, 0, bid, nb);
  for (int id = bid; id < 256; id += nb) {
    const int nt = id & 7, kc = id >> 3;
    gemm_tile<EPI_ATOM>(p, p.U + kc * 256, DFF, p.WT_DOWN + kc * 256, DFF, 256, (MT / 256 - 1) * 256, nt * 256, smem, nullptr, 0);
  }
  }
#endif
  grid.sync();
#if PH & (1 << 10)
  { IDS
  for (int r = gw; r < MT; r += ngw) {
    float* x = p.out + O_Y + (size_t)r * 2048;
    f32x4 v[8];
    float ss = 0.f;
#pragma unroll
    for (int i = 0; i < 8; ++i) {
      v[i] = *(const f32x4*)(x + i * 256 + lane * 4);
      ss += v[i][0] * v[i][0] + v[i][1] * v[i][1] + v[i][2] * v[i][2] + v[i][3] * v[i][3];
    }
    ss = wave_sum(ss);
    float rr = rsqrtf(ss * (1.f / 2048.f) + 1e-6f);
#pragma unroll
    for (int i = 0; i < 8; ++i) {
      f32x4 gg = *(const f32x4*)(p.g_fin + i * 256 + lane * 4);
      f32x4 o = {v[i][0] * rr * gg[0], v[i][1] * rr * gg[1], v[i][2] * rr * gg[2], v[i][3] * rr * gg[3]};
      *(f32x4*)(x + i * 256 + lane * 4) = o;
    }
  }
  }
#endif
}

extern "C" void kernel_launch(void* const* d_in, const int* in_sizes, int n_in, void* d_out, int out_size, void* d_ws, size_t ws_size,
                              hipStream_t stream) {
  static int grid_blocks = 0;
  if (!grid_blocks) {
    int dev = 0, cus = 0, per_cu = 0;
    hipGetDevice(&dev);
    hipDeviceGetAttribute(&cus, hipDeviceAttributeMultiprocessorCount, dev);
    if (hipFuncSetAttribute((const void*)fwd_megakernel, hipFuncAttributeMaxDynamicSharedMemorySize, LDS_BYTES) != hipSuccess)
      fprintf(stderr, "kernel_launch: hipFuncSetAttribute failed\n");
    hipOccupancyMaxActiveBlocksPerMultiprocessor(&per_cu, (const void*)fwd_megakernel, NTHREADS, LDS_BYTES);
    if (per_cu < 1) per_cu = 1;
    if (per_cu > 1) per_cu = 1;
    grid_blocks = cus * per_cu;
  }
  Params p{};
  const float* const* in = (const float* const*)d_in;
  p.x_p = in[0]; p.x_s = in[1]; p.c_ak = in[2]; p.c_av = in[3]; p.c_idx = in[4]; p.c_ckv = in[5]; p.c_kr = in[6]; p.rel = in[7];
  p.g_mix = in[8]; p.w_in = in[9]; p.g_q = in[10]; p.w_uq = in[11]; p.g_kv = in[12]; p.w_uk = in[13]; p.w_uv = in[14]; p.w_out = in[15];
  p.g_ffn = in[16]; p.w_up = in[17]; p.w_down = in[18]; p.g_fin = in[19];
  p.out = (float*)d_out;
  char* ws = (char*)d_ws;
  size_t off = 0;
  auto alloc = [&](size_t bytes) { char* r = ws + off; off += (bytes + 255) & ~(size_t)255; return r; };
  p.WT_UQ = (u16*)alloc((size_t)3072 * 512 * 2);
  p.WT_UK = (u16*)alloc((size_t)2048 * 256 * 2);
  p.WT_UV = (u16*)alloc((size_t)2048 * 256 * 2);
  p.WT_OUT = (u16*)alloc((size_t)2048 * 2048 * 2);
  p.WT_UP = (u16*)alloc((size_t)8192 * 2048 * 2);
  p.WT_DOWN = (u16*)alloc((size_t)2048 * 8192 * 2);
  p.CQ = (u16*)alloc((size_t)MT * 512 * 2);
  p.CKV = (u16*)alloc((size_t)KROWS * 256 * 2);
  p.KR = (u16*)alloc((size_t)KROWS * 64 * 2);
  p.GA = (u16*)alloc((size_t)MT * 2048 * 2);
  p.GB = (u16*)alloc((size_t)MT * 2048 * 2);
  p.CS = (float*)alloc((size_t)MT * 32 * 4);
  p.SN = (float*)alloc((size_t)MT * 32 * 4);
  const size_t ubase = off;
  p.WT_IN = (u16*)alloc((size_t)INP * 2048 * 2);
  p.H = (u16*)alloc((size_t)MT * 2048 * 2);
  p.AQ = (u16*)alloc((size_t)MT * 2048 * 2);
  p.KA = (u16*)alloc((size_t)MP * 2048 * 2);
  p.VAT = (u16*)alloc((size_t)MP * 2048 * 2);
  p.IXQ = (u16*)alloc((size_t)MT * 1024 * 2);
  p.IXK = (u16*)alloc((size_t)KROWS * 64 * 2);
  p.SEL = (unsigned long long*)alloc((size_t)MT * 256 * 8);
  p.IXW = (float*)alloc((size_t)MT * 16 * 4);
  const size_t endA = off;
  off = ubase;
  p.QB = (u16*)alloc((size_t)MT * 3072 * 2);
  p.KB = (u16*)alloc((size_t)KROWS * 2048 * 2);
  p.VBT_P = (u16*)alloc((size_t)2048 * MP * 2);
  p.VBT_S = (u16*)alloc((size_t)16 * 2048 * VSS * 2);
  const size_t endB = off;
  off = ubase;
  p.H2 = (u16*)alloc((size_t)MT * 2048 * 2);
  p.U = (u16*)alloc((size_t)MT * DFF * 2);
  const size_t endC = off;
  size_t need = endA > endB ? endA : endB;
  if (endC > need) need = endC;
  if (need > ws_size) { fprintf(stderr, "kernel_launch: workspace too small: need %zu have %zu\n", need, ws_size); return; }
  void* args[] = {&p};
  hipError_t e = hipLaunchCooperativeKernel((const void*)fwd_megakernel, dim3(grid_blocks), dim3(NTHREADS), args, LDS_BYTES, stream);
  if (e != hipSuccess) fprintf(stderr, "cooperative launch failed: %s (grid %d)\n", hipGetErrorString(e), grid_blocks);
}
```
